# Optimizing an MI355X kernel written in HIP

```python
import jax, jax.numpy as jnp
from jax import lax
import numpy as np


D_MODEL = 1024
BATCH = 8
SEQ = 8192
DEPTH = 2

HEAD_DIM = 64
EPS = 1e-6
A_HEADS = 8
A_PATTERNS = ((128, 1), (512, 4), (2048, 16))
B_Q_HEADS = 8
B_KV_HEADS = 2
B_GROUP = B_Q_HEADS // B_KV_HEADS
B_WINDOW = 128
ATTN_BLOCK = 128
ROPE_THETA = 500000.0
ROT_DIM = HEAD_DIM // 4
C_HEADS = 8
C_KEY_DIM = D_MODEL // C_HEADS
C_VAL_DIM = D_MODEL // C_HEADS
C_CHUNK = 64
D_FF = (7 * D_MODEL) // 2
N_EXPERTS = 8
TOP_K = 2
MOE_BLOCK = 128

N_EVEN = (DEPTH + 1) // 2
N_ODD = DEPTH // 2
A_WIDTH = A_HEADS * HEAD_DIM
B_Q_WIDTH = B_Q_HEADS * HEAD_DIM
B_KV_WIDTH = B_KV_HEADS * HEAD_DIM
IN_ATTN = 3 * A_WIDTH + B_Q_WIDTH + 2 * B_KV_WIDTH
MIX_ATTN = A_WIDTH + B_Q_WIDTH
C_K_WIDTH = C_HEADS * C_KEY_DIM
C_V_WIDTH = C_HEADS * C_VAL_DIM
IN_REC = 2 * C_K_WIDTH + 2 * C_V_WIDTH

kernel_name = "hybrid_dilated_swa_hgrn2_moe"


def rms_norm(x, g):
    xf = x.astype(jnp.float32)
    y = xf * lax.rsqrt(jnp.mean(xf * xf, axis=-1, keepdims=True) + EPS)
    return (y * g.astype(jnp.float32)).astype(x.dtype)


def rope(x, cos, sin):
    half = ROT_DIM // 2
    xf = x.astype(jnp.float32)
    x1 = xf[..., :half]
    x2 = xf[..., half:ROT_DIM]
    out = jnp.concatenate([x1 * cos - x2 * sin, x2 * cos + x1 * sin, xf[..., ROT_DIM:]], axis=-1)
    return out.astype(x.dtype)


def banded_attention(q, k, v, n_back, sink=None):
    bsz, grp, rep, L, dh = q.shape
    blk = ATTN_BLOCK
    pad = (-L) % blk
    lp = L + pad
    nb = lp // blk
    q = jnp.pad(q, ((0, 0), (0, 0), (0, 0), (0, pad), (0, 0)))
    k = jnp.pad(k, ((0, 0), (0, 0), (0, pad), (0, 0)))
    v = jnp.pad(v, ((0, 0), (0, 0), (0, pad), (0, 0)))
    qb = q.reshape(bsz, grp, rep, nb, blk, dh)
    kb = k.reshape(bsz, grp, nb, blk, dh)
    vb = v.reshape(bsz, grp, nb, blk, dh)
    kk = jnp.concatenate([jnp.concatenate([jnp.zeros_like(kb[:, :, :1]), kb[:, :, :-1]], axis=2), kb], axis=3)
    vv = jnp.concatenate([jnp.concatenate([jnp.zeros_like(vb[:, :, :1]), vb[:, :, :-1]], axis=2), vb], axis=3)
    s = jnp.einsum('bgrnqd,bgnkd->bgrnqk', qb, kk, preferred_element_type=jnp.float32) * (dh ** -0.5)
    qi = jnp.arange(blk)[:, None]
    kj = jnp.arange(2 * blk)[None, :]
    dist = blk + qi - kj
    band = (dist >= 0) & (dist <= n_back)
    valid = band[None] & ((jnp.arange(nb)[:, None, None] > 0) | (kj >= blk)[None])
    s = jnp.where(valid, s, -jnp.inf)
    m = jnp.max(s, axis=-1, keepdims=True)
    if sink is not None:
        sk = sink.astype(jnp.float32)[None, :, :, None, None, None]
        m = jnp.maximum(m, sk)
    p = jnp.exp(s - m)
    l = jnp.sum(p, axis=-1, keepdims=True)
    if sink is not None:
        l = l + jnp.exp(sk - m)
    o = jnp.einsum('bgrnqk,bgnkd->bgrnqd', p, vv.astype(jnp.float32)) / l
    lse = (m + jnp.log(l))[..., 0]
    o = o.reshape(bsz, grp, rep, lp, dh)[:, :, :, :L].astype(q.dtype)
    lse = lse.reshape(bsz, grp, rep, lp)[:, :, :, :L]
    return o, lse


def dilated_attention(q, k, v):
    bsz, nh, S, dh = q.shape
    outs, lses = [], []
    for window, d in A_PATTERNS:
        L = S // d
        def to_res(t):
            return t.reshape(bsz, nh, L, d, dh).transpose(0, 1, 3, 2, 4).reshape(bsz, nh * d, L, dh)
        o, lse = banded_attention(to_res(q)[:, :, None], to_res(k), to_res(v), window // d)
        outs.append(o[:, :, 0].reshape(bsz, nh, d, L, dh).transpose(0, 1, 3, 2, 4).reshape(bsz, nh, S, dh))
        lses.append(lse[:, :, 0].reshape(bsz, nh, d, L).transpose(0, 1, 3, 2).reshape(bsz, nh, S))
    w = jax.nn.softmax(jnp.stack(lses, axis=0), axis=0)
    out = jnp.sum(w[..., None] * jnp.stack(outs, axis=0).astype(jnp.float32), axis=0)
    return out.astype(q.dtype)


def attn_mixer(h, w_in, sinks, w_out, cos, sin):
    bsz, S, _ = h.shape
    proj = h @ w_in
    splits = [A_WIDTH, 2 * A_WIDTH, 3 * A_WIDTH, 3 * A_WIDTH + B_Q_WIDTH, 3 * A_WIDTH + B_Q_WIDTH + B_KV_WIDTH]
    qa, ka, va, qb, kb, vb = jnp.split(proj, splits, axis=-1)
    heads = lambda t, n: t.reshape(bsz, S, n, HEAD_DIM)
    qa = rope(heads(qa, A_HEADS), cos, sin).transpose(0, 2, 1, 3)
    ka = rope(heads(ka, A_HEADS), cos, sin).transpose(0, 2, 1, 3)
    va = heads(va, A_HEADS).transpose(0, 2, 1, 3)
    oa = dilated_attention(qa, ka, va)
    qb = rope(heads(qb, B_Q_HEADS), cos, sin).reshape(bsz, S, B_KV_HEADS, B_GROUP, HEAD_DIM).transpose(0, 2, 3, 1, 4)
    kb = rope(heads(kb, B_KV_HEADS), cos, sin).transpose(0, 2, 1, 3)
    vb = heads(vb, B_KV_HEADS).transpose(0, 2, 1, 3)
    ob, _ = banded_attention(qb, kb, vb, B_WINDOW - 1, sinks.reshape(B_KV_HEADS, B_GROUP))
    mix = jnp.concatenate([oa.transpose(0, 2, 1, 3).reshape(bsz, S, A_WIDTH),
                           ob.transpose(0, 3, 1, 2, 4).reshape(bsz, S, B_Q_WIDTH)], axis=-1)
    return mix @ w_out


def hgrn2_mixer(h, w_in, lower_bound, norm_g, w_out):
    bsz, S, _ = h.shape
    proj = h @ w_in
    q, f, i, g = jnp.split(proj, [C_K_WIDTH, 2 * C_K_WIDTH, 2 * C_K_WIDTH + C_V_WIDTH], axis=-1)
    q = jax.nn.silu(q.astype(jnp.float32))
    fg = lower_bound + (1.0 - lower_bound) * jax.nn.sigmoid(f.astype(jnp.float32))
    k = 1.0 - fg
    logf = jnp.log(fg)
    nc = S // C_CHUNK
    def chunked(t, dim):
        return t.reshape(bsz, nc, C_CHUNK, C_HEADS, dim).transpose(1, 0, 3, 2, 4)
    qc = chunked(q, C_KEY_DIM)
    kc = chunked(k, C_KEY_DIM)
    vc = chunked(i.astype(jnp.float32), C_VAL_DIM)
    bc = jnp.cumsum(chunked(logf, C_KEY_DIM), axis=3)
    causal = jnp.tril(jnp.ones((C_CHUNK, C_CHUNK), dtype=bool))

    def step(state, xs):
        qt, kt, vt, bt = xs
        diff = bt[:, :, :, None, :] - bt[:, :, None, :, :]
        decay = jnp.exp(jnp.where(causal[:, :, None], diff, -jnp.inf))
        att = jnp.einsum('bhtk,bhsk,bhtsk->bhts', qt, kt, decay)
        o = jnp.einsum('bhts,bhsv->bhtv', att, vt) + jnp.einsum('bhtk,bhkv->bhtv', qt * jnp.exp(bt), state)
        b_last = bt[:, :, -1:, :]
        state = jnp.exp(b_last[:, :, 0, :])[..., None] * state + \
            jnp.einsum('bhsk,bhsv->bhkv', kt * jnp.exp(b_last - bt), vt)
        return state, o

    init = jnp.zeros((bsz, C_HEADS, C_KEY_DIM, C_VAL_DIM), jnp.float32)
    _, o = lax.scan(step, init, (qc, kc, vc, bc))
    o = o.transpose(1, 0, 3, 2, 4).reshape(bsz, S, C_HEADS, C_VAL_DIM)
    o = o * lax.rsqrt(jnp.mean(o * o, axis=-1, keepdims=True) + EPS)
    o = o.reshape(bsz, S, C_V_WIDTH) * norm_g.astype(jnp.float32) * jax.nn.silu(g.astype(jnp.float32))
    return o.astype(h.dtype) @ w_out


def swiglu(h, w_gate, w_up, w_down):
    return (jax.nn.silu(h @ w_gate) * (h @ w_up)) @ w_down


def moe_swiglu(h, w_router, w_gate, w_up, w_down):
    bsz, S, D = h.shape
    N = bsz * S
    t = h.reshape(N, D)
    logits = (t @ w_router).astype(jnp.float32)
    top_v, top_e = lax.top_k(logits, TOP_K)
    gates = jax.nn.softmax(top_v, axis=-1)
    e_flat = top_e.reshape(-1).astype(jnp.int32)
    g_flat = gates.reshape(-1)
    tok_flat = jnp.arange(N * TOP_K, dtype=jnp.int32) // TOP_K
    order = jnp.argsort(e_flat)
    e_sorted = e_flat[order]
    tok_sorted = tok_flat[order]
    g_sorted = g_flat[order]
    sizes = jnp.bincount(e_flat, length=N_EXPERTS).astype(jnp.int32)
    padded = ((sizes + MOE_BLOCK - 1) // MOE_BLOCK) * MOE_BLOCK
    start = jnp.cumsum(sizes) - sizes
    pend = jnp.cumsum(padded)
    pstart = pend - padded
    dest = pstart[e_sorted] + (jnp.arange(N * TOP_K, dtype=jnp.int32) - start[e_sorted])
    P = N * TOP_K + N_EXPERTS * MOE_BLOCK
    nblk = P // MOE_BLOCK
    buf = jnp.zeros((P, D), t.dtype).at[dest].set(t[tok_sorted])
    blk_e = jnp.minimum(jnp.searchsorted(pend, jnp.arange(nblk, dtype=jnp.int32) * MOE_BLOCK, side='right'),
                        N_EXPERTS - 1).astype(jnp.int32)

    def expert_block(args):
        xb, e = args
        return (jax.nn.silu(xb @ w_gate[e]) * (xb @ w_up[e])) @ w_down[e]

    yb = lax.map(expert_block, (buf.reshape(nblk, MOE_BLOCK, D), blk_e))
    y = yb.reshape(P, D)[dest] * g_sorted[:, None].astype(t.dtype)
    out = jax.ops.segment_sum(y, tok_sorted, num_segments=N)
    return out.reshape(bsz, S, D)


def setup_inputs(seed: int = 0) -> dict:
    key = jax.random.key(seed)
    ks = jax.random.split(key, 24)
    nrm = lambda k, shape, fan_in: jax.random.normal(k, shape, jnp.float32) * (fan_in ** -0.5)
    x = jax.random.normal(ks[0], (BATCH, SEQ, D_MODEL), jnp.float32)
    offsets = jax.random.randint(ks[1], (BATCH, 1), 0, 1024, dtype=jnp.int32)
    positions = offsets + jnp.arange(SEQ, dtype=jnp.int32)[None, :]
    g_mix = 1.0 + 0.02 * jax.random.normal(ks[2], (DEPTH, D_MODEL), jnp.float32)
    g_ffn = 1.0 + 0.02 * jax.random.normal(ks[3], (DEPTH, D_MODEL), jnp.float32)
    g_final = 1.0 + 0.02 * jax.random.normal(ks[4], (D_MODEL,), jnp.float32)
    w_in_attn = nrm(ks[5], (N_EVEN, D_MODEL, IN_ATTN), D_MODEL)
    w_out_attn = nrm(ks[6], (N_EVEN, MIX_ATTN, D_MODEL), MIX_ATTN)
    attn_sinks = 0.5 * jax.random.normal(ks[7], (N_EVEN, B_Q_HEADS), jnp.float32)
    w_in_rec = nrm(ks[8], (N_ODD, D_MODEL, IN_REC), D_MODEL)
    rec_lower_bounds = 0.5 * jax.random.normal(ks[9], (DEPTH, C_K_WIDTH), jnp.float32)
    rec_norm_g = 1.0 + 0.02 * jax.random.normal(ks[10], (N_ODD, C_V_WIDTH), jnp.float32)
    w_out_rec = nrm(ks[11], (N_ODD, C_V_WIDTH, D_MODEL), C_V_WIDTH)
    w_gate_dense = nrm(ks[12], (N_EVEN, D_MODEL, D_FF), D_MODEL)
    w_up_dense = nrm(ks[13], (N_EVEN, D_MODEL, D_FF), D_MODEL)
    w_down_dense = nrm(ks[14], (N_EVEN, D_FF, D_MODEL), D_FF)
    w_router = nrm(ks[15], (N_ODD, D_MODEL, N_EXPERTS), D_MODEL)
    w_gate_moe = nrm(ks[16], (N_ODD, N_EXPERTS, D_MODEL, D_FF), D_MODEL)
    w_up_moe = nrm(ks[17], (N_ODD, N_EXPERTS, D_MODEL, D_FF), D_MODEL)
    w_down_moe = nrm(ks[18], (N_ODD, N_EXPERTS, D_FF, D_MODEL), D_FF)
    return {"x": x, "positions": positions, "g_mix": g_mix, "g_ffn": g_ffn, "g_final": g_final,
            "w_in_attn": w_in_attn, "w_out_attn": w_out_attn, "attn_sinks": attn_sinks,
            "w_in_rec": w_in_rec, "rec_lower_bounds": rec_lower_bounds, "rec_norm_g": rec_norm_g,
            "w_out_rec": w_out_rec, "w_gate_dense": w_gate_dense, "w_up_dense": w_up_dense,
            "w_down_dense": w_down_dense, "w_router": w_router, "w_gate_moe": w_gate_moe,
            "w_up_moe": w_up_moe, "w_down_moe": w_down_moe}


def reference(x, positions, g_mix, g_ffn, g_final, w_in_attn, w_out_attn, attn_sinks, w_in_rec,
              rec_lower_bounds, rec_norm_g, w_out_rec, w_gate_dense, w_up_dense, w_down_dense,
              w_router, w_gate_moe, w_up_moe, w_down_moe):
    inv_freq = jnp.power(ROPE_THETA, -jnp.arange(0, ROT_DIM, 2, dtype=jnp.float32) / ROT_DIM)
    ang = positions.astype(jnp.float32)[..., None] * inv_freq
    cos = jnp.cos(ang)[:, :, None, :]
    sin = jnp.sin(ang)[:, :, None, :]
    lb = jax.nn.softmax(rec_lower_bounds.astype(jnp.float32), axis=0)
    lb_table = jnp.cumsum(lb, axis=0) - lb[0]
    for layer in range(DEPTH):
        j = layer // 2
        h = rms_norm(x, g_mix[layer])
        if layer % 2 == 0:
            x = x + attn_mixer(h, w_in_attn[j], attn_sinks[j], w_out_attn[j], cos, sin)
            x = x + swiglu(rms_norm(x, g_ffn[layer]), w_gate_dense[j], w_up_dense[j], w_down_dense[j])
        else:
            x = x + hgrn2_mixer(h, w_in_rec[j], lb_table[layer], rec_norm_g[j], w_out_rec[j])
            x = x + moe_swiglu(rms_norm(x, g_ffn[layer]), w_router[j], w_gate_moe[j], w_up_moe[j], w_down_moe[j])
    return rms_norm(x, g_final)
```

```cpp
#include <hip/hip_runtime.h>
#include <cstdio>
#include <cstdint>
namespace pg8 {
#define PG8_LAS __attribute__((address_space(3)))
typedef unsigned short bf16_t;
typedef short bf16x8 __attribute__((ext_vector_type(8)));
typedef float f32x4 __attribute__((ext_vector_type(4)));
typedef unsigned u32x4 __attribute__((ext_vector_type(4)));
constexpr int BM = 256, BK = 64, HALF = 128, HTB = HALF * BK * 2  , STAGE_BYTES = 8 * HTB, NXCD = 8, WGM = 8;

__host__ __device__ __forceinline__ int lds_byte(int r, int c) { const int st = (r >> 4) * 2 + (c >> 5), rr = r & 15, cc = c & 31, ob = rr * 64 + cc * 2; return st * 1024 + (ob ^ (((ob >> 9) & 1) << 5)); }
__host__ __device__ __forceinline__ void stage_rc(int b, int& R, int& C) { const int st = b / 1024, sb = b % 1024, swz = sb ^ (((sb >> 9) & 1) << 5); R = (st >> 1) * 16 + swz / 64; C = (st & 1) * 32 + (swz % 64) / 2; }
__host__ __device__ __forceinline__ int perm32(int rho) { const int n = rho >> 4, i = rho & 15; return 8 * (i >> 2) + 4 * n + (i & 3); }

struct Unit { int pm, pn; };
struct Gemm { const bf16_t* A; const bf16_t* Bt; int M, N, K; };

struct StaticOrder {
    int nM, nN, nwg, G, c;
    __host__ __device__ void init(int M, int N, int G_, int c_) { nM = M / BM; nN = N / BM; nwg = nM * nN; G = G_; c = c_; }
    __host__ __device__ bool next(int i, Unit& u) const {
        const long L = (long)i * G + c; if (L >= nwg) return false;
        int wgid = (int)L; { const int q = nwg / NXCD, r = nwg % NXCD, xcd = wgid % NXCD, off = wgid / NXCD; wgid = (xcd < r ? xcd * (q + 1) : r * (q + 1) + (xcd - r) * q) + off; }
        const int nig = WGM * nN, gid = wgid / nig, fm = gid * WGM, gsz = (nM - fm) < WGM ? (nM - fm) : WGM;
        u.pm = fm + ((wgid % nig) % gsz); u.pn = (wgid % nig) / gsz; return true;
    }
    __device__ __forceinline__ void a_ready(const Unit&) const {}
    __device__ __forceinline__ void done(const Unit&) const {}
};
__device__ __forceinline__ unsigned cvt_pk_bf16(float lo, float hi) { unsigned r; asm volatile("v_cvt_pk_bf16_f32 %0, %1, %2" : "=v"(r) : "v"(lo), "v"(hi)); return r; }
__device__ __forceinline__ float sigmoid_f(float x) { return __builtin_amdgcn_rcpf(1.0f + __builtin_amdgcn_exp2f(-1.44269504089f * x)); }
__device__ __forceinline__ float silu_f(float x) { return x * sigmoid_f(x); }
__device__ __forceinline__ u32x4 pack8(const f32x4& v0, const f32x4& v1) { u32x4 w; w.x = cvt_pk_bf16(v0[0], v0[1]); w.y = cvt_pk_bf16(v0[2], v0[3]); w.z = cvt_pk_bf16(v1[0], v1[1]); w.w = cvt_pk_bf16(v1[2], v1[3]); return w; }
struct EpiBf16Plain {
    static constexpr bool PERM = true, AFTER_DRAIN = false;
    bf16_t* O; int ldc; int nmod;
    __device__ __forceinline__ void operator()(const f32x4 (&acc)[2][2][4][2], const Unit& u, int wr, int wc, int fr, int fq) const {
        const int row0 = u.pm * BM + wr * 64 + fr; const int col0 = (u.pn % nmod) * BM + wc * 32 + 8 * fq;
#pragma unroll
        for (int ai = 0; ai < 2; ++ai)
#pragma unroll
            for (int m = 0; m < 4; ++m) { bf16_t* rowp = O + (size_t)(row0 + ai * HALF + m * 16) * ldc + col0;
#pragma unroll
                for (int bj = 0; bj < 2; ++bj) *(u32x4*)(rowp + bj * HALF) = pack8(acc[ai][bj][m][0], acc[ai][bj][m][1]); }
    }
};
struct EpiRes {
    static constexpr bool PERM = false, AFTER_DRAIN = false;
    const float* base; float* out; int ldc;
    __device__ __forceinline__ void operator()(const f32x4 (&acc)[2][2][4][2], const Unit& u, int wr, int wc, int fr, int fq) const {
        const int row0 = u.pm * BM + wr * 64 + fr, col0 = u.pn * BM + wc * 32 + 4 * fq;
#pragma unroll
        for (int ai = 0; ai < 2; ++ai)
#pragma unroll
            for (int m = 0; m < 4; ++m) { const size_t off = (size_t)(row0 + ai * HALF + m * 16) * ldc + col0;
#pragma unroll
                for (int bj = 0; bj < 2; ++bj)
#pragma unroll
                    for (int n = 0; n < 2; ++n) { const f32x4 bs = *(const f32x4*)(base + off + bj * HALF + n * 16); *(f32x4*)(out + off + bj * HALF + n * 16) = bs + acc[ai][bj][m][n]; }
                asm volatile("" ::: "memory"); }
    }
};
struct EpiSwiglu {
    static constexpr bool PERM = true, AFTER_DRAIN = false;
    bf16_t* O; int ldc; int nN; int tile0;
    __device__ __forceinline__ void operator()(const f32x4 (&acc)[2][2][4][2], const Unit& u, int wr, int wc, int fr, int fq) const {
        const int row0 = (u.pm - tile0) * BM + wr * 64 + fr; const int col0 = (u.pn % nN) * HALF + wc * 32 + 8 * fq;
#pragma unroll
        for (int ai = 0; ai < 2; ++ai)
#pragma unroll
            for (int m = 0; m < 4; ++m) { bf16_t* rowp = O + (size_t)(row0 + ai * HALF + m * 16) * ldc + col0;
                f32x4 h0, h1;
#pragma unroll
                for (int j = 0; j < 4; ++j) { h0[j] = silu_f(acc[ai][0][m][0][j]) * acc[ai][1][m][0][j]; h1[j] = silu_f(acc[ai][0][m][1][j]) * acc[ai][1][m][1][j]; }
                *(u32x4*)rowp = pack8(h0, h1); }
    }
};
struct EpiRec {
    static constexpr bool PERM = true, AFTER_DRAIN = false;
    bf16_t* P; size_t plane; const float* lbk;
    __device__ __forceinline__ void operator()(const f32x4 (&acc)[2][2][4][2], const Unit& u, int wr, int wc, int fr, int fq) const {
        const int hd = u.pn & 7; const bool second = (u.pn >> 3) != 0;
        const int row0 = u.pm * BM + wr * 64 + fr; const int ch0 = hd * HALF + wc * 32 + 8 * fq;
        const f32x4 l0 = *(const f32x4*)(lbk + ch0), l1 = *(const f32x4*)(lbk + ch0 + 4);
        bf16_t* pa = P + (second ? 2 * plane : 0); bf16_t* pb = pa + plane;
#pragma unroll
        for (int ai = 0; ai < 2; ++ai)
#pragma unroll
            for (int m = 0; m < 4; ++m) { const size_t off = (size_t)(row0 + ai * HALF + m * 16) * 1024 + ch0;
                f32x4 a0 = acc[ai][0][m][0], a1 = acc[ai][0][m][1], b0 = acc[ai][1][m][0], b1 = acc[ai][1][m][1];
                if (!second) {
#pragma unroll
                    for (int j = 0; j < 4; ++j) { a0[j] = silu_f(a0[j]); a1[j] = silu_f(a1[j]); b0[j] = l0[j] * sigmoid_f(-b0[j]); b1[j] = l1[j] * sigmoid_f(-b1[j]); }
                } else {
#pragma unroll
                    for (int j = 0; j < 4; ++j) { b0[j] = silu_f(b0[j]); b1[j] = silu_f(b1[j]); }
                }
                *(u32x4*)(pa + off) = pack8(a0, a1); *(u32x4*)(pb + off) = pack8(b0, b1); }
    }
};
struct MoeOrder {
    StaticOrder so; int tile0, nN; int te0, te1, te2, te3, te4, te5, te6;
    __device__ __forceinline__ bool next(int i, Unit& u) const {
        Unit l; if (!so.next(i, l)) return false;
        const int pm = tile0 + l.pm;
        const int e = (pm >= te0) + (pm >= te1) + (pm >= te2) + (pm >= te3) + (pm >= te4) + (pm >= te5) + (pm >= te6);
        u.pm = pm; u.pn = e * nN + l.pn; return true;
    }
    __device__ __forceinline__ void a_ready(const Unit&) const {}
    __device__ __forceinline__ void done(const Unit&) const {}
};

template <class Epi, class Sched, bool ALIGN_EPI = false, bool SP2 = false>
__device__ __forceinline__ void gemm_phase(PG8_LAS unsigned char* lds, const Gemm g, const Sched& S, const Epi& E) {
    const int tid = threadIdx.x, wid = __builtin_amdgcn_readfirstlane(tid >> 6), lane = tid & 63, wr = wid >> 2, wc = wid & 3, fr = lane & 15, fq = lane >> 4;
    const int K = g.K, nt = K / BK;
    unsigned voffA[2], voffB[2];
#pragma unroll
    for (int i = 0; i < 2; ++i) { int R, C; stage_rc(tid * 16 + i * 8192, R, C); const int Rb = Epi::PERM ? ((R & ~31) + perm32(R & 31)) : R;
        voffA[i] = (unsigned)(R * K + C) * 2u; voffB[i] = (unsigned)(Rb * K + C) * 2u; }
    const size_t kstep = (size_t)(BK * 2);
    const size_t hstep = (size_t)HALF * K * 2;
    const size_t tstep = 2 * hstep;
    const unsigned ldsw = (unsigned)wid * 1024u;
    const int aoff = lds_byte(wr * 64 + fr, fq * 8), boff = lds_byte(wc * 32 + fr, fq * 8);
#define PG8_SA(b, h) (((b) * 2 + (h)) * HTB)
#define PG8_SB(b, h) ((4 + (b) * 2 + (h)) * HTB)
#define PG8_STAGE(bufoff, gbase, voff) do { _Pragma("unroll") for (int _i = 0; _i < 2; ++_i) \
        __builtin_amdgcn_global_load_lds((const unsigned*)((const char*)(gbase) + (voff)[_i]), (PG8_LAS unsigned*)(lds + (bufoff) + ldsw + _i * 8192), 16, 0, 0); } while (0)
#define PG8_LDA(dst, b, h) do { _Pragma("unroll") for (int m = 0; m < 4; ++m) _Pragma("unroll") for (int k = 0; k < 2; ++k) dst[m][k] = *(const PG8_LAS bf16x8*)(lds + PG8_SA(b, h) + aoff + m * 2048 + k * 1024); } while (0)
#define PG8_LDB(dst, b, h) do { _Pragma("unroll") for (int n = 0; n < 2; ++n) _Pragma("unroll") for (int k = 0; k < 2; ++k) dst[n][k] = *(const PG8_LAS bf16x8*)(lds + PG8_SB(b, h) + boff + n * 2048 + k * 1024); } while (0)
#define PG8_MMA(ai, bj, At, Bt) do { __builtin_amdgcn_s_setprio(1); _Pragma("unroll") for (int m = 0; m < 4; ++m) _Pragma("unroll") for (int n = 0; n < 2; ++n) _Pragma("unroll") for (int k = 0; k < 2; ++k) \
        acc[ai][bj][m][n] = __builtin_amdgcn_mfma_f32_16x16x32_bf16(Bt[n][k], At[m][k], acc[ai][bj][m][n], 0, 0, 0); __builtin_amdgcn_s_setprio(0); } while (0)
#define PG8_WAIT_V(n) asm volatile("s_waitcnt vmcnt(" #n ")" ::: "memory")
#define PG8_WAIT_L(n) asm volatile("s_waitcnt lgkmcnt(" #n ")" ::: "memory")
#define PG8_BAR __builtin_amdgcn_s_barrier()
#define PG8_SCHED __builtin_amdgcn_sched_barrier(0)
    Unit cur, nxt; int ui = 0;
    if (!S.next(0, cur)) return;
    f32x4 acc[2][2][4][2];
#pragma unroll
    for (int a = 0; a < 2; ++a)
#pragma unroll
        for (int b = 0; b < 2; ++b)
#pragma unroll
            for (int m = 0; m < 4; ++m)
#pragma unroll
                for (int n = 0; n < 2; ++n) acc[a][b][m][n] = (f32x4){0.f, 0.f, 0.f, 0.f};
    bf16x8 At[4][2], B0[2][2], B1[2][2];
    const char* cA = (const char*)g.A + (size_t)cur.pm * tstep; const char* cB = (const char*)g.Bt + (size_t)cur.pn * tstep;
    S.a_ready(cur);
    if constexpr (SP2) {
        PG8_STAGE(PG8_SB(0, 0), cB, voffB); PG8_STAGE(PG8_SB(0, 1), cB + hstep, voffB); PG8_STAGE(PG8_SA(0, 0), cA, voffA); PG8_STAGE(PG8_SA(0, 1), cA + hstep, voffA);
        if (wr == 1) PG8_BAR;
        PG8_WAIT_V(2); PG8_BAR;
        PG8_STAGE(PG8_SB(1, 0), cB + kstep, voffB); PG8_STAGE(PG8_SA(1, 0), cA + kstep, voffA); PG8_STAGE(PG8_SB(1, 1), cB + hstep + kstep, voffB);
        PG8_WAIT_V(6); PG8_BAR;
    } else {
        PG8_STAGE(PG8_SB(0, 0), cB, voffB); PG8_STAGE(PG8_SA(0, 0), cA, voffA); PG8_STAGE(PG8_SB(0, 1), cB + hstep, voffB); PG8_STAGE(PG8_SA(0, 1), cA + hstep, voffA);
        if (wr == 1) PG8_BAR;
        PG8_WAIT_V(4); PG8_BAR;
        PG8_STAGE(PG8_SB(1, 0), cB + kstep, voffB); PG8_STAGE(PG8_SA(1, 0), cA + kstep, voffA); PG8_STAGE(PG8_SB(1, 1), cB + hstep + kstep, voffB);
        PG8_WAIT_V(6); PG8_BAR;
    }
    for (;;) {
        const bool has_next = S.next(ui + 1, nxt);
        const char* nA = has_next ? (const char*)g.A + (size_t)nxt.pm * tstep : cA; const char* nB = has_next ? (const char*)g.Bt + (size_t)nxt.pn * tstep : cB;
        for (int t = 0; t < nt; t += 2) {
            const bool last = (t == nt - 2);
            const char* a1 = cA + (size_t)(t + 1) * kstep;
            const char* a2 = last ? nA : cA + (size_t)(t + 2) * kstep; const char* b2 = last ? nB : cB + (size_t)(t + 2) * kstep;
            const char* a3 = a2 + kstep; const char* b3 = b2 + kstep;
            if (last && has_next) S.a_ready(nxt);
            if constexpr (SP2) {
            PG8_LDB(B0, 0, 0); PG8_LDB(B1, 0, 1); PG8_SCHED; PG8_LDA(At, 0, 0); PG8_STAGE(PG8_SA(1, 1), a1 + hstep, voffA);
            PG8_WAIT_V(8); PG8_WAIT_L(0); PG8_BAR; PG8_MMA(0, 0, At, B0); PG8_MMA(0, 1, At, B1); PG8_BAR; PG8_SCHED;
            PG8_LDA(At, 0, 1); PG8_STAGE(PG8_SB(0, 0), b2, voffB); PG8_STAGE(PG8_SB(0, 1), b2 + hstep, voffB); PG8_STAGE(PG8_SA(0, 0), a2, voffA);
            PG8_WAIT_V(8); PG8_WAIT_L(0); PG8_BAR; PG8_MMA(1, 0, At, B0); PG8_MMA(1, 1, At, B1); PG8_BAR; PG8_SCHED;
            PG8_LDB(B0, 1, 0); PG8_LDB(B1, 1, 1); PG8_SCHED; PG8_LDA(At, 1, 0); PG8_STAGE(PG8_SA(0, 1), a2 + hstep, voffA);
            PG8_WAIT_V(8); PG8_WAIT_L(0); PG8_BAR; PG8_MMA(0, 0, At, B0); PG8_MMA(0, 1, At, B1); PG8_BAR; PG8_SCHED;
            PG8_LDA(At, 1, 1); PG8_STAGE(PG8_SB(1, 0), b3, voffB); PG8_STAGE(PG8_SB(1, 1), b3 + hstep, voffB); PG8_STAGE(PG8_SA(1, 0), a3, voffA);
            PG8_WAIT_V(8); PG8_WAIT_L(0); PG8_BAR; PG8_MMA(1, 0, At, B0); PG8_MMA(1, 1, At, B1); PG8_BAR; PG8_SCHED;
            } else {
            PG8_LDB(B0, 0, 0); PG8_SCHED; PG8_LDA(At, 0, 0); PG8_STAGE(PG8_SA(1, 1), a1 + hstep, voffA);
            PG8_WAIT_L(8); PG8_BAR; PG8_WAIT_L(0); PG8_MMA(0, 0, At, B0); PG8_BAR; PG8_SCHED;
            PG8_LDB(B1, 0, 1); PG8_STAGE(PG8_SB(0, 0), b2, voffB);
            PG8_BAR; PG8_WAIT_L(0); PG8_MMA(0, 1, At, B1); PG8_BAR;
            PG8_LDA(At, 0, 1); PG8_STAGE(PG8_SA(0, 0), a2, voffA);
            PG8_BAR; PG8_WAIT_L(0); PG8_MMA(1, 0, At, B0); PG8_BAR; PG8_SCHED;
            PG8_STAGE(PG8_SB(0, 1), b2 + hstep, voffB);
            PG8_WAIT_V(6); PG8_BAR; PG8_MMA(1, 1, At, B1); PG8_BAR;
            PG8_LDB(B0, 1, 0); PG8_SCHED; PG8_LDA(At, 1, 0); PG8_STAGE(PG8_SA(0, 1), a2 + hstep, voffA);
            PG8_WAIT_L(8); PG8_BAR; PG8_WAIT_L(0); PG8_MMA(0, 0, At, B0); PG8_BAR; PG8_SCHED;
            PG8_LDB(B1, 1, 1); PG8_STAGE(PG8_SB(1, 0), b3, voffB);
            PG8_BAR; PG8_WAIT_L(0); PG8_MMA(0, 1, At, B1); PG8_BAR;
            PG8_LDA(At, 1, 1); PG8_STAGE(PG8_SA(1, 0), a3, voffA);
            PG8_BAR; PG8_WAIT_L(0); PG8_MMA(1, 0, At, B0); PG8_BAR; PG8_SCHED;
            PG8_STAGE(PG8_SB(1, 1), b3 + hstep, voffB);
            PG8_WAIT_V(6); PG8_BAR; PG8_MMA(1, 1, At, B1); PG8_BAR;
            }
        }
        if constexpr (ALIGN_EPI) { if (wr == 0) PG8_BAR; }
        if constexpr (!Epi::AFTER_DRAIN) { E(acc, cur, wr, wc, fr, fq); S.done(cur); }
        if (!has_next) break;
#pragma unroll
        for (int a = 0; a < 2; ++a)
#pragma unroll
            for (int b = 0; b < 2; ++b)
#pragma unroll
                for (int m = 0; m < 4; ++m)
#pragma unroll
                    for (int n = 0; n < 2; ++n) acc[a][b][m][n] = (f32x4){0.f, 0.f, 0.f, 0.f};
        cur = nxt; cA = nA; cB = nB; ++ui;
        if constexpr (ALIGN_EPI) { if (wr == 1) PG8_BAR; }
    }
    PG8_WAIT_V(0);
    if constexpr (!ALIGN_EPI) { if (wr == 0) PG8_BAR; }
    PG8_BAR;
    if constexpr (Epi::AFTER_DRAIN) { E.fused(acc, cur, wr, wc, fr, fq, lds, wid, lane); S.done(cur); }
#undef PG8_SA
#undef PG8_SB
#undef PG8_STAGE
#undef PG8_LDA
#undef PG8_LDB
#undef PG8_MMA
#undef PG8_WAIT_V
#undef PG8_WAIT_L
#undef PG8_BAR
#undef PG8_SCHED
}
}
#ifndef PG8_SP2
#define PG8_SP2 true
#endif
#ifndef PG8_ALIGN
#define PG8_ALIGN true
#endif
constexpr int NWAVES = 8;
constexpr int BATCH = 8, SEQ = 8192, D = 1024, NTOK = BATCH * SEQ;
constexpr int QKV_N = 2304, FF = 3584, NEXP = 8, REC_N = 4096;
constexpr float EPS = 1e-6f;
constexpr int NPH = 22;
#ifndef MK_N_LAUNCHES
#define MK_N_LAUNCHES 1
#endif
constexpr int N_LAUNCHES = MK_N_LAUNCHES;
constexpr size_t MiB = 1u << 20;
constexpr size_t WS_CTL = 0, CTL_ZERO_BYTES = 1 * MiB;
constexpr size_t WS_WMOE_GU = 1 * MiB;
constexpr size_t WS_WMOE_DN = 113 * MiB;
constexpr size_t WS_H = 169 * MiB;
constexpr size_t WS_W_INATT = 297 * MiB;
constexpr size_t WS_W_OUTATT = WS_W_INATT + (size_t)QKV_N * D * 2;
constexpr size_t WS_W_GU = WS_W_OUTATT + (size_t)D * D * 2;
constexpr size_t WS_W_DN = WS_W_GU + (size_t)2 * FF * D * 2;
constexpr size_t WS_W_INREC = WS_W_DN + (size_t)D * FF * 2;
constexpr size_t WS_W_OUTREC = WS_W_INREC + (size_t)REC_N * D * 2;
constexpr size_t WS_BIG = 335 * MiB;
constexpr size_t WS_Y = 297 * MiB;
constexpr size_t WS_HID = 557 * MiB;
constexpr size_t WS_MISC = 1008 * MiB;
constexpr size_t WS_ROPE = WS_MISC;
constexpr size_t WS_META = WS_MISC + 4 * MiB;
constexpr size_t WS_DEST = WS_MISC + 5 * MiB;
constexpr size_t WS_HIST = WS_MISC + 6 * MiB;
constexpr size_t WS_INFO = WS_HIST + 8192;
constexpr size_t WS_LBK = WS_INFO + 256;
constexpr size_t WS_END = 1024 * MiB;
static_assert(WS_W_OUTREC + (size_t)D * D * 2 <= WS_BIG && WS_BIG + 512 * MiB <= WS_MISC && WS_Y + 260 * MiB <= WS_HID && WS_HID + 448 * MiB <= WS_MISC && WS_LBK + 4096 <= WS_END, "d_ws map");
constexpr int CW_BAR = 4096;
constexpr int RING_BYTES = 131072;
constexpr int LDSCTL_OFF = RING_BYTES, MISC_OFF = LDSCTL_OFF + 320;
constexpr int LDS_BYTES = 147456;

#define GAS __attribute__((address_space(1)))
#define LAS __attribute__((address_space(3)))
typedef unsigned short bf16;
typedef unsigned v4u __attribute__((ext_vector_type(4)));
typedef unsigned v2u __attribute__((ext_vector_type(2)));
typedef float f32x4 __attribute__((ext_vector_type(4)));
#define LDS_WAIT() asm volatile("s_waitcnt lgkmcnt(0)" ::: "memory")
__device__ __forceinline__ unsigned f2bf(float f) { unsigned u = __builtin_bit_cast(unsigned, f); return (u + 0x7fffu + ((u >> 16) & 1u)) >> 16; }
__device__ __forceinline__ unsigned pk2(float lo, float hi) { return f2bf(lo) | (f2bf(hi) << 16); }
__device__ __forceinline__ float bflo(unsigned w) { return __builtin_bit_cast(float, w << 16); }
__device__ __forceinline__ float bfhi(unsigned w) { return __builtin_bit_cast(float, w & 0xffff0000u); }
__device__ __forceinline__ float wave_sum(float v) {
#pragma unroll
    for (int o = 1; o < 64; o <<= 1) v += __shfl_xor(v, o);
    return v;
}
#define XB_TMO      128
#define XB_XCNT(j)  (256  + 64 * (j))
#define XB_XSUB(j)  (1280 + 64 * (j))
#define XB_XGEN(j)  (2304 + 64 * (j))
#define XB_TOP      3328
#define XB_TOPGEN   3392
#define XCD_BAR_WORDS 3456
#define XB_SPIN_CAP (1u << 24)

__device__ __forceinline__ unsigned xb_ld(unsigned* p)              { return __hip_atomic_load(p, __ATOMIC_RELAXED, __HIP_MEMORY_SCOPE_AGENT); }
__device__ __forceinline__ unsigned xb_add(unsigned* p, unsigned v) { return __hip_atomic_fetch_add(p, v, __ATOMIC_RELAXED, __HIP_MEMORY_SCOPE_AGENT); }
__device__ __forceinline__ unsigned xb_xcc_id() { return (unsigned)__builtin_amdgcn_s_getreg((3 << 11) | 20) & 0xFu; }
#define XB_SPIN(cond, bar) do { unsigned _sp = 0; while (cond) { __builtin_amdgcn_s_sleep(1); \
    if ((++_sp & 255u) == 0u) { if (xb_ld(&(bar)[XB_TMO])) break; if (_sp > XB_SPIN_CAP) { atomicAdd(&(bar)[XB_TMO], 1u); break; } } } } while (0)

struct XcdBarrier {
    unsigned* bar; unsigned x;
    volatile LAS unsigned* st;
};

__device__ __forceinline__ XcdBarrier xcd_barrier_post(unsigned* bar, volatile LAS unsigned* st) {
    XcdBarrier b; b.bar = bar; b.x = xb_xcc_id(); b.st = st;
    if (threadIdx.x == 0) (void)xb_add(&bar[XB_XCNT(b.x)], 1u);
    return b;
}
__device__ __forceinline__ void xcd_barrier_complete(unsigned* bar, unsigned x, unsigned& nloc, unsigned& nx) {
    const unsigned G = gridDim.x * gridDim.y * gridDim.z;
    unsigned sum, cnt, mine, sp = 0u;
    for (;;) {
        sum = 0u; cnt = 0u; mine = 0u;
#pragma unroll
        for (unsigned j = 0; j < 16; ++j) { const unsigned c = xb_ld(&bar[XB_XCNT(j)]); sum += c; cnt += (c > 0u) ? 1u : 0u; mine = (j == x) ? c : mine; }
        if (sum == G) break;
        __builtin_amdgcn_s_sleep(1);
        if ((++sp & 255u) == 0u) { if (xb_ld(&bar[XB_TMO])) break; if (sp > XB_SPIN_CAP) { atomicAdd(&bar[XB_TMO], 1u); break; } }
    }
    nloc = mine > 0u ? mine : 1u; nx = cnt > 0u ? cnt : 1u;
}

__device__ __forceinline__ void xcd_barrier(const XcdBarrier& b) {
    asm volatile("s_waitcnt vmcnt(0)" ::: "memory");
    __syncthreads();
    if (threadIdx.x == 0) {
        unsigned* bar = b.bar;
        __builtin_amdgcn_s_waitcnt(0);
        unsigned nloc = b.st[0], nx = b.st[1];
        if (nloc == 0u) { xcd_barrier_complete(bar, b.x, nloc, nx); b.st[0] = nloc; b.st[1] = nx; }
        const unsigned old = xb_add(&bar[XB_XSUB(b.x)], 1u);
        const unsigned gen = old / nloc;
        if (old + 1u == (gen + 1u) * nloc) {
            __builtin_amdgcn_fence(__ATOMIC_RELEASE, "agent");
            asm volatile("s_waitcnt vmcnt(0)" ::: "memory");
            const unsigned og = xb_add(&bar[XB_TOP], 1u);
            const unsigned tg = og / nx;
            if (og + 1u == (tg + 1u) * nx) xb_add(&bar[XB_TOPGEN], 1u);
            else XB_SPIN(xb_ld(&bar[XB_TOPGEN]) == tg, bar);
            __builtin_amdgcn_fence(__ATOMIC_ACQUIRE, "agent");
            xb_add(&bar[XB_XGEN(b.x)], 1u);
            asm volatile("s_waitcnt vmcnt(0)" ::: "memory");
        } else {
            XB_SPIN(xb_ld(&bar[XB_XGEN(b.x)]) == gen, bar);
            __builtin_amdgcn_fence(__ATOMIC_ACQUIRE, "agent");
            asm volatile("s_waitcnt vmcnt(0)" ::: "memory");
        }
    }
    __syncthreads();
}
__device__ __forceinline__ void transpose_item(const float* W, int N, bf16* WT, int K, int k0, int n0, int drow0, LAS float* scr, int lane) {
#pragma unroll 8
    for (int i = 0; i < 32; ++i) { const int kk = 2 * i + (lane >> 5); scr[kk * 33 + (lane & 31)] = W[(size_t)(k0 + kk) * N + n0 + (lane & 31)]; }
    LDS_WAIT(); asm volatile("" ::: "memory");
    const int c = lane & 7;
#pragma unroll
    for (int j = 0; j < 4; ++j) { const int n = (lane >> 3) + 8 * j; const LAS float* s = scr + (8 * c) * 33 + n;
        v4u o; o.x = pk2(s[0 * 33], s[1 * 33]); o.y = pk2(s[2 * 33], s[3 * 33]); o.z = pk2(s[4 * 33], s[5 * 33]); o.w = pk2(s[6 * 33], s[7 * 33]);
        *(v4u*)(WT + (size_t)(drow0 + n) * K + k0 + 8 * c) = o; }
    LDS_WAIT(); asm volatile("" ::: "memory");
}
__device__ __forceinline__ int dest_row(int mode, int n0) {
    if (mode == 0) return n0;
    if (mode == 1) return 256 * (n0 >> 7) + (n0 & 127);
    if (mode == 2) return 256 * (n0 >> 7) + 128 + (n0 & 127);
    const int sec = n0 >> 10, c = n0 & 1023, hd = c >> 7, w = c & 127;
    return ((sec >> 1) ? 2048 : 0) + 256 * hd + ((sec & 1) ? 128 : 0) + w;
}
__device__ __forceinline__ void conv_matrix_item(const float* W, int K, int N, bf16* WT, int mode, int r, LAS float* scr, int lane) {
    const int nblk = N / 32, kb = r / nblk, nb = r % nblk;
    transpose_item(W, N, WT, K, 64 * kb, 32 * nb, dest_row(mode, 32 * nb), scr, lane);
}
__device__ __forceinline__ void rms_row_to_bf16(const float* xrow, const float* g, bf16* orow, int lane) {
    const f32x4* xr = (const f32x4*)xrow + lane; const f32x4* gr = (const f32x4*)g + lane;
    f32x4 v[4]; float s = 0.f;
#pragma unroll
    for (int j = 0; j < 4; ++j) { v[j] = xr[64 * j]; s += (v[j].x * v[j].x + v[j].y * v[j].y) + (v[j].z * v[j].z + v[j].w * v[j].w); }
    const float rstd = 1.0f / sqrtf(wave_sum(s) * (1.f / D) + EPS);
    unsigned long long* o8 = (unsigned long long*)orow + lane;
#pragma unroll
    for (int j = 0; j < 4; ++j) { const f32x4 gg = gr[64 * j];
        o8[64 * j] = (unsigned long long)pk2(v[j].x * rstd * gg.x, v[j].y * rstd * gg.y) | ((unsigned long long)pk2(v[j].z * rstd * gg.z, v[j].w * rstd * gg.w) << 32); }
}
__device__ __forceinline__ float inv_freq(int j) {
    return j == 0 ? 1.000000000e+00f : j == 1 ? 1.939227432e-01f : j == 2 ? 3.760603070e-02f : j == 3 ? 7.292664610e-03f : j == 4 ? 1.414213562e-03f : j == 5 ? 2.742481884e-04f : j == 6 ? 5.318295734e-05f : 1.031338525e-05f;
}
struct P0Args { const float *x, *g0, *w_in_attn, *w_out_attn, *w_in_rec, *w_out_rec, *w_gate, *w_up, *w_down, *w_gate_moe, *w_up_moe, *w_down_moe, *rlb; const int* pos; unsigned char* ws; };
__device__ __forceinline__ void phase_prologue(const P0Args& a, LAS unsigned char* lds, int blk, int G, int tid) {
    const int wave = tid >> 6, lane = tid & 63;
    LAS float* scr = (LAS float*)(lds + wave * 16384);
    const int gw = blk * NWAVES + wave, NGW = G * NWAVES;
    unsigned char* ws = a.ws;
    constexpr int I_INATT = 16 * (QKV_N / 32), I_SQ = 16 * 32, I_GU = 16 * (FF / 32), I_DN = (FF / 64) * 32, I_INREC = 16 * (REC_N / 32);
    constexpr int NITEMS = I_INATT + I_SQ + 2 * I_GU + I_DN + I_INREC + I_SQ + NEXP * (2 * I_GU + I_DN);
    for (int it = gw; it < NITEMS; it += NGW) {
        int r = it;
        if (r < I_INATT) { conv_matrix_item(a.w_in_attn, D, QKV_N, (bf16*)(ws + WS_W_INATT), 0, r, scr, lane); continue; } r -= I_INATT;
        if (r < I_SQ) { conv_matrix_item(a.w_out_attn, D, D, (bf16*)(ws + WS_W_OUTATT), 0, r, scr, lane); continue; } r -= I_SQ;
        if (r < I_GU) { conv_matrix_item(a.w_gate, D, FF, (bf16*)(ws + WS_W_GU), 1, r, scr, lane); continue; } r -= I_GU;
        if (r < I_GU) { conv_matrix_item(a.w_up, D, FF, (bf16*)(ws + WS_W_GU), 2, r, scr, lane); continue; } r -= I_GU;
        if (r < I_DN) { conv_matrix_item(a.w_down, FF, D, (bf16*)(ws + WS_W_DN), 0, r, scr, lane); continue; } r -= I_DN;
        if (r < I_INREC) { conv_matrix_item(a.w_in_rec, D, REC_N, (bf16*)(ws + WS_W_INREC), 3, r, scr, lane); continue; } r -= I_INREC;
        if (r < I_SQ) { conv_matrix_item(a.w_out_rec, D, D, (bf16*)(ws + WS_W_OUTREC), 0, r, scr, lane); continue; } r -= I_SQ;
        if (r < NEXP * I_GU) { const int e = r / I_GU, q = r % I_GU; conv_matrix_item(a.w_gate_moe + (size_t)e * D * FF, D, FF, (bf16*)(ws + WS_WMOE_GU) + (size_t)e * 2 * FF * D, 1, q, scr, lane); continue; } r -= NEXP * I_GU;
        if (r < NEXP * I_GU) { const int e = r / I_GU, q = r % I_GU; conv_matrix_item(a.w_up_moe + (size_t)e * D * FF, D, FF, (bf16*)(ws + WS_WMOE_GU) + (size_t)e * 2 * FF * D, 2, q, scr, lane); continue; } r -= NEXP * I_GU;
        { const int e = r / I_DN, q = r % I_DN; conv_matrix_item(a.w_down_moe + (size_t)e * FF * D, FF, D, (bf16*)(ws + WS_WMOE_DN) + (size_t)e * D * FF, 0, q, scr, lane); }
    }
    for (int m = gw; m < NTOK; m += NGW) rms_row_to_bf16(a.x + (size_t)m * D, a.g0, (bf16*)(ws + WS_H) + (size_t)m * D, lane);
    float* rope = (float*)(ws + WS_ROPE);
    for (int i = blk * 512 + tid; i < NTOK * 8; i += G * 512) { const int tok = i >> 3, j = i & 7;
        const float ang = (float)a.pos[tok] * inv_freq(j);
        const double turns = (double)ang * 0.15915494309189533577; const float fr = (float)(turns - __builtin_rint(turns));
        rope[tok * 16 + j] = __builtin_amdgcn_cosf(fr); rope[tok * 16 + 8 + j] = __builtin_amdgcn_sinf(fr); }
    float* lbk = (float*)(ws + WS_LBK);
    for (int i = blk * 512 + tid; i < 1024; i += G * 512) lbk[i] = 1.0f / (1.0f + __expf(a.rlb[1024 + i] - a.rlb[i]));
}
__device__ __forceinline__ void phase_rope(bf16* qkv, const float* rope, int blk, int G, int tid) {
    for (int i = blk * 512 + tid; i < NTOK * 26; i += G * 512) {
        const int tok = i / 26, hx = i % 26;
        const int col = hx < 8 ? hx * 64 : hx < 16 ? 512 + (hx - 8) * 64 : hx < 24 ? 1536 + (hx - 16) * 64 : 2048 + (hx - 24) * 64;
        v4u* p = (v4u*)(qkv + (size_t)tok * QKV_N + col);
        const v4u a = p[0], b = p[1];
        const f32x4* t = (const f32x4*)(rope + (size_t)tok * 16);
        const f32x4 c0 = t[0], c1 = t[1], s0 = t[2], s1 = t[3];
        const float x1[8] = {bflo(a.x), bfhi(a.x), bflo(a.y), bfhi(a.y), bflo(a.z), bfhi(a.z), bflo(a.w), bfhi(a.w)};
        const float x2[8] = {bflo(b.x), bfhi(b.x), bflo(b.y), bfhi(b.y), bflo(b.z), bfhi(b.z), bflo(b.w), bfhi(b.w)};
        const float cs[8] = {c0.x, c0.y, c0.z, c0.w, c1.x, c1.y, c1.z, c1.w}, sn[8] = {s0.x, s0.y, s0.z, s0.w, s1.x, s1.y, s1.z, s1.w};
        float y1[8], y2[8];
#pragma unroll
        for (int j = 0; j < 8; ++j) { y1[j] = x1[j] * cs[j] - x2[j] * sn[j]; y2[j] = x2[j] * cs[j] + x1[j] * sn[j]; }
        v4u oa, ob; oa.x = pk2(y1[0], y1[1]); oa.y = pk2(y1[2], y1[3]); oa.z = pk2(y1[4], y1[5]); oa.w = pk2(y1[6], y1[7]);
        ob.x = pk2(y2[0], y2[1]); ob.y = pk2(y2[2], y2[3]); ob.z = pk2(y2[4], y2[5]); ob.w = pk2(y2[6], y2[7]);
        p[0] = oa; p[1] = ob;
    }
}
__device__ __forceinline__ void attn_key(const bf16* krow, const bf16* vrow, const float (&q)[64], float (&o)[64], float& m, float& l) {
    float s = 0.f;
#pragma unroll
    for (int c = 0; c < 8; ++c) { const v4u kv = *(const v4u*)(krow + 8 * c);
        s += q[8 * c + 0] * bflo(kv.x) + q[8 * c + 1] * bfhi(kv.x) + q[8 * c + 2] * bflo(kv.y) + q[8 * c + 3] * bfhi(kv.y)
           + q[8 * c + 4] * bflo(kv.z) + q[8 * c + 5] * bfhi(kv.z) + q[8 * c + 6] * bflo(kv.w) + q[8 * c + 7] * bfhi(kv.w); }
    s *= 0.125f;
    const float mn = fmaxf(m, s), sc = __expf(m - mn), p = __expf(s - mn);
    l = l * sc + p; m = mn;
#pragma unroll
    for (int c = 0; c < 8; ++c) { const v4u vv = *(const v4u*)(vrow + 8 * c);
        o[8 * c + 0] = o[8 * c + 0] * sc + p * bflo(vv.x); o[8 * c + 1] = o[8 * c + 1] * sc + p * bfhi(vv.x);
        o[8 * c + 2] = o[8 * c + 2] * sc + p * bflo(vv.y); o[8 * c + 3] = o[8 * c + 3] * sc + p * bfhi(vv.y);
        o[8 * c + 4] = o[8 * c + 4] * sc + p * bflo(vv.z); o[8 * c + 5] = o[8 * c + 5] * sc + p * bfhi(vv.z);
        o[8 * c + 6] = o[8 * c + 6] * sc + p * bflo(vv.w); o[8 * c + 7] = o[8 * c + 7] * sc + p * bfhi(vv.w); }
}
__device__ __forceinline__ void phase_attn_naive(const bf16* qkv, const float* sinks, bf16* mix, int blk, int G, int tid) {
    for (int idx = blk * 512 + tid; idx < NTOK * 16; idx += G * 512) {
        const int hx = idx >> 16, tok = idx & 65535, b = tok >> 13, s = tok & 8191;
        const bool isB = hx >= 8; const int qh = hx - 8;
        const int qcol = isB ? 1536 + qh * 64 : hx * 64, kcol = isB ? 2048 + (qh >> 2) * 64 : 512 + hx * 64, vcol = isB ? 2176 + (qh >> 2) * 64 : 1024 + hx * 64, ocol = isB ? 512 + qh * 64 : hx * 64;
        float q[64], o[64]; float m = -INFINITY, l = 0.f;
        { const bf16* qp = qkv + (size_t)tok * QKV_N + qcol;
#pragma unroll
          for (int c = 0; c < 8; ++c) { const v4u w = *(const v4u*)(qp + 8 * c); q[8 * c] = bflo(w.x); q[8 * c + 1] = bfhi(w.x); q[8 * c + 2] = bflo(w.y); q[8 * c + 3] = bfhi(w.y); q[8 * c + 4] = bflo(w.z); q[8 * c + 5] = bfhi(w.z); q[8 * c + 6] = bflo(w.w); q[8 * c + 7] = bfhi(w.w); } }
#pragma unroll
        for (int i = 0; i < 64; ++i) o[i] = 0.f;
        const bf16* rb = qkv + (size_t)(b * SEQ) * QKV_N;
        if (!isB) {
            for (int jj = 0; jj < 387; ++jj) { const int d = jj < 129 ? 1 : jj < 258 ? 4 : 16, j = jj < 129 ? jj : jj < 258 ? jj - 129 : jj - 258;
                const int kt = s - d * j; if (kt < 0) continue;
                const bf16* r = rb + (size_t)kt * QKV_N; attn_key(r + kcol, r + vcol, q, o, m, l); }
        } else {
            for (int j = 0; j < 128; ++j) { const int kt = s - j; if (kt < 0) break;
                const bf16* r = rb + (size_t)kt * QKV_N; attn_key(r + kcol, r + vcol, q, o, m, l); }
            const float sk = sinks[qh]; const float mn = fmaxf(m, sk), sc = __expf(m - mn);
            l = l * sc + __expf(sk - mn); m = mn;
#pragma unroll
            for (int i = 0; i < 64; ++i) o[i] *= sc;
        }
        const float rl = 1.0f / l;
        v4u* op = (v4u*)(mix + (size_t)tok * D + ocol);
#pragma unroll
        for (int c = 0; c < 8; ++c) { v4u w; w.x = pk2(o[8 * c] * rl, o[8 * c + 1] * rl); w.y = pk2(o[8 * c + 2] * rl, o[8 * c + 3] * rl); w.z = pk2(o[8 * c + 4] * rl, o[8 * c + 5] * rl); w.w = pk2(o[8 * c + 6] * rl, o[8 * c + 7] * rl); op[c] = w; }
    }
}
__device__ __forceinline__ void phase_norm(const float* x, const float* g, bf16* out, int blk, int G, int tid) {
    const int wave = tid >> 6, lane = tid & 63;
    for (int m = blk * NWAVES + wave; m < NTOK; m += G * NWAVES) rms_row_to_bf16(x + (size_t)m * D, g, out + (size_t)m * D, lane);
}
__device__ __forceinline__ void phase_hgrn_naive(const bf16* Qp, const bf16* Kp, const bf16* Vp, bf16* Oraw, LAS unsigned char* lds, int blk, int G, int tid) {
    LAS float* sq = (LAS float*)lds; LAS float* sk = sq + 2048; LAS float* sf = sk + 2048; LAS float* sv = sf + 2048; LAS float* part = sv + 2048;
    const int v = tid & 127, kq = tid >> 7;
    const int lr = tid >> 5, lc = (tid & 31) * 4;
    for (int bh = blk; bh < BATCH * 8; bh += G) {
        const int b = bh >> 3, h = bh & 7;
        float S[32];
#pragma unroll
        for (int i = 0; i < 32; ++i) S[i] = 0.f;
        for (int t0 = 0; t0 < SEQ; t0 += 16) {
            const size_t base = (size_t)(b * SEQ + t0 + lr) * D + h * 128 + lc;
            { const v2u w = *(const v2u*)(Qp + base); *(LAS f32x4*)(sq + lr * 128 + lc) = (f32x4){bflo(w.x), bfhi(w.x), bflo(w.y), bfhi(w.y)}; }
            { const v2u w = *(const v2u*)(Kp + base); const f32x4 kk = (f32x4){bflo(w.x), bfhi(w.x), bflo(w.y), bfhi(w.y)}; *(LAS f32x4*)(sk + lr * 128 + lc) = kk; *(LAS f32x4*)(sf + lr * 128 + lc) = (f32x4){1.f - kk.x, 1.f - kk.y, 1.f - kk.z, 1.f - kk.w}; }
            { const v2u w = *(const v2u*)(Vp + base); *(LAS f32x4*)(sv + lr * 128 + lc) = (f32x4){bflo(w.x), bfhi(w.x), bflo(w.y), bfhi(w.y)}; }
            __syncthreads();
            for (int t = 0; t < 16; ++t) {
                const float vt = sv[t * 128 + v]; float po = 0.f;
#pragma unroll
                for (int i4 = 0; i4 < 8; ++i4) { const int kx = t * 128 + kq * 32 + i4 * 4;
                    const f32x4 q4 = *(const LAS f32x4*)(sq + kx), k4 = *(const LAS f32x4*)(sk + kx), f4 = *(const LAS f32x4*)(sf + kx);
#pragma unroll
                    for (int j = 0; j < 4; ++j) { S[i4 * 4 + j] = f4[j] * S[i4 * 4 + j] + k4[j] * vt; po += q4[j] * S[i4 * 4 + j]; } }
                part[(t * 4 + kq) * 128 + v] = po;
            }
            __syncthreads();
            { const f32x4 p0 = *(const LAS f32x4*)(part + (lr * 4 + 0) * 128 + lc), p1 = *(const LAS f32x4*)(part + (lr * 4 + 1) * 128 + lc), p2 = *(const LAS f32x4*)(part + (lr * 4 + 2) * 128 + lc), p3 = *(const LAS f32x4*)(part + (lr * 4 + 3) * 128 + lc);
              const f32x4 r = (p0 + p1) + (p2 + p3); v2u w; w.x = pk2(r.x, r.y); w.y = pk2(r.z, r.w); *(v2u*)(Oraw + base) = w; }
        }
        __syncthreads();
    }
}
__device__ __forceinline__ void phase_gate(bf16* O, const bf16* Gp, const float* norm_g, int blk, int G, int tid) {
    const int wave = tid >> 6, lane = tid & 63;
    for (int m = blk * NWAVES + wave; m < NTOK; m += G * NWAVES) {
        v4u* op = (v4u*)(O + (size_t)m * D + lane * 16); const v4u* gp = (const v4u*)(Gp + (size_t)m * D + lane * 16);
        const v4u a = op[0], b = op[1], ga = gp[0], gb = gp[1];
        float x[16] = {bflo(a.x), bfhi(a.x), bflo(a.y), bfhi(a.y), bflo(a.z), bfhi(a.z), bflo(a.w), bfhi(a.w), bflo(b.x), bfhi(b.x), bflo(b.y), bfhi(b.y), bflo(b.z), bfhi(b.z), bflo(b.w), bfhi(b.w)};
        const float gg[16] = {bflo(ga.x), bfhi(ga.x), bflo(ga.y), bfhi(ga.y), bflo(ga.z), bfhi(ga.z), bflo(ga.w), bfhi(ga.w), bflo(gb.x), bfhi(gb.x), bflo(gb.y), bfhi(gb.y), bflo(gb.z), bfhi(gb.z), bflo(gb.w), bfhi(gb.w)};
        float ss = 0.f;
#pragma unroll
        for (int i = 0; i < 16; ++i) ss += x[i] * x[i];
        ss += __shfl_xor(ss, 1); ss += __shfl_xor(ss, 2); ss += __shfl_xor(ss, 4);
        const float rstd = 1.0f / sqrtf(ss * (1.f / 128.f) + EPS);
        const f32x4* ng = (const f32x4*)(norm_g + lane * 16);
        float y[16];
#pragma unroll
        for (int i4 = 0; i4 < 4; ++i4) { const f32x4 n4 = ng[i4];
#pragma unroll
            for (int j = 0; j < 4; ++j) y[i4 * 4 + j] = x[i4 * 4 + j] * rstd * n4[j] * gg[i4 * 4 + j]; }
        v4u oa, ob; oa.x = pk2(y[0], y[1]); oa.y = pk2(y[2], y[3]); oa.z = pk2(y[4], y[5]); oa.w = pk2(y[6], y[7]);
        ob.x = pk2(y[8], y[9]); ob.y = pk2(y[10], y[11]); ob.z = pk2(y[12], y[13]); ob.w = pk2(y[14], y[15]);
        op[0] = oa; op[1] = ob;
    }
}
__device__ __forceinline__ void phase_router(const float* x, const float* g, const float* w_router, int4* meta, int* hist, LAS unsigned char* lds, int blk, int G, int tid) {
    const int wave = tid >> 6, lane = tid & 63;
    LAS float* swr = (LAS float*)lds;
    LAS int* scnt = (LAS int*)(lds + 32768);
    for (int i = tid; i < 8192; i += 512) swr[i] = w_router[i];
    __syncthreads();
    for (int tb = blk; tb < 256; tb += G) {
        if (tid < 8) scnt[tid] = 0;
        __syncthreads();
        int c0 = 0, c1 = 0, c2 = 0, c3 = 0, c4 = 0, c5 = 0, c6 = 0, c7 = 0;
        for (int i = 0; i < 32; ++i) {
            const int tok = tb * 256 + wave * 32 + i;
            const f32x4* xr = (const f32x4*)(x + (size_t)tok * D) + lane; const f32x4* gr = (const f32x4*)g + lane;
            f32x4 v[4]; float s = 0.f;
#pragma unroll
            for (int j = 0; j < 4; ++j) { v[j] = xr[64 * j]; s += (v[j].x * v[j].x + v[j].y * v[j].y) + (v[j].z * v[j].z + v[j].w * v[j].w); }
            const float rstd = 1.0f / sqrtf(wave_sum(s) * (1.f / D) + EPS);
            float lg[8] = {0.f, 0.f, 0.f, 0.f, 0.f, 0.f, 0.f, 0.f};
#pragma unroll
            for (int j = 0; j < 4; ++j) { const f32x4 gg = gr[64 * j];
#pragma unroll
                for (int c = 0; c < 4; ++c) { const float hv = v[j][c] * rstd * gg[c]; const int d = 256 * j + 4 * lane + c;
                    const f32x4 w0 = *(const LAS f32x4*)(swr + d * 8), w1 = *(const LAS f32x4*)(swr + d * 8 + 4);
                    lg[0] += hv * w0.x; lg[1] += hv * w0.y; lg[2] += hv * w0.z; lg[3] += hv * w0.w; lg[4] += hv * w1.x; lg[5] += hv * w1.y; lg[6] += hv * w1.z; lg[7] += hv * w1.w; } }
#pragma unroll
            for (int e = 0; e < 8; ++e) lg[e] = wave_sum(lg[e]);
            int e0 = 0; float v0 = lg[0];
#pragma unroll
            for (int e = 1; e < 8; ++e) if (lg[e] > v0) { v0 = lg[e]; e0 = e; }
            int e1 = -1; float v1 = -INFINITY;
#pragma unroll
            for (int e = 0; e < 8; ++e) if (e != e0 && lg[e] > v1) { v1 = lg[e]; e1 = e; }
            const float g1 = 1.0f / (1.0f + __expf(v0 - v1)), g0 = 1.0f - g1;
            if (lane == 0) meta[tok] = make_int4(e0, e1, __builtin_bit_cast(int, g0), __builtin_bit_cast(int, g1));
            c0 += (e0 == 0) + (e1 == 0); c1 += (e0 == 1) + (e1 == 1); c2 += (e0 == 2) + (e1 == 2); c3 += (e0 == 3) + (e1 == 3);
            c4 += (e0 == 4) + (e1 == 4); c5 += (e0 == 5) + (e1 == 5); c6 += (e0 == 6) + (e1 == 6); c7 += (e0 == 7) + (e1 == 7);
        }
        if (lane == 0) { const int cc[8] = {c0, c1, c2, c3, c4, c5, c6, c7};
#pragma unroll
            for (int e = 0; e < 8; ++e) __hip_atomic_fetch_add(&scnt[e], cc[e], __ATOMIC_RELAXED, __HIP_MEMORY_SCOPE_WORKGROUP); }
        __syncthreads();
        if (tid < 8) hist[tb * 8 + tid] = scnt[tid];
        __syncthreads();
    }
}
__device__ __forceinline__ void phase_scatter(const float* x, const float* g, const int4* meta, const int* hist, int* dest, int* info, bf16* perm, LAS unsigned char* lds, int blk, int G, int tid) {
    const int wave = tid >> 6, lane = tid & 63;
    LAS int* shist = (LAS int*)lds;
    LAS int* ssize = shist + 2048; LAS int* sbpre = ssize + 8; LAS int* spst = sbpre + 8; LAS int* sntl = spst + 8;
    LAS int* se = sntl + 8; LAS int* sdest = se + 512;
    for (int tb = blk; tb < 256; tb += G) {
        for (int i = tid; i < 2048; i += 512) shist[i] = hist[i];
        __syncthreads();
        if (tid < 8) { int sz = 0, bp = 0; for (int b = 0; b < 256; ++b) { const int hv = shist[b * 8 + tid]; sz += hv; bp += (b < tb) ? hv : 0; } ssize[tid] = sz; sbpre[tid] = bp; }
        __syncthreads();
        if (tid == 0) { int ts = 0; for (int e = 0; e < 8; ++e) { const int nt = (ssize[e] + 255) >> 8; spst[e] = ts * 256; sntl[e] = nt; ts += nt; if (tb == 0) info[e] = ts; } if (tb == 0) info[8] = ts; }
        { const int4 mt = meta[tb * 256 + (tid >> 1)]; se[tid] = (tid & 1) ? mt.y : mt.x; }
        __syncthreads();
        { const int e = se[tid]; int rank = 0; for (int p = 0; p < tid; ++p) rank += (se[p] == e) ? 1 : 0;
          const int dd = spst[e] + sbpre[e] + rank; sdest[tid] = dd; dest[(tb * 256) * 2 + tid] = dd; }
        __syncthreads();
        for (int i = 0; i < 32; ++i) { const int lt = wave * 32 + i, tok = tb * 256 + lt;
            const f32x4* xr = (const f32x4*)(x + (size_t)tok * D) + lane; const f32x4* gr = (const f32x4*)g + lane;
            f32x4 v[4]; float s = 0.f;
#pragma unroll
            for (int j = 0; j < 4; ++j) { v[j] = xr[64 * j]; s += (v[j].x * v[j].x + v[j].y * v[j].y) + (v[j].z * v[j].z + v[j].w * v[j].w); }
            const float rstd = 1.0f / sqrtf(wave_sum(s) * (1.f / D) + EPS);
            unsigned long long* o0 = (unsigned long long*)(perm + (size_t)sdest[2 * lt] * D) + lane; unsigned long long* o1 = (unsigned long long*)(perm + (size_t)sdest[2 * lt + 1] * D) + lane;
#pragma unroll
            for (int j = 0; j < 4; ++j) { const f32x4 gg = gr[64 * j];
                const unsigned long long w = (unsigned long long)pk2(v[j].x * rstd * gg.x, v[j].y * rstd * gg.y) | ((unsigned long long)pk2(v[j].z * rstd * gg.z, v[j].w * rstd * gg.w) << 32);
                o0[64 * j] = w; o1[64 * j] = w; } }
        if (tb < 8) { const int r0 = spst[tb] + ssize[tb], r1 = spst[tb] + sntl[tb] * 256;
            for (int r = r0 + wave; r < r1; r += NWAVES) { unsigned long long* o = (unsigned long long*)(perm + (size_t)r * D) + lane;
#pragma unroll
                for (int j = 0; j < 4; ++j) o[64 * j] = 0ull; } }
        __syncthreads();
    }
}
__device__ __forceinline__ void phase_combine(float* x, const bf16* y, const int4* meta, const int* dest, const float* gf, int blk, int G, int tid) {
    const int wave = tid >> 6, lane = tid & 63;
    for (int m = blk * NWAVES + wave; m < NTOK; m += G * NWAVES) {
        const int4 mt = meta[m]; const float g0 = __builtin_bit_cast(float, mt.z), g1 = __builtin_bit_cast(float, mt.w);
        const int d0 = dest[2 * m], d1 = dest[2 * m + 1];
        f32x4* xr = (f32x4*)(x + (size_t)m * D) + lane; const f32x4* gr = (const f32x4*)gf + lane;
        const v2u* y0 = (const v2u*)(y + (size_t)d0 * D) + lane; const v2u* y1 = (const v2u*)(y + (size_t)d1 * D) + lane;
        f32x4 v[4]; float s = 0.f;
#pragma unroll
        for (int j = 0; j < 4; ++j) { const v2u a = y0[64 * j], b = y1[64 * j]; f32x4 t = xr[64 * j];
            t.x += g0 * bflo(a.x) + g1 * bflo(b.x); t.y += g0 * bfhi(a.x) + g1 * bfhi(b.x); t.z += g0 * bflo(a.y) + g1 * bflo(b.y); t.w += g0 * bfhi(a.y) + g1 * bfhi(b.y);
            v[j] = t; s += (t.x * t.x + t.y * t.y) + (t.z * t.z + t.w * t.w); }
        const float rstd = 1.0f / sqrtf(wave_sum(s) * (1.f / D) + EPS);
#pragma unroll
        for (int j = 0; j < 4; ++j) { const f32x4 gg = gr[64 * j]; xr[64 * j] = (f32x4){v[j].x * rstd * gg.x, v[j].y * rstd * gg.y, v[j].z * rstd * gg.z, v[j].w * rstd * gg.w}; }
    }
}
struct Args { const void* in[19]; float* out; unsigned char* ws; int ph_lo, ph_hi; };
__global__ void __launch_bounds__(NWAVES * 64, 2) fwd(Args args) {
    extern __shared__ __attribute__((aligned(16))) unsigned char lds_raw[];
    LAS unsigned char* lds = (LAS unsigned char*)lds_raw;
    volatile LAS unsigned* MISC = (volatile LAS unsigned*)(lds + MISC_OFF);
    const int tid = threadIdx.x, G = gridDim.x, blk = blockIdx.x;
    unsigned char* ws = args.ws;
    unsigned* ctl = (unsigned*)(ws + WS_CTL);
    for (int u = tid; u < (LDS_BYTES - LDSCTL_OFF) / 4; u += NWAVES * 64) ((LAS unsigned*)(lds + LDSCTL_OFF))[u] = 0u;
    __syncthreads();
    XcdBarrier bar; bar.bar = ctl + CW_BAR; bar.x = 0; bar.st = nullptr;
    if (N_LAUNCHES == 1) bar = xcd_barrier_post(ctl + CW_BAR, MISC + 8);
#define GRID_BAR() do { if (N_LAUNCHES == 1) xcd_barrier(bar); } while (0)
    const int lo = args.ph_lo, hi = args.ph_hi;
#define IN(k) (lo <= (k) && (k) < hi)
#define BOTH(k) (IN(k) && IN((k) + 1))
    const float* x = (const float*)args.in[0]; const int* positions = (const int*)args.in[1];
    const float* g_mix = (const float*)args.in[2]; const float* g_ffn = (const float*)args.in[3]; const float* g_final = (const float*)args.in[4];
    const float* sinks = (const float*)args.in[7]; const float* rec_norm_g = (const float*)args.in[10]; const float* w_router = (const float*)args.in[15];
    float* out = args.out;
    bf16* H = (bf16*)(ws + WS_H); bf16* BIG = (bf16*)(ws + WS_BIG);
    const size_t PLANE = (size_t)NTOK * D;

    if (IN(0)) {
        P0Args pa; pa.x = x; pa.g0 = g_mix; pa.w_in_attn = (const float*)args.in[5]; pa.w_out_attn = (const float*)args.in[6]; pa.w_in_rec = (const float*)args.in[8]; pa.w_out_rec = (const float*)args.in[11];
        pa.w_gate = (const float*)args.in[12]; pa.w_up = (const float*)args.in[13]; pa.w_down = (const float*)args.in[14]; pa.w_gate_moe = (const float*)args.in[16]; pa.w_up_moe = (const float*)args.in[17]; pa.w_down_moe = (const float*)args.in[18];
        pa.rlb = (const float*)args.in[9]; pa.pos = positions; pa.ws = ws;
        phase_prologue(pa, lds, blk, G, tid);
        if (BOTH(0)) GRID_BAR();
    }
    if (IN(1)) {
        pg8::Gemm g{H, (const bf16*)(ws + WS_W_INATT), NTOK, QKV_N, D}; pg8::StaticOrder S; S.init(NTOK, QKV_N, G, blk);
        pg8::EpiBf16Plain E{BIG, QKV_N, 1 << 20};
        pg8::gemm_phase<pg8::EpiBf16Plain, pg8::StaticOrder, PG8_ALIGN, PG8_SP2>(lds, g, S, E);
        if (BOTH(1)) GRID_BAR();
    }
    if (IN(2)) { phase_rope(BIG, (const float*)(ws + WS_ROPE), blk, G, tid); if (BOTH(2)) GRID_BAR(); }
    if (IN(3)) { phase_attn_naive(BIG, sinks, H, blk, G, tid); if (BOTH(3)) GRID_BAR(); }
    if (IN(4)) {
        pg8::Gemm g{H, (const bf16*)(ws + WS_W_OUTATT), NTOK, D, D}; pg8::StaticOrder S; S.init(NTOK, D, G, blk);
        pg8::EpiRes E{x, out, D};
        pg8::gemm_phase<pg8::EpiRes, pg8::StaticOrder, PG8_ALIGN, PG8_SP2>(lds, g, S, E);
        if (BOTH(4)) GRID_BAR();
    }
    if (IN(5)) { phase_norm(out, g_ffn, H, blk, G, tid); if (BOTH(5)) GRID_BAR(); }
    if (IN(6)) {
        pg8::Gemm g{H, (const bf16*)(ws + WS_W_GU), NTOK, 2 * FF, D}; pg8::StaticOrder S; S.init(NTOK, 2 * FF, G, blk);
        pg8::EpiSwiglu E{BIG, FF, 1 << 20, 0};
        pg8::gemm_phase<pg8::EpiSwiglu, pg8::StaticOrder, PG8_ALIGN, PG8_SP2>(lds, g, S, E);
        if (BOTH(6)) GRID_BAR();
    }
    if (IN(7)) {
        pg8::Gemm g{BIG, (const bf16*)(ws + WS_W_DN), NTOK, D, FF}; pg8::StaticOrder S; S.init(NTOK, D, G, blk);
        pg8::EpiRes E{out, out, D};
        pg8::gemm_phase<pg8::EpiRes, pg8::StaticOrder, PG8_ALIGN, PG8_SP2>(lds, g, S, E);
        if (BOTH(7)) GRID_BAR();
    }
    if (IN(8)) { phase_norm(out, g_mix + D, H, blk, G, tid); if (BOTH(8)) GRID_BAR(); }
    if (IN(9)) {
        pg8::Gemm g{H, (const bf16*)(ws + WS_W_INREC), NTOK, REC_N, D}; pg8::StaticOrder S; S.init(NTOK, REC_N, G, blk);
        pg8::EpiRec E{BIG, PLANE, (const float*)(ws + WS_LBK)};
        pg8::gemm_phase<pg8::EpiRec, pg8::StaticOrder, PG8_ALIGN, PG8_SP2>(lds, g, S, E);
        if (BOTH(9)) GRID_BAR();
    }
    if (IN(10)) { phase_hgrn_naive(BIG, BIG + PLANE, BIG + 2 * PLANE, H, lds, blk, G, tid); if (BOTH(10)) GRID_BAR(); }
    if (IN(11)) { phase_gate(H, BIG + 3 * PLANE, rec_norm_g, blk, G, tid); if (BOTH(11)) GRID_BAR(); }
    if (IN(12)) {
        pg8::Gemm g{H, (const bf16*)(ws + WS_W_OUTREC), NTOK, D, D}; pg8::StaticOrder S; S.init(NTOK, D, G, blk);
        pg8::EpiRes E{out, out, D};
        pg8::gemm_phase<pg8::EpiRes, pg8::StaticOrder, PG8_ALIGN, PG8_SP2>(lds, g, S, E);
        if (BOTH(12)) GRID_BAR();
    }
    int4* meta = (int4*)(ws + WS_META); int* hist = (int*)(ws + WS_HIST); int* dest = (int*)(ws + WS_DEST); int* info = (int*)(ws + WS_INFO);
    bf16* Y = (bf16*)(ws + WS_Y); bf16* HID = (bf16*)(ws + WS_HID);
    if (IN(13)) { phase_router(out, g_ffn + D, w_router, meta, hist, lds, blk, G, tid); if (BOTH(13)) GRID_BAR(); }
    if (IN(14)) { phase_scatter(out, g_ffn + D, meta, hist, dest, info, Y, lds, blk, G, tid); if (BOTH(14)) GRID_BAR(); }
    for (int c = 0; c < 3; ++c) {
        if (IN(15 + 2 * c) || IN(16 + 2 * c)) {
            const int T = info[8]; const int tile0 = 256 * c; int ntl = T - tile0; ntl = ntl > 256 ? 256 : ntl; ntl = ntl < 0 ? 0 : ntl;
            pg8::MoeOrder S; S.tile0 = tile0; S.te0 = info[0]; S.te1 = info[1]; S.te2 = info[2]; S.te3 = info[3]; S.te4 = info[4]; S.te5 = info[5]; S.te6 = info[6];
            if (IN(15 + 2 * c)) {
                S.nN = 28; S.so.init(ntl * 256, 2 * FF, G, blk);
                pg8::Gemm g{Y, (const bf16*)(ws + WS_WMOE_GU), 0, 0, D};
                pg8::EpiSwiglu E{HID, FF, 28, tile0};
                pg8::gemm_phase<pg8::EpiSwiglu, pg8::MoeOrder, PG8_ALIGN, PG8_SP2>(lds, g, S, E);
                if (BOTH(15 + 2 * c)) GRID_BAR();
            }
            if (IN(16 + 2 * c)) {
                S.nN = 4; S.so.init(ntl * 256, D, G, blk);
                pg8::Gemm g{HID - (size_t)tile0 * 256 * FF, (const bf16*)(ws + WS_WMOE_DN), 0, 0, FF};
                pg8::EpiBf16Plain E{Y, D, 4};
                pg8::gemm_phase<pg8::EpiBf16Plain, pg8::MoeOrder, PG8_ALIGN, PG8_SP2>(lds, g, S, E);
                if (BOTH(16 + 2 * c)) GRID_BAR();
            }
        }
    }
    if (IN(21)) phase_combine(out, Y, meta, dest, g_final, blk, G, tid);
#undef IN
#undef BOTH
}

extern "C" void kernel_launch(void* const* d_in, const int* in_sizes, int n_in, void* d_out, int out_size, void* d_ws, size_t ws_size, hipStream_t stream) {
    static int grid = 0;
    if (grid == 0) {
        if (n_in != 19 || in_sizes[0] != NTOK * D || out_size != NTOK * D || ws_size < WS_END) { fprintf(stderr, "kernel_launch: unexpected shapes / workspace (n_in %d, ws %zu); nothing launched\n", n_in, ws_size); grid = -1; return; }
        int dev = 0, cus = 0, per_cu = 0;
        if (hipGetDevice(&dev) != hipSuccess || hipDeviceGetAttribute(&cus, hipDeviceAttributeMultiprocessorCount, dev) != hipSuccess) { grid = -1; return; }
        if (hipFuncSetAttribute((const void*)fwd, hipFuncAttributeMaxDynamicSharedMemorySize, LDS_BYTES) != hipSuccess) { fprintf(stderr, "kernel_launch: hipFuncSetAttribute failed\n"); grid = -1; return; }
        if (hipOccupancyMaxActiveBlocksPerMultiprocessor(&per_cu, (const void*)fwd, NWAVES * 64, LDS_BYTES) != hipSuccess || per_cu < 1) fprintf(stderr, "kernel_launch: occupancy query says %d\n", per_cu);
        (void)hipGetLastError();
        grid = cus;
    }
    if (grid < 0) return;
    if (hipMemsetAsync((char*)d_ws + WS_CTL, 0, CTL_ZERO_BYTES, stream) != hipSuccess) return;
    Args a{};
    for (int i = 0; i < 19; ++i) a.in[i] = d_in[i];
    a.out = (float*)d_out; a.ws = (unsigned char*)d_ws;
    if (N_LAUNCHES == 1) { a.ph_lo = 0; a.ph_hi = NPH; hipLaunchKernelGGL(fwd, dim3(grid), dim3(NWAVES * 64), LDS_BYTES, stream, a); }
    else for (int li = 0; li < NPH; ++li) { a.ph_lo = li; a.ph_hi = li + 1; hipLaunchKernelGGL(fwd, dim3(grid), dim3(NWAVES * 64), LDS_BYTES, stream, a); }
}
```

```cpp
#include <hip/hip_runtime.h>
#include <cstdio>
#include <cstdint>
namespace pg8 {
#define PG8_LAS __attribute__((address_space(3)))
typedef unsigned short bf16_t;
typedef short bf16x8 __attribute__((ext_vector_type(8)));
typedef float f32x4 __attribute__((ext_vector_type(4)));
typedef unsigned u32x4 __attribute__((ext_vector_type(4)));
constexpr int BM = 256, BK = 64, HALF = 128, HTB = HALF * BK * 2  , STAGE_BYTES = 8 * HTB, NXCD = 8, WGM = 8;

__host__ __device__ __forceinline__ int lds_byte(int r, int c) { const int st = (r >> 4) * 2 + (c >> 5), rr = r & 15, cc = c & 31, ob = rr * 64 + cc * 2; return st * 1024 + (ob ^ (((ob >> 9) & 1) << 5)); }
__host__ __device__ __forceinline__ void stage_rc(int b, int& R, int& C) { const int st = b / 1024, sb = b % 1024, swz = sb ^ (((sb >> 9) & 1) << 5); R = (st >> 1) * 16 + swz / 64; C = (st & 1) * 32 + (swz % 64) / 2; }
__host__ __device__ __forceinline__ int perm32(int rho) { const int n = rho >> 4, i = rho & 15; return 8 * (i >> 2) + 4 * n + (i & 3); }

struct Unit { int pm, pn; };
struct Gemm { const bf16_t* A; const bf16_t* Bt; int M, N, K; };

struct StaticOrder {
    int nM, nN, nwg, G, c;
    __host__ __device__ void init(int M, int N, int G_, int c_) { nM = M / BM; nN = N / BM; nwg = nM * nN; G = G_; c = c_; }
    __host__ __device__ bool next(int i, Unit& u) const {
        const long L = (long)i * G + c; if (L >= nwg) return false;
        int wgid = (int)L; { const int q = nwg / NXCD, r = nwg % NXCD, xcd = wgid % NXCD, off = wgid / NXCD; wgid = (xcd < r ? xcd * (q + 1) : r * (q + 1) + (xcd - r) * q) + off; }
        const int nig = WGM * nN, gid = wgid / nig, fm = gid * WGM, gsz = (nM - fm) < WGM ? (nM - fm) : WGM;
        u.pm = fm + ((wgid % nig) % gsz); u.pn = (wgid % nig) / gsz; return true;
    }
    __device__ __forceinline__ void a_ready(const Unit&) const {}
    __device__ __forceinline__ void done(const Unit&) const {}
};
__device__ __forceinline__ unsigned cvt_pk_bf16(float lo, float hi) { unsigned r; asm volatile("v_cvt_pk_bf16_f32 %0, %1, %2" : "=v"(r) : "v"(lo), "v"(hi)); return r; }
__device__ __forceinline__ float sigmoid_f(float x) { return __builtin_amdgcn_rcpf(1.0f + __builtin_amdgcn_exp2f(-1.44269504089f * x)); }
__device__ __forceinline__ float silu_f(float x) { return x * sigmoid_f(x); }
__device__ __forceinline__ u32x4 pack8(const f32x4& v0, const f32x4& v1) { u32x4 w; w.x = cvt_pk_bf16(v0[0], v0[1]); w.y = cvt_pk_bf16(v0[2], v0[3]); w.z = cvt_pk_bf16(v1[0], v1[1]); w.w = cvt_pk_bf16(v1[2], v1[3]); return w; }
struct EpiBf16Plain {
    static constexpr bool PERM = true, AFTER_DRAIN = false;
    bf16_t* O; int ldc; int nmod;
    __device__ __forceinline__ void operator()(const f32x4 (&acc)[2][2][4][2], const Unit& u, int wr, int wc, int fr, int fq) const {
        const int row0 = u.pm * BM + wr * 64 + fr; const int col0 = (u.pn % nmod) * BM + wc * 32 + 8 * fq;
#pragma unroll
        for (int ai = 0; ai < 2; ++ai)
#pragma unroll
            for (int m = 0; m < 4; ++m) { bf16_t* rowp = O + (size_t)(row0 + ai * HALF + m * 16) * ldc + col0;
#pragma unroll
                for (int bj = 0; bj < 2; ++bj) *(u32x4*)(rowp + bj * HALF) = pack8(acc[ai][bj][m][0], acc[ai][bj][m][1]); }
    }
};
struct EpiRes {
    static constexpr bool PERM = false, AFTER_DRAIN = false;
    const float* base; float* out; int ldc;
    __device__ __forceinline__ void operator()(const f32x4 (&acc)[2][2][4][2], const Unit& u, int wr, int wc, int fr, int fq) const {
        const int row0 = u.pm * BM + wr * 64 + fr, col0 = u.pn * BM + wc * 32 + 4 * fq;
#pragma unroll
        for (int ai = 0; ai < 2; ++ai)
#pragma unroll
            for (int m = 0; m < 4; ++m) { const size_t off = (size_t)(row0 + ai * HALF + m * 16) * ldc + col0;
#pragma unroll
                for (int bj = 0; bj < 2; ++bj)
#pragma unroll
                    for (int n = 0; n < 2; ++n) { const f32x4 bs = *(const f32x4*)(base + off + bj * HALF + n * 16); *(f32x4*)(out + off + bj * HALF + n * 16) = bs + acc[ai][bj][m][n]; }
                asm volatile("" ::: "memory"); }
    }
};
struct EpiSwiglu {
    static constexpr bool PERM = true, AFTER_DRAIN = false;
    bf16_t* O; int ldc; int nN; int tile0;
    __device__ __forceinline__ void operator()(const f32x4 (&acc)[2][2][4][2], const Unit& u, int wr, int wc, int fr, int fq) const {
        const int row0 = (u.pm - tile0) * BM + wr * 64 + fr; const int col0 = (u.pn % nN) * HALF + wc * 32 + 8 * fq;
#pragma unroll
        for (int ai = 0; ai < 2; ++ai)
#pragma unroll
            for (int m = 0; m < 4; ++m) { bf16_t* rowp = O + (size_t)(row0 + ai * HALF + m * 16) * ldc + col0;
                f32x4 h0, h1;
#pragma unroll
                for (int j = 0; j < 4; ++j) { h0[j] = silu_f(acc[ai][0][m][0][j]) * acc[ai][1][m][0][j]; h1[j] = silu_f(acc[ai][0][m][1][j]) * acc[ai][1][m][1][j]; }
                *(u32x4*)rowp = pack8(h0, h1); }
    }
};
struct EpiRec {
    static constexpr bool PERM = true, AFTER_DRAIN = false;
    bf16_t* P; size_t plane; const float* lbk;
    __device__ __forceinline__ void operator()(const f32x4 (&acc)[2][2][4][2], const Unit& u, int wr, int wc, int fr, int fq) const {
        const int hd = u.pn & 7; const bool second = (u.pn >> 3) != 0;
        const int row0 = u.pm * BM + wr * 64 + fr; const int ch0 = hd * HALF + wc * 32 + 8 * fq;
        const f32x4 l0 = *(const f32x4*)(lbk + ch0), l1 = *(const f32x4*)(lbk + ch0 + 4);
        bf16_t* pa = P + (second ? 2 * plane : 0); bf16_t* pb = pa + plane;
#pragma unroll
        for (int ai = 0; ai < 2; ++ai)
#pragma unroll
            for (int m = 0; m < 4; ++m) { const size_t off = (size_t)(row0 + ai * HALF + m * 16) * 1024 + ch0;
                f32x4 a0 = acc[ai][0][m][0], a1 = acc[ai][0][m][1], b0 = acc[ai][1][m][0], b1 = acc[ai][1][m][1];
                if (!second) {
#pragma unroll
                    for (int j = 0; j < 4; ++j) { a0[j] = silu_f(a0[j]); a1[j] = silu_f(a1[j]); b0[j] = l0[j] * sigmoid_f(-b0[j]); b1[j] = l1[j] * sigmoid_f(-b1[j]); }
                } else {
#pragma unroll
                    for (int j = 0; j < 4; ++j) { b0[j] = silu_f(b0[j]); b1[j] = silu_f(b1[j]); }
                }
                *(u32x4*)(pa + off) = pack8(a0, a1); *(u32x4*)(pb + off) = pack8(b0, b1); }
    }
};
struct MoeOrder {
    StaticOrder so; int tile0, nN; int te0, te1, te2, te3, te4, te5, te6;
    __device__ __forceinline__ bool next(int i, Unit& u) const {
        Unit l; if (!so.next(i, l)) return false;
        const int pm = tile0 + l.pm;
        const int e = (pm >= te0) + (pm >= te1) + (pm >= te2) + (pm >= te3) + (pm >= te4) + (pm >= te5) + (pm >= te6);
        u.pm = pm; u.pn = e * nN + l.pn; return true;
    }
    __device__ __forceinline__ void a_ready(const Unit&) const {}
    __device__ __forceinline__ void done(const Unit&) const {}
};

template <class Epi, class Sched, bool ALIGN_EPI = false, bool SP2 = false>
__device__ __forceinline__ void gemm_phase(PG8_LAS unsigned char* lds, const Gemm g, const Sched& S, const Epi& E) {
    const int tid = threadIdx.x, wid = __builtin_amdgcn_readfirstlane(tid >> 6), lane = tid & 63, wr = wid >> 2, wc = wid & 3, fr = lane & 15, fq = lane >> 4;
    const int K = g.K, nt = K / BK;
    unsigned voffA[2], voffB[2];
#pragma unroll
    for (int i = 0; i < 2; ++i) { int R, C; stage_rc(tid * 16 + i * 8192, R, C); const int Rb = Epi::PERM ? ((R & ~31) + perm32(R & 31)) : R;
        voffA[i] = (unsigned)(R * K + C) * 2u; voffB[i] = (unsigned)(Rb * K + C) * 2u; }
    const size_t kstep = (size_t)(BK * 2);
    const size_t hstep = (size_t)HALF * K * 2;
    const size_t tstep = 2 * hstep;
    const unsigned ldsw = (unsigned)wid * 1024u;
    const int aoff = lds_byte(wr * 64 + fr, fq * 8), boff = lds_byte(wc * 32 + fr, fq * 8);
#define PG8_SA(b, h) (((b) * 2 + (h)) * HTB)
#define PG8_SB(b, h) ((4 + (b) * 2 + (h)) * HTB)
#define PG8_STAGE(bufoff, gbase, voff) do { _Pragma("unroll") for (int _i = 0; _i < 2; ++_i) \
        __builtin_amdgcn_global_load_lds((const unsigned*)((const char*)(gbase) + (voff)[_i]), (PG8_LAS unsigned*)(lds + (bufoff) + ldsw + _i * 8192), 16, 0, 0); } while (0)
#define PG8_LDA(dst, b, h) do { _Pragma("unroll") for (int m = 0; m < 4; ++m) _Pragma("unroll") for (int k = 0; k < 2; ++k) dst[m][k] = *(const PG8_LAS bf16x8*)(lds + PG8_SA(b, h) + aoff + m * 2048 + k * 1024); } while (0)
#define PG8_LDB(dst, b, h) do { _Pragma("unroll") for (int n = 0; n < 2; ++n) _Pragma("unroll") for (int k = 0; k < 2; ++k) dst[n][k] = *(const PG8_LAS bf16x8*)(lds + PG8_SB(b, h) + boff + n * 2048 + k * 1024); } while (0)
#define PG8_MMA(ai, bj, At, Bt) do { __builtin_amdgcn_s_setprio(1); _Pragma("unroll") for (int m = 0; m < 4; ++m) _Pragma("unroll") for (int n = 0; n < 2; ++n) _Pragma("unroll") for (int k = 0; k < 2; ++k) \
        acc[ai][bj][m][n] = __builtin_amdgcn_mfma_f32_16x16x32_bf16(Bt[n][k], At[m][k], acc[ai][bj][m][n], 0, 0, 0); __builtin_amdgcn_s_setprio(0); } while (0)
#define PG8_WAIT_V(n) asm volatile("s_waitcnt vmcnt(" #n ")" ::: "memory")
#define PG8_WAIT_L(n) asm volatile("s_waitcnt lgkmcnt(" #n ")" ::: "memory")
#define PG8_BAR __builtin_amdgcn_s_barrier()
#define PG8_SCHED __builtin_amdgcn_sched_barrier(0)
    Unit cur, nxt; int ui = 0;
    if (!S.next(0, cur)) return;
    f32x4 acc[2][2][4][2];
#pragma unroll
    for (int a = 0; a < 2; ++a)
#pragma unroll
        for (int b = 0; b < 2; ++b)
#pragma unroll
            for (int m = 0; m < 4; ++m)
#pragma unroll
                for (int n = 0; n < 2; ++n) acc[a][b][m][n] = (f32x4){0.f, 0.f, 0.f, 0.f};
    bf16x8 At[4][2], B0[2][2], B1[2][2];
    const char* cA = (const char*)g.A + (size_t)cur.pm * tstep; const char* cB = (const char*)g.Bt + (size_t)cur.pn * tstep;
    S.a_ready(cur);
    if constexpr (SP2) {
        PG8_STAGE(PG8_SB(0, 0), cB, voffB); PG8_STAGE(PG8_SB(0, 1), cB + hstep, voffB); PG8_STAGE(PG8_SA(0, 0), cA, voffA); PG8_STAGE(PG8_SA(0, 1), cA + hstep, voffA);
        if (wr == 1) PG8_BAR;
        PG8_WAIT_V(2); PG8_BAR;
        PG8_STAGE(PG8_SB(1, 0), cB + kstep, voffB); PG8_STAGE(PG8_SA(1, 0), cA + kstep, voffA); PG8_STAGE(PG8_SB(1, 1), cB + hstep + kstep, voffB);
        PG8_WAIT_V(6); PG8_BAR;
    } else {
        PG8_STAGE(PG8_SB(0, 0), cB, voffB); PG8_STAGE(PG8_SA(0, 0), cA, voffA); PG8_STAGE(PG8_SB(0, 1), cB + hstep, voffB); PG8_STAGE(PG8_SA(0, 1), cA + hstep, voffA);
        if (wr == 1) PG8_BAR;
        PG8_WAIT_V(4); PG8_BAR;
        PG8_STAGE(PG8_SB(1, 0), cB + kstep, voffB); PG8_STAGE(PG8_SA(1, 0), cA + kstep, voffA); PG8_STAGE(PG8_SB(1, 1), cB + hstep + kstep, voffB);
        PG8_WAIT_V(6); PG8_BAR;
    }
    for (;;) {
        const bool has_next = S.next(ui + 1, nxt);
        const char* nA = has_next ? (const char*)g.A + (size_t)nxt.pm * tstep : cA; const char* nB = has_next ? (const char*)g.Bt + (size_t)nxt.pn * tstep : cB;
        for (int t = 0; t < nt; t += 2) {
            const bool last = (t == nt - 2);
            const char* a1 = cA + (size_t)(t + 1) * kstep;
            const char* a2 = last ? nA : cA + (size_t)(t + 2) * kstep; const char* b2 = last ? nB : cB + (size_t)(t + 2) * kstep;
            const char* a3 = a2 + kstep; const char* b3 = b2 + kstep;
            if (last && has_next) S.a_ready(nxt);
            if constexpr (SP2) {
            PG8_LDB(B0, 0, 0); PG8_LDB(B1, 0, 1); PG8_SCHED; PG8_LDA(At, 0, 0); PG8_STAGE(PG8_SA(1, 1), a1 + hstep, voffA);
            PG8_WAIT_V(8); PG8_WAIT_L(0); PG8_BAR; PG8_MMA(0, 0, At, B0); PG8_MMA(0, 1, At, B1); PG8_BAR; PG8_SCHED;
            PG8_LDA(At, 0, 1); PG8_STAGE(PG8_SB(0, 0), b2, voffB); PG8_STAGE(PG8_SB(0, 1), b2 + hstep, voffB); PG8_STAGE(PG8_SA(0, 0), a2, voffA);
            PG8_WAIT_V(8); PG8_WAIT_L(0); PG8_BAR; PG8_MMA(1, 0, At, B0); PG8_MMA(1, 1, At, B1); PG8_BAR; PG8_SCHED;
            PG8_LDB(B0, 1, 0); PG8_LDB(B1, 1, 1); PG8_SCHED; PG8_LDA(At, 1, 0); PG8_STAGE(PG8_SA(0, 1), a2 + hstep, voffA);
            PG8_WAIT_V(8); PG8_WAIT_L(0); PG8_BAR; PG8_MMA(0, 0, At, B0); PG8_MMA(0, 1, At, B1); PG8_BAR; PG8_SCHED;
            PG8_LDA(At, 1, 1); PG8_STAGE(PG8_SB(1, 0), b3, voffB); PG8_STAGE(PG8_SB(1, 1), b3 + hstep, voffB); PG8_STAGE(PG8_SA(1, 0), a3, voffA);
            PG8_WAIT_V(8); PG8_WAIT_L(0); PG8_BAR; PG8_MMA(1, 0, At, B0); PG8_MMA(1, 1, At, B1); PG8_BAR; PG8_SCHED;
            } else {
            PG8_LDB(B0, 0, 0); PG8_SCHED; PG8_LDA(At, 0, 0); PG8_STAGE(PG8_SA(1, 1), a1 + hstep, voffA);
            PG8_WAIT_L(8); PG8_BAR; PG8_WAIT_L(0); PG8_MMA(0, 0, At, B0); PG8_BAR; PG8_SCHED;
            PG8_LDB(B1, 0, 1); PG8_STAGE(PG8_SB(0, 0), b2, voffB);
            PG8_BAR; PG8_WAIT_L(0); PG8_MMA(0, 1, At, B1); PG8_BAR;
            PG8_LDA(At, 0, 1); PG8_STAGE(PG8_SA(0, 0), a2, voffA);
            PG8_BAR; PG8_WAIT_L(0); PG8_MMA(1, 0, At, B0); PG8_BAR; PG8_SCHED;
            PG8_STAGE(PG8_SB(0, 1), b2 + hstep, voffB);
            PG8_WAIT_V(6); PG8_BAR; PG8_MMA(1, 1, At, B1); PG8_BAR;
            PG8_LDB(B0, 1, 0); PG8_SCHED; PG8_LDA(At, 1, 0); PG8_STAGE(PG8_SA(0, 1), a2 + hstep, voffA);
            PG8_WAIT_L(8); PG8_BAR; PG8_WAIT_L(0); PG8_MMA(0, 0, At, B0); PG8_BAR; PG8_SCHED;
            PG8_LDB(B1, 1, 1); PG8_STAGE(PG8_SB(1, 0), b3, voffB);
            PG8_BAR; PG8_WAIT_L(0); PG8_MMA(0, 1, At, B1); PG8_BAR;
            PG8_LDA(At, 1, 1); PG8_STAGE(PG8_SA(1, 0), a3, voffA);
            PG8_BAR; PG8_WAIT_L(0); PG8_MMA(1, 0, At, B0); PG8_BAR; PG8_SCHED;
            PG8_STAGE(PG8_SB(1, 1), b3 + hstep, voffB);
            PG8_WAIT_V(6); PG8_BAR; PG8_MMA(1, 1, At, B1); PG8_BAR;
            }
        }
        if constexpr (ALIGN_EPI) { if (wr == 0) PG8_BAR; }
        if constexpr (!Epi::AFTER_DRAIN) { E(acc, cur, wr, wc, fr, fq); S.done(cur); }
        if (!has_next) break;
#pragma unroll
        for (int a = 0; a < 2; ++a)
#pragma unroll
            for (int b = 0; b < 2; ++b)
#pragma unroll
                for (int m = 0; m < 4; ++m)
#pragma unroll
                    for (int n = 0; n < 2; ++n) acc[a][b][m][n] = (f32x4){0.f, 0.f, 0.f, 0.f};
        cur = nxt; cA = nA; cB = nB; ++ui;
        if constexpr (ALIGN_EPI) { if (wr == 1) PG8_BAR; }
    }
    PG8_WAIT_V(0);
    if constexpr (!ALIGN_EPI) { if (wr == 0) PG8_BAR; }
    PG8_BAR;
    if constexpr (Epi::AFTER_DRAIN) { E.fused(acc, cur, wr, wc, fr, fq, lds, wid, lane); S.done(cur); }
#undef PG8_SA
#undef PG8_SB
#undef PG8_STAGE
#undef PG8_LDA
#undef PG8_LDB
#undef PG8_MMA
#undef PG8_WAIT_V
#undef PG8_WAIT_L
#undef PG8_BAR
#undef PG8_SCHED
}
}
#ifndef PG8_SP2
#define PG8_SP2 true
#endif
#ifndef PG8_ALIGN
#define PG8_ALIGN true
#endif
constexpr int NWAVES = 8;
constexpr int BATCH = 8, SEQ = 8192, D = 1024, NTOK = BATCH * SEQ;
constexpr int QKV_N = 2304, FF = 3584, NEXP = 8, REC_N = 4096;
constexpr float EPS = 1e-6f;
constexpr int NPH = 22;
#ifndef MK_N_LAUNCHES
#define MK_N_LAUNCHES 1
#endif
constexpr int N_LAUNCHES = MK_N_LAUNCHES;
constexpr size_t MiB = 1u << 20;
constexpr size_t WS_CTL = 0, CTL_ZERO_BYTES = 1 * MiB;
constexpr size_t WS_WMOE_GU = 1 * MiB;
constexpr size_t WS_WMOE_DN = 113 * MiB;
constexpr size_t WS_H = 169 * MiB;
constexpr size_t WS_W_INATT = 297 * MiB;
constexpr size_t WS_W_OUTATT = WS_W_INATT + (size_t)QKV_N * D * 2;
constexpr size_t WS_W_GU = WS_W_OUTATT + (size_t)D * D * 2;
constexpr size_t WS_W_DN = WS_W_GU + (size_t)2 * FF * D * 2;
constexpr size_t WS_W_INREC = WS_W_DN + (size_t)D * FF * 2;
constexpr size_t WS_W_OUTREC = WS_W_INREC + (size_t)REC_N * D * 2;
constexpr size_t WS_BIG = 335 * MiB;
constexpr size_t WS_Y = 297 * MiB;
constexpr size_t WS_HID = 557 * MiB;
constexpr size_t WS_MISC = 1008 * MiB;
constexpr size_t WS_ROPE = WS_MISC;
constexpr size_t WS_META = WS_MISC + 4 * MiB;
constexpr size_t WS_DEST = WS_MISC + 5 * MiB;
constexpr size_t WS_HIST = WS_MISC + 6 * MiB;
constexpr size_t WS_INFO = WS_HIST + 8192;
constexpr size_t WS_LBK = WS_INFO + 256;
constexpr size_t WS_OB = 623 * MiB;
constexpr size_t WS_LSE = 751 * MiB;
constexpr size_t WS_END = 1024 * MiB;
static_assert(WS_W_OUTREC + (size_t)D * D * 2 <= WS_BIG && WS_BIG + 512 * MiB <= WS_MISC && WS_Y + 260 * MiB <= WS_HID && WS_HID + 448 * MiB <= WS_MISC && WS_LBK + 4096 <= WS_END, "d_ws map");
constexpr int CW_BAR = 4096;
constexpr int RING_BYTES = 131072;
constexpr int LDSCTL_OFF = RING_BYTES, MISC_OFF = LDSCTL_OFF + 320;
constexpr int LDS_BYTES = 147456;

#define GAS __attribute__((address_space(1)))
#define LAS __attribute__((address_space(3)))
typedef unsigned short bf16;
typedef unsigned v4u __attribute__((ext_vector_type(4)));
typedef unsigned v2u __attribute__((ext_vector_type(2)));
typedef float f32x4 __attribute__((ext_vector_type(4)));
#define LDS_WAIT() asm volatile("s_waitcnt lgkmcnt(0)" ::: "memory")
__device__ __forceinline__ unsigned f2bf(float f) { unsigned u = __builtin_bit_cast(unsigned, f); return (u + 0x7fffu + ((u >> 16) & 1u)) >> 16; }
__device__ __forceinline__ unsigned pk2(float lo, float hi) { return f2bf(lo) | (f2bf(hi) << 16); }
__device__ __forceinline__ float bflo(unsigned w) { return __builtin_bit_cast(float, w << 16); }
__device__ __forceinline__ float bfhi(unsigned w) { return __builtin_bit_cast(float, w & 0xffff0000u); }
__device__ __forceinline__ float wave_sum(float v) {
#pragma unroll
    for (int o = 1; o < 64; o <<= 1) v += __shfl_xor(v, o);
    return v;
}
#define XB_TMO      128
#define XB_XCNT(j)  (256  + 64 * (j))
#define XB_XSUB(j)  (1280 + 64 * (j))
#define XB_XGEN(j)  (2304 + 64 * (j))
#define XB_TOP      3328
#define XB_TOPGEN   3392
#define XCD_BAR_WORDS 3456
#define XB_SPIN_CAP (1u << 24)

__device__ __forceinline__ unsigned xb_ld(unsigned* p)              { return __hip_atomic_load(p, __ATOMIC_RELAXED, __HIP_MEMORY_SCOPE_AGENT); }
__device__ __forceinline__ unsigned xb_add(unsigned* p, unsigned v) { return __hip_atomic_fetch_add(p, v, __ATOMIC_RELAXED, __HIP_MEMORY_SCOPE_AGENT); }
__device__ __forceinline__ unsigned xb_xcc_id() { return (unsigned)__builtin_amdgcn_s_getreg((3 << 11) | 20) & 0xFu; }
#define XB_SPIN(cond, bar) do { unsigned _sp = 0; while (cond) { __builtin_amdgcn_s_sleep(1); \
    if ((++_sp & 255u) == 0u) { if (xb_ld(&(bar)[XB_TMO])) break; if (_sp > XB_SPIN_CAP) { atomicAdd(&(bar)[XB_TMO], 1u); break; } } } } while (0)

struct XcdBarrier {
    unsigned* bar; unsigned x;
    volatile LAS unsigned* st;
};

__device__ __forceinline__ XcdBarrier xcd_barrier_post(unsigned* bar, volatile LAS unsigned* st) {
    XcdBarrier b; b.bar = bar; b.x = xb_xcc_id(); b.st = st;
    if (threadIdx.x == 0) (void)xb_add(&bar[XB_XCNT(b.x)], 1u);
    return b;
}
__device__ __forceinline__ void xcd_barrier_complete(unsigned* bar, unsigned x, unsigned& nloc, unsigned& nx) {
    const unsigned G = gridDim.x * gridDim.y * gridDim.z;
    unsigned sum, cnt, mine, sp = 0u;
    for (;;) {
        sum = 0u; cnt = 0u; mine = 0u;
#pragma unroll
        for (unsigned j = 0; j < 16; ++j) { const unsigned c = xb_ld(&bar[XB_XCNT(j)]); sum += c; cnt += (c > 0u) ? 1u : 0u; mine = (j == x) ? c : mine; }
        if (sum == G) break;
        __builtin_amdgcn_s_sleep(1);
        if ((++sp & 255u) == 0u) { if (xb_ld(&bar[XB_TMO])) break; if (sp > XB_SPIN_CAP) { atomicAdd(&bar[XB_TMO], 1u); break; } }
    }
    nloc = mine > 0u ? mine : 1u; nx = cnt > 0u ? cnt : 1u;
}

__device__ __forceinline__ void xcd_barrier(const XcdBarrier& b) {
    asm volatile("s_waitcnt vmcnt(0)" ::: "memory");
    __syncthreads();
    if (threadIdx.x == 0) {
        unsigned* bar = b.bar;
        __builtin_amdgcn_s_waitcnt(0);
        unsigned nloc = b.st[0], nx = b.st[1];
        if (nloc == 0u) { xcd_barrier_complete(bar, b.x, nloc, nx); b.st[0] = nloc; b.st[1] = nx; }
        const unsigned old = xb_add(&bar[XB_XSUB(b.x)], 1u);
        const unsigned gen = old / nloc;
        if (old + 1u == (gen + 1u) * nloc) {
            __builtin_amdgcn_fence(__ATOMIC_RELEASE, "agent");
            asm volatile("s_waitcnt vmcnt(0)" ::: "memory");
            const unsigned og = xb_add(&bar[XB_TOP], 1u);
            const unsigned tg = og / nx;
            if (og + 1u == (tg + 1u) * nx) xb_add(&bar[XB_TOPGEN], 1u);
            else XB_SPIN(xb_ld(&bar[XB_TOPGEN]) == tg, bar);
            __builtin_amdgcn_fence(__ATOMIC_ACQUIRE, "agent");
            xb_add(&bar[XB_XGEN(b.x)], 1u);
            asm volatile("s_waitcnt vmcnt(0)" ::: "memory");
        } else {
            XB_SPIN(xb_ld(&bar[XB_XGEN(b.x)]) == gen, bar);
            __builtin_amdgcn_fence(__ATOMIC_ACQUIRE, "agent");
            asm volatile("s_waitcnt vmcnt(0)" ::: "memory");
        }
    }
    __syncthreads();
}
__device__ __forceinline__ void transpose_item(const float* W, int N, bf16* WT, int K, int k0, int n0, int drow0, LAS float* scr, int lane) {
#pragma unroll 8
    for (int i = 0; i < 32; ++i) { const int kk = 2 * i + (lane >> 5); scr[kk * 33 + (lane & 31)] = W[(size_t)(k0 + kk) * N + n0 + (lane & 31)]; }
    LDS_WAIT(); asm volatile("" ::: "memory");
    const int c = lane & 7;
#pragma unroll
    for (int j = 0; j < 4; ++j) { const int n = (lane >> 3) + 8 * j; const LAS float* s = scr + (8 * c) * 33 + n;
        v4u o; o.x = pk2(s[0 * 33], s[1 * 33]); o.y = pk2(s[2 * 33], s[3 * 33]); o.z = pk2(s[4 * 33], s[5 * 33]); o.w = pk2(s[6 * 33], s[7 * 33]);
        *(v4u*)(WT + (size_t)(drow0 + n) * K + k0 + 8 * c) = o; }
    LDS_WAIT(); asm volatile("" ::: "memory");
}
__device__ __forceinline__ int dest_row(int mode, int n0) {
    if (mode == 0) return n0;
    if (mode == 1) return 256 * (n0 >> 7) + (n0 & 127);
    if (mode == 2) return 256 * (n0 >> 7) + 128 + (n0 & 127);
    const int sec = n0 >> 10, c = n0 & 1023, hd = c >> 7, w = c & 127;
    return ((sec >> 1) ? 2048 : 0) + 256 * hd + ((sec & 1) ? 128 : 0) + w;
}
__device__ __forceinline__ void conv_matrix_item(const float* W, int K, int N, bf16* WT, int mode, int r, LAS float* scr, int lane) {
    const int nblk = N / 32, kb = r / nblk, nb = r % nblk;
    transpose_item(W, N, WT, K, 64 * kb, 32 * nb, dest_row(mode, 32 * nb), scr, lane);
}
__device__ __forceinline__ void rms_row_to_bf16(const float* xrow, const float* g, bf16* orow, int lane) {
    const f32x4* xr = (const f32x4*)xrow + lane; const f32x4* gr = (const f32x4*)g + lane;
    f32x4 v[4]; float s = 0.f;
#pragma unroll
    for (int j = 0; j < 4; ++j) { v[j] = xr[64 * j]; s += (v[j].x * v[j].x + v[j].y * v[j].y) + (v[j].z * v[j].z + v[j].w * v[j].w); }
    const float rstd = 1.0f / sqrtf(wave_sum(s) * (1.f / D) + EPS);
    unsigned long long* o8 = (unsigned long long*)orow + lane;
#pragma unroll
    for (int j = 0; j < 4; ++j) { const f32x4 gg = gr[64 * j];
        o8[64 * j] = (unsigned long long)pk2(v[j].x * rstd * gg.x, v[j].y * rstd * gg.y) | ((unsigned long long)pk2(v[j].z * rstd * gg.z, v[j].w * rstd * gg.w) << 32); }
}
__device__ __forceinline__ float inv_freq(int j) {
    return j == 0 ? 1.000000000e+00f : j == 1 ? 1.939227432e-01f : j == 2 ? 3.760603070e-02f : j == 3 ? 7.292664610e-03f : j == 4 ? 1.414213562e-03f : j == 5 ? 2.742481884e-04f : j == 6 ? 5.318295734e-05f : 1.031338525e-05f;
}
struct P0Args { const float *x, *g0, *w_in_attn, *w_out_attn, *w_in_rec, *w_out_rec, *w_gate, *w_up, *w_down, *w_gate_moe, *w_up_moe, *w_down_moe, *rlb; const int* pos; unsigned char* ws; };
__device__ __forceinline__ void phase_prologue(const P0Args& a, LAS unsigned char* lds, int blk, int G, int tid) {
    const int wave = tid >> 6, lane = tid & 63;
    LAS float* scr = (LAS float*)(lds + wave * 16384);
    const int gw = blk * NWAVES + wave, NGW = G * NWAVES;
    unsigned char* ws = a.ws;
    constexpr int I_INATT = 16 * (QKV_N / 32), I_SQ = 16 * 32, I_GU = 16 * (FF / 32), I_DN = (FF / 64) * 32, I_INREC = 16 * (REC_N / 32);
    constexpr int NITEMS = I_INATT + I_SQ + 2 * I_GU + I_DN + I_INREC + I_SQ + NEXP * (2 * I_GU + I_DN);
    for (int it = gw; it < NITEMS; it += NGW) {
        int r = it;
        if (r < I_INATT) { conv_matrix_item(a.w_in_attn, D, QKV_N, (bf16*)(ws + WS_W_INATT), 0, r, scr, lane); continue; } r -= I_INATT;
        if (r < I_SQ) { conv_matrix_item(a.w_out_attn, D, D, (bf16*)(ws + WS_W_OUTATT), 0, r, scr, lane); continue; } r -= I_SQ;
        if (r < I_GU) { conv_matrix_item(a.w_gate, D, FF, (bf16*)(ws + WS_W_GU), 1, r, scr, lane); continue; } r -= I_GU;
        if (r < I_GU) { conv_matrix_item(a.w_up, D, FF, (bf16*)(ws + WS_W_GU), 2, r, scr, lane); continue; } r -= I_GU;
        if (r < I_DN) { conv_matrix_item(a.w_down, FF, D, (bf16*)(ws + WS_W_DN), 0, r, scr, lane); continue; } r -= I_DN;
        if (r < I_INREC) { conv_matrix_item(a.w_in_rec, D, REC_N, (bf16*)(ws + WS_W_INREC), 3, r, scr, lane); continue; } r -= I_INREC;
        if (r < I_SQ) { conv_matrix_item(a.w_out_rec, D, D, (bf16*)(ws + WS_W_OUTREC), 0, r, scr, lane); continue; } r -= I_SQ;
        if (r < NEXP * I_GU) { const int e = r / I_GU, q = r % I_GU; conv_matrix_item(a.w_gate_moe + (size_t)e * D * FF, D, FF, (bf16*)(ws + WS_WMOE_GU) + (size_t)e * 2 * FF * D, 1, q, scr, lane); continue; } r -= NEXP * I_GU;
        if (r < NEXP * I_GU) { const int e = r / I_GU, q = r % I_GU; conv_matrix_item(a.w_up_moe + (size_t)e * D * FF, D, FF, (bf16*)(ws + WS_WMOE_GU) + (size_t)e * 2 * FF * D, 2, q, scr, lane); continue; } r -= NEXP * I_GU;
        { const int e = r / I_DN, q = r % I_DN; conv_matrix_item(a.w_down_moe + (size_t)e * FF * D, FF, D, (bf16*)(ws + WS_WMOE_DN) + (size_t)e * D * FF, 0, q, scr, lane); }
    }
    for (int m = gw; m < NTOK; m += NGW) rms_row_to_bf16(a.x + (size_t)m * D, a.g0, (bf16*)(ws + WS_H) + (size_t)m * D, lane);
    float* rope = (float*)(ws + WS_ROPE);
    for (int i = blk * 512 + tid; i < NTOK * 8; i += G * 512) { const int tok = i >> 3, j = i & 7;
        const float ang = (float)a.pos[tok] * inv_freq(j);
        const double turns = (double)ang * 0.15915494309189533577; const float fr = (float)(turns - __builtin_rint(turns));
        rope[tok * 16 + j] = __builtin_amdgcn_cosf(fr); rope[tok * 16 + 8 + j] = __builtin_amdgcn_sinf(fr); }
    float* lbk = (float*)(ws + WS_LBK);
    for (int i = blk * 512 + tid; i < 1024; i += G * 512) lbk[i] = 1.0f / (1.0f + __expf(a.rlb[1024 + i] - a.rlb[i]));
}
__device__ __forceinline__ void phase_rope(bf16* qkv, const float* rope, int blk, int G, int tid) {
    for (int i = blk * 512 + tid; i < NTOK * 26; i += G * 512) {
        const int tok = i / 26, hx = i % 26;
        const int col = hx < 8 ? hx * 64 : hx < 16 ? 512 + (hx - 8) * 64 : hx < 24 ? 1536 + (hx - 16) * 64 : 2048 + (hx - 24) * 64;
        v4u* p = (v4u*)(qkv + (size_t)tok * QKV_N + col);
        const v4u a = p[0], b = p[1];
        const f32x4* t = (const f32x4*)(rope + (size_t)tok * 16);
        const f32x4 c0 = t[0], c1 = t[1], s0 = t[2], s1 = t[3];
        const float x1[8] = {bflo(a.x), bfhi(a.x), bflo(a.y), bfhi(a.y), bflo(a.z), bfhi(a.z), bflo(a.w), bfhi(a.w)};
        const float x2[8] = {bflo(b.x), bfhi(b.x), bflo(b.y), bfhi(b.y), bflo(b.z), bfhi(b.z), bflo(b.w), bfhi(b.w)};
        const float cs[8] = {c0.x, c0.y, c0.z, c0.w, c1.x, c1.y, c1.z, c1.w}, sn[8] = {s0.x, s0.y, s0.z, s0.w, s1.x, s1.y, s1.z, s1.w};
        float y1[8], y2[8];
#pragma unroll
        for (int j = 0; j < 8; ++j) { y1[j] = x1[j] * cs[j] - x2[j] * sn[j]; y2[j] = x2[j] * cs[j] + x1[j] * sn[j]; }
        v4u oa, ob; oa.x = pk2(y1[0], y1[1]); oa.y = pk2(y1[2], y1[3]); oa.z = pk2(y1[4], y1[5]); oa.w = pk2(y1[6], y1[7]);
        ob.x = pk2(y2[0], y2[1]); ob.y = pk2(y2[2], y2[3]); ob.z = pk2(y2[4], y2[5]); ob.w = pk2(y2[6], y2[7]);
        p[0] = oa; p[1] = ob;
    }
}
__device__ __forceinline__ void attn_key(const bf16* krow, const bf16* vrow, const float (&q)[64], float (&o)[64], float& m, float& l) {
    float s = 0.f;
#pragma unroll
    for (int c = 0; c < 8; ++c) { const v4u kv = *(const v4u*)(krow + 8 * c);
        s += q[8 * c + 0] * bflo(kv.x) + q[8 * c + 1] * bfhi(kv.x) + q[8 * c + 2] * bflo(kv.y) + q[8 * c + 3] * bfhi(kv.y)
           + q[8 * c + 4] * bflo(kv.z) + q[8 * c + 5] * bfhi(kv.z) + q[8 * c + 6] * bflo(kv.w) + q[8 * c + 7] * bfhi(kv.w); }
    s *= 0.125f;
    const float mn = fmaxf(m, s), sc = __expf(m - mn), p = __expf(s - mn);
    l = l * sc + p; m = mn;
#pragma unroll
    for (int c = 0; c < 8; ++c) { const v4u vv = *(const v4u*)(vrow + 8 * c);
        o[8 * c + 0] = o[8 * c + 0] * sc + p * bflo(vv.x); o[8 * c + 1] = o[8 * c + 1] * sc + p * bfhi(vv.x);
        o[8 * c + 2] = o[8 * c + 2] * sc + p * bflo(vv.y); o[8 * c + 3] = o[8 * c + 3] * sc + p * bfhi(vv.y);
        o[8 * c + 4] = o[8 * c + 4] * sc + p * bflo(vv.z); o[8 * c + 5] = o[8 * c + 5] * sc + p * bfhi(vv.z);
        o[8 * c + 6] = o[8 * c + 6] * sc + p * bflo(vv.w); o[8 * c + 7] = o[8 * c + 7] * sc + p * bfhi(vv.w); }
}
__device__ __forceinline__ void phase_attn_naive(const bf16* qkv, const float* sinks, bf16* mix, int blk, int G, int tid) {
    for (int idx = blk * 512 + tid; idx < NTOK * 16; idx += G * 512) {
        const int hx = idx >> 16, tok = idx & 65535, b = tok >> 13, s = tok & 8191;
        const bool isB = hx >= 8; const int qh = hx - 8;
        const int qcol = isB ? 1536 + qh * 64 : hx * 64, kcol = isB ? 2048 + (qh >> 2) * 64 : 512 + hx * 64, vcol = isB ? 2176 + (qh >> 2) * 64 : 1024 + hx * 64, ocol = isB ? 512 + qh * 64 : hx * 64;
        float q[64], o[64]; float m = -INFINITY, l = 0.f;
        { const bf16* qp = qkv + (size_t)tok * QKV_N + qcol;
#pragma unroll
          for (int c = 0; c < 8; ++c) { const v4u w = *(const v4u*)(qp + 8 * c); q[8 * c] = bflo(w.x); q[8 * c + 1] = bfhi(w.x); q[8 * c + 2] = bflo(w.y); q[8 * c + 3] = bfhi(w.y); q[8 * c + 4] = bflo(w.z); q[8 * c + 5] = bfhi(w.z); q[8 * c + 6] = bflo(w.w); q[8 * c + 7] = bfhi(w.w); } }
#pragma unroll
        for (int i = 0; i < 64; ++i) o[i] = 0.f;
        const bf16* rb = qkv + (size_t)(b * SEQ) * QKV_N;
        if (!isB) {
            for (int jj = 0; jj < 387; ++jj) { const int d = jj < 129 ? 1 : jj < 258 ? 4 : 16, j = jj < 129 ? jj : jj < 258 ? jj - 129 : jj - 258;
                const int kt = s - d * j; if (kt < 0) continue;
                const bf16* r = rb + (size_t)kt * QKV_N; attn_key(r + kcol, r + vcol, q, o, m, l); }
        } else {
            for (int j = 0; j < 128; ++j) { const int kt = s - j; if (kt < 0) break;
                const bf16* r = rb + (size_t)kt * QKV_N; attn_key(r + kcol, r + vcol, q, o, m, l); }
            const float sk = sinks[qh]; const float mn = fmaxf(m, sk), sc = __expf(m - mn);
            l = l * sc + __expf(sk - mn); m = mn;
#pragma unroll
            for (int i = 0; i < 64; ++i) o[i] *= sc;
        }
        const float rl = 1.0f / l;
        v4u* op = (v4u*)(mix + (size_t)tok * D + ocol);
#pragma unroll
        for (int c = 0; c < 8; ++c) { v4u w; w.x = pk2(o[8 * c] * rl, o[8 * c + 1] * rl); w.y = pk2(o[8 * c + 2] * rl, o[8 * c + 3] * rl); w.z = pk2(o[8 * c + 4] * rl, o[8 * c + 5] * rl); w.w = pk2(o[8 * c + 6] * rl, o[8 * c + 7] * rl); op[c] = w; }
    }
}
__device__ __forceinline__ void phase_norm(const float* x, const float* g, bf16* out, int blk, int G, int tid) {
    const int wave = tid >> 6, lane = tid & 63;
    for (int m = blk * NWAVES + wave; m < NTOK; m += G * NWAVES) rms_row_to_bf16(x + (size_t)m * D, g, out + (size_t)m * D, lane);
}
typedef float f32x16 __attribute__((ext_vector_type(16)));
typedef short bf16x8v __attribute__((ext_vector_type(8)));
typedef short s16x4 __attribute__((ext_vector_type(4)));
typedef short v4i16_t __attribute__((ext_vector_type(4)));
__device__ __forceinline__ int crow(int r, int hi) { return (r & 3) + 8 * (r >> 2) + 4 * hi; }
__device__ __forceinline__ s16x4 vtr(const LAS unsigned char* p) { return __builtin_bit_cast(s16x4, __builtin_amdgcn_ds_read_tr16_b64_v4i16((LAS v4i16_t*)p)); }
struct AttnSub { int b, dstride, r, P0, qcol, kcol, vcol, mode, hx; };
__device__ __forceinline__ void attn_subunit(const AttnSub su, const bf16* qkv, const float* sinks, bf16* mix, bf16* OB, float* LSE, LAS unsigned char* lh, int t256, int hw, int lane) {
    const int r32 = lane & 31, hi = lane >> 5;
    const size_t rowb = (size_t)su.b * SEQ;
    {
        const int c = t256 & 7, k0 = t256 >> 3;
        v4u kreg[8], vreg[8];
#pragma unroll
        for (int i = 0; i < 8; ++i) { const int key = k0 + 32 * i, pos = su.P0 - 128 + key;
            if (pos >= 0) { const bf16* rp = qkv + (rowb + su.r + (size_t)su.dstride * pos) * QKV_N; kreg[i] = *(const v4u*)(rp + su.kcol + 8 * c); vreg[i] = *(const v4u*)(rp + su.vcol + 8 * c); }
            else { kreg[i] = (v4u){0u, 0u, 0u, 0u}; vreg[i] = kreg[i]; } }
#pragma unroll
        for (int i = 0; i < 8; ++i) { const int key = k0 + 32 * i;
            *(LAS v4u*)(lh + key * 128 + ((c ^ (key & 7)) * 16)) = kreg[i];
            *(LAS v4u*)(lh + 32768 + (c >> 2) * 16384 + key * 64 + (c & 3) * 16) = vreg[i]; }
    }
    const int qpos = su.P0 + 32 * hw + r32;
    const size_t qrow = rowb + su.r + (size_t)su.dstride * qpos;
    bf16x8v qf[4];
#pragma unroll
    for (int ks = 0; ks < 4; ++ks) qf[ks] = *(const bf16x8v*)(qkv + qrow * QKV_N + su.qcol + 16 * ks + 8 * hi);
    __syncthreads();
    f32x16 oT[2]; oT[0] = (f32x16){}; oT[1] = (f32x16){};
    float m = -1e30f, l = 0.f;
    const float C = 0.125f * 1.4426950408889634f;
    const int mlo = (su.mode == 3) ? 1 : 0;
    int kt = hw; if (su.P0 == 0 && kt < 4) kt = 4;
    for (; kt <= hw + 4; ++kt) {
        f32x16 s = (f32x16){};
        const LAS unsigned char* kb = lh + (32 * kt + r32) * 128; const int sw = r32 & 7;
#pragma unroll
        for (int ks = 0; ks < 4; ++ks) { const bf16x8v kf = *(const LAS bf16x8v*)(kb + (((2 * ks + hi) ^ sw) * 16)); s = __builtin_amdgcn_mfma_f32_32x32x16_bf16(kf, qf[ks], s, 0, 0, 0); }
        if (kt == hw) {
#pragma unroll
            for (int r = 0; r < 16; ++r) if (crow(r, hi) < r32 + mlo) s[r] = -INFINITY; }
        if (kt == hw + 4) {
#pragma unroll
            for (int r = 0; r < 16; ++r) if (crow(r, hi) > r32) s[r] = -INFINITY; }
        float mx = s[0];
#pragma unroll
        for (int r = 1; r < 16; ++r) mx = fmaxf(mx, s[r]);
        mx = fmaxf(mx, __shfl_xor(mx, 32));
        const float mn = fmaxf(m, mx), alpha = __builtin_amdgcn_exp2f((m - mn) * C);
        float ls = 0.f; f32x16 p;
#pragma unroll
        for (int r = 0; r < 16; ++r) { p[r] = __builtin_amdgcn_exp2f((s[r] - mn) * C); ls += p[r]; }
        l = l * alpha + ls; m = mn;
#pragma unroll
        for (int r = 0; r < 16; ++r) { oT[0][r] *= alpha; oT[1][r] *= alpha; }
        v4u pw0, pw1;
        pw0.x = pk2(p[0], p[1]); pw0.y = pk2(p[2], p[3]); pw0.z = pk2(p[4], p[5]); pw0.w = pk2(p[6], p[7]);
        pw1.x = pk2(p[8], p[9]); pw1.y = pk2(p[10], p[11]); pw1.z = pk2(p[12], p[13]); pw1.w = pk2(p[14], p[15]);
        const bf16x8v pa0 = __builtin_bit_cast(bf16x8v, pw0), pa1 = __builtin_bit_cast(bf16x8v, pw1);
        const LAS unsigned char* vb = lh + 32768 + (32 * kt + 4 * hi + ((lane & 15) >> 2)) * 64 + ((lane >> 4) & 1) * 32 + (lane & 3) * 8;
#pragma unroll
        for (int dt = 0; dt < 2; ++dt) {
            const s16x4 a0 = vtr(vb + dt * 16384), a1 = vtr(vb + dt * 16384 + 512), b0 = vtr(vb + dt * 16384 + 1024), b1 = vtr(vb + dt * 16384 + 1536);
            const bf16x8v vf0 = (bf16x8v){a0[0], a0[1], a0[2], a0[3], a1[0], a1[1], a1[2], a1[3]}, vf1 = (bf16x8v){b0[0], b0[1], b0[2], b0[3], b1[0], b1[1], b1[2], b1[3]};
            oT[dt] = __builtin_amdgcn_mfma_f32_32x32x16_bf16(vf0, pa0, oT[dt], 0, 0, 0);
            oT[dt] = __builtin_amdgcn_mfma_f32_32x32x16_bf16(vf1, pa1, oT[dt], 0, 0, 0);
        }
    }
    float lt = l + __shfl_xor(l, 32);
    if (su.mode == 3) { const float sraw = 8.0f * sinks[su.hx]; const float mn = fmaxf(m, sraw), alpha = __builtin_amdgcn_exp2f((m - mn) * C);
        lt = lt * alpha + __builtin_amdgcn_exp2f((sraw - mn) * C); m = mn;
#pragma unroll
        for (int r = 0; r < 16; ++r) { oT[0][r] *= alpha; oT[1][r] *= alpha; } }
    const float inv = 1.0f / lt;
    if (su.mode < 2) {
        bf16* ob = OB + (size_t)su.mode * NTOK * 512 + qrow * 512 + su.hx * 64;
#pragma unroll
        for (int dt = 0; dt < 2; ++dt)
#pragma unroll
            for (int g = 0; g < 4; ++g) { v2u w; w.x = pk2(oT[dt][4 * g] * inv, oT[dt][4 * g + 1] * inv); w.y = pk2(oT[dt][4 * g + 2] * inv, oT[dt][4 * g + 3] * inv); *(v2u*)(ob + 32 * dt + 8 * g + 4 * hi) = w; }
        if (hi == 0) LSE[(size_t)su.mode * NTOK * 8 + qrow * 8 + su.hx] = 0.125f * m + __logf(lt);
    } else if (su.mode == 2) {
        const float l3 = 0.125f * m + __logf(lt), l1 = LSE[qrow * 8 + su.hx], l2 = LSE[(size_t)NTOK * 8 + qrow * 8 + su.hx];
        const float M = fmaxf(l3, fmaxf(l1, l2)); float w1 = __expf(l1 - M), w2 = __expf(l2 - M), w3 = __expf(l3 - M);
        const float ws = 1.0f / (w1 + w2 + w3); w1 *= ws; w2 *= ws; w3 *= ws * inv;
        const bf16* o1 = OB + qrow * 512 + su.hx * 64; const bf16* o2 = o1 + (size_t)NTOK * 512;
        bf16* mp = mix + qrow * D + su.hx * 64;
#pragma unroll
        for (int dt = 0; dt < 2; ++dt)
#pragma unroll
            for (int g = 0; g < 4; ++g) { const int dd = 32 * dt + 8 * g + 4 * hi; const v2u a = *(const v2u*)(o1 + dd), b = *(const v2u*)(o2 + dd);
                v2u w; w.x = pk2(w1 * bflo(a.x) + w2 * bflo(b.x) + w3 * oT[dt][4 * g], w1 * bfhi(a.x) + w2 * bfhi(b.x) + w3 * oT[dt][4 * g + 1]);
                w.y = pk2(w1 * bflo(a.y) + w2 * bflo(b.y) + w3 * oT[dt][4 * g + 2], w1 * bfhi(a.y) + w2 * bfhi(b.y) + w3 * oT[dt][4 * g + 3]); *(v2u*)(mp + dd) = w; }
    } else {
        bf16* mp = mix + qrow * D + 512 + su.hx * 64;
#pragma unroll
        for (int dt = 0; dt < 2; ++dt)
#pragma unroll
            for (int g = 0; g < 4; ++g) { v2u w; w.x = pk2(oT[dt][4 * g] * inv, oT[dt][4 * g + 1] * inv); w.y = pk2(oT[dt][4 * g + 2] * inv, oT[dt][4 * g + 3] * inv); *(v2u*)(mp + 32 * dt + 8 * g + 4 * hi) = w; }
    }
    asm volatile("s_waitcnt vmcnt(0)" ::: "memory");
    __syncthreads();
}
__device__ __forceinline__ void phase_attn(const bf16* qkv, const float* sinks, bf16* mix, bf16* OB, float* LSE, LAS unsigned char* lds, int blk, int G, int tid) {
    const int wave = tid >> 6, lane = tid & 63, hf = wave >> 2, hw = wave & 3, t256 = tid & 255;
    LAS unsigned char* lh = lds + hf * 65536;
    for (int ai = blk; ai < 256; ai += G) {
        const int b = ai >> 5, h = (ai >> 2) & 7, T0 = (ai & 3) * 2048;
        for (int pp = 0; pp < 24; ++pp) {
            const int su = 2 * pp + hf, br = su >> 4, k = su & 15;
            AttnSub s; s.b = b; s.hx = h; s.qcol = h * 64; s.kcol = 512 + h * 64; s.vcol = 1024 + h * 64; s.mode = br;
            if (br == 0) { s.dstride = 1; s.r = 0; s.P0 = T0 + 128 * k; }
            else if (br == 1) { s.dstride = 4; s.r = k >> 2; s.P0 = (T0 >> 2) + 128 * (k & 3); }
            else { s.dstride = 16; s.r = k; s.P0 = T0 >> 4; }
            attn_subunit(s, qkv, sinks, mix, OB, LSE, lh, t256, hw, lane);
        }
    }
    for (int bp = blk; bp < 2048; bp += G) {
        const int b = bp >> 8, nb = (bp >> 2) & 63, kv = (bp >> 1) & 1, qh = kv * 4 + 2 * (bp & 1) + hf;
        AttnSub s; s.b = b; s.hx = qh; s.qcol = 1536 + qh * 64; s.kcol = 2048 + kv * 64; s.vcol = 2176 + kv * 64; s.mode = 3; s.dstride = 1; s.r = 0; s.P0 = 128 * nb;
        attn_subunit(s, qkv, sinks, mix, OB, LSE, lh, t256, hw, lane);
    }
}
__device__ __forceinline__ void phase_hgrn_naive(const bf16* Qp, const bf16* Kp, const bf16* Vp, bf16* Oraw, LAS unsigned char* lds, int blk, int G, int tid) {
    LAS float* sq = (LAS float*)lds; LAS float* sk = sq + 2048; LAS float* sf = sk + 2048; LAS float* sv = sf + 2048; LAS float* part = sv + 2048;
    const int v = tid & 127, kq = tid >> 7;
    const int lr = tid >> 5, lc = (tid & 31) * 4;
    for (int bh = blk; bh < BATCH * 8; bh += G) {
        const int b = bh >> 3, h = bh & 7;
        float S[32];
#pragma unroll
        for (int i = 0; i < 32; ++i) S[i] = 0.f;
        for (int t0 = 0; t0 < SEQ; t0 += 16) {
            const size_t base = (size_t)(b * SEQ + t0 + lr) * D + h * 128 + lc;
            { const v2u w = *(const v2u*)(Qp + base); *(LAS f32x4*)(sq + lr * 128 + lc) = (f32x4){bflo(w.x), bfhi(w.x), bflo(w.y), bfhi(w.y)}; }
            { const v2u w = *(const v2u*)(Kp + base); const f32x4 kk = (f32x4){bflo(w.x), bfhi(w.x), bflo(w.y), bfhi(w.y)}; *(LAS f32x4*)(sk + lr * 128 + lc) = kk; *(LAS f32x4*)(sf + lr * 128 + lc) = (f32x4){1.f - kk.x, 1.f - kk.y, 1.f - kk.z, 1.f - kk.w}; }
            { const v2u w = *(const v2u*)(Vp + base); *(LAS f32x4*)(sv + lr * 128 + lc) = (f32x4){bflo(w.x), bfhi(w.x), bflo(w.y), bfhi(w.y)}; }
            __syncthreads();
            for (int t = 0; t < 16; ++t) {
                const float vt = sv[t * 128 + v]; float po = 0.f;
#pragma unroll
                for (int i4 = 0; i4 < 8; ++i4) { const int kx = t * 128 + kq * 32 + i4 * 4;
                    const f32x4 q4 = *(const LAS f32x4*)(sq + kx), k4 = *(const LAS f32x4*)(sk + kx), f4 = *(const LAS f32x4*)(sf + kx);
#pragma unroll
                    for (int j = 0; j < 4; ++j) { S[i4 * 4 + j] = f4[j] * S[i4 * 4 + j] + k4[j] * vt; po += q4[j] * S[i4 * 4 + j]; } }
                part[(t * 4 + kq) * 128 + v] = po;
            }
            __syncthreads();
            { const f32x4 p0 = *(const LAS f32x4*)(part + (lr * 4 + 0) * 128 + lc), p1 = *(const LAS f32x4*)(part + (lr * 4 + 1) * 128 + lc), p2 = *(const LAS f32x4*)(part + (lr * 4 + 2) * 128 + lc), p3 = *(const LAS f32x4*)(part + (lr * 4 + 3) * 128 + lc);
              const f32x4 r = (p0 + p1) + (p2 + p3); v2u w; w.x = pk2(r.x, r.y); w.y = pk2(r.z, r.w); *(v2u*)(Oraw + base) = w; }
        }
        __syncthreads();
    }
}
__device__ __forceinline__ void phase_gate(bf16* O, const bf16* Gp, const float* norm_g, int blk, int G, int tid) {
    const int wave = tid >> 6, lane = tid & 63;
    for (int m = blk * NWAVES + wave; m < NTOK; m += G * NWAVES) {
        v4u* op = (v4u*)(O + (size_t)m * D + lane * 16); const v4u* gp = (const v4u*)(Gp + (size_t)m * D + lane * 16);
        const v4u a = op[0], b = op[1], ga = gp[0], gb = gp[1];
        float x[16] = {bflo(a.x), bfhi(a.x), bflo(a.y), bfhi(a.y), bflo(a.z), bfhi(a.z), bflo(a.w), bfhi(a.w), bflo(b.x), bfhi(b.x), bflo(b.y), bfhi(b.y), bflo(b.z), bfhi(b.z), bflo(b.w), bfhi(b.w)};
        const float gg[16] = {bflo(ga.x), bfhi(ga.x), bflo(ga.y), bfhi(ga.y), bflo(ga.z), bfhi(ga.z), bflo(ga.w), bfhi(ga.w), bflo(gb.x), bfhi(gb.x), bflo(gb.y), bfhi(gb.y), bflo(gb.z), bfhi(gb.z), bflo(gb.w), bfhi(gb.w)};
        float ss = 0.f;
#pragma unroll
        for (int i = 0; i < 16; ++i) ss += x[i] * x[i];
        ss += __shfl_xor(ss, 1); ss += __shfl_xor(ss, 2); ss += __shfl_xor(ss, 4);
        const float rstd = 1.0f / sqrtf(ss * (1.f / 128.f) + EPS);
        const f32x4* ng = (const f32x4*)(norm_g + lane * 16);
        float y[16];
#pragma unroll
        for (int i4 = 0; i4 < 4; ++i4) { const f32x4 n4 = ng[i4];
#pragma unroll
            for (int j = 0; j < 4; ++j) y[i4 * 4 + j] = x[i4 * 4 + j] * rstd * n4[j] * gg[i4 * 4 + j]; }
        v4u oa, ob; oa.x = pk2(y[0], y[1]); oa.y = pk2(y[2], y[3]); oa.z = pk2(y[4], y[5]); oa.w = pk2(y[6], y[7]);
        ob.x = pk2(y[8], y[9]); ob.y = pk2(y[10], y[11]); ob.z = pk2(y[12], y[13]); ob.w = pk2(y[14], y[15]);
        op[0] = oa; op[1] = ob;
    }
}
__device__ __forceinline__ void phase_router(const float* x, const float* g, const float* w_router, int4* meta, int* hist, LAS unsigned char* lds, int blk, int G, int tid) {
    const int wave = tid >> 6, lane = tid & 63;
    LAS float* swr = (LAS float*)lds;
    LAS int* scnt = (LAS int*)(lds + 32768);
    for (int i = tid; i < 8192; i += 512) swr[i] = w_router[i];
    __syncthreads();
    for (int tb = blk; tb < 256; tb += G) {
        if (tid < 8) scnt[tid] = 0;
        __syncthreads();
        int c0 = 0, c1 = 0, c2 = 0, c3 = 0, c4 = 0, c5 = 0, c6 = 0, c7 = 0;
        for (int i = 0; i < 32; ++i) {
            const int tok = tb * 256 + wave * 32 + i;
            const f32x4* xr = (const f32x4*)(x + (size_t)tok * D) + lane; const f32x4* gr = (const f32x4*)g + lane;
            f32x4 v[4]; float s = 0.f;
#pragma unroll
            for (int j = 0; j < 4; ++j) { v[j] = xr[64 * j]; s += (v[j].x * v[j].x + v[j].y * v[j].y) + (v[j].z * v[j].z + v[j].w * v[j].w); }
            const float rstd = 1.0f / sqrtf(wave_sum(s) * (1.f / D) + EPS);
            float lg[8] = {0.f, 0.f, 0.f, 0.f, 0.f, 0.f, 0.f, 0.f};
#pragma unroll
            for (int j = 0; j < 4; ++j) { const f32x4 gg = gr[64 * j];
#pragma unroll
                for (int c = 0; c < 4; ++c) { const float hv = v[j][c] * rstd * gg[c]; const int d = 256 * j + 4 * lane + c;
                    const f32x4 w0 = *(const LAS f32x4*)(swr + d * 8), w1 = *(const LAS f32x4*)(swr + d * 8 + 4);
                    lg[0] += hv * w0.x; lg[1] += hv * w0.y; lg[2] += hv * w0.z; lg[3] += hv * w0.w; lg[4] += hv * w1.x; lg[5] += hv * w1.y; lg[6] += hv * w1.z; lg[7] += hv * w1.w; } }
#pragma unroll
            for (int e = 0; e < 8; ++e) lg[e] = wave_sum(lg[e]);
            int e0 = 0; float v0 = lg[0];
#pragma unroll
            for (int e = 1; e < 8; ++e) if (lg[e] > v0) { v0 = lg[e]; e0 = e; }
            int e1 = -1; float v1 = -INFINITY;
#pragma unroll
            for (int e = 0; e < 8; ++e) if (e != e0 && lg[e] > v1) { v1 = lg[e]; e1 = e; }
            const float g1 = 1.0f / (1.0f + __expf(v0 - v1)), g0 = 1.0f - g1;
            if (lane == 0) meta[tok] = make_int4(e0, e1, __builtin_bit_cast(int, g0), __builtin_bit_cast(int, g1));
            c0 += (e0 == 0) + (e1 == 0); c1 += (e0 == 1) + (e1 == 1); c2 += (e0 == 2) + (e1 == 2); c3 += (e0 == 3) + (e1 == 3);
            c4 += (e0 == 4) + (e1 == 4); c5 += (e0 == 5) + (e1 == 5); c6 += (e0 == 6) + (e1 == 6); c7 += (e0 == 7) + (e1 == 7);
        }
        if (lane == 0) { const int cc[8] = {c0, c1, c2, c3, c4, c5, c6, c7};
#pragma unroll
            for (int e = 0; e < 8; ++e) __hip_atomic_fetch_add(&scnt[e], cc[e], __ATOMIC_RELAXED, __HIP_MEMORY_SCOPE_WORKGROUP); }
        __syncthreads();
        if (tid < 8) hist[tb * 8 + tid] = scnt[tid];
        __syncthreads();
    }
}
__device__ __forceinline__ void phase_scatter(const float* x, const float* g, const int4* meta, const int* hist, int* dest, int* info, bf16* perm, LAS unsigned char* lds, int blk, int G, int tid) {
    const int wave = tid >> 6, lane = tid & 63;
    LAS int* shist = (LAS int*)lds;
    LAS int* ssize = shist + 2048; LAS int* sbpre = ssize + 8; LAS int* spst = sbpre + 8; LAS int* sntl = spst + 8;
    LAS int* se = sntl + 8; LAS int* sdest = se + 512;
    for (int tb = blk; tb < 256; tb += G) {
        for (int i = tid; i < 2048; i += 512) shist[i] = hist[i];
        __syncthreads();
        if (tid < 8) { int sz = 0, bp = 0; for (int b = 0; b < 256; ++b) { const int hv = shist[b * 8 + tid]; sz += hv; bp += (b < tb) ? hv : 0; } ssize[tid] = sz; sbpre[tid] = bp; }
        __syncthreads();
        if (tid == 0) { int ts = 0; for (int e = 0; e < 8; ++e) { const int nt = (ssize[e] + 255) >> 8; spst[e] = ts * 256; sntl[e] = nt; ts += nt; if (tb == 0) info[e] = ts; } if (tb == 0) info[8] = ts; }
        { const int4 mt = meta[tb * 256 + (tid >> 1)]; se[tid] = (tid & 1) ? mt.y : mt.x; }
        __syncthreads();
        { const int e = se[tid]; int rank = 0; for (int p = 0; p < tid; ++p) rank += (se[p] == e) ? 1 : 0;
          const int dd = spst[e] + sbpre[e] + rank; sdest[tid] = dd; dest[(tb * 256) * 2 + tid] = dd; }
        __syncthreads();
        for (int i = 0; i < 32; ++i) { const int lt = wave * 32 + i, tok = tb * 256 + lt;
            const f32x4* xr = (const f32x4*)(x + (size_t)tok * D) + lane; const f32x4* gr = (const f32x4*)g + lane;
            f32x4 v[4]; float s = 0.f;
#pragma unroll
            for (int j = 0; j < 4; ++j) { v[j] = xr[64 * j]; s += (v[j].x * v[j].x + v[j].y * v[j].y) + (v[j].z * v[j].z + v[j].w * v[j].w); }
            const float rstd = 1.0f / sqrtf(wave_sum(s) * (1.f / D) + EPS);
            unsigned long long* o0 = (unsigned long long*)(perm + (size_t)sdest[2 * lt] * D) + lane; unsigned long long* o1 = (unsigned long long*)(perm + (size_t)sdest[2 * lt + 1] * D) + lane;
#pragma unroll
            for (int j = 0; j < 4; ++j) { const f32x4 gg = gr[64 * j];
                const unsigned long long w = (unsigned long long)pk2(v[j].x * rstd * gg.x, v[j].y * rstd * gg.y) | ((unsigned long long)pk2(v[j].z * rstd * gg.z, v[j].w * rstd * gg.w) << 32);
                o0[64 * j] = w; o1[64 * j] = w; } }
        if (tb < 8) { const int r0 = spst[tb] + ssize[tb], r1 = spst[tb] + sntl[tb] * 256;
            for (int r = r0 + wave; r < r1; r += NWAVES) { unsigned long long* o = (unsigned long long*)(perm + (size_t)r * D) + lane;
#pragma unroll
                for (int j = 0; j < 4; ++j) o[64 * j] = 0ull; } }
        __syncthreads();
    }
}
__device__ __forceinline__ void phase_combine(float* x, const bf16* y, const int4* meta, const int* dest, const float* gf, int blk, int G, int tid) {
    const int wave = tid >> 6, lane = tid & 63;
    for (int m = blk * NWAVES + wave; m < NTOK; m += G * NWAVES) {
        const int4 mt = meta[m]; const float g0 = __builtin_bit_cast(float, mt.z), g1 = __builtin_bit_cast(float, mt.w);
        const int d0 = dest[2 * m], d1 = dest[2 * m + 1];
        f32x4* xr = (f32x4*)(x + (size_t)m * D) + lane; const f32x4* gr = (const f32x4*)gf + lane;
        const v2u* y0 = (const v2u*)(y + (size_t)d0 * D) + lane; const v2u* y1 = (const v2u*)(y + (size_t)d1 * D) + lane;
        f32x4 v[4]; float s = 0.f;
#pragma unroll
        for (int j = 0; j < 4; ++j) { const v2u a = y0[64 * j], b = y1[64 * j]; f32x4 t = xr[64 * j];
            t.x += g0 * bflo(a.x) + g1 * bflo(b.x); t.y += g0 * bfhi(a.x) + g1 * bfhi(b.x); t.z += g0 * bflo(a.y) + g1 * bflo(b.y); t.w += g0 * bfhi(a.y) + g1 * bfhi(b.y);
            v[j] = t; s += (t.x * t.x + t.y * t.y) + (t.z * t.z + t.w * t.w); }
        const float rstd = 1.0f / sqrtf(wave_sum(s) * (1.f / D) + EPS);
#pragma unroll
        for (int j = 0; j < 4; ++j) { const f32x4 gg = gr[64 * j]; xr[64 * j] = (f32x4){v[j].x * rstd * gg.x, v[j].y * rstd * gg.y, v[j].z * rstd * gg.z, v[j].w * rstd * gg.w}; }
    }
}
struct Args { const void* in[19]; float* out; unsigned char* ws; int ph_lo, ph_hi; };
__global__ void __launch_bounds__(NWAVES * 64, 2) fwd(Args args) {
    extern __shared__ __attribute__((aligned(16))) unsigned char lds_raw[];
    LAS unsigned char* lds = (LAS unsigned char*)lds_raw;
    volatile LAS unsigned* MISC = (volatile LAS unsigned*)(lds + MISC_OFF);
    const int tid = threadIdx.x, G = gridDim.x, blk = blockIdx.x;
    unsigned char* ws = args.ws;
    unsigned* ctl = (unsigned*)(ws + WS_CTL);
    for (int u = tid; u < (LDS_BYTES - LDSCTL_OFF) / 4; u += NWAVES * 64) ((LAS unsigned*)(lds + LDSCTL_OFF))[u] = 0u;
    __syncthreads();
    XcdBarrier bar; bar.bar = ctl + CW_BAR; bar.x = 0; bar.st = nullptr;
    if (N_LAUNCHES == 1) bar = xcd_barrier_post(ctl + CW_BAR, MISC + 8);
#define GRID_BAR() do { if (N_LAUNCHES == 1) xcd_barrier(bar); } while (0)
    const int lo = args.ph_lo, hi = args.ph_hi;
#define IN(k) (lo <= (k) && (k) < hi)
#define BOTH(k) (IN(k) && IN((k) + 1))
    const float* x = (const float*)args.in[0]; const int* positions = (const int*)args.in[1];
    const float* g_mix = (const float*)args.in[2]; const float* g_ffn = (const float*)args.in[3]; const float* g_final = (const float*)args.in[4];
    const float* sinks = (const float*)args.in[7]; const float* rec_norm_g = (const float*)args.in[10]; const float* w_router = (const float*)args.in[15];
    float* out = args.out;
    bf16* H = (bf16*)(ws + WS_H); bf16* BIG = (bf16*)(ws + WS_BIG);
    const size_t PLANE = (size_t)NTOK * D;

    if (IN(0)) {
        P0Args pa; pa.x = x; pa.g0 = g_mix; pa.w_in_attn = (const float*)args.in[5]; pa.w_out_attn = (const float*)args.in[6]; pa.w_in_rec = (const float*)args.in[8]; pa.w_out_rec = (const float*)args.in[11];
        pa.w_gate = (const float*)args.in[12]; pa.w_up = (const float*)args.in[13]; pa.w_down = (const float*)args.in[14]; pa.w_gate_moe = (const float*)args.in[16]; pa.w_up_moe = (const float*)args.in[17]; pa.w_down_moe = (const float*)args.in[18];
        pa.rlb = (const float*)args.in[9]; pa.pos = positions; pa.ws = ws;
        phase_prologue(pa, lds, blk, G, tid);
        if (BOTH(0)) GRID_BAR();
    }
    if (IN(1)) {
        pg8::Gemm g{H, (const bf16*)(ws + WS_W_INATT), NTOK, QKV_N, D}; pg8::StaticOrder S; S.init(NTOK, QKV_N, G, blk);
        pg8::EpiBf16Plain E{BIG, QKV_N, 1 << 20};
        pg8::gemm_phase<pg8::EpiBf16Plain, pg8::StaticOrder, PG8_ALIGN, PG8_SP2>(lds, g, S, E);
        if (BOTH(1)) GRID_BAR();
    }
    if (IN(2)) { phase_rope(BIG, (const float*)(ws + WS_ROPE), blk, G, tid); if (BOTH(2)) GRID_BAR(); }
    if (IN(3)) { phase_attn(BIG, sinks, H, (bf16*)(ws + WS_OB), (float*)(ws + WS_LSE), lds, blk, G, tid); if (BOTH(3)) GRID_BAR(); }
    if (IN(4)) {
        pg8::Gemm g{H, (const bf16*)(ws + WS_W_OUTATT), NTOK, D, D}; pg8::StaticOrder S; S.init(NTOK, D, G, blk);
        pg8::EpiRes E{x, out, D};
        pg8::gemm_phase<pg8::EpiRes, pg8::StaticOrder, PG8_ALIGN, PG8_SP2>(lds, g, S, E);
        if (BOTH(4)) GRID_BAR();
    }
    if (IN(5)) { phase_norm(out, g_ffn, H, blk, G, tid); if (BOTH(5)) GRID_BAR(); }
    if (IN(6)) {
        pg8::Gemm g{H, (const bf16*)(ws + WS_W_GU), NTOK, 2 * FF, D}; pg8::StaticOrder S; S.init(NTOK, 2 * FF, G, blk);
        pg8::EpiSwiglu E{BIG, FF, 1 << 20, 0};
        pg8::gemm_phase<pg8::EpiSwiglu, pg8::StaticOrder, PG8_ALIGN, PG8_SP2>(lds, g, S, E);
        if (BOTH(6)) GRID_BAR();
    }
    if (IN(7)) {
        pg8::Gemm g{BIG, (const bf16*)(ws + WS_W_DN), NTOK, D, FF}; pg8::StaticOrder S; S.init(NTOK, D, G, blk);
        pg8::EpiRes E{out, out, D};
        pg8::gemm_phase<pg8::EpiRes, pg8::StaticOrder, PG8_ALIGN, PG8_SP2>(lds, g, S, E);
        if (BOTH(7)) GRID_BAR();
    }
    if (IN(8)) { phase_norm(out, g_mix + D, H, blk, G, tid); if (BOTH(8)) GRID_BAR(); }
    if (IN(9)) {
        pg8::Gemm g{H, (const bf16*)(ws + WS_W_INREC), NTOK, REC_N, D}; pg8::StaticOrder S; S.init(NTOK, REC_N, G, blk);
        pg8::EpiRec E{BIG, PLANE, (const float*)(ws + WS_LBK)};
        pg8::gemm_phase<pg8::EpiRec, pg8::StaticOrder, PG8_ALIGN, PG8_SP2>(lds, g, S, E);
        if (BOTH(9)) GRID_BAR();
    }
    if (IN(10)) { phase_hgrn_naive(BIG, BIG + PLANE, BIG + 2 * PLANE, H, lds, blk, G, tid); if (BOTH(10)) GRID_BAR(); }
    if (IN(11)) { phase_gate(H, BIG + 3 * PLANE, rec_norm_g, blk, G, tid); if (BOTH(11)) GRID_BAR(); }
    if (IN(12)) {
        pg8::Gemm g{H, (const bf16*)(ws + WS_W_OUTREC), NTOK, D, D}; pg8::StaticOrder S; S.init(NTOK, D, G, blk);
        pg8::EpiRes E{out, out, D};
        pg8::gemm_phase<pg8::EpiRes, pg8::StaticOrder, PG8_ALIGN, PG8_SP2>(lds, g, S, E);
        if (BOTH(12)) GRID_BAR();
    }
    int4* meta = (int4*)(ws + WS_META); int* hist = (int*)(ws + WS_HIST); int* dest = (int*)(ws + WS_DEST); int* info = (int*)(ws + WS_INFO);
    bf16* Y = (bf16*)(ws + WS_Y); bf16* HID = (bf16*)(ws + WS_HID);
    if (IN(13)) { phase_router(out, g_ffn + D, w_router, meta, hist, lds, blk, G, tid); if (BOTH(13)) GRID_BAR(); }
    if (IN(14)) { phase_scatter(out, g_ffn + D, meta, hist, dest, info, Y, lds, blk, G, tid); if (BOTH(14)) GRID_BAR(); }
    for (int c = 0; c < 3; ++c) {
        if (IN(15 + 2 * c) || IN(16 + 2 * c)) {
            const int T = info[8]; const int tile0 = 256 * c; int ntl = T - tile0; ntl = ntl > 256 ? 256 : ntl; ntl = ntl < 0 ? 0 : ntl;
            pg8::MoeOrder S; S.tile0 = tile0; S.te0 = info[0]; S.te1 = info[1]; S.te2 = info[2]; S.te3 = info[3]; S.te4 = info[4]; S.te5 = info[5]; S.te6 = info[6];
            if (IN(15 + 2 * c)) {
                S.nN = 28; S.so.init(ntl * 256, 2 * FF, G, blk);
                pg8::Gemm g{Y, (const bf16*)(ws + WS_WMOE_GU), 0, 0, D};
                pg8::EpiSwiglu E{HID, FF, 28, tile0};
                pg8::gemm_phase<pg8::EpiSwiglu, pg8::MoeOrder, PG8_ALIGN, PG8_SP2>(lds, g, S, E);
                if (BOTH(15 + 2 * c)) GRID_BAR();
            }
            if (IN(16 + 2 * c)) {
                S.nN = 4; S.so.init(ntl * 256, D, G, blk);
                pg8::Gemm g{HID - (size_t)tile0 * 256 * FF, (const bf16*)(ws + WS_WMOE_DN), 0, 0, FF};
                pg8::EpiBf16Plain E{Y, D, 4};
                pg8::gemm_phase<pg8::EpiBf16Plain, pg8::MoeOrder, PG8_ALIGN, PG8_SP2>(lds, g, S, E);
                if (BOTH(16 + 2 * c)) GRID_BAR();
            }
        }
    }
    if (IN(21)) phase_combine(out, Y, meta, dest, g_final, blk, G, tid);
#undef IN
#undef BOTH
}

extern "C" void kernel_launch(void* const* d_in, const int* in_sizes, int n_in, void* d_out, int out_size, void* d_ws, size_t ws_size, hipStream_t stream) {
    static int grid = 0;
    if (grid == 0) {
        if (n_in != 19 || in_sizes[0] != NTOK * D || out_size != NTOK * D || ws_size < WS_END) { fprintf(stderr, "kernel_launch: unexpected shapes / workspace (n_in %d, ws %zu); nothing launched\n", n_in, ws_size); grid = -1; return; }
        int dev = 0, cus = 0, per_cu = 0;
        if (hipGetDevice(&dev) != hipSuccess || hipDeviceGetAttribute(&cus, hipDeviceAttributeMultiprocessorCount, dev) != hipSuccess) { grid = -1; return; }
        if (hipFuncSetAttribute((const void*)fwd, hipFuncAttributeMaxDynamicSharedMemorySize, LDS_BYTES) != hipSuccess) { fprintf(stderr, "kernel_launch: hipFuncSetAttribute failed\n"); grid = -1; return; }
        if (hipOccupancyMaxActiveBlocksPerMultiprocessor(&per_cu, (const void*)fwd, NWAVES * 64, LDS_BYTES) != hipSuccess || per_cu < 1) fprintf(stderr, "kernel_launch: occupancy query says %d\n", per_cu);
        (void)hipGetLastError();
        grid = cus;
    }
    if (grid < 0) return;
    if (hipMemsetAsync((char*)d_ws + WS_CTL, 0, CTL_ZERO_BYTES, stream) != hipSuccess) return;
    Args a{};
    for (int i = 0; i < 19; ++i) a.in[i] = d_in[i];
    a.out = (float*)d_out; a.ws = (unsigned char*)d_ws;
    if (N_LAUNCHES == 1) { a.ph_lo = 0; a.ph_hi = NPH; hipLaunchKernelGGL(fwd, dim3(grid), dim3(NWAVES * 64), LDS_BYTES, stream, a); }
    else for (int li = 0; li < NPH; ++li) { a.ph_lo = li; a.ph_hi = li + 1; hipLaunchKernelGGL(fwd, dim3(grid), dim3(NWAVES * 64), LDS_BYTES, stream, a); }
}
```

```cpp
#include <hip/hip_runtime.h>
#include <cstdio>
#include <cstdint>
namespace pg8 {
#define PG8_LAS __attribute__((address_space(3)))
typedef unsigned short bf16_t;
typedef short bf16x8 __attribute__((ext_vector_type(8)));
typedef float f32x4 __attribute__((ext_vector_type(4)));
typedef unsigned u32x4 __attribute__((ext_vector_type(4)));
constexpr int BM = 256, BK = 64, HALF = 128, HTB = HALF * BK * 2  , STAGE_BYTES = 8 * HTB, NXCD = 8, WGM = 8;

__host__ __device__ __forceinline__ int lds_byte(int r, int c) { const int st = (r >> 4) * 2 + (c >> 5), rr = r & 15, cc = c & 31, ob = rr * 64 + cc * 2; return st * 1024 + (ob ^ (((ob >> 9) & 1) << 5)); }
__host__ __device__ __forceinline__ void stage_rc(int b, int& R, int& C) { const int st = b / 1024, sb = b % 1024, swz = sb ^ (((sb >> 9) & 1) << 5); R = (st >> 1) * 16 + swz / 64; C = (st & 1) * 32 + (swz % 64) / 2; }
__host__ __device__ __forceinline__ int perm32(int rho) { const int n = rho >> 4, i = rho & 15; return 8 * (i >> 2) + 4 * n + (i & 3); }

struct Unit { int pm, pn; };
struct Gemm { const bf16_t* A; const bf16_t* Bt; int M, N, K; };

struct StaticOrder {
    int nM, nN, nwg, G, c;
    __host__ __device__ void init(int M, int N, int G_, int c_) { nM = M / BM; nN = N / BM; nwg = nM * nN; G = G_; c = c_; }
    __host__ __device__ bool next(int i, Unit& u) const {
        const long L = (long)i * G + c; if (L >= nwg) return false;
        int wgid = (int)L; { const int q = nwg / NXCD, r = nwg % NXCD, xcd = wgid % NXCD, off = wgid / NXCD; wgid = (xcd < r ? xcd * (q + 1) : r * (q + 1) + (xcd - r) * q) + off; }
        const int nig = WGM * nN, gid = wgid / nig, fm = gid * WGM, gsz = (nM - fm) < WGM ? (nM - fm) : WGM;
        u.pm = fm + ((wgid % nig) % gsz); u.pn = (wgid % nig) / gsz; return true;
    }
    __device__ __forceinline__ void a_ready(const Unit&) const {}
    __device__ __forceinline__ void done(const Unit&) const {}
};
__device__ __forceinline__ unsigned cvt_pk_bf16(float lo, float hi) { unsigned r; asm volatile("v_cvt_pk_bf16_f32 %0, %1, %2" : "=v"(r) : "v"(lo), "v"(hi)); return r; }
__device__ __forceinline__ float sigmoid_f(float x) { return __builtin_amdgcn_rcpf(1.0f + __builtin_amdgcn_exp2f(-1.44269504089f * x)); }
__device__ __forceinline__ float silu_f(float x) { return x * sigmoid_f(x); }
__device__ __forceinline__ u32x4 pack8(const f32x4& v0, const f32x4& v1) { u32x4 w; w.x = cvt_pk_bf16(v0[0], v0[1]); w.y = cvt_pk_bf16(v0[2], v0[3]); w.z = cvt_pk_bf16(v1[0], v1[1]); w.w = cvt_pk_bf16(v1[2], v1[3]); return w; }
struct EpiBf16Plain {
    static constexpr bool PERM = true, AFTER_DRAIN = false;
    bf16_t* O; int ldc; int nmod;
    __device__ __forceinline__ void operator()(const f32x4 (&acc)[2][2][4][2], const Unit& u, int wr, int wc, int fr, int fq) const {
        const int row0 = u.pm * BM + wr * 64 + fr; const int col0 = (u.pn % nmod) * BM + wc * 32 + 8 * fq;
#pragma unroll
        for (int ai = 0; ai < 2; ++ai)
#pragma unroll
            for (int m = 0; m < 4; ++m) { bf16_t* rowp = O + (size_t)(row0 + ai * HALF + m * 16) * ldc + col0;
#pragma unroll
                for (int bj = 0; bj < 2; ++bj) *(u32x4*)(rowp + bj * HALF) = pack8(acc[ai][bj][m][0], acc[ai][bj][m][1]); }
    }
};
struct EpiRes {
    static constexpr bool PERM = false, AFTER_DRAIN = false;
    const float* base; float* out; int ldc;
    __device__ __forceinline__ void operator()(const f32x4 (&acc)[2][2][4][2], const Unit& u, int wr, int wc, int fr, int fq) const {
        const int row0 = u.pm * BM + wr * 64 + fr, col0 = u.pn * BM + wc * 32 + 4 * fq;
#pragma unroll
        for (int ai = 0; ai < 2; ++ai)
#pragma unroll
            for (int m = 0; m < 4; ++m) { const size_t off = (size_t)(row0 + ai * HALF + m * 16) * ldc + col0;
#pragma unroll
                for (int bj = 0; bj < 2; ++bj)
#pragma unroll
                    for (int n = 0; n < 2; ++n) { const f32x4 bs = *(const f32x4*)(base + off + bj * HALF + n * 16); *(f32x4*)(out + off + bj * HALF + n * 16) = bs + acc[ai][bj][m][n]; }
                asm volatile("" ::: "memory"); }
    }
};
struct EpiSwiglu {
    static constexpr bool PERM = true, AFTER_DRAIN = false;
    bf16_t* O; int ldc; int nN; int tile0;
    __device__ __forceinline__ void operator()(const f32x4 (&acc)[2][2][4][2], const Unit& u, int wr, int wc, int fr, int fq) const {
        const int row0 = (u.pm - tile0) * BM + wr * 64 + fr; const int col0 = (u.pn % nN) * HALF + wc * 32 + 8 * fq;
#pragma unroll
        for (int ai = 0; ai < 2; ++ai)
#pragma unroll
            for (int m = 0; m < 4; ++m) { bf16_t* rowp = O + (size_t)(row0 + ai * HALF + m * 16) * ldc + col0;
                f32x4 h0, h1;
#pragma unroll
                for (int j = 0; j < 4; ++j) { h0[j] = silu_f(acc[ai][0][m][0][j]) * acc[ai][1][m][0][j]; h1[j] = silu_f(acc[ai][0][m][1][j]) * acc[ai][1][m][1][j]; }
                *(u32x4*)rowp = pack8(h0, h1); }
    }
};
struct EpiRec {
    static constexpr bool PERM = true, AFTER_DRAIN = false;
    bf16_t* P; size_t plane; const float* lbk;
    __device__ __forceinline__ void operator()(const f32x4 (&acc)[2][2][4][2], const Unit& u, int wr, int wc, int fr, int fq) const {
        const int hd = u.pn & 7; const bool second = (u.pn >> 3) != 0;
        const int row0 = u.pm * BM + wr * 64 + fr; const int ch0 = hd * HALF + wc * 32 + 8 * fq;
        const f32x4 l0 = *(const f32x4*)(lbk + ch0), l1 = *(const f32x4*)(lbk + ch0 + 4);
        bf16_t* pa = P + (second ? 2 * plane : 0); bf16_t* pb = pa + plane;
#pragma unroll
        for (int ai = 0; ai < 2; ++ai)
#pragma unroll
            for (int m = 0; m < 4; ++m) { const size_t off = (size_t)(row0 + ai * HALF + m * 16) * 1024 + ch0;
                f32x4 a0 = acc[ai][0][m][0], a1 = acc[ai][0][m][1], b0 = acc[ai][1][m][0], b1 = acc[ai][1][m][1];
                if (!second) {
#pragma unroll
                    for (int j = 0; j < 4; ++j) { a0[j] = silu_f(a0[j]); a1[j] = silu_f(a1[j]); b0[j] = l0[j] * sigmoid_f(-b0[j]); b1[j] = l1[j] * sigmoid_f(-b1[j]); }
                } else {
#pragma unroll
                    for (int j = 0; j < 4; ++j) { b0[j] = silu_f(b0[j]); b1[j] = silu_f(b1[j]); }
                }
                *(u32x4*)(pa + off) = pack8(a0, a1); *(u32x4*)(pb + off) = pack8(b0, b1); }
    }
};
struct MoeOrder {
    StaticOrder so; int tile0, nN; int te0, te1, te2, te3, te4, te5, te6;
    __device__ __forceinline__ bool next(int i, Unit& u) const {
        Unit l; if (!so.next(i, l)) return false;
        const int pm = tile0 + l.pm;
        const int e = (pm >= te0) + (pm >= te1) + (pm >= te2) + (pm >= te3) + (pm >= te4) + (pm >= te5) + (pm >= te6);
        u.pm = pm; u.pn = e * nN + l.pn; return true;
    }
    __device__ __forceinline__ void a_ready(const Unit&) const {}
    __device__ __forceinline__ void done(const Unit&) const {}
};

template <int CTRL> __device__ __forceinline__ float dpp0(float v) { return __builtin_bit_cast(float, __builtin_amdgcn_update_dpp(0, __builtin_bit_cast(int, v), CTRL, 0xf, 0xf, true)); }
typedef unsigned u32x2 __attribute__((ext_vector_type(2)));
struct EpiRec2 {
    static constexpr bool PERM = true, AFTER_DRAIN = false;
    bf16_t* P; size_t plane; const float* lbk; float* DK;
    __device__ __forceinline__ void operator()(const f32x4 (&acc)[2][2][4][2], const Unit& u, int wr, int wc, int fr, int fq) const {
        const int hd = u.pn & 7; const bool second = (u.pn >> 3) != 0;
        const int row0 = u.pm * BM + wr * 64 + fr; const int ch0 = hd * HALF + wc * 32 + 8 * fq;
        if (second) {
#pragma unroll
            for (int ai = 0; ai < 2; ++ai)
#pragma unroll
                for (int m = 0; m < 4; ++m) { const size_t off = (size_t)(row0 + ai * HALF + m * 16) * 1024 + ch0;
                    f32x4 b0 = acc[ai][1][m][0], b1 = acc[ai][1][m][1];
#pragma unroll
                    for (int j = 0; j < 4; ++j) { b0[j] = silu_f(b0[j]); b1[j] = silu_f(b1[j]); }
                    *(u32x4*)(P + 3 * plane + off) = pack8(acc[ai][0][m][0], acc[ai][0][m][1]); *(u32x4*)(P + 4 * plane + off) = pack8(b0, b1); }
        } else {
            const int lane15 = (fq * 16 + fr) | 15;
#pragma unroll
            for (int ai = 0; ai < 2; ++ai)
#pragma unroll
                for (int n = 0; n < 2; ++n) {
                    const f32x4 lbv = *(const f32x4*)(lbk + ch0 + 4 * n);
                    float kk[4][4], bb[4][4];
#pragma unroll
                    for (int m = 0; m < 4; ++m)
#pragma unroll
                        for (int j = 0; j < 4; ++j) { const float k_ = lbv[j] * sigmoid_f(-acc[ai][1][m][n][j]); kk[m][j] = k_; float x = __logf(1.0f - k_);
                            x += dpp0<0x111>(x); x += dpp0<0x112>(x); x += dpp0<0x114>(x); x += dpp0<0x118>(x); bb[m][j] = x; }
                    float run[4] = {0.f, 0.f, 0.f, 0.f};
#pragma unroll
                    for (int m = 0; m < 4; ++m)
#pragma unroll
                        for (int j = 0; j < 4; ++j) { const float tot = __shfl(bb[m][j], lane15); bb[m][j] += run[j]; run[j] += tot; }
#pragma unroll
                    for (int m = 0; m < 4; ++m) { const size_t off = (size_t)(row0 + ai * HALF + m * 16) * 1024 + ch0 + 4 * n;
                        float qe[4], ki[4], ke[4];
#pragma unroll
                        for (int j = 0; j < 4; ++j) { const float bt = bb[m][j]; qe[j] = silu_f(acc[ai][0][m][n][j]) * __expf(bt); ki[j] = kk[m][j] * __expf(fminf(-bt, 80.f)); ke[j] = kk[m][j] * __expf(run[j] - bt); }
                        u32x2 w; w.x = cvt_pk_bf16(qe[0], qe[1]); w.y = cvt_pk_bf16(qe[2], qe[3]); *(u32x2*)(P + off) = w;
                        w.x = cvt_pk_bf16(ki[0], ki[1]); w.y = cvt_pk_bf16(ki[2], ki[3]); *(u32x2*)(P + plane + off) = w;
                        w.x = cvt_pk_bf16(ke[0], ke[1]); w.y = cvt_pk_bf16(ke[2], ke[3]); *(u32x2*)(P + 2 * plane + off) = w; }
                    if (fr == 0) { const int chunk = 4 * u.pm + 2 * ai + wr; *(f32x4*)(DK + (size_t)chunk * 1024 + ch0 + 4 * n) = (f32x4){__expf(run[0]), __expf(run[1]), __expf(run[2]), __expf(run[3])}; }
                }
        }
    }
};
template <class Epi, class Sched, bool ALIGN_EPI = false, bool SP2 = false>
__device__ __forceinline__ void gemm_phase(PG8_LAS unsigned char* lds, const Gemm g, const Sched& S, const Epi& E) {
    const int tid = threadIdx.x, wid = __builtin_amdgcn_readfirstlane(tid >> 6), lane = tid & 63, wr = wid >> 2, wc = wid & 3, fr = lane & 15, fq = lane >> 4;
    const int K = g.K, nt = K / BK;
    unsigned voffA[2], voffB[2];
#pragma unroll
    for (int i = 0; i < 2; ++i) { int R, C; stage_rc(tid * 16 + i * 8192, R, C); const int Rb = Epi::PERM ? ((R & ~31) + perm32(R & 31)) : R;
        voffA[i] = (unsigned)(R * K + C) * 2u; voffB[i] = (unsigned)(Rb * K + C) * 2u; }
    const size_t kstep = (size_t)(BK * 2);
    const size_t hstep = (size_t)HALF * K * 2;
    const size_t tstep = 2 * hstep;
    const unsigned ldsw = (unsigned)wid * 1024u;
    const int aoff = lds_byte(wr * 64 + fr, fq * 8), boff = lds_byte(wc * 32 + fr, fq * 8);
#define PG8_SA(b, h) (((b) * 2 + (h)) * HTB)
#define PG8_SB(b, h) ((4 + (b) * 2 + (h)) * HTB)
#define PG8_STAGE(bufoff, gbase, voff) do { _Pragma("unroll") for (int _i = 0; _i < 2; ++_i) \
        __builtin_amdgcn_global_load_lds((const unsigned*)((const char*)(gbase) + (voff)[_i]), (PG8_LAS unsigned*)(lds + (bufoff) + ldsw + _i * 8192), 16, 0, 0); } while (0)
#define PG8_LDA(dst, b, h) do { _Pragma("unroll") for (int m = 0; m < 4; ++m) _Pragma("unroll") for (int k = 0; k < 2; ++k) dst[m][k] = *(const PG8_LAS bf16x8*)(lds + PG8_SA(b, h) + aoff + m * 2048 + k * 1024); } while (0)
#define PG8_LDB(dst, b, h) do { _Pragma("unroll") for (int n = 0; n < 2; ++n) _Pragma("unroll") for (int k = 0; k < 2; ++k) dst[n][k] = *(const PG8_LAS bf16x8*)(lds + PG8_SB(b, h) + boff + n * 2048 + k * 1024); } while (0)
#define PG8_MMA(ai, bj, At, Bt) do { __builtin_amdgcn_s_setprio(1); _Pragma("unroll") for (int m = 0; m < 4; ++m) _Pragma("unroll") for (int n = 0; n < 2; ++n) _Pragma("unroll") for (int k = 0; k < 2; ++k) \
        acc[ai][bj][m][n] = __builtin_amdgcn_mfma_f32_16x16x32_bf16(Bt[n][k], At[m][k], acc[ai][bj][m][n], 0, 0, 0); __builtin_amdgcn_s_setprio(0); } while (0)
#define PG8_WAIT_V(n) asm volatile("s_waitcnt vmcnt(" #n ")" ::: "memory")
#define PG8_WAIT_L(n) asm volatile("s_waitcnt lgkmcnt(" #n ")" ::: "memory")
#define PG8_BAR __builtin_amdgcn_s_barrier()
#define PG8_SCHED __builtin_amdgcn_sched_barrier(0)
    Unit cur, nxt; int ui = 0;
    if (!S.next(0, cur)) return;
    f32x4 acc[2][2][4][2];
#pragma unroll
    for (int a = 0; a < 2; ++a)
#pragma unroll
        for (int b = 0; b < 2; ++b)
#pragma unroll
            for (int m = 0; m < 4; ++m)
#pragma unroll
                for (int n = 0; n < 2; ++n) acc[a][b][m][n] = (f32x4){0.f, 0.f, 0.f, 0.f};
    bf16x8 At[4][2], B0[2][2], B1[2][2];
    const char* cA = (const char*)g.A + (size_t)cur.pm * tstep; const char* cB = (const char*)g.Bt + (size_t)cur.pn * tstep;
    S.a_ready(cur);
    if constexpr (SP2) {
        PG8_STAGE(PG8_SB(0, 0), cB, voffB); PG8_STAGE(PG8_SB(0, 1), cB + hstep, voffB); PG8_STAGE(PG8_SA(0, 0), cA, voffA); PG8_STAGE(PG8_SA(0, 1), cA + hstep, voffA);
        if (wr == 1) PG8_BAR;
        PG8_WAIT_V(2); PG8_BAR;
        PG8_STAGE(PG8_SB(1, 0), cB + kstep, voffB); PG8_STAGE(PG8_SA(1, 0), cA + kstep, voffA); PG8_STAGE(PG8_SB(1, 1), cB + hstep + kstep, voffB);
        PG8_WAIT_V(6); PG8_BAR;
    } else {
        PG8_STAGE(PG8_SB(0, 0), cB, voffB); PG8_STAGE(PG8_SA(0, 0), cA, voffA); PG8_STAGE(PG8_SB(0, 1), cB + hstep, voffB); PG8_STAGE(PG8_SA(0, 1), cA + hstep, voffA);
        if (wr == 1) PG8_BAR;
        PG8_WAIT_V(4); PG8_BAR;
        PG8_STAGE(PG8_SB(1, 0), cB + kstep, voffB); PG8_STAGE(PG8_SA(1, 0), cA + kstep, voffA); PG8_STAGE(PG8_SB(1, 1), cB + hstep + kstep, voffB);
        PG8_WAIT_V(6); PG8_BAR;
    }
    for (;;) {
        const bool has_next = S.next(ui + 1, nxt);
        const char* nA = has_next ? (const char*)g.A + (size_t)nxt.pm * tstep : cA; const char* nB = has_next ? (const char*)g.Bt + (size_t)nxt.pn * tstep : cB;
        for (int t = 0; t < nt; t += 2) {
            const bool last = (t == nt - 2);
            const char* a1 = cA + (size_t)(t + 1) * kstep;
            const char* a2 = last ? nA : cA + (size_t)(t + 2) * kstep; const char* b2 = last ? nB : cB + (size_t)(t + 2) * kstep;
            const char* a3 = a2 + kstep; const char* b3 = b2 + kstep;
            if (last && has_next) S.a_ready(nxt);
            if constexpr (SP2) {
            PG8_LDB(B0, 0, 0); PG8_LDB(B1, 0, 1); PG8_SCHED; PG8_LDA(At, 0, 0); PG8_STAGE(PG8_SA(1, 1), a1 + hstep, voffA);
            PG8_WAIT_V(8); PG8_WAIT_L(0); PG8_BAR; PG8_MMA(0, 0, At, B0); PG8_MMA(0, 1, At, B1); PG8_BAR; PG8_SCHED;
            PG8_LDA(At, 0, 1); PG8_STAGE(PG8_SB(0, 0), b2, voffB); PG8_STAGE(PG8_SB(0, 1), b2 + hstep, voffB); PG8_STAGE(PG8_SA(0, 0), a2, voffA);
            PG8_WAIT_V(8); PG8_WAIT_L(0); PG8_BAR; PG8_MMA(1, 0, At, B0); PG8_MMA(1, 1, At, B1); PG8_BAR; PG8_SCHED;
            PG8_LDB(B0, 1, 0); PG8_LDB(B1, 1, 1); PG8_SCHED; PG8_LDA(At, 1, 0); PG8_STAGE(PG8_SA(0, 1), a2 + hstep, voffA);
            PG8_WAIT_V(8); PG8_WAIT_L(0); PG8_BAR; PG8_MMA(0, 0, At, B0); PG8_MMA(0, 1, At, B1); PG8_BAR; PG8_SCHED;
            PG8_LDA(At, 1, 1); PG8_STAGE(PG8_SB(1, 0), b3, voffB); PG8_STAGE(PG8_SB(1, 1), b3 + hstep, voffB); PG8_STAGE(PG8_SA(1, 0), a3, voffA);
            PG8_WAIT_V(8); PG8_WAIT_L(0); PG8_BAR; PG8_MMA(1, 0, At, B0); PG8_MMA(1, 1, At, B1); PG8_BAR; PG8_SCHED;
            } else {
            PG8_LDB(B0, 0, 0); PG8_SCHED; PG8_LDA(At, 0, 0); PG8_STAGE(PG8_SA(1, 1), a1 + hstep, voffA);
            PG8_WAIT_L(8); PG8_BAR; PG8_WAIT_L(0); PG8_MMA(0, 0, At, B0); PG8_BAR; PG8_SCHED;
            PG8_LDB(B1, 0, 1); PG8_STAGE(PG8_SB(0, 0), b2, voffB);
            PG8_BAR; PG8_WAIT_L(0); PG8_MMA(0, 1, At, B1); PG8_BAR;
            PG8_LDA(At, 0, 1); PG8_STAGE(PG8_SA(0, 0), a2, voffA);
            PG8_BAR; PG8_WAIT_L(0); PG8_MMA(1, 0, At, B0); PG8_BAR; PG8_SCHED;
            PG8_STAGE(PG8_SB(0, 1), b2 + hstep, voffB);
            PG8_WAIT_V(6); PG8_BAR; PG8_MMA(1, 1, At, B1); PG8_BAR;
            PG8_LDB(B0, 1, 0); PG8_SCHED; PG8_LDA(At, 1, 0); PG8_STAGE(PG8_SA(0, 1), a2 + hstep, voffA);
            PG8_WAIT_L(8); PG8_BAR; PG8_WAIT_L(0); PG8_MMA(0, 0, At, B0); PG8_BAR; PG8_SCHED;
            PG8_LDB(B1, 1, 1); PG8_STAGE(PG8_SB(1, 0), b3, voffB);
            PG8_BAR; PG8_WAIT_L(0); PG8_MMA(0, 1, At, B1); PG8_BAR;
            PG8_LDA(At, 1, 1); PG8_STAGE(PG8_SA(1, 0), a3, voffA);
            PG8_BAR; PG8_WAIT_L(0); PG8_MMA(1, 0, At, B0); PG8_BAR; PG8_SCHED;
            PG8_STAGE(PG8_SB(1, 1), b3 + hstep, voffB);
            PG8_WAIT_V(6); PG8_BAR; PG8_MMA(1, 1, At, B1); PG8_BAR;
            }
        }
        if constexpr (ALIGN_EPI) { if (wr == 0) PG8_BAR; }
        if constexpr (!Epi::AFTER_DRAIN) { E(acc, cur, wr, wc, fr, fq); S.done(cur); }
        if (!has_next) break;
#pragma unroll
        for (int a = 0; a < 2; ++a)
#pragma unroll
            for (int b = 0; b < 2; ++b)
#pragma unroll
                for (int m = 0; m < 4; ++m)
#pragma unroll
                    for (int n = 0; n < 2; ++n) acc[a][b][m][n] = (f32x4){0.f, 0.f, 0.f, 0.f};
        cur = nxt; cA = nA; cB = nB; ++ui;
        if constexpr (ALIGN_EPI) { if (wr == 1) PG8_BAR; }
    }
    PG8_WAIT_V(0);
    if constexpr (!ALIGN_EPI) { if (wr == 0) PG8_BAR; }
    PG8_BAR;
    if constexpr (Epi::AFTER_DRAIN) { E.fused(acc, cur, wr, wc, fr, fq, lds, wid, lane); S.done(cur); }
#undef PG8_SA
#undef PG8_SB
#undef PG8_STAGE
#undef PG8_LDA
#undef PG8_LDB
#undef PG8_MMA
#undef PG8_WAIT_V
#undef PG8_WAIT_L
#undef PG8_BAR
#undef PG8_SCHED
}
}
#ifndef PG8_SP2
#define PG8_SP2 true
#endif
#ifndef PG8_ALIGN
#define PG8_ALIGN true
#endif
constexpr int NWAVES = 8;
constexpr int BATCH = 8, SEQ = 8192, D = 1024, NTOK = BATCH * SEQ;
constexpr int QKV_N = 2304, FF = 3584, NEXP = 8, REC_N = 4096;
constexpr float EPS = 1e-6f;
constexpr int NPH = 22;
#ifndef MK_N_LAUNCHES
#define MK_N_LAUNCHES 1
#endif
constexpr int N_LAUNCHES = MK_N_LAUNCHES;
constexpr size_t MiB = 1u << 20;
constexpr size_t WS_CTL = 0, CTL_ZERO_BYTES = 1 * MiB;
constexpr size_t WS_WMOE_GU = 1 * MiB;
constexpr size_t WS_WMOE_DN = 113 * MiB;
constexpr size_t WS_H = 169 * MiB;
constexpr size_t WS_W_INATT = 297 * MiB;
constexpr size_t WS_W_OUTATT = WS_W_INATT + (size_t)QKV_N * D * 2;
constexpr size_t WS_W_GU = WS_W_OUTATT + (size_t)D * D * 2;
constexpr size_t WS_W_DN = WS_W_GU + (size_t)2 * FF * D * 2;
constexpr size_t WS_W_INREC = WS_W_DN + (size_t)D * FF * 2;
constexpr size_t WS_W_OUTREC = WS_W_INREC + (size_t)REC_N * D * 2;
constexpr size_t WS_BIG = 335 * MiB;
constexpr size_t WS_Y = 297 * MiB;
constexpr size_t WS_HID = 557 * MiB;
constexpr size_t WS_MISC = 1008 * MiB;
constexpr size_t WS_ROPE = WS_MISC;
constexpr size_t WS_META = WS_MISC + 4 * MiB;
constexpr size_t WS_DEST = WS_MISC + 5 * MiB;
constexpr size_t WS_HIST = WS_MISC + 6 * MiB;
constexpr size_t WS_INFO = WS_HIST + 8192;
constexpr size_t WS_LBK = WS_INFO + 256;
constexpr size_t WS_OB = 623 * MiB;
constexpr size_t WS_LSE = 751 * MiB;
constexpr size_t WS_DK = WS_MISC + 8 * MiB;
constexpr size_t WS_END = 1024 * MiB;
static_assert(WS_W_OUTREC + (size_t)D * D * 2 <= WS_BIG && WS_BIG + 640 * MiB <= WS_MISC && WS_Y + 260 * MiB <= WS_HID && WS_HID + 448 * MiB <= WS_MISC && WS_LBK + 4096 <= WS_END, "d_ws map");
constexpr int CW_BAR = 4096;
constexpr int RING_BYTES = 131072;
constexpr int LDSCTL_OFF = RING_BYTES, MISC_OFF = LDSCTL_OFF + 320;
constexpr int LDS_BYTES = 147456;

#define GAS __attribute__((address_space(1)))
#define LAS __attribute__((address_space(3)))
typedef unsigned short bf16;
typedef unsigned v4u __attribute__((ext_vector_type(4)));
typedef unsigned v2u __attribute__((ext_vector_type(2)));
typedef float f32x4 __attribute__((ext_vector_type(4)));
#define LDS_WAIT() asm volatile("s_waitcnt lgkmcnt(0)" ::: "memory")
__device__ __forceinline__ unsigned f2bf(float f) { unsigned u = __builtin_bit_cast(unsigned, f); return (u + 0x7fffu + ((u >> 16) & 1u)) >> 16; }
__device__ __forceinline__ unsigned pk2(float lo, float hi) { return f2bf(lo) | (f2bf(hi) << 16); }
__device__ __forceinline__ float bflo(unsigned w) { return __builtin_bit_cast(float, w << 16); }
__device__ __forceinline__ float bfhi(unsigned w) { return __builtin_bit_cast(float, w & 0xffff0000u); }
__device__ __forceinline__ float wave_sum(float v) {
#pragma unroll
    for (int o = 1; o < 64; o <<= 1) v += __shfl_xor(v, o);
    return v;
}
#define XB_TMO      128
#define XB_XCNT(j)  (256  + 64 * (j))
#define XB_XSUB(j)  (1280 + 64 * (j))
#define XB_XGEN(j)  (2304 + 64 * (j))
#define XB_TOP      3328
#define XB_TOPGEN   3392
#define XCD_BAR_WORDS 3456
#define XB_SPIN_CAP (1u << 24)

__device__ __forceinline__ unsigned xb_ld(unsigned* p)              { return __hip_atomic_load(p, __ATOMIC_RELAXED, __HIP_MEMORY_SCOPE_AGENT); }
__device__ __forceinline__ unsigned xb_add(unsigned* p, unsigned v) { return __hip_atomic_fetch_add(p, v, __ATOMIC_RELAXED, __HIP_MEMORY_SCOPE_AGENT); }
__device__ __forceinline__ unsigned xb_xcc_id() { return (unsigned)__builtin_amdgcn_s_getreg((3 << 11) | 20) & 0xFu; }
#define XB_SPIN(cond, bar) do { unsigned _sp = 0; while (cond) { __builtin_amdgcn_s_sleep(1); \
    if ((++_sp & 255u) == 0u) { if (xb_ld(&(bar)[XB_TMO])) break; if (_sp > XB_SPIN_CAP) { atomicAdd(&(bar)[XB_TMO], 1u); break; } } } } while (0)

struct XcdBarrier {
    unsigned* bar; unsigned x;
    volatile LAS unsigned* st;
};

__device__ __forceinline__ XcdBarrier xcd_barrier_post(unsigned* bar, volatile LAS unsigned* st) {
    XcdBarrier b; b.bar = bar; b.x = xb_xcc_id(); b.st = st;
    if (threadIdx.x == 0) (void)xb_add(&bar[XB_XCNT(b.x)], 1u);
    return b;
}
__device__ __forceinline__ void xcd_barrier_complete(unsigned* bar, unsigned x, unsigned& nloc, unsigned& nx) {
    const unsigned G = gridDim.x * gridDim.y * gridDim.z;
    unsigned sum, cnt, mine, sp = 0u;
    for (;;) {
        sum = 0u; cnt = 0u; mine = 0u;
#pragma unroll
        for (unsigned j = 0; j < 16; ++j) { const unsigned c = xb_ld(&bar[XB_XCNT(j)]); sum += c; cnt += (c > 0u) ? 1u : 0u; mine = (j == x) ? c : mine; }
        if (sum == G) break;
        __builtin_amdgcn_s_sleep(1);
        if ((++sp & 255u) == 0u) { if (xb_ld(&bar[XB_TMO])) break; if (sp > XB_SPIN_CAP) { atomicAdd(&bar[XB_TMO], 1u); break; } }
    }
    nloc = mine > 0u ? mine : 1u; nx = cnt > 0u ? cnt : 1u;
}

__device__ __forceinline__ void xcd_barrier(const XcdBarrier& b) {
    asm volatile("s_waitcnt vmcnt(0)" ::: "memory");
    __syncthreads();
    if (threadIdx.x == 0) {
        unsigned* bar = b.bar;
        __builtin_amdgcn_s_waitcnt(0);
        unsigned nloc = b.st[0], nx = b.st[1];
        if (nloc == 0u) { xcd_barrier_complete(bar, b.x, nloc, nx); b.st[0] = nloc; b.st[1] = nx; }
        const unsigned old = xb_add(&bar[XB_XSUB(b.x)], 1u);
        const unsigned gen = old / nloc;
        if (old + 1u == (gen + 1u) * nloc) {
            __builtin_amdgcn_fence(__ATOMIC_RELEASE, "agent");
            asm volatile("s_waitcnt vmcnt(0)" ::: "memory");
            const unsigned og = xb_add(&bar[XB_TOP], 1u);
            const unsigned tg = og / nx;
            if (og + 1u == (tg + 1u) * nx) xb_add(&bar[XB_TOPGEN], 1u);
            else XB_SPIN(xb_ld(&bar[XB_TOPGEN]) == tg, bar);
            __builtin_amdgcn_fence(__ATOMIC_ACQUIRE, "agent");
            xb_add(&bar[XB_XGEN(b.x)], 1u);
            asm volatile("s_waitcnt vmcnt(0)" ::: "memory");
        } else {
            XB_SPIN(xb_ld(&bar[XB_XGEN(b.x)]) == gen, bar);
            __builtin_amdgcn_fence(__ATOMIC_ACQUIRE, "agent");
            asm volatile("s_waitcnt vmcnt(0)" ::: "memory");
        }
    }
    __syncthreads();
}
__device__ __forceinline__ void transpose_item(const float* W, int N, bf16* WT, int K, int k0, int n0, int drow0, LAS float* scr, int lane) {
#pragma unroll 8
    for (int i = 0; i < 32; ++i) { const int kk = 2 * i + (lane >> 5); scr[kk * 33 + (lane & 31)] = W[(size_t)(k0 + kk) * N + n0 + (lane & 31)]; }
    LDS_WAIT(); asm volatile("" ::: "memory");
    const int c = lane & 7;
#pragma unroll
    for (int j = 0; j < 4; ++j) { const int n = (lane >> 3) + 8 * j; const LAS float* s = scr + (8 * c) * 33 + n;
        v4u o; o.x = pk2(s[0 * 33], s[1 * 33]); o.y = pk2(s[2 * 33], s[3 * 33]); o.z = pk2(s[4 * 33], s[5 * 33]); o.w = pk2(s[6 * 33], s[7 * 33]);
        *(v4u*)(WT + (size_t)(drow0 + n) * K + k0 + 8 * c) = o; }
    LDS_WAIT(); asm volatile("" ::: "memory");
}
__device__ __forceinline__ int dest_row(int mode, int n0) {
    if (mode == 0) return n0;
    if (mode == 1) return 256 * (n0 >> 7) + (n0 & 127);
    if (mode == 2) return 256 * (n0 >> 7) + 128 + (n0 & 127);
    const int sec = n0 >> 10, c = n0 & 1023, hd = c >> 7, w = c & 127;
    return ((sec >> 1) ? 2048 : 0) + 256 * hd + ((sec & 1) ? 128 : 0) + w;
}
__device__ __forceinline__ void conv_matrix_item(const float* W, int K, int N, bf16* WT, int mode, int r, LAS float* scr, int lane) {
    const int nblk = N / 32, kb = r / nblk, nb = r % nblk;
    transpose_item(W, N, WT, K, 64 * kb, 32 * nb, dest_row(mode, 32 * nb), scr, lane);
}
__device__ __forceinline__ void rms_row_to_bf16(const float* xrow, const float* g, bf16* orow, int lane) {
    const f32x4* xr = (const f32x4*)xrow + lane; const f32x4* gr = (const f32x4*)g + lane;
    f32x4 v[4]; float s = 0.f;
#pragma unroll
    for (int j = 0; j < 4; ++j) { v[j] = xr[64 * j]; s += (v[j].x * v[j].x + v[j].y * v[j].y) + (v[j].z * v[j].z + v[j].w * v[j].w); }
    const float rstd = 1.0f / sqrtf(wave_sum(s) * (1.f / D) + EPS);
    unsigned long long* o8 = (unsigned long long*)orow + lane;
#pragma unroll
    for (int j = 0; j < 4; ++j) { const f32x4 gg = gr[64 * j];
        o8[64 * j] = (unsigned long long)pk2(v[j].x * rstd * gg.x, v[j].y * rstd * gg.y) | ((unsigned long long)pk2(v[j].z * rstd * gg.z, v[j].w * rstd * gg.w) << 32); }
}
__device__ __forceinline__ float inv_freq(int j) {
    return j == 0 ? 1.000000000e+00f : j == 1 ? 1.939227432e-01f : j == 2 ? 3.760603070e-02f : j == 3 ? 7.292664610e-03f : j == 4 ? 1.414213562e-03f : j == 5 ? 2.742481884e-04f : j == 6 ? 5.318295734e-05f : 1.031338525e-05f;
}
struct P0Args { const float *x, *g0, *w_in_attn, *w_out_attn, *w_in_rec, *w_out_rec, *w_gate, *w_up, *w_down, *w_gate_moe, *w_up_moe, *w_down_moe, *rlb; const int* pos; unsigned char* ws; };
__device__ __forceinline__ void phase_prologue(const P0Args& a, LAS unsigned char* lds, int blk, int G, int tid) {
    const int wave = tid >> 6, lane = tid & 63;
    LAS float* scr = (LAS float*)(lds + wave * 16384);
    const int gw = blk * NWAVES + wave, NGW = G * NWAVES;
    unsigned char* ws = a.ws;
    constexpr int I_INATT = 16 * (QKV_N / 32), I_SQ = 16 * 32, I_GU = 16 * (FF / 32), I_DN = (FF / 64) * 32, I_INREC = 16 * (REC_N / 32);
    constexpr int NITEMS = I_INATT + I_SQ + 2 * I_GU + I_DN + I_INREC + I_SQ + NEXP * (2 * I_GU + I_DN);
    for (int it = gw; it < NITEMS; it += NGW) {
        int r = it;
        if (r < I_INATT) { conv_matrix_item(a.w_in_attn, D, QKV_N, (bf16*)(ws + WS_W_INATT), 0, r, scr, lane); continue; } r -= I_INATT;
        if (r < I_SQ) { conv_matrix_item(a.w_out_attn, D, D, (bf16*)(ws + WS_W_OUTATT), 0, r, scr, lane); continue; } r -= I_SQ;
        if (r < I_GU) { conv_matrix_item(a.w_gate, D, FF, (bf16*)(ws + WS_W_GU), 1, r, scr, lane); continue; } r -= I_GU;
        if (r < I_GU) { conv_matrix_item(a.w_up, D, FF, (bf16*)(ws + WS_W_GU), 2, r, scr, lane); continue; } r -= I_GU;
        if (r < I_DN) { conv_matrix_item(a.w_down, FF, D, (bf16*)(ws + WS_W_DN), 0, r, scr, lane); continue; } r -= I_DN;
        if (r < I_INREC) { conv_matrix_item(a.w_in_rec, D, REC_N, (bf16*)(ws + WS_W_INREC), 3, r, scr, lane); continue; } r -= I_INREC;
        if (r < I_SQ) { conv_matrix_item(a.w_out_rec, D, D, (bf16*)(ws + WS_W_OUTREC), 0, r, scr, lane); continue; } r -= I_SQ;
        if (r < NEXP * I_GU) { const int e = r / I_GU, q = r % I_GU; conv_matrix_item(a.w_gate_moe + (size_t)e * D * FF, D, FF, (bf16*)(ws + WS_WMOE_GU) + (size_t)e * 2 * FF * D, 1, q, scr, lane); continue; } r -= NEXP * I_GU;
        if (r < NEXP * I_GU) { const int e = r / I_GU, q = r % I_GU; conv_matrix_item(a.w_up_moe + (size_t)e * D * FF, D, FF, (bf16*)(ws + WS_WMOE_GU) + (size_t)e * 2 * FF * D, 2, q, scr, lane); continue; } r -= NEXP * I_GU;
        { const int e = r / I_DN, q = r % I_DN; conv_matrix_item(a.w_down_moe + (size_t)e * FF * D, FF, D, (bf16*)(ws + WS_WMOE_DN) + (size_t)e * D * FF, 0, q, scr, lane); }
    }
    for (int m = gw; m < NTOK; m += NGW) rms_row_to_bf16(a.x + (size_t)m * D, a.g0, (bf16*)(ws + WS_H) + (size_t)m * D, lane);
    float* rope = (float*)(ws + WS_ROPE);
    for (int i = blk * 512 + tid; i < NTOK * 8; i += G * 512) { const int tok = i >> 3, j = i & 7;
        const float ang = (float)a.pos[tok] * inv_freq(j);
        const double turns = (double)ang * 0.15915494309189533577; const float fr = (float)(turns - __builtin_rint(turns));
        rope[tok * 16 + j] = __builtin_amdgcn_cosf(fr); rope[tok * 16 + 8 + j] = __builtin_amdgcn_sinf(fr); }
    float* lbk = (float*)(ws + WS_LBK);
    for (int i = blk * 512 + tid; i < 1024; i += G * 512) lbk[i] = 1.0f / (1.0f + __expf(a.rlb[1024 + i] - a.rlb[i]));
}
__device__ __forceinline__ void phase_rope(bf16* qkv, const float* rope, int blk, int G, int tid) {
    for (int i = blk * 512 + tid; i < NTOK * 26; i += G * 512) {
        const int tok = i / 26, hx = i % 26;
        const int col = hx < 8 ? hx * 64 : hx < 16 ? 512 + (hx - 8) * 64 : hx < 24 ? 1536 + (hx - 16) * 64 : 2048 + (hx - 24) * 64;
        v4u* p = (v4u*)(qkv + (size_t)tok * QKV_N + col);
        const v4u a = p[0], b = p[1];
        const f32x4* t = (const f32x4*)(rope + (size_t)tok * 16);
        const f32x4 c0 = t[0], c1 = t[1], s0 = t[2], s1 = t[3];
        const float x1[8] = {bflo(a.x), bfhi(a.x), bflo(a.y), bfhi(a.y), bflo(a.z), bfhi(a.z), bflo(a.w), bfhi(a.w)};
        const float x2[8] = {bflo(b.x), bfhi(b.x), bflo(b.y), bfhi(b.y), bflo(b.z), bfhi(b.z), bflo(b.w), bfhi(b.w)};
        const float cs[8] = {c0.x, c0.y, c0.z, c0.w, c1.x, c1.y, c1.z, c1.w}, sn[8] = {s0.x, s0.y, s0.z, s0.w, s1.x, s1.y, s1.z, s1.w};
        float y1[8], y2[8];
#pragma unroll
        for (int j = 0; j < 8; ++j) { y1[j] = x1[j] * cs[j] - x2[j] * sn[j]; y2[j] = x2[j] * cs[j] + x1[j] * sn[j]; }
        v4u oa, ob; oa.x = pk2(y1[0], y1[1]); oa.y = pk2(y1[2], y1[3]); oa.z = pk2(y1[4], y1[5]); oa.w = pk2(y1[6], y1[7]);
        ob.x = pk2(y2[0], y2[1]); ob.y = pk2(y2[2], y2[3]); ob.z = pk2(y2[4], y2[5]); ob.w = pk2(y2[6], y2[7]);
        p[0] = oa; p[1] = ob;
    }
}
__device__ __forceinline__ void attn_key(const bf16* krow, const bf16* vrow, const float (&q)[64], float (&o)[64], float& m, float& l) {
    float s = 0.f;
#pragma unroll
    for (int c = 0; c < 8; ++c) { const v4u kv = *(const v4u*)(krow + 8 * c);
        s += q[8 * c + 0] * bflo(kv.x) + q[8 * c + 1] * bfhi(kv.x) + q[8 * c + 2] * bflo(kv.y) + q[8 * c + 3] * bfhi(kv.y)
           + q[8 * c + 4] * bflo(kv.z) + q[8 * c + 5] * bfhi(kv.z) + q[8 * c + 6] * bflo(kv.w) + q[8 * c + 7] * bfhi(kv.w); }
    s *= 0.125f;
    const float mn = fmaxf(m, s), sc = __expf(m - mn), p = __expf(s - mn);
    l = l * sc + p; m = mn;
#pragma unroll
    for (int c = 0; c < 8; ++c) { const v4u vv = *(const v4u*)(vrow + 8 * c);
        o[8 * c + 0] = o[8 * c + 0] * sc + p * bflo(vv.x); o[8 * c + 1] = o[8 * c + 1] * sc + p * bfhi(vv.x);
        o[8 * c + 2] = o[8 * c + 2] * sc + p * bflo(vv.y); o[8 * c + 3] = o[8 * c + 3] * sc + p * bfhi(vv.y);
        o[8 * c + 4] = o[8 * c + 4] * sc + p * bflo(vv.z); o[8 * c + 5] = o[8 * c + 5] * sc + p * bfhi(vv.z);
        o[8 * c + 6] = o[8 * c + 6] * sc + p * bflo(vv.w); o[8 * c + 7] = o[8 * c + 7] * sc + p * bfhi(vv.w); }
}
__device__ __forceinline__ void phase_attn_naive(const bf16* qkv, const float* sinks, bf16* mix, int blk, int G, int tid) {
    for (int idx = blk * 512 + tid; idx < NTOK * 16; idx += G * 512) {
        const int hx = idx >> 16, tok = idx & 65535, b = tok >> 13, s = tok & 8191;
        const bool isB = hx >= 8; const int qh = hx - 8;
        const int qcol = isB ? 1536 + qh * 64 : hx * 64, kcol = isB ? 2048 + (qh >> 2) * 64 : 512 + hx * 64, vcol = isB ? 2176 + (qh >> 2) * 64 : 1024 + hx * 64, ocol = isB ? 512 + qh * 64 : hx * 64;
        float q[64], o[64]; float m = -INFINITY, l = 0.f;
        { const bf16* qp = qkv + (size_t)tok * QKV_N + qcol;
#pragma unroll
          for (int c = 0; c < 8; ++c) { const v4u w = *(const v4u*)(qp + 8 * c); q[8 * c] = bflo(w.x); q[8 * c + 1] = bfhi(w.x); q[8 * c + 2] = bflo(w.y); q[8 * c + 3] = bfhi(w.y); q[8 * c + 4] = bflo(w.z); q[8 * c + 5] = bfhi(w.z); q[8 * c + 6] = bflo(w.w); q[8 * c + 7] = bfhi(w.w); } }
#pragma unroll
        for (int i = 0; i < 64; ++i) o[i] = 0.f;
        const bf16* rb = qkv + (size_t)(b * SEQ) * QKV_N;
        if (!isB) {
            for (int jj = 0; jj < 387; ++jj) { const int d = jj < 129 ? 1 : jj < 258 ? 4 : 16, j = jj < 129 ? jj : jj < 258 ? jj - 129 : jj - 258;
                const int kt = s - d * j; if (kt < 0) continue;
                const bf16* r = rb + (size_t)kt * QKV_N; attn_key(r + kcol, r + vcol, q, o, m, l); }
        } else {
            for (int j = 0; j < 128; ++j) { const int kt = s - j; if (kt < 0) break;
                const bf16* r = rb + (size_t)kt * QKV_N; attn_key(r + kcol, r + vcol, q, o, m, l); }
            const float sk = sinks[qh]; const float mn = fmaxf(m, sk), sc = __expf(m - mn);
            l = l * sc + __expf(sk - mn); m = mn;
#pragma unroll
            for (int i = 0; i < 64; ++i) o[i] *= sc;
        }
        const float rl = 1.0f / l;
        v4u* op = (v4u*)(mix + (size_t)tok * D + ocol);
#pragma unroll
        for (int c = 0; c < 8; ++c) { v4u w; w.x = pk2(o[8 * c] * rl, o[8 * c + 1] * rl); w.y = pk2(o[8 * c + 2] * rl, o[8 * c + 3] * rl); w.z = pk2(o[8 * c + 4] * rl, o[8 * c + 5] * rl); w.w = pk2(o[8 * c + 6] * rl, o[8 * c + 7] * rl); op[c] = w; }
    }
}
__device__ __forceinline__ void phase_norm(const float* x, const float* g, bf16* out, int blk, int G, int tid) {
    const int wave = tid >> 6, lane = tid & 63;
    for (int m = blk * NWAVES + wave; m < NTOK; m += G * NWAVES) rms_row_to_bf16(x + (size_t)m * D, g, out + (size_t)m * D, lane);
}
typedef float f32x16 __attribute__((ext_vector_type(16)));
typedef short bf16x8v __attribute__((ext_vector_type(8)));
typedef short s16x4 __attribute__((ext_vector_type(4)));
typedef short v4i16_t __attribute__((ext_vector_type(4)));
__device__ __forceinline__ int crow(int r, int hi) { return (r & 3) + 8 * (r >> 2) + 4 * hi; }
__device__ __forceinline__ s16x4 vtr(const LAS unsigned char* p) { return __builtin_bit_cast(s16x4, __builtin_amdgcn_ds_read_tr16_b64_v4i16((LAS v4i16_t*)p)); }
struct AttnSub { int b, dstride, r, P0, qcol, kcol, vcol, mode, hx; };
__device__ __forceinline__ void attn_subunit(const AttnSub su, const bf16* qkv, const float* sinks, bf16* mix, bf16* OB, float* LSE, LAS unsigned char* lh, int t256, int hw, int lane) {
    const int r32 = lane & 31, hi = lane >> 5;
    const size_t rowb = (size_t)su.b * SEQ;
    {
        const int c = t256 & 7, k0 = t256 >> 3;
        v4u kreg[8], vreg[8];
#pragma unroll
        for (int i = 0; i < 8; ++i) { const int key = k0 + 32 * i, pos = su.P0 - 128 + key;
            if (pos >= 0) { const bf16* rp = qkv + (rowb + su.r + (size_t)su.dstride * pos) * QKV_N; kreg[i] = *(const v4u*)(rp + su.kcol + 8 * c); vreg[i] = *(const v4u*)(rp + su.vcol + 8 * c); }
            else { kreg[i] = (v4u){0u, 0u, 0u, 0u}; vreg[i] = kreg[i]; } }
#pragma unroll
        for (int i = 0; i < 8; ++i) { const int key = k0 + 32 * i;
            *(LAS v4u*)(lh + key * 128 + ((c ^ (key & 7)) * 16)) = kreg[i];
            *(LAS v4u*)(lh + 32768 + (c >> 2) * 16384 + key * 64 + (c & 3) * 16) = vreg[i]; }
    }
    const int qpos = su.P0 + 32 * hw + r32;
    const size_t qrow = rowb + su.r + (size_t)su.dstride * qpos;
    bf16x8v qf[4];
#pragma unroll
    for (int ks = 0; ks < 4; ++ks) qf[ks] = *(const bf16x8v*)(qkv + qrow * QKV_N + su.qcol + 16 * ks + 8 * hi);
    __syncthreads();
    f32x16 oT[2]; oT[0] = (f32x16){}; oT[1] = (f32x16){};
    float m = -1e30f, l = 0.f;
    const float C = 0.125f * 1.4426950408889634f;
    const int mlo = (su.mode == 3) ? 1 : 0;
    int kt = hw; if (su.P0 == 0 && kt < 4) kt = 4;
    for (; kt <= hw + 4; ++kt) {
        f32x16 s = (f32x16){};
        const LAS unsigned char* kb = lh + (32 * kt + r32) * 128; const int sw = r32 & 7;
#pragma unroll
        for (int ks = 0; ks < 4; ++ks) { const bf16x8v kf = *(const LAS bf16x8v*)(kb + (((2 * ks + hi) ^ sw) * 16)); s = __builtin_amdgcn_mfma_f32_32x32x16_bf16(kf, qf[ks], s, 0, 0, 0); }
        if (kt == hw) {
#pragma unroll
            for (int r = 0; r < 16; ++r) if (crow(r, hi) < r32 + mlo) s[r] = -INFINITY; }
        if (kt == hw + 4) {
#pragma unroll
            for (int r = 0; r < 16; ++r) if (crow(r, hi) > r32) s[r] = -INFINITY; }
        float mx = s[0];
#pragma unroll
        for (int r = 1; r < 16; ++r) mx = fmaxf(mx, s[r]);
        mx = fmaxf(mx, __shfl_xor(mx, 32));
        const float mn = fmaxf(m, mx), alpha = __builtin_amdgcn_exp2f((m - mn) * C);
        float ls = 0.f; f32x16 p;
#pragma unroll
        for (int r = 0; r < 16; ++r) { p[r] = __builtin_amdgcn_exp2f((s[r] - mn) * C); ls += p[r]; }
        l = l * alpha + ls; m = mn;
#pragma unroll
        for (int r = 0; r < 16; ++r) { oT[0][r] *= alpha; oT[1][r] *= alpha; }
        v4u pw0, pw1;
        pw0.x = pk2(p[0], p[1]); pw0.y = pk2(p[2], p[3]); pw0.z = pk2(p[4], p[5]); pw0.w = pk2(p[6], p[7]);
        pw1.x = pk2(p[8], p[9]); pw1.y = pk2(p[10], p[11]); pw1.z = pk2(p[12], p[13]); pw1.w = pk2(p[14], p[15]);
        const bf16x8v pa0 = __builtin_bit_cast(bf16x8v, pw0), pa1 = __builtin_bit_cast(bf16x8v, pw1);
        const LAS unsigned char* vb = lh + 32768 + (32 * kt + 4 * hi + ((lane & 15) >> 2)) * 64 + ((lane >> 4) & 1) * 32 + (lane & 3) * 8;
#pragma unroll
        for (int dt = 0; dt < 2; ++dt) {
            const s16x4 a0 = vtr(vb + dt * 16384), a1 = vtr(vb + dt * 16384 + 512), b0 = vtr(vb + dt * 16384 + 1024), b1 = vtr(vb + dt * 16384 + 1536);
            const bf16x8v vf0 = (bf16x8v){a0[0], a0[1], a0[2], a0[3], a1[0], a1[1], a1[2], a1[3]}, vf1 = (bf16x8v){b0[0], b0[1], b0[2], b0[3], b1[0], b1[1], b1[2], b1[3]};
            oT[dt] = __builtin_amdgcn_mfma_f32_32x32x16_bf16(vf0, pa0, oT[dt], 0, 0, 0);
            oT[dt] = __builtin_amdgcn_mfma_f32_32x32x16_bf16(vf1, pa1, oT[dt], 0, 0, 0);
        }
    }
    float lt = l + __shfl_xor(l, 32);
    if (su.mode == 3) { const float sraw = 8.0f * sinks[su.hx]; const float mn = fmaxf(m, sraw), alpha = __builtin_amdgcn_exp2f((m - mn) * C);
        lt = lt * alpha + __builtin_amdgcn_exp2f((sraw - mn) * C); m = mn;
#pragma unroll
        for (int r = 0; r < 16; ++r) { oT[0][r] *= alpha; oT[1][r] *= alpha; } }
    const float inv = 1.0f / lt;
    if (su.mode < 2) {
        bf16* ob = OB + (size_t)su.mode * NTOK * 512 + qrow * 512 + su.hx * 64;
#pragma unroll
        for (int dt = 0; dt < 2; ++dt)
#pragma unroll
            for (int g = 0; g < 4; ++g) { v2u w; w.x = pk2(oT[dt][4 * g] * inv, oT[dt][4 * g + 1] * inv); w.y = pk2(oT[dt][4 * g + 2] * inv, oT[dt][4 * g + 3] * inv); *(v2u*)(ob + 32 * dt + 8 * g + 4 * hi) = w; }
        if (hi == 0) LSE[(size_t)su.mode * NTOK * 8 + qrow * 8 + su.hx] = 0.125f * m + __logf(lt);
    } else if (su.mode == 2) {
        const float l3 = 0.125f * m + __logf(lt), l1 = LSE[qrow * 8 + su.hx], l2 = LSE[(size_t)NTOK * 8 + qrow * 8 + su.hx];
        const float M = fmaxf(l3, fmaxf(l1, l2)); float w1 = __expf(l1 - M), w2 = __expf(l2 - M), w3 = __expf(l3 - M);
        const float ws = 1.0f / (w1 + w2 + w3); w1 *= ws; w2 *= ws; w3 *= ws * inv;
        const bf16* o1 = OB + qrow * 512 + su.hx * 64; const bf16* o2 = o1 + (size_t)NTOK * 512;
        bf16* mp = mix + qrow * D + su.hx * 64;
#pragma unroll
        for (int dt = 0; dt < 2; ++dt)
#pragma unroll
            for (int g = 0; g < 4; ++g) { const int dd = 32 * dt + 8 * g + 4 * hi; const v2u a = *(const v2u*)(o1 + dd), b = *(const v2u*)(o2 + dd);
                v2u w; w.x = pk2(w1 * bflo(a.x) + w2 * bflo(b.x) + w3 * oT[dt][4 * g], w1 * bfhi(a.x) + w2 * bfhi(b.x) + w3 * oT[dt][4 * g + 1]);
                w.y = pk2(w1 * bflo(a.y) + w2 * bflo(b.y) + w3 * oT[dt][4 * g + 2], w1 * bfhi(a.y) + w2 * bfhi(b.y) + w3 * oT[dt][4 * g + 3]); *(v2u*)(mp + dd) = w; }
    } else {
        bf16* mp = mix + qrow * D + 512 + su.hx * 64;
#pragma unroll
        for (int dt = 0; dt < 2; ++dt)
#pragma unroll
            for (int g = 0; g < 4; ++g) { v2u w; w.x = pk2(oT[dt][4 * g] * inv, oT[dt][4 * g + 1] * inv); w.y = pk2(oT[dt][4 * g + 2] * inv, oT[dt][4 * g + 3] * inv); *(v2u*)(mp + 32 * dt + 8 * g + 4 * hi) = w; }
    }
    asm volatile("s_waitcnt vmcnt(0)" ::: "memory");
    __syncthreads();
}
__device__ __forceinline__ void phase_attn(const bf16* qkv, const float* sinks, bf16* mix, bf16* OB, float* LSE, LAS unsigned char* lds, int blk, int G, int tid) {
    const int wave = tid >> 6, lane = tid & 63, hf = wave >> 2, hw = wave & 3, t256 = tid & 255;
    LAS unsigned char* lh = lds + hf * 65536;
    for (int ai = blk; ai < 256; ai += G) {
        const int b = ai >> 5, h = (ai >> 2) & 7, T0 = (ai & 3) * 2048;
        for (int pp = 0; pp < 24; ++pp) {
            const int su = 2 * pp + hf, br = su >> 4, k = su & 15;
            AttnSub s; s.b = b; s.hx = h; s.qcol = h * 64; s.kcol = 512 + h * 64; s.vcol = 1024 + h * 64; s.mode = br;
            if (br == 0) { s.dstride = 1; s.r = 0; s.P0 = T0 + 128 * k; }
            else if (br == 1) { s.dstride = 4; s.r = k >> 2; s.P0 = (T0 >> 2) + 128 * (k & 3); }
            else { s.dstride = 16; s.r = k; s.P0 = T0 >> 4; }
            attn_subunit(s, qkv, sinks, mix, OB, LSE, lh, t256, hw, lane);
        }
    }
    for (int bp = blk; bp < 2048; bp += G) {
        const int b = bp >> 8, nb = (bp >> 2) & 63, kv = (bp >> 1) & 1, qh = kv * 4 + 2 * (bp & 1) + hf;
        AttnSub s; s.b = b; s.hx = qh; s.qcol = 1536 + qh * 64; s.kcol = 2048 + kv * 64; s.vcol = 2176 + kv * 64; s.mode = 3; s.dstride = 1; s.r = 0; s.P0 = 128 * nb;
        attn_subunit(s, qkv, sinks, mix, OB, LSE, lh, t256, hw, lane);
    }
}
__device__ __forceinline__ void phase_hgrn_naive(const bf16* Qp, const bf16* Kp, const bf16* Vp, bf16* Oraw, LAS unsigned char* lds, int blk, int G, int tid) {
    LAS float* sq = (LAS float*)lds; LAS float* sk = sq + 2048; LAS float* sf = sk + 2048; LAS float* sv = sf + 2048; LAS float* part = sv + 2048;
    const int v = tid & 127, kq = tid >> 7;
    const int lr = tid >> 5, lc = (tid & 31) * 4;
    for (int bh = blk; bh < BATCH * 8; bh += G) {
        const int b = bh >> 3, h = bh & 7;
        float S[32];
#pragma unroll
        for (int i = 0; i < 32; ++i) S[i] = 0.f;
        for (int t0 = 0; t0 < SEQ; t0 += 16) {
            const size_t base = (size_t)(b * SEQ + t0 + lr) * D + h * 128 + lc;
            { const v2u w = *(const v2u*)(Qp + base); *(LAS f32x4*)(sq + lr * 128 + lc) = (f32x4){bflo(w.x), bfhi(w.x), bflo(w.y), bfhi(w.y)}; }
            { const v2u w = *(const v2u*)(Kp + base); const f32x4 kk = (f32x4){bflo(w.x), bfhi(w.x), bflo(w.y), bfhi(w.y)}; *(LAS f32x4*)(sk + lr * 128 + lc) = kk; *(LAS f32x4*)(sf + lr * 128 + lc) = (f32x4){1.f - kk.x, 1.f - kk.y, 1.f - kk.z, 1.f - kk.w}; }
            { const v2u w = *(const v2u*)(Vp + base); *(LAS f32x4*)(sv + lr * 128 + lc) = (f32x4){bflo(w.x), bfhi(w.x), bflo(w.y), bfhi(w.y)}; }
            __syncthreads();
            for (int t = 0; t < 16; ++t) {
                const float vt = sv[t * 128 + v]; float po = 0.f;
#pragma unroll
                for (int i4 = 0; i4 < 8; ++i4) { const int kx = t * 128 + kq * 32 + i4 * 4;
                    const f32x4 q4 = *(const LAS f32x4*)(sq + kx), k4 = *(const LAS f32x4*)(sk + kx), f4 = *(const LAS f32x4*)(sf + kx);
#pragma unroll
                    for (int j = 0; j < 4; ++j) { S[i4 * 4 + j] = f4[j] * S[i4 * 4 + j] + k4[j] * vt; po += q4[j] * S[i4 * 4 + j]; } }
                part[(t * 4 + kq) * 128 + v] = po;
            }
            __syncthreads();
            { const f32x4 p0 = *(const LAS f32x4*)(part + (lr * 4 + 0) * 128 + lc), p1 = *(const LAS f32x4*)(part + (lr * 4 + 1) * 128 + lc), p2 = *(const LAS f32x4*)(part + (lr * 4 + 2) * 128 + lc), p3 = *(const LAS f32x4*)(part + (lr * 4 + 3) * 128 + lc);
              const f32x4 r = (p0 + p1) + (p2 + p3); v2u w; w.x = pk2(r.x, r.y); w.y = pk2(r.z, r.w); *(v2u*)(Oraw + base) = w; }
        }
        __syncthreads();
    }
}
__device__ __forceinline__ void phase_gate(bf16* O, const bf16* Gp, const float* norm_g, int blk, int G, int tid) {
    const int wave = tid >> 6, lane = tid & 63;
    for (int m = blk * NWAVES + wave; m < NTOK; m += G * NWAVES) {
        v4u* op = (v4u*)(O + (size_t)m * D + lane * 16); const v4u* gp = (const v4u*)(Gp + (size_t)m * D + lane * 16);
        const v4u a = op[0], b = op[1], ga = gp[0], gb = gp[1];
        float x[16] = {bflo(a.x), bfhi(a.x), bflo(a.y), bfhi(a.y), bflo(a.z), bfhi(a.z), bflo(a.w), bfhi(a.w), bflo(b.x), bfhi(b.x), bflo(b.y), bfhi(b.y), bflo(b.z), bfhi(b.z), bflo(b.w), bfhi(b.w)};
        const float gg[16] = {bflo(ga.x), bfhi(ga.x), bflo(ga.y), bfhi(ga.y), bflo(ga.z), bfhi(ga.z), bflo(ga.w), bfhi(ga.w), bflo(gb.x), bfhi(gb.x), bflo(gb.y), bfhi(gb.y), bflo(gb.z), bfhi(gb.z), bflo(gb.w), bfhi(gb.w)};
        float ss = 0.f;
#pragma unroll
        for (int i = 0; i < 16; ++i) ss += x[i] * x[i];
        ss += __shfl_xor(ss, 1); ss += __shfl_xor(ss, 2); ss += __shfl_xor(ss, 4);
        const float rstd = 1.0f / sqrtf(ss * (1.f / 128.f) + EPS);
        const f32x4* ng = (const f32x4*)(norm_g + lane * 16);
        float y[16];
#pragma unroll
        for (int i4 = 0; i4 < 4; ++i4) { const f32x4 n4 = ng[i4];
#pragma unroll
            for (int j = 0; j < 4; ++j) y[i4 * 4 + j] = x[i4 * 4 + j] * rstd * n4[j] * gg[i4 * 4 + j]; }
        v4u oa, ob; oa.x = pk2(y[0], y[1]); oa.y = pk2(y[2], y[3]); oa.z = pk2(y[4], y[5]); oa.w = pk2(y[6], y[7]);
        ob.x = pk2(y[8], y[9]); ob.y = pk2(y[10], y[11]); ob.z = pk2(y[12], y[13]); ob.w = pk2(y[14], y[15]);
        op[0] = oa; op[1] = ob;
    }
}
__device__ __forceinline__ void phase_router(const float* x, const float* g, const float* w_router, int4* meta, int* hist, LAS unsigned char* lds, int blk, int G, int tid) {
    const int wave = tid >> 6, lane = tid & 63;
    LAS float* swr = (LAS float*)lds;
    LAS int* scnt = (LAS int*)(lds + 32768);
    for (int i = tid; i < 8192; i += 512) swr[i] = w_router[i];
    __syncthreads();
    for (int tb = blk; tb < 256; tb += G) {
        if (tid < 8) scnt[tid] = 0;
        __syncthreads();
        int c0 = 0, c1 = 0, c2 = 0, c3 = 0, c4 = 0, c5 = 0, c6 = 0, c7 = 0;
        for (int i = 0; i < 32; ++i) {
            const int tok = tb * 256 + wave * 32 + i;
            const f32x4* xr = (const f32x4*)(x + (size_t)tok * D) + lane; const f32x4* gr = (const f32x4*)g + lane;
            f32x4 v[4]; float s = 0.f;
#pragma unroll
            for (int j = 0; j < 4; ++j) { v[j] = xr[64 * j]; s += (v[j].x * v[j].x + v[j].y * v[j].y) + (v[j].z * v[j].z + v[j].w * v[j].w); }
            const float rstd = 1.0f / sqrtf(wave_sum(s) * (1.f / D) + EPS);
            float lg[8] = {0.f, 0.f, 0.f, 0.f, 0.f, 0.f, 0.f, 0.f};
#pragma unroll
            for (int j = 0; j < 4; ++j) { const f32x4 gg = gr[64 * j];
#pragma unroll
                for (int c = 0; c < 4; ++c) { const float hv = v[j][c] * rstd * gg[c]; const int d = 256 * j + 4 * lane + c;
                    const f32x4 w0 = *(const LAS f32x4*)(swr + d * 8), w1 = *(const LAS f32x4*)(swr + d * 8 + 4);
                    lg[0] += hv * w0.x; lg[1] += hv * w0.y; lg[2] += hv * w0.z; lg[3] += hv * w0.w; lg[4] += hv * w1.x; lg[5] += hv * w1.y; lg[6] += hv * w1.z; lg[7] += hv * w1.w; } }
#pragma unroll
            for (int e = 0; e < 8; ++e) lg[e] = wave_sum(lg[e]);
            int e0 = 0; float v0 = lg[0];
#pragma unroll
            for (int e = 1; e < 8; ++e) if (lg[e] > v0) { v0 = lg[e]; e0 = e; }
            int e1 = -1; float v1 = -INFINITY;
#pragma unroll
            for (int e = 0; e < 8; ++e) if (e != e0 && lg[e] > v1) { v1 = lg[e]; e1 = e; }
            const float g1 = 1.0f / (1.0f + __expf(v0 - v1)), g0 = 1.0f - g1;
            if (lane == 0) meta[tok] = make_int4(e0, e1, __builtin_bit_cast(int, g0), __builtin_bit_cast(int, g1));
            c0 += (e0 == 0) + (e1 == 0); c1 += (e0 == 1) + (e1 == 1); c2 += (e0 == 2) + (e1 == 2); c3 += (e0 == 3) + (e1 == 3);
            c4 += (e0 == 4) + (e1 == 4); c5 += (e0 == 5) + (e1 == 5); c6 += (e0 == 6) + (e1 == 6); c7 += (e0 == 7) + (e1 == 7);
        }
        if (lane == 0) { const int cc[8] = {c0, c1, c2, c3, c4, c5, c6, c7};
#pragma unroll
            for (int e = 0; e < 8; ++e) __hip_atomic_fetch_add(&scnt[e], cc[e], __ATOMIC_RELAXED, __HIP_MEMORY_SCOPE_WORKGROUP); }
        __syncthreads();
        if (tid < 8) hist[tb * 8 + tid] = scnt[tid];
        __syncthreads();
    }
}
__device__ __forceinline__ void phase_scatter(const float* x, const float* g, const int4* meta, const int* hist, int* dest, int* info, bf16* perm, LAS unsigned char* lds, int blk, int G, int tid) {
    const int wave = tid >> 6, lane = tid & 63;
    LAS int* shist = (LAS int*)lds;
    LAS int* ssize = shist + 2048; LAS int* sbpre = ssize + 8; LAS int* spst = sbpre + 8; LAS int* sntl = spst + 8;
    LAS int* se = sntl + 8; LAS int* sdest = se + 512;
    for (int tb = blk; tb < 256; tb += G) {
        for (int i = tid; i < 2048; i += 512) shist[i] = hist[i];
        __syncthreads();
        if (tid < 8) { int sz = 0, bp = 0; for (int b = 0; b < 256; ++b) { const int hv = shist[b * 8 + tid]; sz += hv; bp += (b < tb) ? hv : 0; } ssize[tid] = sz; sbpre[tid] = bp; }
        __syncthreads();
        if (tid == 0) { int ts = 0; for (int e = 0; e < 8; ++e) { const int nt = (ssize[e] + 255) >> 8; spst[e] = ts * 256; sntl[e] = nt; ts += nt; if (tb == 0) info[e] = ts; } if (tb == 0) info[8] = ts; }
        { const int4 mt = meta[tb * 256 + (tid >> 1)]; se[tid] = (tid & 1) ? mt.y : mt.x; }
        __syncthreads();
        { const int e = se[tid]; int rank = 0; for (int p = 0; p < tid; ++p) rank += (se[p] == e) ? 1 : 0;
          const int dd = spst[e] + sbpre[e] + rank; sdest[tid] = dd; dest[(tb * 256) * 2 + tid] = dd; }
        __syncthreads();
        for (int i = 0; i < 32; ++i) { const int lt = wave * 32 + i, tok = tb * 256 + lt;
            const f32x4* xr = (const f32x4*)(x + (size_t)tok * D) + lane; const f32x4* gr = (const f32x4*)g + lane;
            f32x4 v[4]; float s = 0.f;
#pragma unroll
            for (int j = 0; j < 4; ++j) { v[j] = xr[64 * j]; s += (v[j].x * v[j].x + v[j].y * v[j].y) + (v[j].z * v[j].z + v[j].w * v[j].w); }
            const float rstd = 1.0f / sqrtf(wave_sum(s) * (1.f / D) + EPS);
            unsigned long long* o0 = (unsigned long long*)(perm + (size_t)sdest[2 * lt] * D) + lane; unsigned long long* o1 = (unsigned long long*)(perm + (size_t)sdest[2 * lt + 1] * D) + lane;
#pragma unroll
            for (int j = 0; j < 4; ++j) { const f32x4 gg = gr[64 * j];
                const unsigned long long w = (unsigned long long)pk2(v[j].x * rstd * gg.x, v[j].y * rstd * gg.y) | ((unsigned long long)pk2(v[j].z * rstd * gg.z, v[j].w * rstd * gg.w) << 32);
                o0[64 * j] = w; o1[64 * j] = w; } }
        if (tb < 8) { const int r0 = spst[tb] + ssize[tb], r1 = spst[tb] + sntl[tb] * 256;
            for (int r = r0 + wave; r < r1; r += NWAVES) { unsigned long long* o = (unsigned long long*)(perm + (size_t)r * D) + lane;
#pragma unroll
                for (int j = 0; j < 4; ++j) o[64 * j] = 0ull; } }
        __syncthreads();
    }
}
__device__ __forceinline__ void phase_combine(float* x, const bf16* y, const int4* meta, const int* dest, const float* gf, int blk, int G, int tid) {
    const int wave = tid >> 6, lane = tid & 63;
    for (int m = blk * NWAVES + wave; m < NTOK; m += G * NWAVES) {
        const int4 mt = meta[m]; const float g0 = __builtin_bit_cast(float, mt.z), g1 = __builtin_bit_cast(float, mt.w);
        const int d0 = dest[2 * m], d1 = dest[2 * m + 1];
        f32x4* xr = (f32x4*)(x + (size_t)m * D) + lane; const f32x4* gr = (const f32x4*)gf + lane;
        const v2u* y0 = (const v2u*)(y + (size_t)d0 * D) + lane; const v2u* y1 = (const v2u*)(y + (size_t)d1 * D) + lane;
        f32x4 v[4]; float s = 0.f;
#pragma unroll
        for (int j = 0; j < 4; ++j) { const v2u a = y0[64 * j], b = y1[64 * j]; f32x4 t = xr[64 * j];
            t.x += g0 * bflo(a.x) + g1 * bflo(b.x); t.y += g0 * bfhi(a.x) + g1 * bfhi(b.x); t.z += g0 * bflo(a.y) + g1 * bflo(b.y); t.w += g0 * bfhi(a.y) + g1 * bfhi(b.y);
            v[j] = t; s += (t.x * t.x + t.y * t.y) + (t.z * t.z + t.w * t.w); }
        const float rstd = 1.0f / sqrtf(wave_sum(s) * (1.f / D) + EPS);
#pragma unroll
        for (int j = 0; j < 4; ++j) { const f32x4 gg = gr[64 * j]; xr[64 * j] = (f32x4){v[j].x * rstd * gg.x, v[j].y * rstd * gg.y, v[j].z * rstd * gg.z, v[j].w * rstd * gg.w}; }
    }
}
constexpr int HG_QE = 0, HG_KI = 16384, HG_KE = 32768, HG_V = 49152, HG_ST = 65536, HG_DK = 132096, HG_SSQ = 132608;
__device__ __forceinline__ void phase_hgrn(const bf16* QE, const bf16* KI, const bf16* KE, const bf16* Vp, const bf16* Gp, const float* DK, const float* norm_g, bf16* Og, LAS unsigned char* lds, int blk, int G, int tid) {
    const int wave = tid >> 6, lane = tid & 63, r32 = lane & 31, hi = lane >> 5, tb = wave >> 2, vb = wave & 3;
    const int sw = r32 & 15;
    const int trl = (4 * hi + ((lane & 15) >> 2)) * 64 + ((lane >> 4) & 1) * 32 + (lane & 3) * 8;
    LAS float* dk_l = (LAS float*)(lds + HG_DK); LAS float* ssq = (LAS float*)(lds + HG_SSQ);
    for (int bh = blk; bh < BATCH * 8; bh += G) {
        const int b = bh >> 3, h = bh & 7;
        f32x16 S0 = (f32x16){}, S1 = (f32x16){};
        v4u rq[2], rk[2], re[2], rv[2]; f32x4 rd = (f32x4){0.f, 0.f, 0.f, 0.f};
#define HG_LOAD(c) do { const size_t row0_ = (size_t)b * SEQ + 64 * (c); \
            _Pragma("unroll") for (int i = 0; i < 2; ++i) { const int idx = tid + 512 * i, row = idx >> 4, cc = idx & 15; const size_t go = (row0_ + row) * 1024 + h * 128 + cc * 8; \
                rq[i] = *(const v4u*)(QE + go); rk[i] = *(const v4u*)(KI + go); re[i] = *(const v4u*)(KE + go); rv[i] = *(const v4u*)(Vp + go); } \
            if (tid < 32) rd = *(const f32x4*)(DK + ((size_t)b * 128 + (c)) * 1024 + h * 128 + tid * 4); } while (0)
#define HG_STORE() do { \
            _Pragma("unroll") for (int i = 0; i < 2; ++i) { const int idx = tid + 512 * i, row = idx >> 4, cc = idx & 15; \
                *(LAS v4u*)(lds + HG_QE + row * 256 + ((cc ^ (row & 15)) * 16)) = rq[i]; *(LAS v4u*)(lds + HG_KI + row * 256 + ((cc ^ (row & 15)) * 16)) = rk[i]; \
                *(LAS v4u*)(lds + HG_KE + (cc >> 2) * 4096 + row * 64 + (cc & 3) * 16) = re[i]; *(LAS v4u*)(lds + HG_V + (cc >> 2) * 4096 + row * 64 + (cc & 3) * 16) = rv[i]; } \
            if (tid < 32) *(LAS f32x4*)(dk_l + tid * 4) = rd; } while (0)
        HG_LOAD(0); HG_STORE();
        __syncthreads();
        for (int c = 0; c < 128; ++c) {
            if (c + 1 < 128) HG_LOAD(c + 1);
            LAS unsigned char* st_cur = lds + HG_ST + (c & 1) * 32768; LAS unsigned char* st_nxt = lds + HG_ST + ((c + 1) & 1) * 32768;
            bf16x8v qf[8];
#pragma unroll
            for (int ks = 0; ks < 8; ++ks) qf[ks] = *(const LAS bf16x8v*)(lds + HG_QE + (32 * tb + r32) * 256 + (((2 * ks + hi) ^ sw) * 16));
            f32x16 X0 = (f32x16){}, X1 = (f32x16){};
#pragma unroll
            for (int ks = 0; ks < 8; ++ks) { const bf16x8v kf = *(const LAS bf16x8v*)(lds + HG_KI + r32 * 256 + (((2 * ks + hi) ^ sw) * 16)); X0 = __builtin_amdgcn_mfma_f32_32x32x16_bf16(kf, qf[ks], X0, 0, 0, 0); }
            if (tb == 1) {
#pragma unroll
                for (int ks = 0; ks < 8; ++ks) { const bf16x8v kf = *(const LAS bf16x8v*)(lds + HG_KI + (32 + r32) * 256 + (((2 * ks + hi) ^ sw) * 16)); X1 = __builtin_amdgcn_mfma_f32_32x32x16_bf16(kf, qf[ks], X1, 0, 0, 0); }
#pragma unroll
                for (int r = 0; r < 16; ++r) if (crow(r, hi) > r32) X1[r] = 0.f;
            } else {
#pragma unroll
                for (int r = 0; r < 16; ++r) if (crow(r, hi) > r32) X0[r] = 0.f;
            }
            bf16x8v vf[4];
#pragma unroll
            for (int s4 = 0; s4 < 4; ++s4) { const LAS unsigned char* p = lds + HG_V + vb * 4096 + s4 * 1024 + trl; const s16x4 a0 = vtr(p), a1 = vtr(p + 512); vf[s4] = (bf16x8v){a0[0], a0[1], a0[2], a0[3], a1[0], a1[1], a1[2], a1[3]}; }
            f32x16 oT = (f32x16){};
            { v4u pw0, pw1; pw0.x = pk2(X0[0], X0[1]); pw0.y = pk2(X0[2], X0[3]); pw0.z = pk2(X0[4], X0[5]); pw0.w = pk2(X0[6], X0[7]); pw1.x = pk2(X0[8], X0[9]); pw1.y = pk2(X0[10], X0[11]); pw1.z = pk2(X0[12], X0[13]); pw1.w = pk2(X0[14], X0[15]);
              oT = __builtin_amdgcn_mfma_f32_32x32x16_bf16(vf[0], __builtin_bit_cast(bf16x8v, pw0), oT, 0, 0, 0); oT = __builtin_amdgcn_mfma_f32_32x32x16_bf16(vf[1], __builtin_bit_cast(bf16x8v, pw1), oT, 0, 0, 0); }
            if (tb == 1) { v4u pw0, pw1; pw0.x = pk2(X1[0], X1[1]); pw0.y = pk2(X1[2], X1[3]); pw0.z = pk2(X1[4], X1[5]); pw0.w = pk2(X1[6], X1[7]); pw1.x = pk2(X1[8], X1[9]); pw1.y = pk2(X1[10], X1[11]); pw1.z = pk2(X1[12], X1[13]); pw1.w = pk2(X1[14], X1[15]);
              oT = __builtin_amdgcn_mfma_f32_32x32x16_bf16(vf[2], __builtin_bit_cast(bf16x8v, pw0), oT, 0, 0, 0); oT = __builtin_amdgcn_mfma_f32_32x32x16_bf16(vf[3], __builtin_bit_cast(bf16x8v, pw1), oT, 0, 0, 0); }
            if (c > 0) {
#pragma unroll
                for (int ks = 0; ks < 8; ++ks) { const bf16x8v sf = *(const LAS bf16x8v*)(st_cur + (32 * vb + r32) * 256 + (((2 * ks + hi) ^ sw) * 16)); oT = __builtin_amdgcn_mfma_f32_32x32x16_bf16(sf, qf[ks], oT, 0, 0, 0); }
            }
            { float ss = 0.f;
#pragma unroll
              for (int r = 0; r < 16; ++r) ss += oT[r] * oT[r];
              ss += __shfl_xor(ss, 32); if (hi == 0) ssq[(tb * 4 + vb) * 32 + r32] = ss; }
#pragma unroll
            for (int i = 0; i < 2; ++i) { const int kb = 2 * tb + i; f32x16 S = i ? S1 : S0;
#pragma unroll
                for (int g = 0; g < 4; ++g) { const f32x4 d4 = *(const LAS f32x4*)(dk_l + 32 * kb + 8 * g + 4 * hi);
#pragma unroll
                    for (int j = 0; j < 4; ++j) S[4 * g + j] *= d4[j]; }
#pragma unroll
                for (int s4 = 0; s4 < 4; ++s4) { const LAS unsigned char* p = lds + HG_KE + kb * 4096 + s4 * 1024 + trl; const s16x4 a0 = vtr(p), a1 = vtr(p + 512);
                    const bf16x8v kef = (bf16x8v){a0[0], a0[1], a0[2], a0[3], a1[0], a1[1], a1[2], a1[3]};
                    S = __builtin_amdgcn_mfma_f32_32x32x16_bf16(kef, vf[s4], S, 0, 0, 0); }
#pragma unroll
                for (int g = 0; g < 4; ++g) { v2u w; w.x = pk2(S[4 * g], S[4 * g + 1]); w.y = pk2(S[4 * g + 2], S[4 * g + 3]);
                    *(LAS v2u*)(st_nxt + (32 * vb + r32) * 256 + (((4 * kb + g) ^ sw) * 16) + hi * 8) = w; }
                if (i) S1 = S; else S0 = S; }
            __syncthreads();
            { const float tot = (ssq[(tb * 4 + 0) * 32 + r32] + ssq[(tb * 4 + 1) * 32 + r32]) + (ssq[(tb * 4 + 2) * 32 + r32] + ssq[(tb * 4 + 3) * 32 + r32]);
              const float rstd = 1.0f / sqrtf(tot * (1.f / 128.f) + EPS);
              const size_t rowo = ((size_t)b * SEQ + 64 * c + 32 * tb + r32) * 1024 + h * 128 + 32 * vb + 4 * hi;
#pragma unroll
              for (int g = 0; g < 4; ++g) { const f32x4 ng = *(const f32x4*)(norm_g + h * 128 + 32 * vb + 8 * g + 4 * hi); const v2u gg = *(const v2u*)(Gp + rowo + 8 * g);
                  v2u w; w.x = pk2(oT[4 * g] * rstd * ng.x * bflo(gg.x), oT[4 * g + 1] * rstd * ng.y * bfhi(gg.x)); w.y = pk2(oT[4 * g + 2] * rstd * ng.z * bflo(gg.y), oT[4 * g + 3] * rstd * ng.w * bfhi(gg.y));
                  *(v2u*)(Og + rowo + 8 * g) = w; } }
            if (c + 1 < 128) HG_STORE();
            __syncthreads();
        }
#undef HG_LOAD
#undef HG_STORE
    }
}
struct Args { const void* in[19]; float* out; unsigned char* ws; int ph_lo, ph_hi; };
__global__ void __launch_bounds__(NWAVES * 64, 2) fwd(Args args) {
    extern __shared__ __attribute__((aligned(16))) unsigned char lds_raw[];
    LAS unsigned char* lds = (LAS unsigned char*)lds_raw;
    volatile LAS unsigned* MISC = (volatile LAS unsigned*)(lds + MISC_OFF);
    const int tid = threadIdx.x, G = gridDim.x, blk = blockIdx.x;
    unsigned char* ws = args.ws;
    unsigned* ctl = (unsigned*)(ws + WS_CTL);
    for (int u = tid; u < (LDS_BYTES - LDSCTL_OFF) / 4; u += NWAVES * 64) ((LAS unsigned*)(lds + LDSCTL_OFF))[u] = 0u;
    __syncthreads();
    XcdBarrier bar; bar.bar = ctl + CW_BAR; bar.x = 0; bar.st = nullptr;
    if (N_LAUNCHES == 1) bar = xcd_barrier_post(ctl + CW_BAR, MISC + 8);
#define GRID_BAR() do { if (N_LAUNCHES == 1) xcd_barrier(bar); } while (0)
    const int lo = args.ph_lo, hi = args.ph_hi;
#define IN(k) (lo <= (k) && (k) < hi)
#define BOTH(k) (IN(k) && IN((k) + 1))
    const float* x = (const float*)args.in[0]; const int* positions = (const int*)args.in[1];
    const float* g_mix = (const float*)args.in[2]; const float* g_ffn = (const float*)args.in[3]; const float* g_final = (const float*)args.in[4];
    const float* sinks = (const float*)args.in[7]; const float* rec_norm_g = (const float*)args.in[10]; const float* w_router = (const float*)args.in[15];
    float* out = args.out;
    bf16* H = (bf16*)(ws + WS_H); bf16* BIG = (bf16*)(ws + WS_BIG);
    const size_t PLANE = (size_t)NTOK * D;

    if (IN(0)) {
        P0Args pa; pa.x = x; pa.g0 = g_mix; pa.w_in_attn = (const float*)args.in[5]; pa.w_out_attn = (const float*)args.in[6]; pa.w_in_rec = (const float*)args.in[8]; pa.w_out_rec = (const float*)args.in[11];
        pa.w_gate = (const float*)args.in[12]; pa.w_up = (const float*)args.in[13]; pa.w_down = (const float*)args.in[14]; pa.w_gate_moe = (const float*)args.in[16]; pa.w_up_moe = (const float*)args.in[17]; pa.w_down_moe = (const float*)args.in[18];
        pa.rlb = (const float*)args.in[9]; pa.pos = positions; pa.ws = ws;
        phase_prologue(pa, lds, blk, G, tid);
        if (BOTH(0)) GRID_BAR();
    }
    if (IN(1)) {
        pg8::Gemm g{H, (const bf16*)(ws + WS_W_INATT), NTOK, QKV_N, D}; pg8::StaticOrder S; S.init(NTOK, QKV_N, G, blk);
        pg8::EpiBf16Plain E{BIG, QKV_N, 1 << 20};
        pg8::gemm_phase<pg8::EpiBf16Plain, pg8::StaticOrder, PG8_ALIGN, PG8_SP2>(lds, g, S, E);
        if (BOTH(1)) GRID_BAR();
    }
    if (IN(2)) { phase_rope(BIG, (const float*)(ws + WS_ROPE), blk, G, tid); if (BOTH(2)) GRID_BAR(); }
    if (IN(3)) { phase_attn(BIG, sinks, H, (bf16*)(ws + WS_OB), (float*)(ws + WS_LSE), lds, blk, G, tid); if (BOTH(3)) GRID_BAR(); }
    if (IN(4)) {
        pg8::Gemm g{H, (const bf16*)(ws + WS_W_OUTATT), NTOK, D, D}; pg8::StaticOrder S; S.init(NTOK, D, G, blk);
        pg8::EpiRes E{x, out, D};
        pg8::gemm_phase<pg8::EpiRes, pg8::StaticOrder, PG8_ALIGN, PG8_SP2>(lds, g, S, E);
        if (BOTH(4)) GRID_BAR();
    }
    if (IN(5)) { phase_norm(out, g_ffn, H, blk, G, tid); if (BOTH(5)) GRID_BAR(); }
    if (IN(6)) {
        pg8::Gemm g{H, (const bf16*)(ws + WS_W_GU), NTOK, 2 * FF, D}; pg8::StaticOrder S; S.init(NTOK, 2 * FF, G, blk);
        pg8::EpiSwiglu E{BIG, FF, 1 << 20, 0};
        pg8::gemm_phase<pg8::EpiSwiglu, pg8::StaticOrder, PG8_ALIGN, PG8_SP2>(lds, g, S, E);
        if (BOTH(6)) GRID_BAR();
    }
    if (IN(7)) {
        pg8::Gemm g{BIG, (const bf16*)(ws + WS_W_DN), NTOK, D, FF}; pg8::StaticOrder S; S.init(NTOK, D, G, blk);
        pg8::EpiRes E{out, out, D};
        pg8::gemm_phase<pg8::EpiRes, pg8::StaticOrder, PG8_ALIGN, PG8_SP2>(lds, g, S, E);
        if (BOTH(7)) GRID_BAR();
    }
    if (IN(8)) { phase_norm(out, g_mix + D, H, blk, G, tid); if (BOTH(8)) GRID_BAR(); }
    if (IN(9)) {
        pg8::Gemm g{H, (const bf16*)(ws + WS_W_INREC), NTOK, REC_N, D}; pg8::StaticOrder S; S.init(NTOK, REC_N, G, blk);
        pg8::EpiRec2 E{BIG, PLANE, (const float*)(ws + WS_LBK), (float*)(ws + WS_DK)};
        pg8::gemm_phase<pg8::EpiRec2, pg8::StaticOrder, PG8_ALIGN, PG8_SP2>(lds, g, S, E);
        if (BOTH(9)) GRID_BAR();
    }
    if (IN(10)) { phase_hgrn(BIG, BIG + PLANE, BIG + 2 * PLANE, BIG + 3 * PLANE, BIG + 4 * PLANE, (const float*)(ws + WS_DK), rec_norm_g, H, lds, blk, G, tid); if (BOTH(10)) GRID_BAR(); }
    if (IN(12)) {
        pg8::Gemm g{H, (const bf16*)(ws + WS_W_OUTREC), NTOK, D, D}; pg8::StaticOrder S; S.init(NTOK, D, G, blk);
        pg8::EpiRes E{out, out, D};
        pg8::gemm_phase<pg8::EpiRes, pg8::StaticOrder, PG8_ALIGN, PG8_SP2>(lds, g, S, E);
        if (BOTH(12)) GRID_BAR();
    }
    int4* meta = (int4*)(ws + WS_META); int* hist = (int*)(ws + WS_HIST); int* dest = (int*)(ws + WS_DEST); int* info = (int*)(ws + WS_INFO);
    bf16* Y = (bf16*)(ws + WS_Y); bf16* HID = (bf16*)(ws + WS_HID);
    if (IN(13)) { phase_router(out, g_ffn + D, w_router, meta, hist, lds, blk, G, tid); if (BOTH(13)) GRID_BAR(); }
    if (IN(14)) { phase_scatter(out, g_ffn + D, meta, hist, dest, info, Y, lds, blk, G, tid); if (BOTH(14)) GRID_BAR(); }
    for (int c = 0; c < 3; ++c) {
        if (IN(15 + 2 * c) || IN(16 + 2 * c)) {
            const int T = info[8]; const int tile0 = 256 * c; int ntl = T - tile0; ntl = ntl > 256 ? 256 : ntl; ntl = ntl < 0 ? 0 : ntl;
            pg8::MoeOrder S; S.tile0 = tile0; S.te0 = info[0]; S.te1 = info[1]; S.te2 = info[2]; S.te3 = info[3]; S.te4 = info[4]; S.te5 = info[5]; S.te6 = info[6];
            if (IN(15 + 2 * c)) {
                S.nN = 28; S.so.init(ntl * 256, 2 * FF, G, blk);
                pg8::Gemm g{Y, (const bf16*)(ws + WS_WMOE_GU), 0, 0, D};
                pg8::EpiSwiglu E{HID, FF, 28, tile0};
                pg8::gemm_phase<pg8::EpiSwiglu, pg8::MoeOrder, PG8_ALIGN, PG8_SP2>(lds, g, S, E);
                if (BOTH(15 + 2 * c)) GRID_BAR();
            }
            if (IN(16 + 2 * c)) {
                S.nN = 4; S.so.init(ntl * 256, D, G, blk);
                pg8::Gemm g{HID - (size_t)tile0 * 256 * FF, (const bf16*)(ws + WS_WMOE_DN), 0, 0, FF};
                pg8::EpiBf16Plain E{Y, D, 4};
                pg8::gemm_phase<pg8::EpiBf16Plain, pg8::MoeOrder, PG8_ALIGN, PG8_SP2>(lds, g, S, E);
                if (BOTH(16 + 2 * c)) GRID_BAR();
            }
        }
    }
    if (IN(21)) phase_combine(out, Y, meta, dest, g_final, blk, G, tid);
#undef IN
#undef BOTH
}

extern "C" void kernel_launch(void* const* d_in, const int* in_sizes, int n_in, void* d_out, int out_size, void* d_ws, size_t ws_size, hipStream_t stream) {
    static int grid = 0;
    if (grid == 0) {
        if (n_in != 19 || in_sizes[0] != NTOK * D || out_size != NTOK * D || ws_size < WS_END) { fprintf(stderr, "kernel_launch: unexpected shapes / workspace (n_in %d, ws %zu); nothing launched\n", n_in, ws_size); grid = -1; return; }
        int dev = 0, cus = 0, per_cu = 0;
        if (hipGetDevice(&dev) != hipSuccess || hipDeviceGetAttribute(&cus, hipDeviceAttributeMultiprocessorCount, dev) != hipSuccess) { grid = -1; return; }
        if (hipFuncSetAttribute((const void*)fwd, hipFuncAttributeMaxDynamicSharedMemorySize, LDS_BYTES) != hipSuccess) { fprintf(stderr, "kernel_launch: hipFuncSetAttribute failed\n"); grid = -1; return; }
        if (hipOccupancyMaxActiveBlocksPerMultiprocessor(&per_cu, (const void*)fwd, NWAVES * 64, LDS_BYTES) != hipSuccess || per_cu < 1) fprintf(stderr, "kernel_launch: occupancy query says %d\n", per_cu);
        (void)hipGetLastError();
        grid = cus;
    }
    if (grid < 0) return;
    if (hipMemsetAsync((char*)d_ws + WS_CTL, 0, CTL_ZERO_BYTES, stream) != hipSuccess) return;
    Args a{};
    for (int i = 0; i < 19; ++i) a.in[i] = d_in[i];
    a.out = (float*)d_out; a.ws = (unsigned char*)d_ws;
    if (N_LAUNCHES == 1) { a.ph_lo = 0; a.ph_hi = NPH; hipLaunchKernelGGL(fwd, dim3(grid), dim3(NWAVES * 64), LDS_BYTES, stream, a); }
    else for (int li = 0; li < NPH; ++li) { a.ph_lo = li; a.ph_hi = li + 1; hipLaunchKernelGGL(fwd, dim3(grid), dim3(NWAVES * 64), LDS_BYTES, stream, a); }
}
```

```cpp
#include <hip/hip_runtime.h>
#include <cstdio>
#include <cstdint>
#define PROBE_PHASE -1
namespace pg8 {
#define PG8_LAS __attribute__((address_space(3)))
typedef unsigned short bf16_t;
typedef short bf16x8 __attribute__((ext_vector_type(8)));
typedef float f32x4 __attribute__((ext_vector_type(4)));
typedef unsigned u32x4 __attribute__((ext_vector_type(4)));
constexpr int BM = 256, BK = 64, HALF = 128, HTB = HALF * BK * 2  , STAGE_BYTES = 8 * HTB, NXCD = 8, WGM = 8;

__host__ __device__ __forceinline__ int lds_byte(int r, int c) { const int st = (r >> 4) * 2 + (c >> 5), rr = r & 15, cc = c & 31, ob = rr * 64 + cc * 2; return st * 1024 + (ob ^ (((ob >> 9) & 1) << 5)); }
__host__ __device__ __forceinline__ void stage_rc(int b, int& R, int& C) { const int st = b / 1024, sb = b % 1024, swz = sb ^ (((sb >> 9) & 1) << 5); R = (st >> 1) * 16 + swz / 64; C = (st & 1) * 32 + (swz % 64) / 2; }
__host__ __device__ __forceinline__ int perm32(int rho) { const int n = rho >> 4, i = rho & 15; return 8 * (i >> 2) + 4 * n + (i & 3); }

struct Unit { int pm, pn; };
struct Gemm { const bf16_t* A; const bf16_t* Bt; int M, N, K; };

struct StaticOrder {
    int nM, nN, nwg, G, c;
    __host__ __device__ void init(int M, int N, int G_, int c_) { nM = M / BM; nN = N / BM; nwg = nM * nN; G = G_; c = c_; }
    __host__ __device__ bool next(int i, Unit& u) const {
        const long L = (long)i * G + c; if (L >= nwg) return false;
        int wgid = (int)L; { const int q = nwg / NXCD, r = nwg % NXCD, xcd = wgid % NXCD, off = wgid / NXCD; wgid = (xcd < r ? xcd * (q + 1) : r * (q + 1) + (xcd - r) * q) + off; }
        const int nig = WGM * nN, gid = wgid / nig, fm = gid * WGM, gsz = (nM - fm) < WGM ? (nM - fm) : WGM;
        u.pm = fm + ((wgid % nig) % gsz); u.pn = (wgid % nig) / gsz; return true;
    }
    __device__ __forceinline__ void a_ready(const Unit&) const {}
    __device__ __forceinline__ void done(const Unit&) const {}
};
__device__ __forceinline__ unsigned cvt_pk_bf16(float lo, float hi) { unsigned r; asm volatile("v_cvt_pk_bf16_f32 %0, %1, %2" : "=v"(r) : "v"(lo), "v"(hi)); return r; }
__device__ __forceinline__ float sigmoid_f(float x) { return __builtin_amdgcn_rcpf(1.0f + __builtin_amdgcn_exp2f(-1.44269504089f * x)); }
__device__ __forceinline__ float silu_f(float x) { return x * sigmoid_f(x); }
__device__ __forceinline__ u32x4 pack8(const f32x4& v0, const f32x4& v1) { u32x4 w; w.x = cvt_pk_bf16(v0[0], v0[1]); w.y = cvt_pk_bf16(v0[2], v0[3]); w.z = cvt_pk_bf16(v1[0], v1[1]); w.w = cvt_pk_bf16(v1[2], v1[3]); return w; }
struct EpiBf16Plain {
    static constexpr bool PERM = true, AFTER_DRAIN = false;
    bf16_t* O; int ldc; int nmod;
    __device__ __forceinline__ void operator()(const f32x4 (&acc)[2][2][4][2], const Unit& u, int wr, int wc, int fr, int fq) const {
        const int row0 = u.pm * BM + wr * 64 + fr; const int col0 = (u.pn % nmod) * BM + wc * 32 + 8 * fq;
#pragma unroll
        for (int ai = 0; ai < 2; ++ai)
#pragma unroll
            for (int m = 0; m < 4; ++m) { bf16_t* rowp = O + (size_t)(row0 + ai * HALF + m * 16) * ldc + col0;
#pragma unroll
                for (int bj = 0; bj < 2; ++bj) *(u32x4*)(rowp + bj * HALF) = pack8(acc[ai][bj][m][0], acc[ai][bj][m][1]); }
    }
};
struct EpiRes {
    static constexpr bool PERM = false, AFTER_DRAIN = false;
    const float* base; float* out; int ldc;
    __device__ __forceinline__ void operator()(const f32x4 (&acc)[2][2][4][2], const Unit& u, int wr, int wc, int fr, int fq) const {
        const int row0 = u.pm * BM + wr * 64 + fr, col0 = u.pn * BM + wc * 32 + 4 * fq;
#pragma unroll
        for (int ai = 0; ai < 2; ++ai)
#pragma unroll
            for (int m = 0; m < 4; ++m) { const size_t off = (size_t)(row0 + ai * HALF + m * 16) * ldc + col0;
#pragma unroll
                for (int bj = 0; bj < 2; ++bj)
#pragma unroll
                    for (int n = 0; n < 2; ++n) { const f32x4 bs = *(const f32x4*)(base + off + bj * HALF + n * 16); *(f32x4*)(out + off + bj * HALF + n * 16) = bs + acc[ai][bj][m][n]; }
                asm volatile("" ::: "memory"); }
    }
};
struct EpiSwiglu {
    static constexpr bool PERM = true, AFTER_DRAIN = false;
    bf16_t* O; int ldc; int nN; int tile0;
    __device__ __forceinline__ void operator()(const f32x4 (&acc)[2][2][4][2], const Unit& u, int wr, int wc, int fr, int fq) const {
        const int row0 = (u.pm - tile0) * BM + wr * 64 + fr; const int col0 = (u.pn % nN) * HALF + wc * 32 + 8 * fq;
#pragma unroll
        for (int ai = 0; ai < 2; ++ai)
#pragma unroll
            for (int m = 0; m < 4; ++m) { bf16_t* rowp = O + (size_t)(row0 + ai * HALF + m * 16) * ldc + col0;
                f32x4 h0, h1;
#pragma unroll
                for (int j = 0; j < 4; ++j) { h0[j] = silu_f(acc[ai][0][m][0][j]) * acc[ai][1][m][0][j]; h1[j] = silu_f(acc[ai][0][m][1][j]) * acc[ai][1][m][1][j]; }
                *(u32x4*)rowp = pack8(h0, h1); }
    }
};
struct EpiRec {
    static constexpr bool PERM = true, AFTER_DRAIN = false;
    bf16_t* P; size_t plane; const float* lbk;
    __device__ __forceinline__ void operator()(const f32x4 (&acc)[2][2][4][2], const Unit& u, int wr, int wc, int fr, int fq) const {
        const int hd = u.pn & 7; const bool second = (u.pn >> 3) != 0;
        const int row0 = u.pm * BM + wr * 64 + fr; const int ch0 = hd * HALF + wc * 32 + 8 * fq;
        const f32x4 l0 = *(const f32x4*)(lbk + ch0), l1 = *(const f32x4*)(lbk + ch0 + 4);
        bf16_t* pa = P + (second ? 2 * plane : 0); bf16_t* pb = pa + plane;
#pragma unroll
        for (int ai = 0; ai < 2; ++ai)
#pragma unroll
            for (int m = 0; m < 4; ++m) { const size_t off = (size_t)(row0 + ai * HALF + m * 16) * 1024 + ch0;
                f32x4 a0 = acc[ai][0][m][0], a1 = acc[ai][0][m][1], b0 = acc[ai][1][m][0], b1 = acc[ai][1][m][1];
                if (!second) {
#pragma unroll
                    for (int j = 0; j < 4; ++j) { a0[j] = silu_f(a0[j]); a1[j] = silu_f(a1[j]); b0[j] = l0[j] * sigmoid_f(-b0[j]); b1[j] = l1[j] * sigmoid_f(-b1[j]); }
                } else {
#pragma unroll
                    for (int j = 0; j < 4; ++j) { b0[j] = silu_f(b0[j]); b1[j] = silu_f(b1[j]); }
                }
                *(u32x4*)(pa + off) = pack8(a0, a1); *(u32x4*)(pb + off) = pack8(b0, b1); }
    }
};
struct MoeOrder {
    StaticOrder so; int tile0, nN; int te0, te1, te2, te3, te4, te5, te6;
    __device__ __forceinline__ bool next(int i, Unit& u) const {
        Unit l; if (!so.next(i, l)) return false;
        const int pm = tile0 + l.pm;
        const int e = (pm >= te0) + (pm >= te1) + (pm >= te2) + (pm >= te3) + (pm >= te4) + (pm >= te5) + (pm >= te6);
        u.pm = pm; u.pn = e * nN + l.pn; return true;
    }
    __device__ __forceinline__ void a_ready(const Unit&) const {}
    __device__ __forceinline__ void done(const Unit&) const {}
};

template <int CTRL> __device__ __forceinline__ float dpp0(float v) { return __builtin_bit_cast(float, __builtin_amdgcn_update_dpp(0, __builtin_bit_cast(int, v), CTRL, 0xf, 0xf, true)); }
typedef unsigned u32x2 __attribute__((ext_vector_type(2)));
struct EpiRec2 {
    static constexpr bool PERM = true, AFTER_DRAIN = false;
    bf16_t* P; size_t plane; const float* lbk; float* DK;
    __device__ __forceinline__ void operator()(const f32x4 (&acc)[2][2][4][2], const Unit& u, int wr, int wc, int fr, int fq) const {
        const int hd = u.pn & 7; const bool second = (u.pn >> 3) != 0;
        const int row0 = u.pm * BM + wr * 64 + fr; const int ch0 = hd * HALF + wc * 32 + 8 * fq;
        if (second) {
#pragma unroll
            for (int ai = 0; ai < 2; ++ai)
#pragma unroll
                for (int m = 0; m < 4; ++m) { const size_t off = (size_t)(row0 + ai * HALF + m * 16) * 1024 + ch0;
                    f32x4 b0 = acc[ai][1][m][0], b1 = acc[ai][1][m][1];
#pragma unroll
                    for (int j = 0; j < 4; ++j) { b0[j] = silu_f(b0[j]); b1[j] = silu_f(b1[j]); }
                    *(u32x4*)(P + 3 * plane + off) = pack8(acc[ai][0][m][0], acc[ai][0][m][1]); *(u32x4*)(P + 4 * plane + off) = pack8(b0, b1); }
        } else {
            const int lane15 = (fq * 16 + fr) | 15;
#pragma unroll
            for (int ai = 0; ai < 2; ++ai)
#pragma unroll
                for (int n = 0; n < 2; ++n) {
                    const f32x4 lbv = *(const f32x4*)(lbk + ch0 + 4 * n);
                    float kk[4][4], bb[4][4];
#pragma unroll
                    for (int m = 0; m < 4; ++m)
#pragma unroll
                        for (int j = 0; j < 4; ++j) { const float k_ = lbv[j] * sigmoid_f(-acc[ai][1][m][n][j]); kk[m][j] = k_; float x = __logf(1.0f - k_);
                            x += dpp0<0x111>(x); x += dpp0<0x112>(x); x += dpp0<0x114>(x); x += dpp0<0x118>(x); bb[m][j] = x; }
                    float run[4] = {0.f, 0.f, 0.f, 0.f};
#pragma unroll
                    for (int m = 0; m < 4; ++m)
#pragma unroll
                        for (int j = 0; j < 4; ++j) { const float tot = __shfl(bb[m][j], lane15); bb[m][j] += run[j]; run[j] += tot; }
#pragma unroll
                    for (int m = 0; m < 4; ++m) { const size_t off = (size_t)(row0 + ai * HALF + m * 16) * 1024 + ch0 + 4 * n;
                        float qe[4], ki[4], ke[4];
#pragma unroll
                        for (int j = 0; j < 4; ++j) { const float bt = bb[m][j]; qe[j] = silu_f(acc[ai][0][m][n][j]) * __expf(bt); ki[j] = kk[m][j] * __expf(fminf(-bt, 80.f)); ke[j] = kk[m][j] * __expf(run[j] - bt); }
                        u32x2 w; w.x = cvt_pk_bf16(qe[0], qe[1]); w.y = cvt_pk_bf16(qe[2], qe[3]); *(u32x2*)(P + off) = w;
                        w.x = cvt_pk_bf16(ki[0], ki[1]); w.y = cvt_pk_bf16(ki[2], ki[3]); *(u32x2*)(P + plane + off) = w;
                        w.x = cvt_pk_bf16(ke[0], ke[1]); w.y = cvt_pk_bf16(ke[2], ke[3]); *(u32x2*)(P + 2 * plane + off) = w; }
                    if (fr == 0) { const int chunk = 4 * u.pm + 2 * ai + wr; *(f32x4*)(DK + (size_t)chunk * 1024 + ch0 + 4 * n) = (f32x4){__expf(run[0]), __expf(run[1]), __expf(run[2]), __expf(run[3])}; }
                }
        }
    }
};
template <class Epi, class Sched, bool ALIGN_EPI = false, bool SP2 = false>
__device__ __forceinline__ void gemm_phase(PG8_LAS unsigned char* lds, const Gemm g, const Sched& S, const Epi& E) {
    const int tid = threadIdx.x, wid = __builtin_amdgcn_readfirstlane(tid >> 6), lane = tid & 63, wr = wid >> 2, wc = wid & 3, fr = lane & 15, fq = lane >> 4;
    const int K = g.K, nt = K / BK;
    unsigned voffA[2], voffB[2];
#pragma unroll
    for (int i = 0; i < 2; ++i) { int R, C; stage_rc(tid * 16 + i * 8192, R, C); const int Rb = Epi::PERM ? ((R & ~31) + perm32(R & 31)) : R;
        voffA[i] = (unsigned)(R * K + C) * 2u; voffB[i] = (unsigned)(Rb * K + C) * 2u; }
    const size_t kstep = (size_t)(BK * 2);
    const size_t hstep = (size_t)HALF * K * 2;
    const size_t tstep = 2 * hstep;
    const unsigned ldsw = (unsigned)wid * 1024u;
    const int aoff = lds_byte(wr * 64 + fr, fq * 8), boff = lds_byte(wc * 32 + fr, fq * 8);
#define PG8_SA(b, h) (((b) * 2 + (h)) * HTB)
#define PG8_SB(b, h) ((4 + (b) * 2 + (h)) * HTB)
#define PG8_STAGE(bufoff, gbase, voff) do { _Pragma("unroll") for (int _i = 0; _i < 2; ++_i) \
        __builtin_amdgcn_global_load_lds((const unsigned*)((const char*)(gbase) + (voff)[_i]), (PG8_LAS unsigned*)(lds + (bufoff) + ldsw + _i * 8192), 16, 0, 0); } while (0)
#define PG8_LDA(dst, b, h) do { _Pragma("unroll") for (int m = 0; m < 4; ++m) _Pragma("unroll") for (int k = 0; k < 2; ++k) dst[m][k] = *(const PG8_LAS bf16x8*)(lds + PG8_SA(b, h) + aoff + m * 2048 + k * 1024); } while (0)
#define PG8_LDB(dst, b, h) do { _Pragma("unroll") for (int n = 0; n < 2; ++n) _Pragma("unroll") for (int k = 0; k < 2; ++k) dst[n][k] = *(const PG8_LAS bf16x8*)(lds + PG8_SB(b, h) + boff + n * 2048 + k * 1024); } while (0)
#define PG8_MMA(ai, bj, At, Bt) do { __builtin_amdgcn_s_setprio(1); _Pragma("unroll") for (int m = 0; m < 4; ++m) _Pragma("unroll") for (int n = 0; n < 2; ++n) _Pragma("unroll") for (int k = 0; k < 2; ++k) \
        acc[ai][bj][m][n] = __builtin_amdgcn_mfma_f32_16x16x32_bf16(Bt[n][k], At[m][k], acc[ai][bj][m][n], 0, 0, 0); __builtin_amdgcn_s_setprio(0); } while (0)
#define PG8_WAIT_V(n) asm volatile("s_waitcnt vmcnt(" #n ")" ::: "memory")
#define PG8_WAIT_L(n) asm volatile("s_waitcnt lgkmcnt(" #n ")" ::: "memory")
#define PG8_BAR __builtin_amdgcn_s_barrier()
#define PG8_SCHED __builtin_amdgcn_sched_barrier(0)
    Unit cur, nxt; int ui = 0;
    if (!S.next(0, cur)) return;
    f32x4 acc[2][2][4][2];
#pragma unroll
    for (int a = 0; a < 2; ++a)
#pragma unroll
        for (int b = 0; b < 2; ++b)
#pragma unroll
            for (int m = 0; m < 4; ++m)
#pragma unroll
                for (int n = 0; n < 2; ++n) acc[a][b][m][n] = (f32x4){0.f, 0.f, 0.f, 0.f};
    bf16x8 At[4][2], B0[2][2], B1[2][2];
    const char* cA = (const char*)g.A + (size_t)cur.pm * tstep; const char* cB = (const char*)g.Bt + (size_t)cur.pn * tstep;
    S.a_ready(cur);
    if constexpr (SP2) {
        PG8_STAGE(PG8_SB(0, 0), cB, voffB); PG8_STAGE(PG8_SB(0, 1), cB + hstep, voffB); PG8_STAGE(PG8_SA(0, 0), cA, voffA); PG8_STAGE(PG8_SA(0, 1), cA + hstep, voffA);
        if (wr == 1) PG8_BAR;
        PG8_WAIT_V(2); PG8_BAR;
        PG8_STAGE(PG8_SB(1, 0), cB + kstep, voffB); PG8_STAGE(PG8_SA(1, 0), cA + kstep, voffA); PG8_STAGE(PG8_SB(1, 1), cB + hstep + kstep, voffB);
        PG8_WAIT_V(6); PG8_BAR;
    } else {
        PG8_STAGE(PG8_SB(0, 0), cB, voffB); PG8_STAGE(PG8_SA(0, 0), cA, voffA); PG8_STAGE(PG8_SB(0, 1), cB + hstep, voffB); PG8_STAGE(PG8_SA(0, 1), cA + hstep, voffA);
        if (wr == 1) PG8_BAR;
        PG8_WAIT_V(4); PG8_BAR;
        PG8_STAGE(PG8_SB(1, 0), cB + kstep, voffB); PG8_STAGE(PG8_SA(1, 0), cA + kstep, voffA); PG8_STAGE(PG8_SB(1, 1), cB + hstep + kstep, voffB);
        PG8_WAIT_V(6); PG8_BAR;
    }
    for (;;) {
        const bool has_next = S.next(ui + 1, nxt);
        const char* nA = has_next ? (const char*)g.A + (size_t)nxt.pm * tstep : cA; const char* nB = has_next ? (const char*)g.Bt + (size_t)nxt.pn * tstep : cB;
        for (int t = 0; t < nt; t += 2) {
            const bool last = (t == nt - 2);
            const char* a1 = cA + (size_t)(t + 1) * kstep;
            const char* a2 = last ? nA : cA + (size_t)(t + 2) * kstep; const char* b2 = last ? nB : cB + (size_t)(t + 2) * kstep;
            const char* a3 = a2 + kstep; const char* b3 = b2 + kstep;
            if (last && has_next) S.a_ready(nxt);
            if constexpr (SP2) {
            PG8_LDB(B0, 0, 0); PG8_LDB(B1, 0, 1); PG8_SCHED; PG8_LDA(At, 0, 0); PG8_STAGE(PG8_SA(1, 1), a1 + hstep, voffA);
            PG8_WAIT_V(8); PG8_WAIT_L(0); PG8_BAR; PG8_MMA(0, 0, At, B0); PG8_MMA(0, 1, At, B1); PG8_BAR; PG8_SCHED;
            PG8_LDA(At, 0, 1); PG8_STAGE(PG8_SB(0, 0), b2, voffB); PG8_STAGE(PG8_SB(0, 1), b2 + hstep, voffB); PG8_STAGE(PG8_SA(0, 0), a2, voffA);
            PG8_WAIT_V(8); PG8_WAIT_L(0); PG8_BAR; PG8_MMA(1, 0, At, B0); PG8_MMA(1, 1, At, B1); PG8_BAR; PG8_SCHED;
            PG8_LDB(B0, 1, 0); PG8_LDB(B1, 1, 1); PG8_SCHED; PG8_LDA(At, 1, 0); PG8_STAGE(PG8_SA(0, 1), a2 + hstep, voffA);
            PG8_WAIT_V(8); PG8_WAIT_L(0); PG8_BAR; PG8_MMA(0, 0, At, B0); PG8_MMA(0, 1, At, B1); PG8_BAR; PG8_SCHED;
            PG8_LDA(At, 1, 1); PG8_STAGE(PG8_SB(1, 0), b3, voffB); PG8_STAGE(PG8_SB(1, 1), b3 + hstep, voffB); PG8_STAGE(PG8_SA(1, 0), a3, voffA);
            PG8_WAIT_V(8); PG8_WAIT_L(0); PG8_BAR; PG8_MMA(1, 0, At, B0); PG8_MMA(1, 1, At, B1); PG8_BAR; PG8_SCHED;
            } else {
            PG8_LDB(B0, 0, 0); PG8_SCHED; PG8_LDA(At, 0, 0); PG8_STAGE(PG8_SA(1, 1), a1 + hstep, voffA);
            PG8_WAIT_L(8); PG8_BAR; PG8_WAIT_L(0); PG8_MMA(0, 0, At, B0); PG8_BAR; PG8_SCHED;
            PG8_LDB(B1, 0, 1); PG8_STAGE(PG8_SB(0, 0), b2, voffB);
            PG8_BAR; PG8_WAIT_L(0); PG8_MMA(0, 1, At, B1); PG8_BAR;
            PG8_LDA(At, 0, 1); PG8_STAGE(PG8_SA(0, 0), a2, voffA);
            PG8_BAR; PG8_WAIT_L(0); PG8_MMA(1, 0, At, B0); PG8_BAR; PG8_SCHED;
            PG8_STAGE(PG8_SB(0, 1), b2 + hstep, voffB);
            PG8_WAIT_V(6); PG8_BAR; PG8_MMA(1, 1, At, B1); PG8_BAR;
            PG8_LDB(B0, 1, 0); PG8_SCHED; PG8_LDA(At, 1, 0); PG8_STAGE(PG8_SA(0, 1), a2 + hstep, voffA);
            PG8_WAIT_L(8); PG8_BAR; PG8_WAIT_L(0); PG8_MMA(0, 0, At, B0); PG8_BAR; PG8_SCHED;
            PG8_LDB(B1, 1, 1); PG8_STAGE(PG8_SB(1, 0), b3, voffB);
            PG8_BAR; PG8_WAIT_L(0); PG8_MMA(0, 1, At, B1); PG8_BAR;
            PG8_LDA(At, 1, 1); PG8_STAGE(PG8_SA(1, 0), a3, voffA);
            PG8_BAR; PG8_WAIT_L(0); PG8_MMA(1, 0, At, B0); PG8_BAR; PG8_SCHED;
            PG8_STAGE(PG8_SB(1, 1), b3 + hstep, voffB);
            PG8_WAIT_V(6); PG8_BAR; PG8_MMA(1, 1, At, B1); PG8_BAR;
            }
        }
        if constexpr (ALIGN_EPI) { if (wr == 0) PG8_BAR; }
        if constexpr (!Epi::AFTER_DRAIN) { E(acc, cur, wr, wc, fr, fq); S.done(cur); }
        if (!has_next) break;
#pragma unroll
        for (int a = 0; a < 2; ++a)
#pragma unroll
            for (int b = 0; b < 2; ++b)
#pragma unroll
                for (int m = 0; m < 4; ++m)
#pragma unroll
                    for (int n = 0; n < 2; ++n) acc[a][b][m][n] = (f32x4){0.f, 0.f, 0.f, 0.f};
        cur = nxt; cA = nA; cB = nB; ++ui;
        if constexpr (ALIGN_EPI) { if (wr == 1) PG8_BAR; }
    }
    PG8_WAIT_V(0);
    if constexpr (!ALIGN_EPI) { if (wr == 0) PG8_BAR; }
    PG8_BAR;
    if constexpr (Epi::AFTER_DRAIN) { E.fused(acc, cur, wr, wc, fr, fq, lds, wid, lane); S.done(cur); }
#undef PG8_SA
#undef PG8_SB
#undef PG8_STAGE
#undef PG8_LDA
#undef PG8_LDB
#undef PG8_MMA
#undef PG8_WAIT_V
#undef PG8_WAIT_L
#undef PG8_BAR
#undef PG8_SCHED
}
}
#ifndef PG8_SP2
#define PG8_SP2 true
#endif
#ifndef PG8_ALIGN
#define PG8_ALIGN true
#endif
constexpr int NWAVES = 8;
constexpr int BATCH = 8, SEQ = 8192, D = 1024, NTOK = BATCH * SEQ;
constexpr int QKV_N = 2304, FF = 3584, NEXP = 8, REC_N = 4096;
constexpr float EPS = 1e-6f;
constexpr int NPH = 22;
#ifndef MK_N_LAUNCHES
#define MK_N_LAUNCHES 1
#endif
constexpr int N_LAUNCHES = MK_N_LAUNCHES;
constexpr size_t MiB = 1u << 20;
constexpr size_t WS_CTL = 0, CTL_ZERO_BYTES = 1 * MiB;
constexpr size_t WS_WMOE_GU = 1 * MiB;
constexpr size_t WS_WMOE_DN = 113 * MiB;
constexpr size_t WS_H = 169 * MiB;
constexpr size_t WS_W_INATT = 297 * MiB;
constexpr size_t WS_W_OUTATT = WS_W_INATT + (size_t)QKV_N * D * 2;
constexpr size_t WS_W_GU = WS_W_OUTATT + (size_t)D * D * 2;
constexpr size_t WS_W_DN = WS_W_GU + (size_t)2 * FF * D * 2;
constexpr size_t WS_W_INREC = WS_W_DN + (size_t)D * FF * 2;
constexpr size_t WS_W_OUTREC = WS_W_INREC + (size_t)REC_N * D * 2;
constexpr size_t WS_BIG = 335 * MiB;
constexpr size_t WS_Y = 297 * MiB;
constexpr size_t WS_HID = 557 * MiB;
constexpr size_t WS_MISC = 1008 * MiB;
constexpr size_t WS_ROPE = WS_MISC;
constexpr size_t WS_META = WS_MISC + 4 * MiB;
constexpr size_t WS_DEST = WS_MISC + 5 * MiB;
constexpr size_t WS_HIST = WS_MISC + 6 * MiB;
constexpr size_t WS_INFO = WS_HIST + 8192;
constexpr size_t WS_LBK = WS_INFO + 256;
constexpr size_t WS_OB = 623 * MiB;
constexpr size_t WS_LSE = 751 * MiB;
constexpr size_t WS_DK = WS_MISC + 8 * MiB;
constexpr size_t WS_HL = 976 * MiB;
constexpr size_t WS_HP = 988 * MiB;
constexpr size_t WS_END = 1024 * MiB;
static_assert(WS_W_OUTREC + (size_t)D * D * 2 <= WS_BIG && WS_BIG + 640 * MiB <= WS_MISC && WS_Y + 260 * MiB <= WS_HID && WS_HID + 448 * MiB <= WS_MISC && WS_LBK + 4096 <= WS_END, "d_ws map");
constexpr int CW_BAR = 4096;
constexpr int RING_BYTES = 131072;
constexpr int LDSCTL_OFF = RING_BYTES, MISC_OFF = LDSCTL_OFF + 320;
constexpr int LDS_BYTES = 147456;

#define GAS __attribute__((address_space(1)))
#define LAS __attribute__((address_space(3)))
typedef unsigned short bf16;
typedef unsigned v4u __attribute__((ext_vector_type(4)));
typedef unsigned v2u __attribute__((ext_vector_type(2)));
typedef float f32x4 __attribute__((ext_vector_type(4)));
#define LDS_WAIT() asm volatile("s_waitcnt lgkmcnt(0)" ::: "memory")
__device__ __forceinline__ unsigned f2bf(float f) { unsigned u = __builtin_bit_cast(unsigned, f); return (u + 0x7fffu + ((u >> 16) & 1u)) >> 16; }
__device__ __forceinline__ unsigned pk2(float lo, float hi) { return f2bf(lo) | (f2bf(hi) << 16); }
__device__ __forceinline__ float bflo(unsigned w) { return __builtin_bit_cast(float, w << 16); }
__device__ __forceinline__ float bfhi(unsigned w) { return __builtin_bit_cast(float, w & 0xffff0000u); }
__device__ __forceinline__ float wave_sum(float v) {
#pragma unroll
    for (int o = 1; o < 64; o <<= 1) v += __shfl_xor(v, o);
    return v;
}
#define XB_TMO      128
#define XB_XCNT(j)  (256  + 64 * (j))
#define XB_XSUB(j)  (1280 + 64 * (j))
#define XB_XGEN(j)  (2304 + 64 * (j))
#define XB_TOP      3328
#define XB_TOPGEN   3392
#define XCD_BAR_WORDS 3456
#define XB_SPIN_CAP (1u << 24)

__device__ __forceinline__ unsigned xb_ld(unsigned* p)              { return __hip_atomic_load(p, __ATOMIC_RELAXED, __HIP_MEMORY_SCOPE_AGENT); }
__device__ __forceinline__ unsigned xb_add(unsigned* p, unsigned v) { return __hip_atomic_fetch_add(p, v, __ATOMIC_RELAXED, __HIP_MEMORY_SCOPE_AGENT); }
__device__ __forceinline__ unsigned xb_xcc_id() { return (unsigned)__builtin_amdgcn_s_getreg((3 << 11) | 20) & 0xFu; }
#define XB_SPIN(cond, bar) do { unsigned _sp = 0; while (cond) { __builtin_amdgcn_s_sleep(1); \
    if ((++_sp & 255u) == 0u) { if (xb_ld(&(bar)[XB_TMO])) break; if (_sp > XB_SPIN_CAP) { atomicAdd(&(bar)[XB_TMO], 1u); break; } } } } while (0)

struct XcdBarrier {
    unsigned* bar; unsigned x;
    volatile LAS unsigned* st;
};

__device__ __forceinline__ XcdBarrier xcd_barrier_post(unsigned* bar, volatile LAS unsigned* st) {
    XcdBarrier b; b.bar = bar; b.x = xb_xcc_id(); b.st = st;
    if (threadIdx.x == 0) (void)xb_add(&bar[XB_XCNT(b.x)], 1u);
    return b;
}
__device__ __forceinline__ void xcd_barrier_complete(unsigned* bar, unsigned x, unsigned& nloc, unsigned& nx) {
    const unsigned G = gridDim.x * gridDim.y * gridDim.z;
    unsigned sum, cnt, mine, sp = 0u;
    for (;;) {
        sum = 0u; cnt = 0u; mine = 0u;
#pragma unroll
        for (unsigned j = 0; j < 16; ++j) { const unsigned c = xb_ld(&bar[XB_XCNT(j)]); sum += c; cnt += (c > 0u) ? 1u : 0u; mine = (j == x) ? c : mine; }
        if (sum == G) break;
        __builtin_amdgcn_s_sleep(1);
        if ((++sp & 255u) == 0u) { if (xb_ld(&bar[XB_TMO])) break; if (sp > XB_SPIN_CAP) { atomicAdd(&bar[XB_TMO], 1u); break; } }
    }
    nloc = mine > 0u ? mine : 1u; nx = cnt > 0u ? cnt : 1u;
}

__device__ __forceinline__ void xcd_barrier(const XcdBarrier& b) {
    asm volatile("s_waitcnt vmcnt(0)" ::: "memory");
    __syncthreads();
    if (threadIdx.x == 0) {
        unsigned* bar = b.bar;
        __builtin_amdgcn_s_waitcnt(0);
        unsigned nloc = b.st[0], nx = b.st[1];
        if (nloc == 0u) { xcd_barrier_complete(bar, b.x, nloc, nx); b.st[0] = nloc; b.st[1] = nx; }
        const unsigned old = xb_add(&bar[XB_XSUB(b.x)], 1u);
        const unsigned gen = old / nloc;
        if (old + 1u == (gen + 1u) * nloc) {
            __builtin_amdgcn_fence(__ATOMIC_RELEASE, "agent");
            asm volatile("s_waitcnt vmcnt(0)" ::: "memory");
            const unsigned og = xb_add(&bar[XB_TOP], 1u);
            const unsigned tg = og / nx;
            if (og + 1u == (tg + 1u) * nx) xb_add(&bar[XB_TOPGEN], 1u);
            else XB_SPIN(xb_ld(&bar[XB_TOPGEN]) == tg, bar);
            __builtin_amdgcn_fence(__ATOMIC_ACQUIRE, "agent");
            xb_add(&bar[XB_XGEN(b.x)], 1u);
            asm volatile("s_waitcnt vmcnt(0)" ::: "memory");
        } else {
            XB_SPIN(xb_ld(&bar[XB_XGEN(b.x)]) == gen, bar);
            __builtin_amdgcn_fence(__ATOMIC_ACQUIRE, "agent");
            asm volatile("s_waitcnt vmcnt(0)" ::: "memory");
        }
    }
    __syncthreads();
}
__device__ __forceinline__ void transpose_item(const float* W, int N, bf16* WT, int K, int k0, int n0, int drow0, LAS float* scr, int lane) {
#pragma unroll 8
    for (int i = 0; i < 32; ++i) { const int kk = 2 * i + (lane >> 5); scr[kk * 33 + (lane & 31)] = W[(size_t)(k0 + kk) * N + n0 + (lane & 31)]; }
    LDS_WAIT(); asm volatile("" ::: "memory");
    const int c = lane & 7;
#pragma unroll
    for (int j = 0; j < 4; ++j) { const int n = (lane >> 3) + 8 * j; const LAS float* s = scr + (8 * c) * 33 + n;
        v4u o; o.x = pk2(s[0 * 33], s[1 * 33]); o.y = pk2(s[2 * 33], s[3 * 33]); o.z = pk2(s[4 * 33], s[5 * 33]); o.w = pk2(s[6 * 33], s[7 * 33]);
        *(v4u*)(WT + (size_t)(drow0 + n) * K + k0 + 8 * c) = o; }
    LDS_WAIT(); asm volatile("" ::: "memory");
}
__device__ __forceinline__ int dest_row(int mode, int n0) {
    if (mode == 0) return n0;
    if (mode == 1) return 256 * (n0 >> 7) + (n0 & 127);
    if (mode == 2) return 256 * (n0 >> 7) + 128 + (n0 & 127);
    const int sec = n0 >> 10, c = n0 & 1023, hd = c >> 7, w = c & 127;
    return ((sec >> 1) ? 2048 : 0) + 256 * hd + ((sec & 1) ? 128 : 0) + w;
}
__device__ __forceinline__ void conv_matrix_item(const float* W, int K, int N, bf16* WT, int mode, int r, LAS float* scr, int lane) {
    const int nblk = N / 32, kb = r / nblk, nb = r % nblk;
    transpose_item(W, N, WT, K, 64 * kb, 32 * nb, dest_row(mode, 32 * nb), scr, lane);
}
__device__ __forceinline__ void rms_row_to_bf16(const float* xrow, const float* g, bf16* orow, int lane) {
    const f32x4* xr = (const f32x4*)xrow + lane; const f32x4* gr = (const f32x4*)g + lane;
    f32x4 v[4]; float s = 0.f;
#pragma unroll
    for (int j = 0; j < 4; ++j) { v[j] = xr[64 * j]; s += (v[j].x * v[j].x + v[j].y * v[j].y) + (v[j].z * v[j].z + v[j].w * v[j].w); }
    const float rstd = 1.0f / sqrtf(wave_sum(s) * (1.f / D) + EPS);
    unsigned long long* o8 = (unsigned long long*)orow + lane;
#pragma unroll
    for (int j = 0; j < 4; ++j) { const f32x4 gg = gr[64 * j];
        o8[64 * j] = (unsigned long long)pk2(v[j].x * rstd * gg.x, v[j].y * rstd * gg.y) | ((unsigned long long)pk2(v[j].z * rstd * gg.z, v[j].w * rstd * gg.w) << 32); }
}
__device__ __forceinline__ float inv_freq(int j) {
    return j == 0 ? 1.000000000e+00f : j == 1 ? 1.939227432e-01f : j == 2 ? 3.760603070e-02f : j == 3 ? 7.292664610e-03f : j == 4 ? 1.414213562e-03f : j == 5 ? 2.742481884e-04f : j == 6 ? 5.318295734e-05f : 1.031338525e-05f;
}
struct P0Args { const float *x, *g0, *w_in_attn, *w_out_attn, *w_in_rec, *w_out_rec, *w_gate, *w_up, *w_down, *w_gate_moe, *w_up_moe, *w_down_moe, *rlb; const int* pos; unsigned char* ws; };
__device__ __forceinline__ void phase_prologue(const P0Args& a, LAS unsigned char* lds, int blk, int G, int tid) {
    const int wave = tid >> 6, lane = tid & 63;
    LAS float* scr = (LAS float*)(lds + wave * 16384);
    const int gw = blk * NWAVES + wave, NGW = G * NWAVES;
    unsigned char* ws = a.ws;
    constexpr int I_INATT = 16 * (QKV_N / 32), I_SQ = 16 * 32, I_GU = 16 * (FF / 32), I_DN = (FF / 64) * 32, I_INREC = 16 * (REC_N / 32);
    constexpr int NITEMS = I_INATT + I_SQ + 2 * I_GU + I_DN + I_INREC + I_SQ + NEXP * (2 * I_GU + I_DN);
    for (int it = gw; it < NITEMS; it += NGW) {
        int r = it;
        if (r < I_INATT) { conv_matrix_item(a.w_in_attn, D, QKV_N, (bf16*)(ws + WS_W_INATT), 0, r, scr, lane); continue; } r -= I_INATT;
        if (r < I_SQ) { conv_matrix_item(a.w_out_attn, D, D, (bf16*)(ws + WS_W_OUTATT), 0, r, scr, lane); continue; } r -= I_SQ;
        if (r < I_GU) { conv_matrix_item(a.w_gate, D, FF, (bf16*)(ws + WS_W_GU), 1, r, scr, lane); continue; } r -= I_GU;
        if (r < I_GU) { conv_matrix_item(a.w_up, D, FF, (bf16*)(ws + WS_W_GU), 2, r, scr, lane); continue; } r -= I_GU;
        if (r < I_DN) { conv_matrix_item(a.w_down, FF, D, (bf16*)(ws + WS_W_DN), 0, r, scr, lane); continue; } r -= I_DN;
        if (r < I_INREC) { conv_matrix_item(a.w_in_rec, D, REC_N, (bf16*)(ws + WS_W_INREC), 3, r, scr, lane); continue; } r -= I_INREC;
        if (r < I_SQ) { conv_matrix_item(a.w_out_rec, D, D, (bf16*)(ws + WS_W_OUTREC), 0, r, scr, lane); continue; } r -= I_SQ;
        if (r < NEXP * I_GU) { const int e = r / I_GU, q = r % I_GU; conv_matrix_item(a.w_gate_moe + (size_t)e * D * FF, D, FF, (bf16*)(ws + WS_WMOE_GU) + (size_t)e * 2 * FF * D, 1, q, scr, lane); continue; } r -= NEXP * I_GU;
        if (r < NEXP * I_GU) { const int e = r / I_GU, q = r % I_GU; conv_matrix_item(a.w_up_moe + (size_t)e * D * FF, D, FF, (bf16*)(ws + WS_WMOE_GU) + (size_t)e * 2 * FF * D, 2, q, scr, lane); continue; } r -= NEXP * I_GU;
        { const int e = r / I_DN, q = r % I_DN; conv_matrix_item(a.w_down_moe + (size_t)e * FF * D, FF, D, (bf16*)(ws + WS_WMOE_DN) + (size_t)e * D * FF, 0, q, scr, lane); }
    }
    for (int m = gw; m < NTOK; m += NGW) rms_row_to_bf16(a.x + (size_t)m * D, a.g0, (bf16*)(ws + WS_H) + (size_t)m * D, lane);
    float* rope = (float*)(ws + WS_ROPE);
    for (int i = blk * 512 + tid; i < NTOK * 8; i += G * 512) { const int tok = i >> 3, j = i & 7;
        const float ang = (float)a.pos[tok] * inv_freq(j);
        const double turns = (double)ang * 0.15915494309189533577; const float fr = (float)(turns - __builtin_rint(turns));
        rope[tok * 16 + j] = __builtin_amdgcn_cosf(fr); rope[tok * 16 + 8 + j] = __builtin_amdgcn_sinf(fr); }
    float* lbk = (float*)(ws + WS_LBK);
    for (int i = blk * 512 + tid; i < 1024; i += G * 512) lbk[i] = 1.0f / (1.0f + __expf(a.rlb[1024 + i] - a.rlb[i]));
}
__device__ __forceinline__ void phase_rope(bf16* qkv, const float* rope, int blk, int G, int tid) {
    for (int i = blk * 512 + tid; i < NTOK * 26; i += G * 512) {
        const int tok = i / 26, hx = i % 26;
        const int col = hx < 8 ? hx * 64 : hx < 16 ? 512 + (hx - 8) * 64 : hx < 24 ? 1536 + (hx - 16) * 64 : 2048 + (hx - 24) * 64;
        v4u* p = (v4u*)(qkv + (size_t)tok * QKV_N + col);
        const v4u a = p[0], b = p[1];
        const f32x4* t = (const f32x4*)(rope + (size_t)tok * 16);
        const f32x4 c0 = t[0], c1 = t[1], s0 = t[2], s1 = t[3];
        const float x1[8] = {bflo(a.x), bfhi(a.x), bflo(a.y), bfhi(a.y), bflo(a.z), bfhi(a.z), bflo(a.w), bfhi(a.w)};
        const float x2[8] = {bflo(b.x), bfhi(b.x), bflo(b.y), bfhi(b.y), bflo(b.z), bfhi(b.z), bflo(b.w), bfhi(b.w)};
        const float cs[8] = {c0.x, c0.y, c0.z, c0.w, c1.x, c1.y, c1.z, c1.w}, sn[8] = {s0.x, s0.y, s0.z, s0.w, s1.x, s1.y, s1.z, s1.w};
        float y1[8], y2[8];
#pragma unroll
        for (int j = 0; j < 8; ++j) { y1[j] = x1[j] * cs[j] - x2[j] * sn[j]; y2[j] = x2[j] * cs[j] + x1[j] * sn[j]; }
        v4u oa, ob; oa.x = pk2(y1[0], y1[1]); oa.y = pk2(y1[2], y1[3]); oa.z = pk2(y1[4], y1[5]); oa.w = pk2(y1[6], y1[7]);
        ob.x = pk2(y2[0], y2[1]); ob.y = pk2(y2[2], y2[3]); ob.z = pk2(y2[4], y2[5]); ob.w = pk2(y2[6], y2[7]);
        p[0] = oa; p[1] = ob;
    }
}
__device__ __forceinline__ void attn_key(const bf16* krow, const bf16* vrow, const float (&q)[64], float (&o)[64], float& m, float& l) {
    float s = 0.f;
#pragma unroll
    for (int c = 0; c < 8; ++c) { const v4u kv = *(const v4u*)(krow + 8 * c);
        s += q[8 * c + 0] * bflo(kv.x) + q[8 * c + 1] * bfhi(kv.x) + q[8 * c + 2] * bflo(kv.y) + q[8 * c + 3] * bfhi(kv.y)
           + q[8 * c + 4] * bflo(kv.z) + q[8 * c + 5] * bfhi(kv.z) + q[8 * c + 6] * bflo(kv.w) + q[8 * c + 7] * bfhi(kv.w); }
    s *= 0.125f;
    const float mn = fmaxf(m, s), sc = __expf(m - mn), p = __expf(s - mn);
    l = l * sc + p; m = mn;
#pragma unroll
    for (int c = 0; c < 8; ++c) { const v4u vv = *(const v4u*)(vrow + 8 * c);
        o[8 * c + 0] = o[8 * c + 0] * sc + p * bflo(vv.x); o[8 * c + 1] = o[8 * c + 1] * sc + p * bfhi(vv.x);
        o[8 * c + 2] = o[8 * c + 2] * sc + p * bflo(vv.y); o[8 * c + 3] = o[8 * c + 3] * sc + p * bfhi(vv.y);
        o[8 * c + 4] = o[8 * c + 4] * sc + p * bflo(vv.z); o[8 * c + 5] = o[8 * c + 5] * sc + p * bfhi(vv.z);
        o[8 * c + 6] = o[8 * c + 6] * sc + p * bflo(vv.w); o[8 * c + 7] = o[8 * c + 7] * sc + p * bfhi(vv.w); }
}
__device__ __forceinline__ void phase_attn_naive(const bf16* qkv, const float* sinks, bf16* mix, int blk, int G, int tid) {
    for (int idx = blk * 512 + tid; idx < NTOK * 16; idx += G * 512) {
        const int hx = idx >> 16, tok = idx & 65535, b = tok >> 13, s = tok & 8191;
        const bool isB = hx >= 8; const int qh = hx - 8;
        const int qcol = isB ? 1536 + qh * 64 : hx * 64, kcol = isB ? 2048 + (qh >> 2) * 64 : 512 + hx * 64, vcol = isB ? 2176 + (qh >> 2) * 64 : 1024 + hx * 64, ocol = isB ? 512 + qh * 64 : hx * 64;
        float q[64], o[64]; float m = -INFINITY, l = 0.f;
        { const bf16* qp = qkv + (size_t)tok * QKV_N + qcol;
#pragma unroll
          for (int c = 0; c < 8; ++c) { const v4u w = *(const v4u*)(qp + 8 * c); q[8 * c] = bflo(w.x); q[8 * c + 1] = bfhi(w.x); q[8 * c + 2] = bflo(w.y); q[8 * c + 3] = bfhi(w.y); q[8 * c + 4] = bflo(w.z); q[8 * c + 5] = bfhi(w.z); q[8 * c + 6] = bflo(w.w); q[8 * c + 7] = bfhi(w.w); } }
#pragma unroll
        for (int i = 0; i < 64; ++i) o[i] = 0.f;
        const bf16* rb = qkv + (size_t)(b * SEQ) * QKV_N;
        if (!isB) {
            for (int jj = 0; jj < 387; ++jj) { const int d = jj < 129 ? 1 : jj < 258 ? 4 : 16, j = jj < 129 ? jj : jj < 258 ? jj - 129 : jj - 258;
                const int kt = s - d * j; if (kt < 0) continue;
                const bf16* r = rb + (size_t)kt * QKV_N; attn_key(r + kcol, r + vcol, q, o, m, l); }
        } else {
            for (int j = 0; j < 128; ++j) { const int kt = s - j; if (kt < 0) break;
                const bf16* r = rb + (size_t)kt * QKV_N; attn_key(r + kcol, r + vcol, q, o, m, l); }
            const float sk = sinks[qh]; const float mn = fmaxf(m, sk), sc = __expf(m - mn);
            l = l * sc + __expf(sk - mn); m = mn;
#pragma unroll
            for (int i = 0; i < 64; ++i) o[i] *= sc;
        }
        const float rl = 1.0f / l;
        v4u* op = (v4u*)(mix + (size_t)tok * D + ocol);
#pragma unroll
        for (int c = 0; c < 8; ++c) { v4u w; w.x = pk2(o[8 * c] * rl, o[8 * c + 1] * rl); w.y = pk2(o[8 * c + 2] * rl, o[8 * c + 3] * rl); w.z = pk2(o[8 * c + 4] * rl, o[8 * c + 5] * rl); w.w = pk2(o[8 * c + 6] * rl, o[8 * c + 7] * rl); op[c] = w; }
    }
}
__device__ __forceinline__ void phase_norm(const float* x, const float* g, bf16* out, int blk, int G, int tid) {
    const int wave = tid >> 6, lane = tid & 63;
    for (int m = blk * NWAVES + wave; m < NTOK; m += G * NWAVES) rms_row_to_bf16(x + (size_t)m * D, g, out + (size_t)m * D, lane);
}
typedef float f32x16 __attribute__((ext_vector_type(16)));
typedef short bf16x8v __attribute__((ext_vector_type(8)));
typedef short s16x4 __attribute__((ext_vector_type(4)));
typedef short v4i16_t __attribute__((ext_vector_type(4)));
__device__ __forceinline__ int crow(int r, int hi) { return (r & 3) + 8 * (r >> 2) + 4 * hi; }
__device__ __forceinline__ s16x4 vtr(const LAS unsigned char* p) { return __builtin_bit_cast(s16x4, __builtin_amdgcn_ds_read_tr16_b64_v4i16((LAS v4i16_t*)p)); }
struct AttnSub { int b, dstride, r, P0, qcol, kcol, vcol, mode, hx; };
__device__ __forceinline__ void attn_subunit(const AttnSub su, const bf16* qkv, const float* sinks, bf16* mix, bf16* OB, float* LSE, LAS unsigned char* lh, int t256, int hw, int lane) {
    const int r32 = lane & 31, hi = lane >> 5;
    const size_t rowb = (size_t)su.b * SEQ;
    {
        const int c = t256 & 7, k0 = t256 >> 3;
        v4u kreg[8], vreg[8];
#pragma unroll
        for (int i = 0; i < 8; ++i) { const int key = k0 + 32 * i, pos = su.P0 - 128 + key;
            if (pos >= 0) { const bf16* rp = qkv + (rowb + su.r + (size_t)su.dstride * pos) * QKV_N; kreg[i] = *(const v4u*)(rp + su.kcol + 8 * c); vreg[i] = *(const v4u*)(rp + su.vcol + 8 * c); }
            else { kreg[i] = (v4u){0u, 0u, 0u, 0u}; vreg[i] = kreg[i]; } }
#pragma unroll
        for (int i = 0; i < 8; ++i) { const int key = k0 + 32 * i;
            *(LAS v4u*)(lh + key * 128 + ((c ^ (key & 7)) * 16)) = kreg[i];
            *(LAS v4u*)(lh + 32768 + (c >> 2) * 16384 + key * 64 + (c & 3) * 16) = vreg[i]; }
    }
    const int qpos = su.P0 + 32 * hw + r32;
    const size_t qrow = rowb + su.r + (size_t)su.dstride * qpos;
    bf16x8v qf[4];
#pragma unroll
    for (int ks = 0; ks < 4; ++ks) qf[ks] = *(const bf16x8v*)(qkv + qrow * QKV_N + su.qcol + 16 * ks + 8 * hi);
    __syncthreads();
    f32x16 oT[2]; oT[0] = (f32x16){}; oT[1] = (f32x16){};
    float m = -1e30f, l = 0.f;
    const float C = 0.125f * 1.4426950408889634f;
    const int mlo = (su.mode == 3) ? 1 : 0;
    int kt = hw; if (su.P0 == 0 && kt < 4) kt = 4;
    for (; kt <= hw + 4; ++kt) {
        f32x16 s = (f32x16){};
        const LAS unsigned char* kb = lh + (32 * kt + r32) * 128; const int sw = r32 & 7;
#pragma unroll
        for (int ks = 0; ks < 4; ++ks) { const bf16x8v kf = *(const LAS bf16x8v*)(kb + (((2 * ks + hi) ^ sw) * 16)); s = __builtin_amdgcn_mfma_f32_32x32x16_bf16(kf, qf[ks], s, 0, 0, 0); }
        if (kt == hw) {
#pragma unroll
            for (int r = 0; r < 16; ++r) if (crow(r, hi) < r32 + mlo) s[r] = -INFINITY; }
        if (kt == hw + 4) {
#pragma unroll
            for (int r = 0; r < 16; ++r) if (crow(r, hi) > r32) s[r] = -INFINITY; }
        float mx = s[0];
#pragma unroll
        for (int r = 1; r < 16; ++r) mx = fmaxf(mx, s[r]);
        mx = fmaxf(mx, __shfl_xor(mx, 32));
        const float mn = fmaxf(m, mx), alpha = __builtin_amdgcn_exp2f((m - mn) * C);
        float ls = 0.f; f32x16 p;
#pragma unroll
        for (int r = 0; r < 16; ++r) { p[r] = __builtin_amdgcn_exp2f((s[r] - mn) * C); ls += p[r]; }
        l = l * alpha + ls; m = mn;
#pragma unroll
        for (int r = 0; r < 16; ++r) { oT[0][r] *= alpha; oT[1][r] *= alpha; }
        v4u pw0, pw1;
        pw0.x = pk2(p[0], p[1]); pw0.y = pk2(p[2], p[3]); pw0.z = pk2(p[4], p[5]); pw0.w = pk2(p[6], p[7]);
        pw1.x = pk2(p[8], p[9]); pw1.y = pk2(p[10], p[11]); pw1.z = pk2(p[12], p[13]); pw1.w = pk2(p[14], p[15]);
        const bf16x8v pa0 = __builtin_bit_cast(bf16x8v, pw0), pa1 = __builtin_bit_cast(bf16x8v, pw1);
        const LAS unsigned char* vb = lh + 32768 + (32 * kt + 4 * hi + ((lane & 15) >> 2)) * 64 + ((lane >> 4) & 1) * 32 + (lane & 3) * 8;
#pragma unroll
        for (int dt = 0; dt < 2; ++dt) {
            const s16x4 a0 = vtr(vb + dt * 16384), a1 = vtr(vb + dt * 16384 + 512), b0 = vtr(vb + dt * 16384 + 1024), b1 = vtr(vb + dt * 16384 + 1536);
            const bf16x8v vf0 = (bf16x8v){a0[0], a0[1], a0[2], a0[3], a1[0], a1[1], a1[2], a1[3]}, vf1 = (bf16x8v){b0[0], b0[1], b0[2], b0[3], b1[0], b1[1], b1[2], b1[3]};
            oT[dt] = __builtin_amdgcn_mfma_f32_32x32x16_bf16(vf0, pa0, oT[dt], 0, 0, 0);
            oT[dt] = __builtin_amdgcn_mfma_f32_32x32x16_bf16(vf1, pa1, oT[dt], 0, 0, 0);
        }
    }
    float lt = l + __shfl_xor(l, 32);
    if (su.mode == 3) { const float sraw = 8.0f * sinks[su.hx]; const float mn = fmaxf(m, sraw), alpha = __builtin_amdgcn_exp2f((m - mn) * C);
        lt = lt * alpha + __builtin_amdgcn_exp2f((sraw - mn) * C); m = mn;
#pragma unroll
        for (int r = 0; r < 16; ++r) { oT[0][r] *= alpha; oT[1][r] *= alpha; } }
    const float inv = 1.0f / lt;
    if (su.mode < 2) {
        bf16* ob = OB + (size_t)su.mode * NTOK * 512 + qrow * 512 + su.hx * 64;
#pragma unroll
        for (int dt = 0; dt < 2; ++dt)
#pragma unroll
            for (int g = 0; g < 4; ++g) { v2u w; w.x = pk2(oT[dt][4 * g] * inv, oT[dt][4 * g + 1] * inv); w.y = pk2(oT[dt][4 * g + 2] * inv, oT[dt][4 * g + 3] * inv); *(v2u*)(ob + 32 * dt + 8 * g + 4 * hi) = w; }
        if (hi == 0) LSE[(size_t)su.mode * NTOK * 8 + qrow * 8 + su.hx] = 0.125f * m + __logf(lt);
    } else if (su.mode == 2) {
        const float l3 = 0.125f * m + __logf(lt), l1 = LSE[qrow * 8 + su.hx], l2 = LSE[(size_t)NTOK * 8 + qrow * 8 + su.hx];
        const float M = fmaxf(l3, fmaxf(l1, l2)); float w1 = __expf(l1 - M), w2 = __expf(l2 - M), w3 = __expf(l3 - M);
        const float ws = 1.0f / (w1 + w2 + w3); w1 *= ws; w2 *= ws; w3 *= ws * inv;
        const bf16* o1 = OB + qrow * 512 + su.hx * 64; const bf16* o2 = o1 + (size_t)NTOK * 512;
        bf16* mp = mix + qrow * D + su.hx * 64;
#pragma unroll
        for (int dt = 0; dt < 2; ++dt)
#pragma unroll
            for (int g = 0; g < 4; ++g) { const int dd = 32 * dt + 8 * g + 4 * hi; const v2u a = *(const v2u*)(o1 + dd), b = *(const v2u*)(o2 + dd);
                v2u w; w.x = pk2(w1 * bflo(a.x) + w2 * bflo(b.x) + w3 * oT[dt][4 * g], w1 * bfhi(a.x) + w2 * bfhi(b.x) + w3 * oT[dt][4 * g + 1]);
                w.y = pk2(w1 * bflo(a.y) + w2 * bflo(b.y) + w3 * oT[dt][4 * g + 2], w1 * bfhi(a.y) + w2 * bfhi(b.y) + w3 * oT[dt][4 * g + 3]); *(v2u*)(mp + dd) = w; }
    } else {
        bf16* mp = mix + qrow * D + 512 + su.hx * 64;
#pragma unroll
        for (int dt = 0; dt < 2; ++dt)
#pragma unroll
            for (int g = 0; g < 4; ++g) { v2u w; w.x = pk2(oT[dt][4 * g] * inv, oT[dt][4 * g + 1] * inv); w.y = pk2(oT[dt][4 * g + 2] * inv, oT[dt][4 * g + 3] * inv); *(v2u*)(mp + 32 * dt + 8 * g + 4 * hi) = w; }
    }
    asm volatile("s_waitcnt vmcnt(0)" ::: "memory");
    __syncthreads();
}
__device__ __forceinline__ void phase_attn(const bf16* qkv, const float* sinks, bf16* mix, bf16* OB, float* LSE, LAS unsigned char* lds, int blk, int G, int tid) {
    const int wave = tid >> 6, lane = tid & 63, hf = wave >> 2, hw = wave & 3, t256 = tid & 255;
    LAS unsigned char* lh = lds + hf * 65536;
    for (int ai = blk; ai < 256; ai += G) {
        const int b = ai >> 5, h = (ai >> 2) & 7, T0 = (ai & 3) * 2048;
        for (int pp = 0; pp < 24; ++pp) {
            const int su = 2 * pp + hf, br = su >> 4, k = su & 15;
            AttnSub s; s.b = b; s.hx = h; s.qcol = h * 64; s.kcol = 512 + h * 64; s.vcol = 1024 + h * 64; s.mode = br;
            if (br == 0) { s.dstride = 1; s.r = 0; s.P0 = T0 + 128 * k; }
            else if (br == 1) { s.dstride = 4; s.r = k >> 2; s.P0 = (T0 >> 2) + 128 * (k & 3); }
            else { s.dstride = 16; s.r = k; s.P0 = T0 >> 4; }
            attn_subunit(s, qkv, sinks, mix, OB, LSE, lh, t256, hw, lane);
        }
    }
    for (int bp = blk; bp < 2048; bp += G) {
        const int b = bp >> 8, nb = (bp >> 2) & 63, kv = (bp >> 1) & 1, qh = kv * 4 + 2 * (bp & 1) + hf;
        AttnSub s; s.b = b; s.hx = qh; s.qcol = 1536 + qh * 64; s.kcol = 2048 + kv * 64; s.vcol = 2176 + kv * 64; s.mode = 3; s.dstride = 1; s.r = 0; s.P0 = 128 * nb;
        attn_subunit(s, qkv, sinks, mix, OB, LSE, lh, t256, hw, lane);
    }
}
__device__ __forceinline__ void phase_hgrn_naive(const bf16* Qp, const bf16* Kp, const bf16* Vp, bf16* Oraw, LAS unsigned char* lds, int blk, int G, int tid) {
    LAS float* sq = (LAS float*)lds; LAS float* sk = sq + 2048; LAS float* sf = sk + 2048; LAS float* sv = sf + 2048; LAS float* part = sv + 2048;
    const int v = tid & 127, kq = tid >> 7;
    const int lr = tid >> 5, lc = (tid & 31) * 4;
    for (int bh = blk; bh < BATCH * 8; bh += G) {
        const int b = bh >> 3, h = bh & 7;
        float S[32];
#pragma unroll
        for (int i = 0; i < 32; ++i) S[i] = 0.f;
        for (int t0 = 0; t0 < SEQ; t0 += 16) {
            const size_t base = (size_t)(b * SEQ + t0 + lr) * D + h * 128 + lc;
            { const v2u w = *(const v2u*)(Qp + base); *(LAS f32x4*)(sq + lr * 128 + lc) = (f32x4){bflo(w.x), bfhi(w.x), bflo(w.y), bfhi(w.y)}; }
            { const v2u w = *(const v2u*)(Kp + base); const f32x4 kk = (f32x4){bflo(w.x), bfhi(w.x), bflo(w.y), bfhi(w.y)}; *(LAS f32x4*)(sk + lr * 128 + lc) = kk; *(LAS f32x4*)(sf + lr * 128 + lc) = (f32x4){1.f - kk.x, 1.f - kk.y, 1.f - kk.z, 1.f - kk.w}; }
            { const v2u w = *(const v2u*)(Vp + base); *(LAS f32x4*)(sv + lr * 128 + lc) = (f32x4){bflo(w.x), bfhi(w.x), bflo(w.y), bfhi(w.y)}; }
            __syncthreads();
            for (int t = 0; t < 16; ++t) {
                const float vt = sv[t * 128 + v]; float po = 0.f;
#pragma unroll
                for (int i4 = 0; i4 < 8; ++i4) { const int kx = t * 128 + kq * 32 + i4 * 4;
                    const f32x4 q4 = *(const LAS f32x4*)(sq + kx), k4 = *(const LAS f32x4*)(sk + kx), f4 = *(const LAS f32x4*)(sf + kx);
#pragma unroll
                    for (int j = 0; j < 4; ++j) { S[i4 * 4 + j] = f4[j] * S[i4 * 4 + j] + k4[j] * vt; po += q4[j] * S[i4 * 4 + j]; } }
                part[(t * 4 + kq) * 128 + v] = po;
            }
            __syncthreads();
            { const f32x4 p0 = *(const LAS f32x4*)(part + (lr * 4 + 0) * 128 + lc), p1 = *(const LAS f32x4*)(part + (lr * 4 + 1) * 128 + lc), p2 = *(const LAS f32x4*)(part + (lr * 4 + 2) * 128 + lc), p3 = *(const LAS f32x4*)(part + (lr * 4 + 3) * 128 + lc);
              const f32x4 r = (p0 + p1) + (p2 + p3); v2u w; w.x = pk2(r.x, r.y); w.y = pk2(r.z, r.w); *(v2u*)(Oraw + base) = w; }
        }
        __syncthreads();
    }
}
__device__ __forceinline__ void phase_gate(bf16* O, const bf16* Gp, const float* norm_g, int blk, int G, int tid) {
    const int wave = tid >> 6, lane = tid & 63;
    for (int m = blk * NWAVES + wave; m < NTOK; m += G * NWAVES) {
        v4u* op = (v4u*)(O + (size_t)m * D + lane * 16); const v4u* gp = (const v4u*)(Gp + (size_t)m * D + lane * 16);
        const v4u a = op[0], b = op[1], ga = gp[0], gb = gp[1];
        float x[16] = {bflo(a.x), bfhi(a.x), bflo(a.y), bfhi(a.y), bflo(a.z), bfhi(a.z), bflo(a.w), bfhi(a.w), bflo(b.x), bfhi(b.x), bflo(b.y), bfhi(b.y), bflo(b.z), bfhi(b.z), bflo(b.w), bfhi(b.w)};
        const float gg[16] = {bflo(ga.x), bfhi(ga.x), bflo(ga.y), bfhi(ga.y), bflo(ga.z), bfhi(ga.z), bflo(ga.w), bfhi(ga.w), bflo(gb.x), bfhi(gb.x), bflo(gb.y), bfhi(gb.y), bflo(gb.z), bfhi(gb.z), bflo(gb.w), bfhi(gb.w)};
        float ss = 0.f;
#pragma unroll
        for (int i = 0; i < 16; ++i) ss += x[i] * x[i];
        ss += __shfl_xor(ss, 1); ss += __shfl_xor(ss, 2); ss += __shfl_xor(ss, 4);
        const float rstd = 1.0f / sqrtf(ss * (1.f / 128.f) + EPS);
        const f32x4* ng = (const f32x4*)(norm_g + lane * 16);
        float y[16];
#pragma unroll
        for (int i4 = 0; i4 < 4; ++i4) { const f32x4 n4 = ng[i4];
#pragma unroll
            for (int j = 0; j < 4; ++j) y[i4 * 4 + j] = x[i4 * 4 + j] * rstd * n4[j] * gg[i4 * 4 + j]; }
        v4u oa, ob; oa.x = pk2(y[0], y[1]); oa.y = pk2(y[2], y[3]); oa.z = pk2(y[4], y[5]); oa.w = pk2(y[6], y[7]);
        ob.x = pk2(y[8], y[9]); ob.y = pk2(y[10], y[11]); ob.z = pk2(y[12], y[13]); ob.w = pk2(y[14], y[15]);
        op[0] = oa; op[1] = ob;
    }
}
__device__ __forceinline__ void phase_router(const float* x, const float* g, const float* w_router, int4* meta, int* hist, LAS unsigned char* lds, int blk, int G, int tid) {
    const int wave = tid >> 6, lane = tid & 63;
    LAS float* swr = (LAS float*)lds;
    LAS int* scnt = (LAS int*)(lds + 32768);
    for (int i = tid; i < 8192; i += 512) swr[i] = w_router[i];
    __syncthreads();
    for (int tb = blk; tb < 256; tb += G) {
        if (tid < 8) scnt[tid] = 0;
        __syncthreads();
        int c0 = 0, c1 = 0, c2 = 0, c3 = 0, c4 = 0, c5 = 0, c6 = 0, c7 = 0;
        for (int i = 0; i < 32; ++i) {
            const int tok = tb * 256 + wave * 32 + i;
            const f32x4* xr = (const f32x4*)(x + (size_t)tok * D) + lane; const f32x4* gr = (const f32x4*)g + lane;
            f32x4 v[4]; float s = 0.f;
#pragma unroll
            for (int j = 0; j < 4; ++j) { v[j] = xr[64 * j]; s += (v[j].x * v[j].x + v[j].y * v[j].y) + (v[j].z * v[j].z + v[j].w * v[j].w); }
            const float rstd = 1.0f / sqrtf(wave_sum(s) * (1.f / D) + EPS);
            float lg[8] = {0.f, 0.f, 0.f, 0.f, 0.f, 0.f, 0.f, 0.f};
#pragma unroll
            for (int j = 0; j < 4; ++j) { const f32x4 gg = gr[64 * j];
#pragma unroll
                for (int c = 0; c < 4; ++c) { const float hv = v[j][c] * rstd * gg[c]; const int d = 256 * j + 4 * lane + c;
                    const f32x4 w0 = *(const LAS f32x4*)(swr + d * 8), w1 = *(const LAS f32x4*)(swr + d * 8 + 4);
                    lg[0] += hv * w0.x; lg[1] += hv * w0.y; lg[2] += hv * w0.z; lg[3] += hv * w0.w; lg[4] += hv * w1.x; lg[5] += hv * w1.y; lg[6] += hv * w1.z; lg[7] += hv * w1.w; } }
#pragma unroll
            for (int e = 0; e < 8; ++e) lg[e] = wave_sum(lg[e]);
            int e0 = 0; float v0 = lg[0];
#pragma unroll
            for (int e = 1; e < 8; ++e) if (lg[e] > v0) { v0 = lg[e]; e0 = e; }
            int e1 = -1; float v1 = -INFINITY;
#pragma unroll
            for (int e = 0; e < 8; ++e) if (e != e0 && lg[e] > v1) { v1 = lg[e]; e1 = e; }
            const float g1 = 1.0f / (1.0f + __expf(v0 - v1)), g0 = 1.0f - g1;
            if (lane == 0) meta[tok] = make_int4(e0, e1, __builtin_bit_cast(int, g0), __builtin_bit_cast(int, g1));
            c0 += (e0 == 0) + (e1 == 0); c1 += (e0 == 1) + (e1 == 1); c2 += (e0 == 2) + (e1 == 2); c3 += (e0 == 3) + (e1 == 3);
            c4 += (e0 == 4) + (e1 == 4); c5 += (e0 == 5) + (e1 == 5); c6 += (e0 == 6) + (e1 == 6); c7 += (e0 == 7) + (e1 == 7);
        }
        if (lane == 0) { const int cc[8] = {c0, c1, c2, c3, c4, c5, c6, c7};
#pragma unroll
            for (int e = 0; e < 8; ++e) __hip_atomic_fetch_add(&scnt[e], cc[e], __ATOMIC_RELAXED, __HIP_MEMORY_SCOPE_WORKGROUP); }
        __syncthreads();
        if (tid < 8) hist[tb * 8 + tid] = scnt[tid];
        __syncthreads();
    }
}
__device__ __forceinline__ void phase_scatter(const float* x, const float* g, const int4* meta, const int* hist, int* dest, int* info, bf16* perm, LAS unsigned char* lds, int blk, int G, int tid) {
    const int wave = tid >> 6, lane = tid & 63;
    LAS int* shist = (LAS int*)lds;
    LAS int* ssize = shist + 2048; LAS int* sbpre = ssize + 8; LAS int* spst = sbpre + 8; LAS int* sntl = spst + 8;
    LAS int* se = sntl + 8; LAS int* sdest = se + 512;
    for (int tb = blk; tb < 256; tb += G) {
        for (int i = tid; i < 2048; i += 512) shist[i] = hist[i];
        __syncthreads();
        if (tid < 8) { int sz = 0, bp = 0; for (int b = 0; b < 256; ++b) { const int hv = shist[b * 8 + tid]; sz += hv; bp += (b < tb) ? hv : 0; } ssize[tid] = sz; sbpre[tid] = bp; }
        __syncthreads();
        if (tid == 0) { int ts = 0; for (int e = 0; e < 8; ++e) { const int nt = (ssize[e] + 255) >> 8; spst[e] = ts * 256; sntl[e] = nt; ts += nt; if (tb == 0) info[e] = ts; } if (tb == 0) info[8] = ts; }
        { const int4 mt = meta[tb * 256 + (tid >> 1)]; se[tid] = (tid & 1) ? mt.y : mt.x; }
        __syncthreads();
        { const int e = se[tid]; int rank = 0; for (int p = 0; p < tid; ++p) rank += (se[p] == e) ? 1 : 0;
          const int dd = spst[e] + sbpre[e] + rank; sdest[tid] = dd; dest[(tb * 256) * 2 + tid] = dd; }
        __syncthreads();
        for (int i = 0; i < 32; ++i) { const int lt = wave * 32 + i, tok = tb * 256 + lt;
            const f32x4* xr = (const f32x4*)(x + (size_t)tok * D) + lane; const f32x4* gr = (const f32x4*)g + lane;
            f32x4 v[4]; float s = 0.f;
#pragma unroll
            for (int j = 0; j < 4; ++j) { v[j] = xr[64 * j]; s += (v[j].x * v[j].x + v[j].y * v[j].y) + (v[j].z * v[j].z + v[j].w * v[j].w); }
            const float rstd = 1.0f / sqrtf(wave_sum(s) * (1.f / D) + EPS);
            unsigned long long* o0 = (unsigned long long*)(perm + (size_t)sdest[2 * lt] * D) + lane; unsigned long long* o1 = (unsigned long long*)(perm + (size_t)sdest[2 * lt + 1] * D) + lane;
#pragma unroll
            for (int j = 0; j < 4; ++j) { const f32x4 gg = gr[64 * j];
                const unsigned long long w = (unsigned long long)pk2(v[j].x * rstd * gg.x, v[j].y * rstd * gg.y) | ((unsigned long long)pk2(v[j].z * rstd * gg.z, v[j].w * rstd * gg.w) << 32);
                o0[64 * j] = w; o1[64 * j] = w; } }
        if (tb < 8) { const int r0 = spst[tb] + ssize[tb], r1 = spst[tb] + sntl[tb] * 256;
            for (int r = r0 + wave; r < r1; r += NWAVES) { unsigned long long* o = (unsigned long long*)(perm + (size_t)r * D) + lane;
#pragma unroll
                for (int j = 0; j < 4; ++j) o[64 * j] = 0ull; } }
        __syncthreads();
    }
}
__device__ __forceinline__ void phase_combine(float* x, const bf16* y, const int4* meta, const int* dest, const float* gf, int blk, int G, int tid) {
    const int wave = tid >> 6, lane = tid & 63;
    for (int m = blk * NWAVES + wave; m < NTOK; m += G * NWAVES) {
        const int4 mt = meta[m]; const float g0 = __builtin_bit_cast(float, mt.z), g1 = __builtin_bit_cast(float, mt.w);
        const int d0 = dest[2 * m], d1 = dest[2 * m + 1];
        f32x4* xr = (f32x4*)(x + (size_t)m * D) + lane; const f32x4* gr = (const f32x4*)gf + lane;
        const v2u* y0 = (const v2u*)(y + (size_t)d0 * D) + lane; const v2u* y1 = (const v2u*)(y + (size_t)d1 * D) + lane;
        f32x4 v[4]; float s = 0.f;
#pragma unroll
        for (int j = 0; j < 4; ++j) { const v2u a = y0[64 * j], b = y1[64 * j]; f32x4 t = xr[64 * j];
            t.x += g0 * bflo(a.x) + g1 * bflo(b.x); t.y += g0 * bfhi(a.x) + g1 * bfhi(b.x); t.z += g0 * bflo(a.y) + g1 * bflo(b.y); t.w += g0 * bfhi(a.y) + g1 * bfhi(b.y);
            v[j] = t; s += (t.x * t.x + t.y * t.y) + (t.z * t.z + t.w * t.w); }
        const float rstd = 1.0f / sqrtf(wave_sum(s) * (1.f / D) + EPS);
#pragma unroll
        for (int j = 0; j < 4; ++j) { const f32x4 gg = gr[64 * j]; xr[64 * j] = (f32x4){v[j].x * rstd * gg.x, v[j].y * rstd * gg.y, v[j].z * rstd * gg.z, v[j].w * rstd * gg.w}; }
    }
}
constexpr int HG_NSEG = 4, HG_CPS = 32;
constexpr int HG_QE = 0, HG_KI = 16384, HG_KE = 32768, HG_V = 49152, HG_ST = 65536, HG_DK = 132096, HG_SSQ = 132608, HG_NG = 133632;
__device__ __forceinline__ void phase_hgrn(const bf16* QE, const bf16* KI, const bf16* KE, const bf16* Vp, const bf16* Gp, const float* DK, const float* norm_g, bf16* Og, const float* HL, const float* HP, LAS unsigned char* lds, int blk, int G, int tid) {
    const int wave = tid >> 6, lane = tid & 63, r32 = lane & 31, hi = lane >> 5, tb = wave >> 2, vb = wave & 3;
    const int sw = r32 & 15;
    const int trl = (4 * hi + ((lane & 15) >> 2)) * 64 + ((lane >> 4) & 1) * 32 + (lane & 3) * 8;
    LAS float* dk_l = (LAS float*)(lds + HG_DK); LAS float* ssq = (LAS float*)(lds + HG_SSQ);
    for (int un = blk; un < BATCH * 8 * HG_NSEG; un += G) {
        const int bh = un >> 2, seg = un & 3, b = bh >> 3, h = bh & 7, c0 = seg * HG_CPS;
        f32x16 S0 = (f32x16){}, S1 = (f32x16){};
        {
            const float* L = HL + (size_t)bh * 3 * 16384; const float* Pt = HP + (size_t)bh * 3 * 128;
            LAS float* sl = (LAS float*)lds;
#pragma unroll 2
            for (int i = 0; i < 8; ++i) { const int idx = (tid + 512 * i) * 4, k = idx >> 7; f32x4 a = (f32x4){0.f, 0.f, 0.f, 0.f};
                if (seg > 0) a = *(const f32x4*)(L + idx);
                if (seg > 1) a = a * Pt[128 + k] + *(const f32x4*)(L + 16384 + idx);
                if (seg > 2) a = a * Pt[256 + k] + *(const f32x4*)(L + 32768 + idx);
                *(LAS f32x4*)(sl + idx) = a; }
            __syncthreads();
#pragma unroll
            for (int i = 0; i < 2; ++i) { const int kb = 2 * tb + i; f32x16 S;
#pragma unroll
                for (int r = 0; r < 16; ++r) S[r] = sl[(32 * kb + crow(r, hi)) * 128 + 32 * vb + r32];
#pragma unroll
                for (int g = 0; g < 4; ++g) { v2u w; w.x = pk2(S[4 * g], S[4 * g + 1]); w.y = pk2(S[4 * g + 2], S[4 * g + 3]);
                    *(LAS v2u*)(lds + HG_ST + (32 * vb + r32) * 256 + (((4 * kb + g) ^ sw) * 16) + hi * 8) = w; }
                if (i) S1 = S; else S0 = S; }
            __syncthreads();
        }
        if (tid < 32) *(LAS f32x4*)(lds + HG_NG + tid * 16) = *(const f32x4*)(norm_g + h * 128 + tid * 4);
        v4u rq[2], rk[2], re[2], rv[2]; f32x4 rd = (f32x4){0.f, 0.f, 0.f, 0.f};
#define HG_LOAD(c) do { const size_t row0_ = (size_t)b * SEQ + 64 * (c); \
            _Pragma("unroll") for (int i = 0; i < 2; ++i) { const int idx = tid + 512 * i, row = idx >> 4, cc = idx & 15; const size_t go = (row0_ + row) * 1024 + h * 128 + cc * 8; \
                rq[i] = *(const v4u*)(QE + go); rk[i] = *(const v4u*)(KI + go); re[i] = *(const v4u*)(KE + go); rv[i] = *(const v4u*)(Vp + go); } \
            if (tid < 32) rd = *(const f32x4*)(DK + ((size_t)b * 128 + (c)) * 1024 + h * 128 + tid * 4); } while (0)
#define HG_STORE() do { \
            _Pragma("unroll") for (int i = 0; i < 2; ++i) { const int idx = tid + 512 * i, row = idx >> 4, cc = idx & 15; \
                *(LAS v4u*)(lds + HG_QE + row * 256 + ((cc ^ (row & 15)) * 16)) = rq[i]; *(LAS v4u*)(lds + HG_KI + row * 256 + ((cc ^ (row & 15)) * 16)) = rk[i]; \
                *(LAS v4u*)(lds + HG_KE + (cc >> 2) * 4096 + row * 64 + (cc & 3) * 16) = re[i]; *(LAS v4u*)(lds + HG_V + (cc >> 2) * 4096 + row * 64 + (cc & 3) * 16) = rv[i]; } \
            if (tid < 32) *(LAS f32x4*)(dk_l + tid * 4) = rd; } while (0)
        HG_LOAD(c0); HG_STORE();
        __syncthreads();
        for (int cl = 0; cl < HG_CPS; ++cl) { const int c = c0 + cl;
            if (cl + 1 < HG_CPS) HG_LOAD(c + 1);
            const size_t rowo = ((size_t)b * SEQ + 64 * c + 32 * tb + r32) * 1024 + h * 128 + 32 * vb + 4 * hi;
            v2u ggv[4];
#pragma unroll
            for (int g = 0; g < 4; ++g) ggv[g] = *(const v2u*)(Gp + rowo + 8 * g);
            LAS unsigned char* st_cur = lds + HG_ST + (cl & 1) * 32768; LAS unsigned char* st_nxt = lds + HG_ST + ((cl + 1) & 1) * 32768;
            bf16x8v qf[8];
#pragma unroll
            for (int ks = 0; ks < 8; ++ks) qf[ks] = *(const LAS bf16x8v*)(lds + HG_QE + (32 * tb + r32) * 256 + (((2 * ks + hi) ^ sw) * 16));
            f32x16 oT = (f32x16){};
#pragma unroll
            for (int ks = 0; ks < 8; ++ks) { const bf16x8v sf = *(const LAS bf16x8v*)(st_cur + (32 * vb + r32) * 256 + (((2 * ks + hi) ^ sw) * 16)); oT = __builtin_amdgcn_mfma_f32_32x32x16_bf16(sf, qf[ks], oT, 0, 0, 0); }
            v4u pw[4];
            { f32x16 X0 = (f32x16){};
#pragma unroll
              for (int ks = 0; ks < 8; ++ks) { const bf16x8v kf = *(const LAS bf16x8v*)(lds + HG_KI + r32 * 256 + (((2 * ks + hi) ^ sw) * 16)); X0 = __builtin_amdgcn_mfma_f32_32x32x16_bf16(kf, qf[ks], X0, 0, 0, 0); }
              if (tb == 0) {
#pragma unroll
                  for (int r = 0; r < 16; ++r) if (crow(r, hi) > r32) X0[r] = 0.f; }
              pw[0].x = pk2(X0[0], X0[1]); pw[0].y = pk2(X0[2], X0[3]); pw[0].z = pk2(X0[4], X0[5]); pw[0].w = pk2(X0[6], X0[7]); pw[1].x = pk2(X0[8], X0[9]); pw[1].y = pk2(X0[10], X0[11]); pw[1].z = pk2(X0[12], X0[13]); pw[1].w = pk2(X0[14], X0[15]); }
            if (tb == 1) { f32x16 X1 = (f32x16){};
#pragma unroll
              for (int ks = 0; ks < 8; ++ks) { const bf16x8v kf = *(const LAS bf16x8v*)(lds + HG_KI + (32 + r32) * 256 + (((2 * ks + hi) ^ sw) * 16)); X1 = __builtin_amdgcn_mfma_f32_32x32x16_bf16(kf, qf[ks], X1, 0, 0, 0); }
#pragma unroll
              for (int r = 0; r < 16; ++r) if (crow(r, hi) > r32) X1[r] = 0.f;
              pw[2].x = pk2(X1[0], X1[1]); pw[2].y = pk2(X1[2], X1[3]); pw[2].z = pk2(X1[4], X1[5]); pw[2].w = pk2(X1[6], X1[7]); pw[3].x = pk2(X1[8], X1[9]); pw[3].y = pk2(X1[10], X1[11]); pw[3].z = pk2(X1[12], X1[13]); pw[3].w = pk2(X1[14], X1[15]); }
            asm volatile("" ::: "memory");
            bf16x8v vf[4];
#pragma unroll
            for (int s4 = 0; s4 < 4; ++s4) { const LAS unsigned char* p = lds + HG_V + vb * 4096 + s4 * 1024 + trl; const s16x4 a0 = vtr(p), a1 = vtr(p + 512); vf[s4] = (bf16x8v){a0[0], a0[1], a0[2], a0[3], a1[0], a1[1], a1[2], a1[3]}; }
            oT = __builtin_amdgcn_mfma_f32_32x32x16_bf16(vf[0], __builtin_bit_cast(bf16x8v, pw[0]), oT, 0, 0, 0); oT = __builtin_amdgcn_mfma_f32_32x32x16_bf16(vf[1], __builtin_bit_cast(bf16x8v, pw[1]), oT, 0, 0, 0);
            if (tb == 1) { oT = __builtin_amdgcn_mfma_f32_32x32x16_bf16(vf[2], __builtin_bit_cast(bf16x8v, pw[2]), oT, 0, 0, 0); oT = __builtin_amdgcn_mfma_f32_32x32x16_bf16(vf[3], __builtin_bit_cast(bf16x8v, pw[3]), oT, 0, 0, 0); }
            { float ss = 0.f;
#pragma unroll
              for (int r = 0; r < 16; ++r) ss += oT[r] * oT[r];
              ss += __shfl_xor(ss, 32); if (hi == 0) ssq[(tb * 4 + vb) * 32 + r32] = ss; }
#pragma unroll
            for (int i = 0; i < 2; ++i) { const int kb = 2 * tb + i; f32x16 S = i ? S1 : S0;
#pragma unroll
                for (int g = 0; g < 4; ++g) { const f32x4 d4 = *(const LAS f32x4*)(dk_l + 32 * kb + 8 * g + 4 * hi);
#pragma unroll
                    for (int j = 0; j < 4; ++j) S[4 * g + j] *= d4[j]; }
#pragma unroll
                for (int s4 = 0; s4 < 4; ++s4) { const LAS unsigned char* p = lds + HG_KE + kb * 4096 + s4 * 1024 + trl; const s16x4 a0 = vtr(p), a1 = vtr(p + 512);
                    const bf16x8v kef = (bf16x8v){a0[0], a0[1], a0[2], a0[3], a1[0], a1[1], a1[2], a1[3]};
                    S = __builtin_amdgcn_mfma_f32_32x32x16_bf16(kef, vf[s4], S, 0, 0, 0); }
#pragma unroll
                for (int g = 0; g < 4; ++g) { v2u w; w.x = pk2(S[4 * g], S[4 * g + 1]); w.y = pk2(S[4 * g + 2], S[4 * g + 3]);
                    *(LAS v2u*)(st_nxt + (32 * vb + r32) * 256 + (((4 * kb + g) ^ sw) * 16) + hi * 8) = w; }
                if (i) S1 = S; else S0 = S; }
            __syncthreads();
            { const float tot = (ssq[(tb * 4 + 0) * 32 + r32] + ssq[(tb * 4 + 1) * 32 + r32]) + (ssq[(tb * 4 + 2) * 32 + r32] + ssq[(tb * 4 + 3) * 32 + r32]);
              const float rstd = 1.0f / sqrtf(tot * (1.f / 128.f) + EPS);
#pragma unroll
              for (int g = 0; g < 4; ++g) { const f32x4 ng = *(const LAS f32x4*)(lds + HG_NG + (32 * vb + 8 * g + 4 * hi) * 4); const v2u gg = ggv[g];
                  v2u w; w.x = pk2(oT[4 * g] * rstd * ng.x * bflo(gg.x), oT[4 * g + 1] * rstd * ng.y * bfhi(gg.x)); w.y = pk2(oT[4 * g + 2] * rstd * ng.z * bflo(gg.y), oT[4 * g + 3] * rstd * ng.w * bfhi(gg.y));
                  *(v2u*)(Og + rowo + 8 * g) = w; } }
            if (cl + 1 < HG_CPS) HG_STORE();
            __syncthreads();
        }
#undef HG_LOAD
#undef HG_STORE
    }
}

__device__ __forceinline__ void phase_hgrn_state(const bf16* KE, const bf16* Vp, const float* DK, float* HL, float* HP, LAS unsigned char* lds, int blk, int G, int tid) {
    const int wave = tid >> 6, lane = tid & 63, r32 = lane & 31, hi = lane >> 5, tb = wave >> 2, vb = wave & 3;
    const int trl = (4 * hi + ((lane & 15) >> 2)) * 64 + ((lane >> 4) & 1) * 32 + (lane & 3) * 8;
    LAS float* dk_l = (LAS float*)(lds + HG_DK);
    for (int un = blk; un < BATCH * 8 * 3; un += G) {
        const int bh = un / 3, seg = un % 3, b = bh >> 3, h = bh & 7, c0 = seg * HG_CPS;
        f32x16 S0 = (f32x16){}, S1 = (f32x16){};
        float ptot = 1.0f;
        v4u re[2], rv[2]; f32x4 rd = (f32x4){0.f, 0.f, 0.f, 0.f};
#define HS_LOAD(c) do { const size_t row0_ = (size_t)b * SEQ + 64 * (c); \
            _Pragma("unroll") for (int i = 0; i < 2; ++i) { const int idx = tid + 512 * i, row = idx >> 4, cc = idx & 15; const size_t go = (row0_ + row) * 1024 + h * 128 + cc * 8; \
                re[i] = *(const v4u*)(KE + go); rv[i] = *(const v4u*)(Vp + go); } \
            if (tid < 32) rd = *(const f32x4*)(DK + ((size_t)b * 128 + (c)) * 1024 + h * 128 + tid * 4); } while (0)
#define HS_STORE() do { \
            _Pragma("unroll") for (int i = 0; i < 2; ++i) { const int idx = tid + 512 * i, row = idx >> 4, cc = idx & 15; \
                *(LAS v4u*)(lds + HG_KE + (cc >> 2) * 4096 + row * 64 + (cc & 3) * 16) = re[i]; *(LAS v4u*)(lds + HG_V + (cc >> 2) * 4096 + row * 64 + (cc & 3) * 16) = rv[i]; } \
            if (tid < 32) *(LAS f32x4*)(dk_l + tid * 4) = rd; } while (0)
        HS_LOAD(c0); HS_STORE();
        __syncthreads();
        for (int cl = 0; cl < HG_CPS; ++cl) {
            if (cl + 1 < HG_CPS) HS_LOAD(c0 + cl + 1);
            bf16x8v vf[4];
#pragma unroll
            for (int s4 = 0; s4 < 4; ++s4) { const LAS unsigned char* p = lds + HG_V + vb * 4096 + s4 * 1024 + trl; const s16x4 a0 = vtr(p), a1 = vtr(p + 512); vf[s4] = (bf16x8v){a0[0], a0[1], a0[2], a0[3], a1[0], a1[1], a1[2], a1[3]}; }
#pragma unroll
            for (int i = 0; i < 2; ++i) { const int kb = 2 * tb + i; f32x16 S = i ? S1 : S0;
#pragma unroll
                for (int g = 0; g < 4; ++g) { const f32x4 d4 = *(const LAS f32x4*)(dk_l + 32 * kb + 8 * g + 4 * hi);
#pragma unroll
                    for (int j = 0; j < 4; ++j) S[4 * g + j] *= d4[j]; }
#pragma unroll
                for (int s4 = 0; s4 < 4; ++s4) { const LAS unsigned char* p = lds + HG_KE + kb * 4096 + s4 * 1024 + trl; const s16x4 a0 = vtr(p), a1 = vtr(p + 512);
                    const bf16x8v kef = (bf16x8v){a0[0], a0[1], a0[2], a0[3], a1[0], a1[1], a1[2], a1[3]};
                    S = __builtin_amdgcn_mfma_f32_32x32x16_bf16(kef, vf[s4], S, 0, 0, 0); }
                if (i) S1 = S; else S0 = S; }
            if (tid < 128) ptot *= dk_l[tid];
            __syncthreads();
            if (cl + 1 < HG_CPS) HS_STORE();
            __syncthreads();
        }
        float* L = HL + ((size_t)bh * 3 + seg) * 16384;
#pragma unroll
        for (int i = 0; i < 2; ++i) { const int kb = 2 * tb + i; const f32x16 S = i ? S1 : S0;
#pragma unroll
            for (int r = 0; r < 16; ++r) L[(32 * kb + crow(r, hi)) * 128 + 32 * vb + r32] = S[r]; }
        if (tid < 128) HP[((size_t)bh * 3 + seg) * 128 + tid] = ptot;
#undef HS_LOAD
#undef HS_STORE
    }
}
struct Args { const void* in[19]; float* out; unsigned char* ws; int ph_lo, ph_hi; };
__global__ void __launch_bounds__(NWAVES * 64, 2) fwd(Args args) {
    extern __shared__ __attribute__((aligned(16))) unsigned char lds_raw[];
    LAS unsigned char* lds = (LAS unsigned char*)lds_raw;
    volatile LAS unsigned* MISC = (volatile LAS unsigned*)(lds + MISC_OFF);
    const int tid = threadIdx.x, G = gridDim.x, blk = blockIdx.x;
    unsigned char* ws = args.ws;
    unsigned* ctl = (unsigned*)(ws + WS_CTL);
    for (int u = tid; u < (LDS_BYTES - LDSCTL_OFF) / 4; u += NWAVES * 64) ((LAS unsigned*)(lds + LDSCTL_OFF))[u] = 0u;
    __syncthreads();
    XcdBarrier bar; bar.bar = ctl + CW_BAR; bar.x = 0; bar.st = nullptr;
    if (N_LAUNCHES == 1) bar = xcd_barrier_post(ctl + CW_BAR, MISC + 8);
#define GRID_BAR() do { if (N_LAUNCHES == 1) xcd_barrier(bar); } while (0)
    const int lo = args.ph_lo, hi = args.ph_hi;
#define IN(k) (lo <= (k) && (k) < hi)
#define BOTH(k) (IN(k) && IN((k) + 1))
#ifndef PROBE_PHASE
#define PROBE_PHASE -1
#endif
#define REP(k) ((k) == PROBE_PHASE ? 2 : 1)
    const float* x = (const float*)args.in[0]; const int* positions = (const int*)args.in[1];
    const float* g_mix = (const float*)args.in[2]; const float* g_ffn = (const float*)args.in[3]; const float* g_final = (const float*)args.in[4];
    const float* sinks = (const float*)args.in[7]; const float* rec_norm_g = (const float*)args.in[10]; const float* w_router = (const float*)args.in[15];
    float* out = args.out;
    bf16* H = (bf16*)(ws + WS_H); bf16* BIG = (bf16*)(ws + WS_BIG);
    const size_t PLANE = (size_t)NTOK * D;

    if (IN(0)) for (int rep_ = 0; rep_ < REP(0); ++rep_) {
        P0Args pa; pa.x = x; pa.g0 = g_mix; pa.w_in_attn = (const float*)args.in[5]; pa.w_out_attn = (const float*)args.in[6]; pa.w_in_rec = (const float*)args.in[8]; pa.w_out_rec = (const float*)args.in[11];
        pa.w_gate = (const float*)args.in[12]; pa.w_up = (const float*)args.in[13]; pa.w_down = (const float*)args.in[14]; pa.w_gate_moe = (const float*)args.in[16]; pa.w_up_moe = (const float*)args.in[17]; pa.w_down_moe = (const float*)args.in[18];
        pa.rlb = (const float*)args.in[9]; pa.pos = positions; pa.ws = ws;
        phase_prologue(pa, lds, blk, G, tid);
        if (BOTH(0)) GRID_BAR();
    }
    if (IN(1)) {
        pg8::Gemm g{H, (const bf16*)(ws + WS_W_INATT), NTOK, QKV_N, D}; pg8::StaticOrder S; S.init(NTOK, QKV_N, G, blk);
        pg8::EpiBf16Plain E{BIG, QKV_N, 1 << 20};
        pg8::gemm_phase<pg8::EpiBf16Plain, pg8::StaticOrder, PG8_ALIGN, PG8_SP2>(lds, g, S, E);
        if (BOTH(1)) GRID_BAR();
    }
    if (IN(2)) { phase_rope(BIG, (const float*)(ws + WS_ROPE), blk, G, tid); if (BOTH(2)) GRID_BAR(); }
    if (IN(3)) for (int rep_ = 0; rep_ < REP(3); ++rep_) { phase_attn(BIG, sinks, H, (bf16*)(ws + WS_OB), (float*)(ws + WS_LSE), lds, blk, G, tid); if (BOTH(3)) GRID_BAR(); }
    if (IN(4)) {
        pg8::Gemm g{H, (const bf16*)(ws + WS_W_OUTATT), NTOK, D, D}; pg8::StaticOrder S; S.init(NTOK, D, G, blk);
        pg8::EpiRes E{x, out, D};
        pg8::gemm_phase<pg8::EpiRes, pg8::StaticOrder, PG8_ALIGN, PG8_SP2>(lds, g, S, E);
        if (BOTH(4)) GRID_BAR();
    }
    if (IN(5)) { phase_norm(out, g_ffn, H, blk, G, tid); if (BOTH(5)) GRID_BAR(); }
    if (IN(6)) {
        pg8::Gemm g{H, (const bf16*)(ws + WS_W_GU), NTOK, 2 * FF, D}; pg8::StaticOrder S; S.init(NTOK, 2 * FF, G, blk);
        pg8::EpiSwiglu E{BIG, FF, 1 << 20, 0};
        pg8::gemm_phase<pg8::EpiSwiglu, pg8::StaticOrder, PG8_ALIGN, PG8_SP2>(lds, g, S, E);
#if PROBE_PHASE == 6
        GRID_BAR(); pg8::gemm_phase<pg8::EpiSwiglu, pg8::StaticOrder, PG8_ALIGN, PG8_SP2>(lds, g, S, E);
#endif
        if (BOTH(6)) GRID_BAR();
    }
    if (IN(7)) {
        pg8::Gemm g{BIG, (const bf16*)(ws + WS_W_DN), NTOK, D, FF}; pg8::StaticOrder S; S.init(NTOK, D, G, blk);
        pg8::EpiRes E{out, out, D};
        pg8::gemm_phase<pg8::EpiRes, pg8::StaticOrder, PG8_ALIGN, PG8_SP2>(lds, g, S, E);
        if (BOTH(7)) GRID_BAR();
    }
    if (IN(8)) { phase_norm(out, g_mix + D, H, blk, G, tid); if (BOTH(8)) GRID_BAR(); }
    if (IN(9)) {
        pg8::Gemm g{H, (const bf16*)(ws + WS_W_INREC), NTOK, REC_N, D}; pg8::StaticOrder S; S.init(NTOK, REC_N, G, blk);
        pg8::EpiRec2 E{BIG, PLANE, (const float*)(ws + WS_LBK), (float*)(ws + WS_DK)};
        pg8::gemm_phase<pg8::EpiRec2, pg8::StaticOrder, PG8_ALIGN, PG8_SP2>(lds, g, S, E);
        if (BOTH(9)) GRID_BAR();
    }
    if (IN(10)) for (int rep_ = 0; rep_ < REP(10); ++rep_) { phase_hgrn_state(BIG + 2 * PLANE, BIG + 3 * PLANE, (const float*)(ws + WS_DK), (float*)(ws + WS_HL), (float*)(ws + WS_HP), lds, blk, G, tid); if (BOTH(10)) GRID_BAR(); }
    if (IN(11)) for (int rep_ = 0; rep_ < REP(11); ++rep_) { phase_hgrn(BIG, BIG + PLANE, BIG + 2 * PLANE, BIG + 3 * PLANE, BIG + 4 * PLANE, (const float*)(ws + WS_DK), rec_norm_g, H, (const float*)(ws + WS_HL), (const float*)(ws + WS_HP), lds, blk, G, tid); if (BOTH(11)) GRID_BAR(); }
    if (IN(12)) {
        pg8::Gemm g{H, (const bf16*)(ws + WS_W_OUTREC), NTOK, D, D}; pg8::StaticOrder S; S.init(NTOK, D, G, blk);
        pg8::EpiRes E{out, out, D};
        pg8::gemm_phase<pg8::EpiRes, pg8::StaticOrder, PG8_ALIGN, PG8_SP2>(lds, g, S, E);
        if (BOTH(12)) GRID_BAR();
    }
    int4* meta = (int4*)(ws + WS_META); int* hist = (int*)(ws + WS_HIST); int* dest = (int*)(ws + WS_DEST); int* info = (int*)(ws + WS_INFO);
    bf16* Y = (bf16*)(ws + WS_Y); bf16* HID = (bf16*)(ws + WS_HID);
    if (IN(13)) for (int rep_ = 0; rep_ < REP(13); ++rep_) { phase_router(out, g_ffn + D, w_router, meta, hist, lds, blk, G, tid); if (BOTH(13)) GRID_BAR(); }
    if (IN(14)) for (int rep_ = 0; rep_ < REP(14); ++rep_) { phase_scatter(out, g_ffn + D, meta, hist, dest, info, Y, lds, blk, G, tid); if (BOTH(14)) GRID_BAR(); }
    for (int c = 0; c < 3; ++c) {
        if (IN(15 + 2 * c) || IN(16 + 2 * c)) {
            const int T = info[8]; const int tile0 = 256 * c; int ntl = T - tile0; ntl = ntl > 256 ? 256 : ntl; ntl = ntl < 0 ? 0 : ntl;
            pg8::MoeOrder S; S.tile0 = tile0; S.te0 = info[0]; S.te1 = info[1]; S.te2 = info[2]; S.te3 = info[3]; S.te4 = info[4]; S.te5 = info[5]; S.te6 = info[6];
            if (IN(15 + 2 * c)) {
                S.nN = 28; S.so.init(ntl * 256, 2 * FF, G, blk);
                pg8::Gemm g{Y, (const bf16*)(ws + WS_WMOE_GU), 0, 0, D};
                pg8::EpiSwiglu E{HID, FF, 28, tile0};
                pg8::gemm_phase<pg8::EpiSwiglu, pg8::MoeOrder, PG8_ALIGN, PG8_SP2>(lds, g, S, E);
                if (BOTH(15 + 2 * c)) GRID_BAR();
            }
            if (IN(16 + 2 * c)) {
                S.nN = 4; S.so.init(ntl * 256, D, G, blk);
                pg8::Gemm g{HID - (size_t)tile0 * 256 * FF, (const bf16*)(ws + WS_WMOE_DN), 0, 0, FF};
                pg8::EpiBf16Plain E{Y, D, 4};
                pg8::gemm_phase<pg8::EpiBf16Plain, pg8::MoeOrder, PG8_ALIGN, PG8_SP2>(lds, g, S, E);
                if (BOTH(16 + 2 * c)) GRID_BAR();
            }
        }
    }
    if (IN(21)) phase_combine(out, Y, meta, dest, g_final, blk, G, tid);
#undef IN
#undef BOTH
}

extern "C" void kernel_launch(void* const* d_in, const int* in_sizes, int n_in, void* d_out, int out_size, void* d_ws, size_t ws_size, hipStream_t stream) {
    static int grid = 0;
    if (grid == 0) {
        if (n_in != 19 || in_sizes[0] != NTOK * D || out_size != NTOK * D || ws_size < WS_END) { fprintf(stderr, "kernel_launch: unexpected shapes / workspace (n_in %d, ws %zu); nothing launched\n", n_in, ws_size); grid = -1; return; }
        int dev = 0, cus = 0, per_cu = 0;
        if (hipGetDevice(&dev) != hipSuccess || hipDeviceGetAttribute(&cus, hipDeviceAttributeMultiprocessorCount, dev) != hipSuccess) { grid = -1; return; }
        if (hipFuncSetAttribute((const void*)fwd, hipFuncAttributeMaxDynamicSharedMemorySize, LDS_BYTES) != hipSuccess) { fprintf(stderr, "kernel_launch: hipFuncSetAttribute failed\n"); grid = -1; return; }
        if (hipOccupancyMaxActiveBlocksPerMultiprocessor(&per_cu, (const void*)fwd, NWAVES * 64, LDS_BYTES) != hipSuccess || per_cu < 1) fprintf(stderr, "kernel_launch: occupancy query says %d\n", per_cu);
        (void)hipGetLastError();
        grid = cus;
    }
    if (grid < 0) return;
    if (hipMemsetAsync((char*)d_ws + WS_CTL, 0, CTL_ZERO_BYTES, stream) != hipSuccess) return;
    Args a{};
    for (int i = 0; i < 19; ++i) a.in[i] = d_in[i];
    a.out = (float*)d_out; a.ws = (unsigned char*)d_ws;
    if (N_LAUNCHES == 1) { a.ph_lo = 0; a.ph_hi = NPH; hipLaunchKernelGGL(fwd, dim3(grid), dim3(NWAVES * 64), LDS_BYTES, stream, a); }
    else for (int li = 0; li < NPH; ++li) { a.ph_lo = li; a.ph_hi = li + 1; hipLaunchKernelGGL(fwd, dim3(grid), dim3(NWAVES * 64), LDS_BYTES, stream, a); }
}
```

```cpp
#include <hip/hip_runtime.h>
#include <cstdio>
#include <cstdint>
#define PROBE_PHASE -1
namespace pg8 {
#define PG8_LAS __attribute__((address_space(3)))
typedef unsigned short bf16_t;
typedef short bf16x8 __attribute__((ext_vector_type(8)));
typedef float f32x4 __attribute__((ext_vector_type(4)));
typedef unsigned u32x4 __attribute__((ext_vector_type(4)));
constexpr int BM = 256, BK = 64, HALF = 128, HTB = HALF * BK * 2  , STAGE_BYTES = 8 * HTB, NXCD = 8, WGM = 8;

__host__ __device__ __forceinline__ int lds_byte(int r, int c) { const int st = (r >> 4) * 2 + (c >> 5), rr = r & 15, cc = c & 31, ob = rr * 64 + cc * 2; return st * 1024 + (ob ^ (((ob >> 9) & 1) << 5)); }
__host__ __device__ __forceinline__ void stage_rc(int b, int& R, int& C) { const int st = b / 1024, sb = b % 1024, swz = sb ^ (((sb >> 9) & 1) << 5); R = (st >> 1) * 16 + swz / 64; C = (st & 1) * 32 + (swz % 64) / 2; }
__host__ __device__ __forceinline__ int perm32(int rho) { const int n = rho >> 4, i = rho & 15; return 8 * (i >> 2) + 4 * n + (i & 3); }

struct Unit { int pm, pn; };
struct Gemm { const bf16_t* A; const bf16_t* Bt; int M, N, K; };

struct StaticOrder {
    int nM, nN, nwg, G, c;
    __host__ __device__ void init(int M, int N, int G_, int c_) { nM = M / BM; nN = N / BM; nwg = nM * nN; G = G_; c = c_; }
    __host__ __device__ bool next(int i, Unit& u) const {
        const long L = (long)i * G + c; if (L >= nwg) return false;
        int wgid = (int)L; { const int q = nwg / NXCD, r = nwg % NXCD, xcd = wgid % NXCD, off = wgid / NXCD; wgid = (xcd < r ? xcd * (q + 1) : r * (q + 1) + (xcd - r) * q) + off; }
        const int nig = WGM * nN, gid = wgid / nig, fm = gid * WGM, gsz = (nM - fm) < WGM ? (nM - fm) : WGM;
        u.pm = fm + ((wgid % nig) % gsz); u.pn = (wgid % nig) / gsz; return true;
    }
    __device__ __forceinline__ void a_ready(const Unit&) const {}
    __device__ __forceinline__ void done(const Unit&) const {}
};
__device__ __forceinline__ unsigned cvt_pk_bf16(float lo, float hi) { unsigned r; asm volatile("v_cvt_pk_bf16_f32 %0, %1, %2" : "=v"(r) : "v"(lo), "v"(hi)); return r; }
typedef unsigned u32x2 __attribute__((ext_vector_type(2)));
__device__ __forceinline__ float sigmoid_f(float x) { return __builtin_amdgcn_rcpf(1.0f + __builtin_amdgcn_exp2f(-1.44269504089f * x)); }
__device__ __forceinline__ float silu_f(float x) { return x * sigmoid_f(x); }
__device__ __forceinline__ u32x4 pack8(const f32x4& v0, const f32x4& v1) { u32x4 w; w.x = cvt_pk_bf16(v0[0], v0[1]); w.y = cvt_pk_bf16(v0[2], v0[3]); w.z = cvt_pk_bf16(v1[0], v1[1]); w.w = cvt_pk_bf16(v1[2], v1[3]); return w; }
struct EpiBf16Plain {
    static constexpr bool PERM = true, AFTER_DRAIN = false;
    bf16_t* O; int ldc; int nmod;
    __device__ __forceinline__ void operator()(const f32x4 (&acc)[2][2][4][2], const Unit& u, int wr, int wc, int fr, int fq) const {
        const int row0 = u.pm * BM + wr * 64 + fr; const int col0 = (u.pn % nmod) * BM + wc * 32 + 8 * fq;
#pragma unroll
        for (int ai = 0; ai < 2; ++ai)
#pragma unroll
            for (int m = 0; m < 4; ++m) { bf16_t* rowp = O + (size_t)(row0 + ai * HALF + m * 16) * ldc + col0;
#pragma unroll
                for (int bj = 0; bj < 2; ++bj) *(u32x4*)(rowp + bj * HALF) = pack8(acc[ai][bj][m][0], acc[ai][bj][m][1]); }
    }
};
struct EpiRes {
    static constexpr bool PERM = false, AFTER_DRAIN = false;
    const float* base; float* out; int ldc; bf16_t* hb; unsigned* ssq;
    __device__ __forceinline__ void operator()(const f32x4 (&acc)[2][2][4][2], const Unit& u, int wr, int wc, int fr, int fq) const {
        const int row0 = u.pm * BM + wr * 64 + fr, col0 = u.pn * BM + wc * 32 + 4 * fq;
#pragma unroll
        for (int ai = 0; ai < 2; ++ai)
#pragma unroll
            for (int m = 0; m < 4; ++m) { const int row = row0 + ai * HALF + m * 16; const size_t off = (size_t)row * ldc + col0; float ss = 0.f;
#pragma unroll
                for (int bj = 0; bj < 2; ++bj)
#pragma unroll
                    for (int n = 0; n < 2; ++n) { const f32x4 v = *(const f32x4*)(base + off + bj * HALF + n * 16) + acc[ai][bj][m][n]; *(f32x4*)(out + off + bj * HALF + n * 16) = v;
                        u32x2 w; w.x = cvt_pk_bf16(v[0], v[1]); w.y = cvt_pk_bf16(v[2], v[3]); *(u32x2*)(hb + off + bj * HALF + n * 16) = w;
                        ss += (v[0] * v[0] + v[1] * v[1]) + (v[2] * v[2] + v[3] * v[3]); }
                ss += __shfl_xor(ss, 16); ss += __shfl_xor(ss, 32);
                if (fq == 0) __hip_atomic_fetch_add(ssq + row, __float2uint_rn(ss * 65536.0f), __ATOMIC_RELAXED, __HIP_MEMORY_SCOPE_AGENT);
                asm volatile("" ::: "memory"); }
    }
};
struct EpiSwiglu {
    static constexpr bool PERM = true, AFTER_DRAIN = false;
    bf16_t* O; int ldc; int nN; int tile0; const unsigned* ssq; const float* rsd;
    __device__ __forceinline__ void operator()(const f32x4 (&acc)[2][2][4][2], const Unit& u, int wr, int wc, int fr, int fq) const {
        const int row0 = (u.pm - tile0) * BM + wr * 64 + fr; const int col0 = (u.pn % nN) * HALF + wc * 32 + 8 * fq; const int arow0 = u.pm * BM + wr * 64 + fr;
#pragma unroll
        for (int ai = 0; ai < 2; ++ai)
#pragma unroll
            for (int m = 0; m < 4; ++m) { bf16_t* rowp = O + (size_t)(row0 + ai * HALF + m * 16) * ldc + col0;
                const int ar = arow0 + ai * HALF + m * 16; const float rs = rsd ? rsd[ar] : 1.0f / sqrtf((float)ssq[ar] * (1.f / (1024.f * 65536.f)) + 1e-6f);
                f32x4 h0, h1;
#pragma unroll
                for (int j = 0; j < 4; ++j) { h0[j] = silu_f(rs * acc[ai][0][m][0][j]) * (rs * acc[ai][1][m][0][j]); h1[j] = silu_f(rs * acc[ai][0][m][1][j]) * (rs * acc[ai][1][m][1][j]); }
                *(u32x4*)rowp = pack8(h0, h1); }
    }
};
struct EpiRec {
    static constexpr bool PERM = true, AFTER_DRAIN = false;
    bf16_t* P; size_t plane; const float* lbk;
    __device__ __forceinline__ void operator()(const f32x4 (&acc)[2][2][4][2], const Unit& u, int wr, int wc, int fr, int fq) const {
        const int hd = u.pn & 7; const bool second = (u.pn >> 3) != 0;
        const int row0 = u.pm * BM + wr * 64 + fr; const int ch0 = hd * HALF + wc * 32 + 8 * fq;
        const f32x4 l0 = *(const f32x4*)(lbk + ch0), l1 = *(const f32x4*)(lbk + ch0 + 4);
        bf16_t* pa = P + (second ? 2 * plane : 0); bf16_t* pb = pa + plane;
#pragma unroll
        for (int ai = 0; ai < 2; ++ai)
#pragma unroll
            for (int m = 0; m < 4; ++m) { const size_t off = (size_t)(row0 + ai * HALF + m * 16) * 1024 + ch0;
                f32x4 a0 = acc[ai][0][m][0], a1 = acc[ai][0][m][1], b0 = acc[ai][1][m][0], b1 = acc[ai][1][m][1];
                if (!second) {
#pragma unroll
                    for (int j = 0; j < 4; ++j) { a0[j] = silu_f(a0[j]); a1[j] = silu_f(a1[j]); b0[j] = l0[j] * sigmoid_f(-b0[j]); b1[j] = l1[j] * sigmoid_f(-b1[j]); }
                } else {
#pragma unroll
                    for (int j = 0; j < 4; ++j) { b0[j] = silu_f(b0[j]); b1[j] = silu_f(b1[j]); }
                }
                *(u32x4*)(pa + off) = pack8(a0, a1); *(u32x4*)(pb + off) = pack8(b0, b1); }
    }
};
struct MoeOrder {
    StaticOrder so; int tile0, nN; int te0, te1, te2, te3, te4, te5, te6;
    __device__ __forceinline__ bool next(int i, Unit& u) const {
        Unit l; if (!so.next(i, l)) return false;
        const int pm = tile0 + l.pm;
        const int e = (pm >= te0) + (pm >= te1) + (pm >= te2) + (pm >= te3) + (pm >= te4) + (pm >= te5) + (pm >= te6);
        u.pm = pm; u.pn = e * nN + l.pn; return true;
    }
    __device__ __forceinline__ void a_ready(const Unit&) const {}
    __device__ __forceinline__ void done(const Unit&) const {}
};

template <int CTRL> __device__ __forceinline__ float dpp0(float v) { return __builtin_bit_cast(float, __builtin_amdgcn_update_dpp(0, __builtin_bit_cast(int, v), CTRL, 0xf, 0xf, true)); }
struct EpiRec2 {
    static constexpr bool PERM = true, AFTER_DRAIN = false;
    bf16_t* P; size_t plane; const float* lbk; float* DK; const unsigned* ssq;
    __device__ __forceinline__ void operator()(const f32x4 (&acc)[2][2][4][2], const Unit& u, int wr, int wc, int fr, int fq) const {
        const int hd = u.pn & 7; const bool second = (u.pn >> 3) != 0;
        const int row0 = u.pm * BM + wr * 64 + fr; const int ch0 = hd * HALF + wc * 32 + 8 * fq;
        if (second) {
#pragma unroll
            for (int ai = 0; ai < 2; ++ai)
#pragma unroll
                for (int m = 0; m < 4; ++m) { const size_t off = (size_t)(row0 + ai * HALF + m * 16) * 1024 + ch0;
                    const float rsm = 1.0f / sqrtf((float)ssq[row0 + ai * HALF + m * 16] * (1.f / (1024.f * 65536.f)) + 1e-6f);
                    f32x4 b0 = acc[ai][1][m][0], b1 = acc[ai][1][m][1]; const f32x4 a0 = acc[ai][0][m][0] * rsm, a1 = acc[ai][0][m][1] * rsm;
#pragma unroll
                    for (int j = 0; j < 4; ++j) { b0[j] = silu_f(rsm * b0[j]); b1[j] = silu_f(rsm * b1[j]); }
                    *(u32x4*)(P + 3 * plane + off) = pack8(a0, a1); *(u32x4*)(P + 4 * plane + off) = pack8(b0, b1); }
        } else {
            const int lane15 = (fq * 16 + fr) | 15;
#pragma unroll
            for (int ai = 0; ai < 2; ++ai) {
                float rs4[4];
#pragma unroll
                for (int m = 0; m < 4; ++m) rs4[m] = 1.0f / sqrtf((float)ssq[row0 + ai * HALF + m * 16] * (1.f / (1024.f * 65536.f)) + 1e-6f);
#pragma unroll
                for (int n = 0; n < 2; ++n) {
                    const f32x4 lbv = *(const f32x4*)(lbk + ch0 + 4 * n);
                    float kk[4][4], bb[4][4];
#pragma unroll
                    for (int m = 0; m < 4; ++m)
#pragma unroll
                        for (int j = 0; j < 4; ++j) { const float k_ = lbv[j] * sigmoid_f(-rs4[m] * acc[ai][1][m][n][j]); kk[m][j] = k_; float x = __logf(1.0f - k_);
                            x += dpp0<0x111>(x); x += dpp0<0x112>(x); x += dpp0<0x114>(x); x += dpp0<0x118>(x); bb[m][j] = x; }
                    float run[4] = {0.f, 0.f, 0.f, 0.f};
#pragma unroll
                    for (int m = 0; m < 4; ++m)
#pragma unroll
                        for (int j = 0; j < 4; ++j) { const float tot = __shfl(bb[m][j], lane15); bb[m][j] += run[j]; run[j] += tot; }
#pragma unroll
                    for (int m = 0; m < 4; ++m) { const size_t off = (size_t)(row0 + ai * HALF + m * 16) * 1024 + ch0 + 4 * n;
                        float qe[4], ki[4], ke[4];
#pragma unroll
                        for (int j = 0; j < 4; ++j) { const float bt = bb[m][j]; qe[j] = silu_f(rs4[m] * acc[ai][0][m][n][j]) * __expf(bt); ki[j] = kk[m][j] * __expf(fminf(-bt, 80.f)); ke[j] = kk[m][j] * __expf(run[j] - bt); }
                        u32x2 w; w.x = cvt_pk_bf16(qe[0], qe[1]); w.y = cvt_pk_bf16(qe[2], qe[3]); *(u32x2*)(P + off) = w;
                        w.x = cvt_pk_bf16(ki[0], ki[1]); w.y = cvt_pk_bf16(ki[2], ki[3]); *(u32x2*)(P + plane + off) = w;
                        w.x = cvt_pk_bf16(ke[0], ke[1]); w.y = cvt_pk_bf16(ke[2], ke[3]); *(u32x2*)(P + 2 * plane + off) = w; }
                    if (fr == 0) { const int chunk = 4 * u.pm + 2 * ai + wr; *(f32x4*)(DK + (size_t)chunk * 1024 + ch0 + 4 * n) = (f32x4){__expf(run[0]), __expf(run[1]), __expf(run[2]), __expf(run[3])}; }
                }
            }
        }
    }
};
template <class Epi, class Sched, bool ALIGN_EPI = false, bool SP2 = false>
__device__ __forceinline__ void gemm_phase(PG8_LAS unsigned char* lds, const Gemm g, const Sched& S, const Epi& E) {
    const int tid = threadIdx.x, wid = __builtin_amdgcn_readfirstlane(tid >> 6), lane = tid & 63, wr = wid >> 2, wc = wid & 3, fr = lane & 15, fq = lane >> 4;
    const int K = g.K, nt = K / BK;
    unsigned voffA[2], voffB[2];
#pragma unroll
    for (int i = 0; i < 2; ++i) { int R, C; stage_rc(tid * 16 + i * 8192, R, C); const int Rb = Epi::PERM ? ((R & ~31) + perm32(R & 31)) : R;
        voffA[i] = (unsigned)(R * K + C) * 2u; voffB[i] = (unsigned)(Rb * K + C) * 2u; }
    const size_t kstep = (size_t)(BK * 2);
    const size_t hstep = (size_t)HALF * K * 2;
    const size_t tstep = 2 * hstep;
    const unsigned ldsw = (unsigned)wid * 1024u;
    const int aoff = lds_byte(wr * 64 + fr, fq * 8), boff = lds_byte(wc * 32 + fr, fq * 8);
#define PG8_SA(b, h) (((b) * 2 + (h)) * HTB)
#define PG8_SB(b, h) ((4 + (b) * 2 + (h)) * HTB)
#define PG8_STAGE(bufoff, gbase, voff) do { _Pragma("unroll") for (int _i = 0; _i < 2; ++_i) \
        __builtin_amdgcn_global_load_lds((const unsigned*)((const char*)(gbase) + (voff)[_i]), (PG8_LAS unsigned*)(lds + (bufoff) + ldsw + _i * 8192), 16, 0, 0); } while (0)
#define PG8_LDA(dst, b, h) do { _Pragma("unroll") for (int m = 0; m < 4; ++m) _Pragma("unroll") for (int k = 0; k < 2; ++k) dst[m][k] = *(const PG8_LAS bf16x8*)(lds + PG8_SA(b, h) + aoff + m * 2048 + k * 1024); } while (0)
#define PG8_LDB(dst, b, h) do { _Pragma("unroll") for (int n = 0; n < 2; ++n) _Pragma("unroll") for (int k = 0; k < 2; ++k) dst[n][k] = *(const PG8_LAS bf16x8*)(lds + PG8_SB(b, h) + boff + n * 2048 + k * 1024); } while (0)
#define PG8_MMA(ai, bj, At, Bt) do { __builtin_amdgcn_s_setprio(1); _Pragma("unroll") for (int m = 0; m < 4; ++m) _Pragma("unroll") for (int n = 0; n < 2; ++n) _Pragma("unroll") for (int k = 0; k < 2; ++k) \
        acc[ai][bj][m][n] = __builtin_amdgcn_mfma_f32_16x16x32_bf16(Bt[n][k], At[m][k], acc[ai][bj][m][n], 0, 0, 0); __builtin_amdgcn_s_setprio(0); } while (0)
#define PG8_WAIT_V(n) asm volatile("s_waitcnt vmcnt(" #n ")" ::: "memory")
#define PG8_WAIT_L(n) asm volatile("s_waitcnt lgkmcnt(" #n ")" ::: "memory")
#define PG8_BAR __builtin_amdgcn_s_barrier()
#define PG8_SCHED __builtin_amdgcn_sched_barrier(0)
    Unit cur, nxt; int ui = 0;
    if (!S.next(0, cur)) return;
    f32x4 acc[2][2][4][2];
#pragma unroll
    for (int a = 0; a < 2; ++a)
#pragma unroll
        for (int b = 0; b < 2; ++b)
#pragma unroll
            for (int m = 0; m < 4; ++m)
#pragma unroll
                for (int n = 0; n < 2; ++n) acc[a][b][m][n] = (f32x4){0.f, 0.f, 0.f, 0.f};
    bf16x8 At[4][2], B0[2][2], B1[2][2];
    const char* cA = (const char*)g.A + (size_t)cur.pm * tstep; const char* cB = (const char*)g.Bt + (size_t)cur.pn * tstep;
    S.a_ready(cur);
    if constexpr (SP2) {
        PG8_STAGE(PG8_SB(0, 0), cB, voffB); PG8_STAGE(PG8_SB(0, 1), cB + hstep, voffB); PG8_STAGE(PG8_SA(0, 0), cA, voffA); PG8_STAGE(PG8_SA(0, 1), cA + hstep, voffA);
        if (wr == 1) PG8_BAR;
        PG8_WAIT_V(2); PG8_BAR;
        PG8_STAGE(PG8_SB(1, 0), cB + kstep, voffB); PG8_STAGE(PG8_SA(1, 0), cA + kstep, voffA); PG8_STAGE(PG8_SB(1, 1), cB + hstep + kstep, voffB);
        PG8_WAIT_V(6); PG8_BAR;
    } else {
        PG8_STAGE(PG8_SB(0, 0), cB, voffB); PG8_STAGE(PG8_SA(0, 0), cA, voffA); PG8_STAGE(PG8_SB(0, 1), cB + hstep, voffB); PG8_STAGE(PG8_SA(0, 1), cA + hstep, voffA);
        if (wr == 1) PG8_BAR;
        PG8_WAIT_V(4); PG8_BAR;
        PG8_STAGE(PG8_SB(1, 0), cB + kstep, voffB); PG8_STAGE(PG8_SA(1, 0), cA + kstep, voffA); PG8_STAGE(PG8_SB(1, 1), cB + hstep + kstep, voffB);
        PG8_WAIT_V(6); PG8_BAR;
    }
    for (;;) {
        const bool has_next = S.next(ui + 1, nxt);
        const char* nA = has_next ? (const char*)g.A + (size_t)nxt.pm * tstep : cA; const char* nB = has_next ? (const char*)g.Bt + (size_t)nxt.pn * tstep : cB;
        for (int t = 0; t < nt; t += 2) {
            const bool last = (t == nt - 2);
            const char* a1 = cA + (size_t)(t + 1) * kstep;
            const char* a2 = last ? nA : cA + (size_t)(t + 2) * kstep; const char* b2 = last ? nB : cB + (size_t)(t + 2) * kstep;
            const char* a3 = a2 + kstep; const char* b3 = b2 + kstep;
            if (last && has_next) S.a_ready(nxt);
            if constexpr (SP2) {
            PG8_LDB(B0, 0, 0); PG8_LDB(B1, 0, 1); PG8_SCHED; PG8_LDA(At, 0, 0); PG8_STAGE(PG8_SA(1, 1), a1 + hstep, voffA);
            PG8_WAIT_V(8); PG8_WAIT_L(0); PG8_BAR; PG8_MMA(0, 0, At, B0); PG8_MMA(0, 1, At, B1); PG8_BAR; PG8_SCHED;
            PG8_LDA(At, 0, 1); PG8_STAGE(PG8_SB(0, 0), b2, voffB); PG8_STAGE(PG8_SB(0, 1), b2 + hstep, voffB); PG8_STAGE(PG8_SA(0, 0), a2, voffA);
            PG8_WAIT_V(8); PG8_WAIT_L(0); PG8_BAR; PG8_MMA(1, 0, At, B0); PG8_MMA(1, 1, At, B1); PG8_BAR; PG8_SCHED;
            PG8_LDB(B0, 1, 0); PG8_LDB(B1, 1, 1); PG8_SCHED; PG8_LDA(At, 1, 0); PG8_STAGE(PG8_SA(0, 1), a2 + hstep, voffA);
            PG8_WAIT_V(8); PG8_WAIT_L(0); PG8_BAR; PG8_MMA(0, 0, At, B0); PG8_MMA(0, 1, At, B1); PG8_BAR; PG8_SCHED;
            PG8_LDA(At, 1, 1); PG8_STAGE(PG8_SB(1, 0), b3, voffB); PG8_STAGE(PG8_SB(1, 1), b3 + hstep, voffB); PG8_STAGE(PG8_SA(1, 0), a3, voffA);
            PG8_WAIT_V(8); PG8_WAIT_L(0); PG8_BAR; PG8_MMA(1, 0, At, B0); PG8_MMA(1, 1, At, B1); PG8_BAR; PG8_SCHED;
            } else {
            PG8_LDB(B0, 0, 0); PG8_SCHED; PG8_LDA(At, 0, 0); PG8_STAGE(PG8_SA(1, 1), a1 + hstep, voffA);
            PG8_WAIT_L(8); PG8_BAR; PG8_WAIT_L(0); PG8_MMA(0, 0, At, B0); PG8_BAR; PG8_SCHED;
            PG8_LDB(B1, 0, 1); PG8_STAGE(PG8_SB(0, 0), b2, voffB);
            PG8_BAR; PG8_WAIT_L(0); PG8_MMA(0, 1, At, B1); PG8_BAR;
            PG8_LDA(At, 0, 1); PG8_STAGE(PG8_SA(0, 0), a2, voffA);
            PG8_BAR; PG8_WAIT_L(0); PG8_MMA(1, 0, At, B0); PG8_BAR; PG8_SCHED;
            PG8_STAGE(PG8_SB(0, 1), b2 + hstep, voffB);
            PG8_WAIT_V(6); PG8_BAR; PG8_MMA(1, 1, At, B1); PG8_BAR;
            PG8_LDB(B0, 1, 0); PG8_SCHED; PG8_LDA(At, 1, 0); PG8_STAGE(PG8_SA(0, 1), a2 + hstep, voffA);
            PG8_WAIT_L(8); PG8_BAR; PG8_WAIT_L(0); PG8_MMA(0, 0, At, B0); PG8_BAR; PG8_SCHED;
            PG8_LDB(B1, 1, 1); PG8_STAGE(PG8_SB(1, 0), b3, voffB);
            PG8_BAR; PG8_WAIT_L(0); PG8_MMA(0, 1, At, B1); PG8_BAR;
            PG8_LDA(At, 1, 1); PG8_STAGE(PG8_SA(1, 0), a3, voffA);
            PG8_BAR; PG8_WAIT_L(0); PG8_MMA(1, 0, At, B0); PG8_BAR; PG8_SCHED;
            PG8_STAGE(PG8_SB(1, 1), b3 + hstep, voffB);
            PG8_WAIT_V(6); PG8_BAR; PG8_MMA(1, 1, At, B1); PG8_BAR;
            }
        }
        if constexpr (ALIGN_EPI) { if (wr == 0) PG8_BAR; }
        if constexpr (!Epi::AFTER_DRAIN) { E(acc, cur, wr, wc, fr, fq); S.done(cur); }
        if (!has_next) break;
#pragma unroll
        for (int a = 0; a < 2; ++a)
#pragma unroll
            for (int b = 0; b < 2; ++b)
#pragma unroll
                for (int m = 0; m < 4; ++m)
#pragma unroll
                    for (int n = 0; n < 2; ++n) acc[a][b][m][n] = (f32x4){0.f, 0.f, 0.f, 0.f};
        cur = nxt; cA = nA; cB = nB; ++ui;
        if constexpr (ALIGN_EPI) { if (wr == 1) PG8_BAR; }
    }
    PG8_WAIT_V(0);
    if constexpr (!ALIGN_EPI) { if (wr == 0) PG8_BAR; }
    PG8_BAR;
    if constexpr (Epi::AFTER_DRAIN) { E.fused(acc, cur, wr, wc, fr, fq, lds, wid, lane); S.done(cur); }
#undef PG8_SA
#undef PG8_SB
#undef PG8_STAGE
#undef PG8_LDA
#undef PG8_LDB
#undef PG8_MMA
#undef PG8_WAIT_V
#undef PG8_WAIT_L
#undef PG8_BAR
#undef PG8_SCHED
}
}
#ifndef PG8_SP2
#define PG8_SP2 true
#endif
#ifndef PG8_ALIGN
#define PG8_ALIGN true
#endif
constexpr int NWAVES = 8;
constexpr int BATCH = 8, SEQ = 8192, D = 1024, NTOK = BATCH * SEQ;
constexpr int QKV_N = 2304, FF = 3584, NEXP = 8, REC_N = 4096;
constexpr float EPS = 1e-6f;
constexpr int NPH = 22;
#ifndef MK_N_LAUNCHES
#define MK_N_LAUNCHES 1
#endif
constexpr int N_LAUNCHES = MK_N_LAUNCHES;
constexpr size_t MiB = 1u << 20;
constexpr size_t WS_CTL = 0, CTL_ZERO_BYTES = 1 * MiB;
constexpr size_t WS_WMOE_GU = 1 * MiB;
constexpr size_t WS_WMOE_DN = 113 * MiB;
constexpr size_t WS_H = 169 * MiB;
constexpr size_t WS_W_INATT = 297 * MiB;
constexpr size_t WS_W_OUTATT = WS_W_INATT + (size_t)QKV_N * D * 2;
constexpr size_t WS_W_GU = WS_W_OUTATT + (size_t)D * D * 2;
constexpr size_t WS_W_DN = WS_W_GU + (size_t)2 * FF * D * 2;
constexpr size_t WS_W_INREC = WS_W_DN + (size_t)D * FF * 2;
constexpr size_t WS_W_OUTREC = WS_W_INREC + (size_t)REC_N * D * 2;
constexpr size_t WS_BIG = 335 * MiB;
constexpr size_t WS_Y = 297 * MiB;
constexpr size_t WS_HID = 557 * MiB;
constexpr size_t WS_MISC = 1008 * MiB;
constexpr size_t WS_ROPE = WS_MISC;
constexpr size_t WS_META = WS_MISC + 4 * MiB;
constexpr size_t WS_DEST = WS_MISC + 5 * MiB;
constexpr size_t WS_HIST = WS_MISC + 6 * MiB;
constexpr size_t WS_INFO = WS_HIST + 8192;
constexpr size_t WS_LBK = WS_INFO + 256;
constexpr size_t WS_OB = 623 * MiB;
constexpr size_t WS_LSE = 751 * MiB;
constexpr size_t WS_DK = WS_MISC + 8 * MiB;
constexpr size_t WS_HL = 976 * MiB;
constexpr size_t WS_HP = 988 * MiB;
constexpr size_t WS_H2 = 847 * MiB;
constexpr size_t WS_RSP = WS_MISC + 12 * MiB;
constexpr size_t CTL_SSQ1 = 128 * 1024, CTL_SSQ2 = 384 * 1024, CTL_SSQ3 = 640 * 1024;
constexpr size_t WS_END = 1024 * MiB;
static_assert(WS_W_OUTREC + (size_t)D * D * 2 <= WS_BIG && WS_BIG + 640 * MiB <= WS_MISC && WS_Y + 260 * MiB <= WS_HID && WS_HID + 448 * MiB <= WS_MISC && WS_LBK + 4096 <= WS_END, "d_ws map");
constexpr int CW_BAR = 4096;
constexpr int RING_BYTES = 131072;
constexpr int LDSCTL_OFF = RING_BYTES, MISC_OFF = LDSCTL_OFF + 320;
constexpr int LDS_BYTES = 147456;

#define GAS __attribute__((address_space(1)))
#define LAS __attribute__((address_space(3)))
typedef unsigned short bf16;
typedef unsigned v4u __attribute__((ext_vector_type(4)));
typedef unsigned v2u __attribute__((ext_vector_type(2)));
typedef float f32x4 __attribute__((ext_vector_type(4)));
#define LDS_WAIT() asm volatile("s_waitcnt lgkmcnt(0)" ::: "memory")
__device__ __forceinline__ unsigned f2bf(float f) { unsigned u = __builtin_bit_cast(unsigned, f); return (u + 0x7fffu + ((u >> 16) & 1u)) >> 16; }
__device__ __forceinline__ unsigned pk2(float lo, float hi) { return f2bf(lo) | (f2bf(hi) << 16); }
__device__ __forceinline__ float bflo(unsigned w) { return __builtin_bit_cast(float, w << 16); }
__device__ __forceinline__ float bfhi(unsigned w) { return __builtin_bit_cast(float, w & 0xffff0000u); }
__device__ __forceinline__ float wave_sum(float v) {
#pragma unroll
    for (int o = 1; o < 64; o <<= 1) v += __shfl_xor(v, o);
    return v;
}
#define XB_TMO      128
#define XB_XCNT(j)  (256  + 64 * (j))
#define XB_XSUB(j)  (1280 + 64 * (j))
#define XB_XGEN(j)  (2304 + 64 * (j))
#define XB_TOP      3328
#define XB_TOPGEN   3392
#define XCD_BAR_WORDS 3456
#define XB_SPIN_CAP (1u << 24)

__device__ __forceinline__ unsigned xb_ld(unsigned* p)              { return __hip_atomic_load(p, __ATOMIC_RELAXED, __HIP_MEMORY_SCOPE_AGENT); }
__device__ __forceinline__ unsigned xb_add(unsigned* p, unsigned v) { return __hip_atomic_fetch_add(p, v, __ATOMIC_RELAXED, __HIP_MEMORY_SCOPE_AGENT); }
__device__ __forceinline__ unsigned xb_xcc_id() { return (unsigned)__builtin_amdgcn_s_getreg((3 << 11) | 20) & 0xFu; }
#define XB_SPIN(cond, bar) do { unsigned _sp = 0; while (cond) { __builtin_amdgcn_s_sleep(1); \
    if ((++_sp & 255u) == 0u) { if (xb_ld(&(bar)[XB_TMO])) break; if (_sp > XB_SPIN_CAP) { atomicAdd(&(bar)[XB_TMO], 1u); break; } } } } while (0)

struct XcdBarrier {
    unsigned* bar; unsigned x;
    volatile LAS unsigned* st;
};

__device__ __forceinline__ XcdBarrier xcd_barrier_post(unsigned* bar, volatile LAS unsigned* st) {
    XcdBarrier b; b.bar = bar; b.x = xb_xcc_id(); b.st = st;
    if (threadIdx.x == 0) (void)xb_add(&bar[XB_XCNT(b.x)], 1u);
    return b;
}
__device__ __forceinline__ void xcd_barrier_complete(unsigned* bar, unsigned x, unsigned& nloc, unsigned& nx) {
    const unsigned G = gridDim.x * gridDim.y * gridDim.z;
    unsigned sum, cnt, mine, sp = 0u;
    for (;;) {
        sum = 0u; cnt = 0u; mine = 0u;
#pragma unroll
        for (unsigned j = 0; j < 16; ++j) { const unsigned c = xb_ld(&bar[XB_XCNT(j)]); sum += c; cnt += (c > 0u) ? 1u : 0u; mine = (j == x) ? c : mine; }
        if (sum == G) break;
        __builtin_amdgcn_s_sleep(1);
        if ((++sp & 255u) == 0u) { if (xb_ld(&bar[XB_TMO])) break; if (sp > XB_SPIN_CAP) { atomicAdd(&bar[XB_TMO], 1u); break; } }
    }
    nloc = mine > 0u ? mine : 1u; nx = cnt > 0u ? cnt : 1u;
}

__device__ __forceinline__ void xcd_barrier(const XcdBarrier& b) {
    asm volatile("s_waitcnt vmcnt(0)" ::: "memory");
    __syncthreads();
    if (threadIdx.x == 0) {
        unsigned* bar = b.bar;
        __builtin_amdgcn_s_waitcnt(0);
        unsigned nloc = b.st[0], nx = b.st[1];
        if (nloc == 0u) { xcd_barrier_complete(bar, b.x, nloc, nx); b.st[0] = nloc; b.st[1] = nx; }
        const unsigned old = xb_add(&bar[XB_XSUB(b.x)], 1u);
        const unsigned gen = old / nloc;
        if (old + 1u == (gen + 1u) * nloc) {
            __builtin_amdgcn_fence(__ATOMIC_RELEASE, "agent");
            asm volatile("s_waitcnt vmcnt(0)" ::: "memory");
            const unsigned og = xb_add(&bar[XB_TOP], 1u);
            const unsigned tg = og / nx;
            if (og + 1u == (tg + 1u) * nx) xb_add(&bar[XB_TOPGEN], 1u);
            else XB_SPIN(xb_ld(&bar[XB_TOPGEN]) == tg, bar);
            __builtin_amdgcn_fence(__ATOMIC_ACQUIRE, "agent");
            xb_add(&bar[XB_XGEN(b.x)], 1u);
            asm volatile("s_waitcnt vmcnt(0)" ::: "memory");
        } else {
            XB_SPIN(xb_ld(&bar[XB_XGEN(b.x)]) == gen, bar);
            __builtin_amdgcn_fence(__ATOMIC_ACQUIRE, "agent");
            asm volatile("s_waitcnt vmcnt(0)" ::: "memory");
        }
    }
    __syncthreads();
}
__device__ __forceinline__ void transpose_item(const float* W, int N, bf16* WT, int K, int k0, int n0, int drow0, LAS float* scr, int lane, const float* gk) {
#pragma unroll 8
    for (int i = 0; i < 32; ++i) { const int kk = 2 * i + (lane >> 5); scr[kk * 33 + (lane & 31)] = W[(size_t)(k0 + kk) * N + n0 + (lane & 31)]; }
    LDS_WAIT(); asm volatile("" ::: "memory");
    const int c = lane & 7;
    f32x4 g0 = (f32x4){1.f, 1.f, 1.f, 1.f}, g1 = g0;
    if (gk) { g0 = *(const f32x4*)(gk + k0 + 8 * c); g1 = *(const f32x4*)(gk + k0 + 8 * c + 4); }
#pragma unroll
    for (int j = 0; j < 4; ++j) { const int n = (lane >> 3) + 8 * j; const LAS float* s = scr + (8 * c) * 33 + n;
        v4u o; o.x = pk2(s[0 * 33] * g0.x, s[1 * 33] * g0.y); o.y = pk2(s[2 * 33] * g0.z, s[3 * 33] * g0.w); o.z = pk2(s[4 * 33] * g1.x, s[5 * 33] * g1.y); o.w = pk2(s[6 * 33] * g1.z, s[7 * 33] * g1.w);
        *(v4u*)(WT + (size_t)(drow0 + n) * K + k0 + 8 * c) = o; }
    LDS_WAIT(); asm volatile("" ::: "memory");
}
__device__ __forceinline__ int dest_row(int mode, int n0) {
    if (mode == 0) return n0;
    if (mode == 1) return 256 * (n0 >> 7) + (n0 & 127);
    if (mode == 2) return 256 * (n0 >> 7) + 128 + (n0 & 127);
    const int sec = n0 >> 10, c = n0 & 1023, hd = c >> 7, w = c & 127;
    return ((sec >> 1) ? 2048 : 0) + 256 * hd + ((sec & 1) ? 128 : 0) + w;
}
__device__ __forceinline__ void conv_matrix_item(const float* W, int K, int N, bf16* WT, int mode, int r, LAS float* scr, int lane, const float* gk = nullptr) {
    const int nblk = N / 32, kb = r / nblk, nb = r % nblk;
    transpose_item(W, N, WT, K, 64 * kb, 32 * nb, dest_row(mode, 32 * nb), scr, lane, gk);
}
__device__ __forceinline__ void rms_row_to_bf16(const float* xrow, const float* g, bf16* orow, int lane) {
    const f32x4* xr = (const f32x4*)xrow + lane; const f32x4* gr = (const f32x4*)g + lane;
    f32x4 v[4]; float s = 0.f;
#pragma unroll
    for (int j = 0; j < 4; ++j) { v[j] = xr[64 * j]; s += (v[j].x * v[j].x + v[j].y * v[j].y) + (v[j].z * v[j].z + v[j].w * v[j].w); }
    const float rstd = 1.0f / sqrtf(wave_sum(s) * (1.f / D) + EPS);
    unsigned long long* o8 = (unsigned long long*)orow + lane;
#pragma unroll
    for (int j = 0; j < 4; ++j) { const f32x4 gg = gr[64 * j];
        o8[64 * j] = (unsigned long long)pk2(v[j].x * rstd * gg.x, v[j].y * rstd * gg.y) | ((unsigned long long)pk2(v[j].z * rstd * gg.z, v[j].w * rstd * gg.w) << 32); }
}
__device__ __forceinline__ float inv_freq(int j) {
    return j == 0 ? 1.000000000e+00f : j == 1 ? 1.939227432e-01f : j == 2 ? 3.760603070e-02f : j == 3 ? 7.292664610e-03f : j == 4 ? 1.414213562e-03f : j == 5 ? 2.742481884e-04f : j == 6 ? 5.318295734e-05f : 1.031338525e-05f;
}
struct P0Args { const float *g_ffn0, *g_mix1, *g_ffn1; const float *x, *g0, *w_in_attn, *w_out_attn, *w_in_rec, *w_out_rec, *w_gate, *w_up, *w_down, *w_gate_moe, *w_up_moe, *w_down_moe, *rlb; const int* pos; unsigned char* ws; };
__device__ __forceinline__ void phase_prologue(const P0Args& a, LAS unsigned char* lds, int blk, int G, int tid) {
    const int wave = tid >> 6, lane = tid & 63;
    LAS float* scr = (LAS float*)(lds + wave * 16384);
    const int gw = blk * NWAVES + wave, NGW = G * NWAVES;
    unsigned char* ws = a.ws;
    constexpr int I_INATT = 16 * (QKV_N / 32), I_SQ = 16 * 32, I_GU = 16 * (FF / 32), I_DN = (FF / 64) * 32, I_INREC = 16 * (REC_N / 32);
    constexpr int NITEMS = I_INATT + I_SQ + 2 * I_GU + I_DN + I_INREC + I_SQ + NEXP * (2 * I_GU + I_DN);
    for (int it = gw; it < NITEMS; it += NGW) {
        int r = it;
        if (r < I_INATT) { conv_matrix_item(a.w_in_attn, D, QKV_N, (bf16*)(ws + WS_W_INATT), 0, r, scr, lane); continue; } r -= I_INATT;
        if (r < I_SQ) { conv_matrix_item(a.w_out_attn, D, D, (bf16*)(ws + WS_W_OUTATT), 0, r, scr, lane); continue; } r -= I_SQ;
        if (r < I_GU) { conv_matrix_item(a.w_gate, D, FF, (bf16*)(ws + WS_W_GU), 1, r, scr, lane, a.g_ffn0); continue; } r -= I_GU;
        if (r < I_GU) { conv_matrix_item(a.w_up, D, FF, (bf16*)(ws + WS_W_GU), 2, r, scr, lane, a.g_ffn0); continue; } r -= I_GU;
        if (r < I_DN) { conv_matrix_item(a.w_down, FF, D, (bf16*)(ws + WS_W_DN), 0, r, scr, lane); continue; } r -= I_DN;
        if (r < I_INREC) { conv_matrix_item(a.w_in_rec, D, REC_N, (bf16*)(ws + WS_W_INREC), 3, r, scr, lane, a.g_mix1); continue; } r -= I_INREC;
        if (r < I_SQ) { conv_matrix_item(a.w_out_rec, D, D, (bf16*)(ws + WS_W_OUTREC), 0, r, scr, lane); continue; } r -= I_SQ;
        if (r < NEXP * I_GU) { const int e = r / I_GU, q = r % I_GU; conv_matrix_item(a.w_gate_moe + (size_t)e * D * FF, D, FF, (bf16*)(ws + WS_WMOE_GU) + (size_t)e * 2 * FF * D, 1, q, scr, lane, a.g_ffn1); continue; } r -= NEXP * I_GU;
        if (r < NEXP * I_GU) { const int e = r / I_GU, q = r % I_GU; conv_matrix_item(a.w_up_moe + (size_t)e * D * FF, D, FF, (bf16*)(ws + WS_WMOE_GU) + (size_t)e * 2 * FF * D, 2, q, scr, lane, a.g_ffn1); continue; } r -= NEXP * I_GU;
        { const int e = r / I_DN, q = r % I_DN; conv_matrix_item(a.w_down_moe + (size_t)e * FF * D, FF, D, (bf16*)(ws + WS_WMOE_DN) + (size_t)e * D * FF, 0, q, scr, lane); }
    }
    for (int m = gw; m < NTOK; m += NGW) rms_row_to_bf16(a.x + (size_t)m * D, a.g0, (bf16*)(ws + WS_H) + (size_t)m * D, lane);
    float* rope = (float*)(ws + WS_ROPE);
    for (int i = blk * 512 + tid; i < NTOK * 8; i += G * 512) { const int tok = i >> 3, j = i & 7;
        const float ang = (float)a.pos[tok] * inv_freq(j);
        const double turns = (double)ang * 0.15915494309189533577; const float fr = (float)(turns - __builtin_rint(turns));
        rope[tok * 16 + j] = __builtin_amdgcn_cosf(fr); rope[tok * 16 + 8 + j] = __builtin_amdgcn_sinf(fr); }
    float* lbk = (float*)(ws + WS_LBK);
    for (int i = blk * 512 + tid; i < 1024; i += G * 512) lbk[i] = 1.0f / (1.0f + __expf(a.rlb[1024 + i] - a.rlb[i]));
}
__device__ __forceinline__ void phase_rope(bf16* qkv, const float* rope, int blk, int G, int tid) {
    for (int i = blk * 512 + tid; i < NTOK * 26; i += G * 512) {
        const int tok = i / 26, hx = i % 26;
        const int col = hx < 8 ? hx * 64 : hx < 16 ? 512 + (hx - 8) * 64 : hx < 24 ? 1536 + (hx - 16) * 64 : 2048 + (hx - 24) * 64;
        v4u* p = (v4u*)(qkv + (size_t)tok * QKV_N + col);
        const v4u a = p[0], b = p[1];
        const f32x4* t = (const f32x4*)(rope + (size_t)tok * 16);
        const f32x4 c0 = t[0], c1 = t[1], s0 = t[2], s1 = t[3];
        const float x1[8] = {bflo(a.x), bfhi(a.x), bflo(a.y), bfhi(a.y), bflo(a.z), bfhi(a.z), bflo(a.w), bfhi(a.w)};
        const float x2[8] = {bflo(b.x), bfhi(b.x), bflo(b.y), bfhi(b.y), bflo(b.z), bfhi(b.z), bflo(b.w), bfhi(b.w)};
        const float cs[8] = {c0.x, c0.y, c0.z, c0.w, c1.x, c1.y, c1.z, c1.w}, sn[8] = {s0.x, s0.y, s0.z, s0.w, s1.x, s1.y, s1.z, s1.w};
        float y1[8], y2[8];
#pragma unroll
        for (int j = 0; j < 8; ++j) { y1[j] = x1[j] * cs[j] - x2[j] * sn[j]; y2[j] = x2[j] * cs[j] + x1[j] * sn[j]; }
        v4u oa, ob; oa.x = pk2(y1[0], y1[1]); oa.y = pk2(y1[2], y1[3]); oa.z = pk2(y1[4], y1[5]); oa.w = pk2(y1[6], y1[7]);
        ob.x = pk2(y2[0], y2[1]); ob.y = pk2(y2[2], y2[3]); ob.z = pk2(y2[4], y2[5]); ob.w = pk2(y2[6], y2[7]);
        p[0] = oa; p[1] = ob;
    }
}
__device__ __forceinline__ void attn_key(const bf16* krow, const bf16* vrow, const float (&q)[64], float (&o)[64], float& m, float& l) {
    float s = 0.f;
#pragma unroll
    for (int c = 0; c < 8; ++c) { const v4u kv = *(const v4u*)(krow + 8 * c);
        s += q[8 * c + 0] * bflo(kv.x) + q[8 * c + 1] * bfhi(kv.x) + q[8 * c + 2] * bflo(kv.y) + q[8 * c + 3] * bfhi(kv.y)
           + q[8 * c + 4] * bflo(kv.z) + q[8 * c + 5] * bfhi(kv.z) + q[8 * c + 6] * bflo(kv.w) + q[8 * c + 7] * bfhi(kv.w); }
    s *= 0.125f;
    const float mn = fmaxf(m, s), sc = __expf(m - mn), p = __expf(s - mn);
    l = l * sc + p; m = mn;
#pragma unroll
    for (int c = 0; c < 8; ++c) { const v4u vv = *(const v4u*)(vrow + 8 * c);
        o[8 * c + 0] = o[8 * c + 0] * sc + p * bflo(vv.x); o[8 * c + 1] = o[8 * c + 1] * sc + p * bfhi(vv.x);
        o[8 * c + 2] = o[8 * c + 2] * sc + p * bflo(vv.y); o[8 * c + 3] = o[8 * c + 3] * sc + p * bfhi(vv.y);
        o[8 * c + 4] = o[8 * c + 4] * sc + p * bflo(vv.z); o[8 * c + 5] = o[8 * c + 5] * sc + p * bfhi(vv.z);
        o[8 * c + 6] = o[8 * c + 6] * sc + p * bflo(vv.w); o[8 * c + 7] = o[8 * c + 7] * sc + p * bfhi(vv.w); }
}
__device__ __forceinline__ void phase_attn_naive(const bf16* qkv, const float* sinks, bf16* mix, int blk, int G, int tid) {
    for (int idx = blk * 512 + tid; idx < NTOK * 16; idx += G * 512) {
        const int hx = idx >> 16, tok = idx & 65535, b = tok >> 13, s = tok & 8191;
        const bool isB = hx >= 8; const int qh = hx - 8;
        const int qcol = isB ? 1536 + qh * 64 : hx * 64, kcol = isB ? 2048 + (qh >> 2) * 64 : 512 + hx * 64, vcol = isB ? 2176 + (qh >> 2) * 64 : 1024 + hx * 64, ocol = isB ? 512 + qh * 64 : hx * 64;
        float q[64], o[64]; float m = -INFINITY, l = 0.f;
        { const bf16* qp = qkv + (size_t)tok * QKV_N + qcol;
#pragma unroll
          for (int c = 0; c < 8; ++c) { const v4u w = *(const v4u*)(qp + 8 * c); q[8 * c] = bflo(w.x); q[8 * c + 1] = bfhi(w.x); q[8 * c + 2] = bflo(w.y); q[8 * c + 3] = bfhi(w.y); q[8 * c + 4] = bflo(w.z); q[8 * c + 5] = bfhi(w.z); q[8 * c + 6] = bflo(w.w); q[8 * c + 7] = bfhi(w.w); } }
#pragma unroll
        for (int i = 0; i < 64; ++i) o[i] = 0.f;
        const bf16* rb = qkv + (size_t)(b * SEQ) * QKV_N;
        if (!isB) {
            for (int jj = 0; jj < 387; ++jj) { const int d = jj < 129 ? 1 : jj < 258 ? 4 : 16, j = jj < 129 ? jj : jj < 258 ? jj - 129 : jj - 258;
                const int kt = s - d * j; if (kt < 0) continue;
                const bf16* r = rb + (size_t)kt * QKV_N; attn_key(r + kcol, r + vcol, q, o, m, l); }
        } else {
            for (int j = 0; j < 128; ++j) { const int kt = s - j; if (kt < 0) break;
                const bf16* r = rb + (size_t)kt * QKV_N; attn_key(r + kcol, r + vcol, q, o, m, l); }
            const float sk = sinks[qh]; const float mn = fmaxf(m, sk), sc = __expf(m - mn);
            l = l * sc + __expf(sk - mn); m = mn;
#pragma unroll
            for (int i = 0; i < 64; ++i) o[i] *= sc;
        }
        const float rl = 1.0f / l;
        v4u* op = (v4u*)(mix + (size_t)tok * D + ocol);
#pragma unroll
        for (int c = 0; c < 8; ++c) { v4u w; w.x = pk2(o[8 * c] * rl, o[8 * c + 1] * rl); w.y = pk2(o[8 * c + 2] * rl, o[8 * c + 3] * rl); w.z = pk2(o[8 * c + 4] * rl, o[8 * c + 5] * rl); w.w = pk2(o[8 * c + 6] * rl, o[8 * c + 7] * rl); op[c] = w; }
    }
}
__device__ __forceinline__ void phase_norm(const float* x, const float* g, bf16* out, int blk, int G, int tid) {
    const int wave = tid >> 6, lane = tid & 63;
    for (int m = blk * NWAVES + wave; m < NTOK; m += G * NWAVES) rms_row_to_bf16(x + (size_t)m * D, g, out + (size_t)m * D, lane);
}
typedef float f32x16 __attribute__((ext_vector_type(16)));
typedef short bf16x8v __attribute__((ext_vector_type(8)));
typedef short s16x4 __attribute__((ext_vector_type(4)));
typedef short v4i16_t __attribute__((ext_vector_type(4)));
__device__ __forceinline__ int crow(int r, int hi) { return (r & 3) + 8 * (r >> 2) + 4 * hi; }
__device__ __forceinline__ s16x4 vtr(const LAS unsigned char* p) { return __builtin_bit_cast(s16x4, __builtin_amdgcn_ds_read_tr16_b64_v4i16((LAS v4i16_t*)p)); }
struct AttnSub { int b, dstride, r, P0, qcol, kcol, vcol, mode, hx; };
__device__ __forceinline__ void attn_subunit(const AttnSub su, const bf16* qkv, const float* sinks, bf16* mix, bf16* OB, float* LSE, LAS unsigned char* lh, int t256, int hw, int lane) {
    const int r32 = lane & 31, hi = lane >> 5;
    const size_t rowb = (size_t)su.b * SEQ;
    {
        const int c = t256 & 7, k0 = t256 >> 3;
        v4u kreg[8], vreg[8];
#pragma unroll
        for (int i = 0; i < 8; ++i) { const int key = k0 + 32 * i, pos = su.P0 - 128 + key;
            if (pos >= 0) { const bf16* rp = qkv + (rowb + su.r + (size_t)su.dstride * pos) * QKV_N; kreg[i] = *(const v4u*)(rp + su.kcol + 8 * c); vreg[i] = *(const v4u*)(rp + su.vcol + 8 * c); }
            else { kreg[i] = (v4u){0u, 0u, 0u, 0u}; vreg[i] = kreg[i]; } }
#pragma unroll
        for (int i = 0; i < 8; ++i) { const int key = k0 + 32 * i;
            *(LAS v4u*)(lh + key * 128 + ((c ^ (key & 7)) * 16)) = kreg[i];
            *(LAS v4u*)(lh + 32768 + (c >> 2) * 16384 + key * 64 + (c & 3) * 16) = vreg[i]; }
    }
    const int qpos = su.P0 + 32 * hw + r32;
    const size_t qrow = rowb + su.r + (size_t)su.dstride * qpos;
    bf16x8v qf[4];
#pragma unroll
    for (int ks = 0; ks < 4; ++ks) qf[ks] = *(const bf16x8v*)(qkv + qrow * QKV_N + su.qcol + 16 * ks + 8 * hi);
    __syncthreads();
    f32x16 oT[2]; oT[0] = (f32x16){}; oT[1] = (f32x16){};
    float m = -1e30f, l = 0.f;
    const float C = 0.125f * 1.4426950408889634f;
    const int mlo = (su.mode == 3) ? 1 : 0;
    int kt = hw; if (su.P0 == 0 && kt < 4) kt = 4;
    for (; kt <= hw + 4; ++kt) {
        f32x16 s = (f32x16){};
        const LAS unsigned char* kb = lh + (32 * kt + r32) * 128; const int sw = r32 & 7;
#pragma unroll
        for (int ks = 0; ks < 4; ++ks) { const bf16x8v kf = *(const LAS bf16x8v*)(kb + (((2 * ks + hi) ^ sw) * 16)); s = __builtin_amdgcn_mfma_f32_32x32x16_bf16(kf, qf[ks], s, 0, 0, 0); }
        if (kt == hw) {
#pragma unroll
            for (int r = 0; r < 16; ++r) if (crow(r, hi) < r32 + mlo) s[r] = -INFINITY; }
        if (kt == hw + 4) {
#pragma unroll
            for (int r = 0; r < 16; ++r) if (crow(r, hi) > r32) s[r] = -INFINITY; }
        float mx = s[0];
#pragma unroll
        for (int r = 1; r < 16; ++r) mx = fmaxf(mx, s[r]);
        mx = fmaxf(mx, __shfl_xor(mx, 32));
        const float mn = fmaxf(m, mx), alpha = __builtin_amdgcn_exp2f((m - mn) * C);
        float ls = 0.f; f32x16 p;
#pragma unroll
        for (int r = 0; r < 16; ++r) { p[r] = __builtin_amdgcn_exp2f((s[r] - mn) * C); ls += p[r]; }
        l = l * alpha + ls; m = mn;
#pragma unroll
        for (int r = 0; r < 16; ++r) { oT[0][r] *= alpha; oT[1][r] *= alpha; }
        v4u pw0, pw1;
        pw0.x = pk2(p[0], p[1]); pw0.y = pk2(p[2], p[3]); pw0.z = pk2(p[4], p[5]); pw0.w = pk2(p[6], p[7]);
        pw1.x = pk2(p[8], p[9]); pw1.y = pk2(p[10], p[11]); pw1.z = pk2(p[12], p[13]); pw1.w = pk2(p[14], p[15]);
        const bf16x8v pa0 = __builtin_bit_cast(bf16x8v, pw0), pa1 = __builtin_bit_cast(bf16x8v, pw1);
        const LAS unsigned char* vb = lh + 32768 + (32 * kt + 4 * hi + ((lane & 15) >> 2)) * 64 + ((lane >> 4) & 1) * 32 + (lane & 3) * 8;
#pragma unroll
        for (int dt = 0; dt < 2; ++dt) {
            const s16x4 a0 = vtr(vb + dt * 16384), a1 = vtr(vb + dt * 16384 + 512), b0 = vtr(vb + dt * 16384 + 1024), b1 = vtr(vb + dt * 16384 + 1536);
            const bf16x8v vf0 = (bf16x8v){a0[0], a0[1], a0[2], a0[3], a1[0], a1[1], a1[2], a1[3]}, vf1 = (bf16x8v){b0[0], b0[1], b0[2], b0[3], b1[0], b1[1], b1[2], b1[3]};
            oT[dt] = __builtin_amdgcn_mfma_f32_32x32x16_bf16(vf0, pa0, oT[dt], 0, 0, 0);
            oT[dt] = __builtin_amdgcn_mfma_f32_32x32x16_bf16(vf1, pa1, oT[dt], 0, 0, 0);
        }
    }
    float lt = l + __shfl_xor(l, 32);
    if (su.mode == 3) { const float sraw = 8.0f * sinks[su.hx]; const float mn = fmaxf(m, sraw), alpha = __builtin_amdgcn_exp2f((m - mn) * C);
        lt = lt * alpha + __builtin_amdgcn_exp2f((sraw - mn) * C); m = mn;
#pragma unroll
        for (int r = 0; r < 16; ++r) { oT[0][r] *= alpha; oT[1][r] *= alpha; } }
    const float inv = 1.0f / lt;
    if (su.mode < 2) {
        bf16* ob = OB + (size_t)su.mode * NTOK * 512 + qrow * 512 + su.hx * 64;
#pragma unroll
        for (int dt = 0; dt < 2; ++dt)
#pragma unroll
            for (int g = 0; g < 4; ++g) { v2u w; w.x = pk2(oT[dt][4 * g] * inv, oT[dt][4 * g + 1] * inv); w.y = pk2(oT[dt][4 * g + 2] * inv, oT[dt][4 * g + 3] * inv); *(v2u*)(ob + 32 * dt + 8 * g + 4 * hi) = w; }
        if (hi == 0) LSE[(size_t)su.mode * NTOK * 8 + qrow * 8 + su.hx] = 0.125f * m + __logf(lt);
    } else if (su.mode == 2) {
        const float l3 = 0.125f * m + __logf(lt), l1 = LSE[qrow * 8 + su.hx], l2 = LSE[(size_t)NTOK * 8 + qrow * 8 + su.hx];
        const float M = fmaxf(l3, fmaxf(l1, l2)); float w1 = __expf(l1 - M), w2 = __expf(l2 - M), w3 = __expf(l3 - M);
        const float ws = 1.0f / (w1 + w2 + w3); w1 *= ws; w2 *= ws; w3 *= ws * inv;
        const bf16* o1 = OB + qrow * 512 + su.hx * 64; const bf16* o2 = o1 + (size_t)NTOK * 512;
        bf16* mp = mix + qrow * D + su.hx * 64;
#pragma unroll
        for (int dt = 0; dt < 2; ++dt)
#pragma unroll
            for (int g = 0; g < 4; ++g) { const int dd = 32 * dt + 8 * g + 4 * hi; const v2u a = *(const v2u*)(o1 + dd), b = *(const v2u*)(o2 + dd);
                v2u w; w.x = pk2(w1 * bflo(a.x) + w2 * bflo(b.x) + w3 * oT[dt][4 * g], w1 * bfhi(a.x) + w2 * bfhi(b.x) + w3 * oT[dt][4 * g + 1]);
                w.y = pk2(w1 * bflo(a.y) + w2 * bflo(b.y) + w3 * oT[dt][4 * g + 2], w1 * bfhi(a.y) + w2 * bfhi(b.y) + w3 * oT[dt][4 * g + 3]); *(v2u*)(mp + dd) = w; }
    } else {
        bf16* mp = mix + qrow * D + 512 + su.hx * 64;
#pragma unroll
        for (int dt = 0; dt < 2; ++dt)
#pragma unroll
            for (int g = 0; g < 4; ++g) { v2u w; w.x = pk2(oT[dt][4 * g] * inv, oT[dt][4 * g + 1] * inv); w.y = pk2(oT[dt][4 * g + 2] * inv, oT[dt][4 * g + 3] * inv); *(v2u*)(mp + 32 * dt + 8 * g + 4 * hi) = w; }
    }
    asm volatile("s_waitcnt vmcnt(0)" ::: "memory");
    __syncthreads();
}
__device__ __forceinline__ void phase_attn(const bf16* qkv, const float* sinks, bf16* mix, bf16* OB, float* LSE, LAS unsigned char* lds, int blk, int G, int tid) {
    const int wave = tid >> 6, lane = tid & 63, hf = wave >> 2, hw = wave & 3, t256 = tid & 255;
    LAS unsigned char* lh = lds + hf * 65536;
    for (int ai = blk; ai < 256; ai += G) {
        const int b = ai >> 5, h = (ai >> 2) & 7, T0 = (ai & 3) * 2048;
        for (int pp = 0; pp < 24; ++pp) {
            const int su = 2 * pp + hf, br = su >> 4, k = su & 15;
            AttnSub s; s.b = b; s.hx = h; s.qcol = h * 64; s.kcol = 512 + h * 64; s.vcol = 1024 + h * 64; s.mode = br;
            if (br == 0) { s.dstride = 1; s.r = 0; s.P0 = T0 + 128 * k; }
            else if (br == 1) { s.dstride = 4; s.r = k >> 2; s.P0 = (T0 >> 2) + 128 * (k & 3); }
            else { s.dstride = 16; s.r = k; s.P0 = T0 >> 4; }
            attn_subunit(s, qkv, sinks, mix, OB, LSE, lh, t256, hw, lane);
        }
    }
    for (int bp = blk; bp < 2048; bp += G) {
        const int b = bp >> 8, nb = (bp >> 2) & 63, kv = (bp >> 1) & 1, qh = kv * 4 + 2 * (bp & 1) + hf;
        AttnSub s; s.b = b; s.hx = qh; s.qcol = 1536 + qh * 64; s.kcol = 2048 + kv * 64; s.vcol = 2176 + kv * 64; s.mode = 3; s.dstride = 1; s.r = 0; s.P0 = 128 * nb;
        attn_subunit(s, qkv, sinks, mix, OB, LSE, lh, t256, hw, lane);
    }
}
__device__ __forceinline__ void phase_hgrn_naive(const bf16* Qp, const bf16* Kp, const bf16* Vp, bf16* Oraw, LAS unsigned char* lds, int blk, int G, int tid) {
    LAS float* sq = (LAS float*)lds; LAS float* sk = sq + 2048; LAS float* sf = sk + 2048; LAS float* sv = sf + 2048; LAS float* part = sv + 2048;
    const int v = tid & 127, kq = tid >> 7;
    const int lr = tid >> 5, lc = (tid & 31) * 4;
    for (int bh = blk; bh < BATCH * 8; bh += G) {
        const int b = bh >> 3, h = bh & 7;
        float S[32];
#pragma unroll
        for (int i = 0; i < 32; ++i) S[i] = 0.f;
        for (int t0 = 0; t0 < SEQ; t0 += 16) {
            const size_t base = (size_t)(b * SEQ + t0 + lr) * D + h * 128 + lc;
            { const v2u w = *(const v2u*)(Qp + base); *(LAS f32x4*)(sq + lr * 128 + lc) = (f32x4){bflo(w.x), bfhi(w.x), bflo(w.y), bfhi(w.y)}; }
            { const v2u w = *(const v2u*)(Kp + base); const f32x4 kk = (f32x4){bflo(w.x), bfhi(w.x), bflo(w.y), bfhi(w.y)}; *(LAS f32x4*)(sk + lr * 128 + lc) = kk; *(LAS f32x4*)(sf + lr * 128 + lc) = (f32x4){1.f - kk.x, 1.f - kk.y, 1.f - kk.z, 1.f - kk.w}; }
            { const v2u w = *(const v2u*)(Vp + base); *(LAS f32x4*)(sv + lr * 128 + lc) = (f32x4){bflo(w.x), bfhi(w.x), bflo(w.y), bfhi(w.y)}; }
            __syncthreads();
            for (int t = 0; t < 16; ++t) {
                const float vt = sv[t * 128 + v]; float po = 0.f;
#pragma unroll
                for (int i4 = 0; i4 < 8; ++i4) { const int kx = t * 128 + kq * 32 + i4 * 4;
                    const f32x4 q4 = *(const LAS f32x4*)(sq + kx), k4 = *(const LAS f32x4*)(sk + kx), f4 = *(const LAS f32x4*)(sf + kx);
#pragma unroll
                    for (int j = 0; j < 4; ++j) { S[i4 * 4 + j] = f4[j] * S[i4 * 4 + j] + k4[j] * vt; po += q4[j] * S[i4 * 4 + j]; } }
                part[(t * 4 + kq) * 128 + v] = po;
            }
            __syncthreads();
            { const f32x4 p0 = *(const LAS f32x4*)(part + (lr * 4 + 0) * 128 + lc), p1 = *(const LAS f32x4*)(part + (lr * 4 + 1) * 128 + lc), p2 = *(const LAS f32x4*)(part + (lr * 4 + 2) * 128 + lc), p3 = *(const LAS f32x4*)(part + (lr * 4 + 3) * 128 + lc);
              const f32x4 r = (p0 + p1) + (p2 + p3); v2u w; w.x = pk2(r.x, r.y); w.y = pk2(r.z, r.w); *(v2u*)(Oraw + base) = w; }
        }
        __syncthreads();
    }
}
__device__ __forceinline__ void phase_gate(bf16* O, const bf16* Gp, const float* norm_g, int blk, int G, int tid) {
    const int wave = tid >> 6, lane = tid & 63;
    for (int m = blk * NWAVES + wave; m < NTOK; m += G * NWAVES) {
        v4u* op = (v4u*)(O + (size_t)m * D + lane * 16); const v4u* gp = (const v4u*)(Gp + (size_t)m * D + lane * 16);
        const v4u a = op[0], b = op[1], ga = gp[0], gb = gp[1];
        float x[16] = {bflo(a.x), bfhi(a.x), bflo(a.y), bfhi(a.y), bflo(a.z), bfhi(a.z), bflo(a.w), bfhi(a.w), bflo(b.x), bfhi(b.x), bflo(b.y), bfhi(b.y), bflo(b.z), bfhi(b.z), bflo(b.w), bfhi(b.w)};
        const float gg[16] = {bflo(ga.x), bfhi(ga.x), bflo(ga.y), bfhi(ga.y), bflo(ga.z), bfhi(ga.z), bflo(ga.w), bfhi(ga.w), bflo(gb.x), bfhi(gb.x), bflo(gb.y), bfhi(gb.y), bflo(gb.z), bfhi(gb.z), bflo(gb.w), bfhi(gb.w)};
        float ss = 0.f;
#pragma unroll
        for (int i = 0; i < 16; ++i) ss += x[i] * x[i];
        ss += __shfl_xor(ss, 1); ss += __shfl_xor(ss, 2); ss += __shfl_xor(ss, 4);
        const float rstd = 1.0f / sqrtf(ss * (1.f / 128.f) + EPS);
        const f32x4* ng = (const f32x4*)(norm_g + lane * 16);
        float y[16];
#pragma unroll
        for (int i4 = 0; i4 < 4; ++i4) { const f32x4 n4 = ng[i4];
#pragma unroll
            for (int j = 0; j < 4; ++j) y[i4 * 4 + j] = x[i4 * 4 + j] * rstd * n4[j] * gg[i4 * 4 + j]; }
        v4u oa, ob; oa.x = pk2(y[0], y[1]); oa.y = pk2(y[2], y[3]); oa.z = pk2(y[4], y[5]); oa.w = pk2(y[6], y[7]);
        ob.x = pk2(y[8], y[9]); ob.y = pk2(y[10], y[11]); ob.z = pk2(y[12], y[13]); ob.w = pk2(y[14], y[15]);
        op[0] = oa; op[1] = ob;
    }
}
__device__ __forceinline__ void phase_router(const float* x, const float* g, const float* w_router, const unsigned* ssq, int4* meta, int* hist, LAS unsigned char* lds, int blk, int G, int tid) {
    const int wave = tid >> 6, lane = tid & 63;
    LAS float* swr = (LAS float*)lds;
    LAS int* scnt = (LAS int*)(lds + 32768);
    for (int i = tid; i < 8192; i += 512) swr[i] = w_router[i] * g[i >> 3];
    __syncthreads();
    for (int tb = blk; tb < 256; tb += G) {
        if (tid < 8) scnt[tid] = 0;
        __syncthreads();
        int c0 = 0, c1 = 0, c2 = 0, c3 = 0, c4 = 0, c5 = 0, c6 = 0, c7 = 0;
        for (int i = 0; i < 32; i += 2) {
            float lg[2][8];
#pragma unroll
            for (int t2 = 0; t2 < 2; ++t2) { const int tok = tb * 256 + wave * 32 + i + t2;
                const f32x4* xr = (const f32x4*)(x + (size_t)tok * D) + lane;
                f32x4 v[4];
#pragma unroll
                for (int j = 0; j < 4; ++j) v[j] = xr[64 * j];
#pragma unroll
                for (int e = 0; e < 8; ++e) lg[t2][e] = 0.f;
#pragma unroll
                for (int j = 0; j < 4; ++j)
#pragma unroll
                    for (int c = 0; c < 4; ++c) { const float hv = v[j][c]; const int d = 256 * j + 4 * lane + c;
                        const f32x4 w0 = *(const LAS f32x4*)(swr + d * 8), w1 = *(const LAS f32x4*)(swr + d * 8 + 4);
                        lg[t2][0] += hv * w0.x; lg[t2][1] += hv * w0.y; lg[t2][2] += hv * w0.z; lg[t2][3] += hv * w0.w; lg[t2][4] += hv * w1.x; lg[t2][5] += hv * w1.y; lg[t2][6] += hv * w1.z; lg[t2][7] += hv * w1.w; } }
#pragma unroll
            for (int t2 = 0; t2 < 2; ++t2) { const int tok = tb * 256 + wave * 32 + i + t2;
                const float rstd = 1.0f / sqrtf((float)ssq[tok] * (1.f / (1024.f * 65536.f)) + EPS);
#pragma unroll
                for (int e = 0; e < 8; ++e) lg[t2][e] = wave_sum(lg[t2][e]) * rstd;
                int e0 = 0; float v0 = lg[t2][0];
#pragma unroll
                for (int e = 1; e < 8; ++e) if (lg[t2][e] > v0) { v0 = lg[t2][e]; e0 = e; }
                int e1 = -1; float v1 = -INFINITY;
#pragma unroll
                for (int e = 0; e < 8; ++e) if (e != e0 && lg[t2][e] > v1) { v1 = lg[t2][e]; e1 = e; }
                const float g1 = 1.0f / (1.0f + __expf(v0 - v1)), g0 = 1.0f - g1;
                if (lane == 0) meta[tok] = make_int4(e0, e1, __builtin_bit_cast(int, g0), __builtin_bit_cast(int, g1));
                c0 += (e0 == 0) + (e1 == 0); c1 += (e0 == 1) + (e1 == 1); c2 += (e0 == 2) + (e1 == 2); c3 += (e0 == 3) + (e1 == 3);
                c4 += (e0 == 4) + (e1 == 4); c5 += (e0 == 5) + (e1 == 5); c6 += (e0 == 6) + (e1 == 6); c7 += (e0 == 7) + (e1 == 7); }
        }
        if (lane == 0) { const int cc[8] = {c0, c1, c2, c3, c4, c5, c6, c7};
#pragma unroll
            for (int e = 0; e < 8; ++e) __hip_atomic_fetch_add(&scnt[e], cc[e], __ATOMIC_RELAXED, __HIP_MEMORY_SCOPE_WORKGROUP); }
        __syncthreads();
        if (tid < 8) hist[tb * 8 + tid] = scnt[tid];
        __syncthreads();
    }
}
__device__ __forceinline__ void phase_scatter(const bf16* hb, const unsigned* ssq, const int4* meta, const int* hist, int* dest, int* info, bf16* perm, float* rsp, LAS unsigned char* lds, int blk, int G, int tid) {
    const int wave = tid >> 6, lane = tid & 63;
    LAS int* shist = (LAS int*)lds;
    LAS int* ssize = shist + 2048; LAS int* sbpre = ssize + 8; LAS int* spst = sbpre + 8; LAS int* sntl = spst + 8;
    LAS int* se = sntl + 8; LAS int* sdest = se + 512;
    for (int tb = blk; tb < 256; tb += G) {
        for (int i = tid; i < 2048; i += 512) shist[i] = hist[i];
        __syncthreads();
        if (tid < 8) { int sz = 0, bp = 0; for (int b = 0; b < 256; ++b) { const int hv = shist[b * 8 + tid]; sz += hv; bp += (b < tb) ? hv : 0; } ssize[tid] = sz; sbpre[tid] = bp; }
        __syncthreads();
        if (tid == 0) { int ts = 0; for (int e = 0; e < 8; ++e) { const int nt = (ssize[e] + 255) >> 8; spst[e] = ts * 256; sntl[e] = nt; ts += nt; if (tb == 0) info[e] = ts; } if (tb == 0) info[8] = ts; }
        { const int4 mt = meta[tb * 256 + (tid >> 1)]; se[tid] = (tid & 1) ? mt.y : mt.x; }
        __syncthreads();
        { const int e = se[tid]; int rank = 0; for (int p = 0; p < tid; ++p) rank += (se[p] == e) ? 1 : 0;
          const int dd = spst[e] + sbpre[e] + rank; sdest[tid] = dd; dest[(tb * 256) * 2 + tid] = dd;
          rsp[dd] = 1.0f / sqrtf((float)ssq[tb * 256 + (tid >> 1)] * (1.f / (1024.f * 65536.f)) + EPS); }
        __syncthreads();
        for (int i = 0; i < 32; i += 4) {
            v4u ra[4], rb[4];
#pragma unroll
            for (int q = 0; q < 4; ++q) { const v4u* src = (const v4u*)(hb + (size_t)(tb * 256 + wave * 32 + i + q) * D) + lane; ra[q] = src[0]; rb[q] = src[64]; }
#pragma unroll
            for (int q = 0; q < 4; ++q) { const int lt = wave * 32 + i + q;
                v4u* o0 = (v4u*)(perm + (size_t)sdest[2 * lt] * D) + lane; v4u* o1 = (v4u*)(perm + (size_t)sdest[2 * lt + 1] * D) + lane;
                o0[0] = ra[q]; o0[64] = rb[q]; o1[0] = ra[q]; o1[64] = rb[q]; } }
        if (tb < 8) { const int r0 = spst[tb] + ssize[tb], r1 = spst[tb] + sntl[tb] * 256;
            for (int r = r0 + wave; r < r1; r += NWAVES) { v4u* o = (v4u*)(perm + (size_t)r * D) + lane; o[0] = (v4u){0u, 0u, 0u, 0u}; o[64] = (v4u){0u, 0u, 0u, 0u}; if (lane == 0) rsp[r] = 0.f; } }
        __syncthreads();
    }
}
__device__ __forceinline__ void phase_combine(float* x, const bf16* y, const int4* meta, const int* dest, const float* gf, int blk, int G, int tid) {
    const int wave = tid >> 6, lane = tid & 63;
    for (int m = blk * NWAVES + wave; m < NTOK; m += G * NWAVES) {
        const int4 mt = meta[m]; const float g0 = __builtin_bit_cast(float, mt.z), g1 = __builtin_bit_cast(float, mt.w);
        const int d0 = dest[2 * m], d1 = dest[2 * m + 1];
        f32x4* xr = (f32x4*)(x + (size_t)m * D) + lane; const f32x4* gr = (const f32x4*)gf + lane;
        const v2u* y0 = (const v2u*)(y + (size_t)d0 * D) + lane; const v2u* y1 = (const v2u*)(y + (size_t)d1 * D) + lane;
        f32x4 v[4]; float s = 0.f;
#pragma unroll
        for (int j = 0; j < 4; ++j) { const v2u a = y0[64 * j], b = y1[64 * j]; f32x4 t = xr[64 * j];
            t.x += g0 * bflo(a.x) + g1 * bflo(b.x); t.y += g0 * bfhi(a.x) + g1 * bfhi(b.x); t.z += g0 * bflo(a.y) + g1 * bflo(b.y); t.w += g0 * bfhi(a.y) + g1 * bfhi(b.y);
            v[j] = t; s += (t.x * t.x + t.y * t.y) + (t.z * t.z + t.w * t.w); }
        const float rstd = 1.0f / sqrtf(wave_sum(s) * (1.f / D) + EPS);
#pragma unroll
        for (int j = 0; j < 4; ++j) { const f32x4 gg = gr[64 * j]; xr[64 * j] = (f32x4){v[j].x * rstd * gg.x, v[j].y * rstd * gg.y, v[j].z * rstd * gg.z, v[j].w * rstd * gg.w}; }
    }
}
constexpr int HG_NSEG = 4, HG_CPS = 32;
constexpr int HG_QE = 0, HG_KI = 16384, HG_KE = 32768, HG_V = 49152, HG_ST = 65536, HG_DK = 132096, HG_SSQ = 132608, HG_NG = 133632;
__device__ __forceinline__ void phase_hgrn(const bf16* QE, const bf16* KI, const bf16* KE, const bf16* Vp, const bf16* Gp, const float* DK, const float* norm_g, bf16* Og, const float* HL, const float* HP, LAS unsigned char* lds, int blk, int G, int tid) {
    const int wave = tid >> 6, lane = tid & 63, r32 = lane & 31, hi = lane >> 5, tb = wave >> 2, vb = wave & 3;
    const int sw = r32 & 15;
    const int trl = (4 * hi + ((lane & 15) >> 2)) * 64 + ((lane >> 4) & 1) * 32 + (lane & 3) * 8;
    LAS float* dk_l = (LAS float*)(lds + HG_DK); LAS float* ssq = (LAS float*)(lds + HG_SSQ);
    for (int un = blk; un < BATCH * 8 * HG_NSEG; un += G) {
        const int bh = un >> 2, seg = un & 3, b = bh >> 3, h = bh & 7, c0 = seg * HG_CPS;
        f32x16 S0 = (f32x16){}, S1 = (f32x16){};
        {
            const float* L = HL + (size_t)bh * 3 * 16384; const float* Pt = HP + (size_t)bh * 3 * 128;
            LAS float* sl = (LAS float*)lds;
#pragma unroll 2
            for (int i = 0; i < 8; ++i) { const int idx = (tid + 512 * i) * 4, k = idx >> 7; f32x4 a = (f32x4){0.f, 0.f, 0.f, 0.f};
                if (seg > 0) a = *(const f32x4*)(L + idx);
                if (seg > 1) a = a * Pt[128 + k] + *(const f32x4*)(L + 16384 + idx);
                if (seg > 2) a = a * Pt[256 + k] + *(const f32x4*)(L + 32768 + idx);
                *(LAS f32x4*)(sl + idx) = a; }
            __syncthreads();
#pragma unroll
            for (int i = 0; i < 2; ++i) { const int kb = 2 * tb + i; f32x16 S;
#pragma unroll
                for (int r = 0; r < 16; ++r) S[r] = sl[(32 * kb + crow(r, hi)) * 128 + 32 * vb + r32];
#pragma unroll
                for (int g = 0; g < 4; ++g) { v2u w; w.x = pk2(S[4 * g], S[4 * g + 1]); w.y = pk2(S[4 * g + 2], S[4 * g + 3]);
                    *(LAS v2u*)(lds + HG_ST + (32 * vb + r32) * 256 + (((4 * kb + g) ^ sw) * 16) + hi * 8) = w; }
                if (i) S1 = S; else S0 = S; }
            __syncthreads();
        }
        if (tid < 32) *(LAS f32x4*)(lds + HG_NG + tid * 16) = *(const f32x4*)(norm_g + h * 128 + tid * 4);
        v4u rq[2], rk[2], re[2], rv[2]; f32x4 rd = (f32x4){0.f, 0.f, 0.f, 0.f};
#define HG_LOAD(c) do { const size_t row0_ = (size_t)b * SEQ + 64 * (c); \
            _Pragma("unroll") for (int i = 0; i < 2; ++i) { const int idx = tid + 512 * i, row = idx >> 4, cc = idx & 15; const size_t go = (row0_ + row) * 1024 + h * 128 + cc * 8; \
                rq[i] = *(const v4u*)(QE + go); rk[i] = *(const v4u*)(KI + go); re[i] = *(const v4u*)(KE + go); rv[i] = *(const v4u*)(Vp + go); } \
            if (tid < 32) rd = *(const f32x4*)(DK + ((size_t)b * 128 + (c)) * 1024 + h * 128 + tid * 4); } while (0)
#define HG_STORE() do { \
            _Pragma("unroll") for (int i = 0; i < 2; ++i) { const int idx = tid + 512 * i, row = idx >> 4, cc = idx & 15; \
                *(LAS v4u*)(lds + HG_QE + row * 256 + ((cc ^ (row & 15)) * 16)) = rq[i]; *(LAS v4u*)(lds + HG_KI + row * 256 + ((cc ^ (row & 15)) * 16)) = rk[i]; \
                *(LAS v4u*)(lds + HG_KE + (cc >> 2) * 4096 + row * 64 + (cc & 3) * 16) = re[i]; *(LAS v4u*)(lds + HG_V + (cc >> 2) * 4096 + row * 64 + (cc & 3) * 16) = rv[i]; } \
            if (tid < 32) *(LAS f32x4*)(dk_l + tid * 4) = rd; } while (0)
        HG_LOAD(c0); HG_STORE();
        __syncthreads();
        for (int cl = 0; cl < HG_CPS; ++cl) { const int c = c0 + cl;
            if (cl + 1 < HG_CPS) HG_LOAD(c + 1);
            const size_t rowo = ((size_t)b * SEQ + 64 * c + 32 * tb + r32) * 1024 + h * 128 + 32 * vb + 4 * hi;
            v2u ggv[4];
#pragma unroll
            for (int g = 0; g < 4; ++g) ggv[g] = *(const v2u*)(Gp + rowo + 8 * g);
            LAS unsigned char* st_cur = lds + HG_ST + (cl & 1) * 32768; LAS unsigned char* st_nxt = lds + HG_ST + ((cl + 1) & 1) * 32768;
            bf16x8v qf[8];
#pragma unroll
            for (int ks = 0; ks < 8; ++ks) qf[ks] = *(const LAS bf16x8v*)(lds + HG_QE + (32 * tb + r32) * 256 + (((2 * ks + hi) ^ sw) * 16));
            f32x16 oT = (f32x16){};
#pragma unroll
            for (int ks = 0; ks < 8; ++ks) { const bf16x8v sf = *(const LAS bf16x8v*)(st_cur + (32 * vb + r32) * 256 + (((2 * ks + hi) ^ sw) * 16)); oT = __builtin_amdgcn_mfma_f32_32x32x16_bf16(sf, qf[ks], oT, 0, 0, 0); }
            v4u pw[4];
            { f32x16 X0 = (f32x16){};
#pragma unroll
              for (int ks = 0; ks < 8; ++ks) { const bf16x8v kf = *(const LAS bf16x8v*)(lds + HG_KI + r32 * 256 + (((2 * ks + hi) ^ sw) * 16)); X0 = __builtin_amdgcn_mfma_f32_32x32x16_bf16(kf, qf[ks], X0, 0, 0, 0); }
              if (tb == 0) {
#pragma unroll
                  for (int r = 0; r < 16; ++r) if (crow(r, hi) > r32) X0[r] = 0.f; }
              pw[0].x = pk2(X0[0], X0[1]); pw[0].y = pk2(X0[2], X0[3]); pw[0].z = pk2(X0[4], X0[5]); pw[0].w = pk2(X0[6], X0[7]); pw[1].x = pk2(X0[8], X0[9]); pw[1].y = pk2(X0[10], X0[11]); pw[1].z = pk2(X0[12], X0[13]); pw[1].w = pk2(X0[14], X0[15]); }
            if (tb == 1) { f32x16 X1 = (f32x16){};
#pragma unroll
              for (int ks = 0; ks < 8; ++ks) { const bf16x8v kf = *(const LAS bf16x8v*)(lds + HG_KI + (32 + r32) * 256 + (((2 * ks + hi) ^ sw) * 16)); X1 = __builtin_amdgcn_mfma_f32_32x32x16_bf16(kf, qf[ks], X1, 0, 0, 0); }
#pragma unroll
              for (int r = 0; r < 16; ++r) if (crow(r, hi) > r32) X1[r] = 0.f;
              pw[2].x = pk2(X1[0], X1[1]); pw[2].y = pk2(X1[2], X1[3]); pw[2].z = pk2(X1[4], X1[5]); pw[2].w = pk2(X1[6], X1[7]); pw[3].x = pk2(X1[8], X1[9]); pw[3].y = pk2(X1[10], X1[11]); pw[3].z = pk2(X1[12], X1[13]); pw[3].w = pk2(X1[14], X1[15]); }
            asm volatile("" ::: "memory");
            bf16x8v vf[4];
#pragma unroll
            for (int s4 = 0; s4 < 4; ++s4) { const LAS unsigned char* p = lds + HG_V + vb * 4096 + s4 * 1024 + trl; const s16x4 a0 = vtr(p), a1 = vtr(p + 512); vf[s4] = (bf16x8v){a0[0], a0[1], a0[2], a0[3], a1[0], a1[1], a1[2], a1[3]}; }
            oT = __builtin_amdgcn_mfma_f32_32x32x16_bf16(vf[0], __builtin_bit_cast(bf16x8v, pw[0]), oT, 0, 0, 0); oT = __builtin_amdgcn_mfma_f32_32x32x16_bf16(vf[1], __builtin_bit_cast(bf16x8v, pw[1]), oT, 0, 0, 0);
            if (tb == 1) { oT = __builtin_amdgcn_mfma_f32_32x32x16_bf16(vf[2], __builtin_bit_cast(bf16x8v, pw[2]), oT, 0, 0, 0); oT = __builtin_amdgcn_mfma_f32_32x32x16_bf16(vf[3], __builtin_bit_cast(bf16x8v, pw[3]), oT, 0, 0, 0); }
            { float ss = 0.f;
#pragma unroll
              for (int r = 0; r < 16; ++r) ss += oT[r] * oT[r];
              ss += __shfl_xor(ss, 32); if (hi == 0) ssq[(tb * 4 + vb) * 32 + r32] = ss; }
#pragma unroll
            for (int i = 0; i < 2; ++i) { const int kb = 2 * tb + i; f32x16 S = i ? S1 : S0;
#pragma unroll
                for (int g = 0; g < 4; ++g) { const f32x4 d4 = *(const LAS f32x4*)(dk_l + 32 * kb + 8 * g + 4 * hi);
#pragma unroll
                    for (int j = 0; j < 4; ++j) S[4 * g + j] *= d4[j]; }
#pragma unroll
                for (int s4 = 0; s4 < 4; ++s4) { const LAS unsigned char* p = lds + HG_KE + kb * 4096 + s4 * 1024 + trl; const s16x4 a0 = vtr(p), a1 = vtr(p + 512);
                    const bf16x8v kef = (bf16x8v){a0[0], a0[1], a0[2], a0[3], a1[0], a1[1], a1[2], a1[3]};
                    S = __builtin_amdgcn_mfma_f32_32x32x16_bf16(kef, vf[s4], S, 0, 0, 0); }
#pragma unroll
                for (int g = 0; g < 4; ++g) { v2u w; w.x = pk2(S[4 * g], S[4 * g + 1]); w.y = pk2(S[4 * g + 2], S[4 * g + 3]);
                    *(LAS v2u*)(st_nxt + (32 * vb + r32) * 256 + (((4 * kb + g) ^ sw) * 16) + hi * 8) = w; }
                if (i) S1 = S; else S0 = S; }
            __syncthreads();
            { const float tot = (ssq[(tb * 4 + 0) * 32 + r32] + ssq[(tb * 4 + 1) * 32 + r32]) + (ssq[(tb * 4 + 2) * 32 + r32] + ssq[(tb * 4 + 3) * 32 + r32]);
              const float rstd = 1.0f / sqrtf(tot * (1.f / 128.f) + EPS);
#pragma unroll
              for (int g = 0; g < 4; ++g) { const f32x4 ng = *(const LAS f32x4*)(lds + HG_NG + (32 * vb + 8 * g + 4 * hi) * 4); const v2u gg = ggv[g];
                  v2u w; w.x = pk2(oT[4 * g] * rstd * ng.x * bflo(gg.x), oT[4 * g + 1] * rstd * ng.y * bfhi(gg.x)); w.y = pk2(oT[4 * g + 2] * rstd * ng.z * bflo(gg.y), oT[4 * g + 3] * rstd * ng.w * bfhi(gg.y));
                  *(v2u*)(Og + rowo + 8 * g) = w; } }
            if (cl + 1 < HG_CPS) HG_STORE();
            __syncthreads();
        }
#undef HG_LOAD
#undef HG_STORE
    }
}

__device__ __forceinline__ void phase_hgrn_state(const bf16* KE, const bf16* Vp, const float* DK, float* HL, float* HP, LAS unsigned char* lds, int blk, int G, int tid) {
    const int wave = tid >> 6, lane = tid & 63, r32 = lane & 31, hi = lane >> 5, tb = wave >> 2, vb = wave & 3;
    const int trl = (4 * hi + ((lane & 15) >> 2)) * 64 + ((lane >> 4) & 1) * 32 + (lane & 3) * 8;
    LAS float* dk_l = (LAS float*)(lds + HG_DK);
    for (int un = blk; un < BATCH * 8 * 3; un += G) {
        const int bh = un / 3, seg = un % 3, b = bh >> 3, h = bh & 7, c0 = seg * HG_CPS;
        f32x16 S0 = (f32x16){}, S1 = (f32x16){};
        float ptot = 1.0f;
        v4u re[2], rv[2]; f32x4 rd = (f32x4){0.f, 0.f, 0.f, 0.f};
#define HS_LOAD(c) do { const size_t row0_ = (size_t)b * SEQ + 64 * (c); \
            _Pragma("unroll") for (int i = 0; i < 2; ++i) { const int idx = tid + 512 * i, row = idx >> 4, cc = idx & 15; const size_t go = (row0_ + row) * 1024 + h * 128 + cc * 8; \
                re[i] = *(const v4u*)(KE + go); rv[i] = *(const v4u*)(Vp + go); } \
            if (tid < 32) rd = *(const f32x4*)(DK + ((size_t)b * 128 + (c)) * 1024 + h * 128 + tid * 4); } while (0)
#define HS_STORE() do { \
            _Pragma("unroll") for (int i = 0; i < 2; ++i) { const int idx = tid + 512 * i, row = idx >> 4, cc = idx & 15; \
                *(LAS v4u*)(lds + HG_KE + (cc >> 2) * 4096 + row * 64 + (cc & 3) * 16) = re[i]; *(LAS v4u*)(lds + HG_V + (cc >> 2) * 4096 + row * 64 + (cc & 3) * 16) = rv[i]; } \
            if (tid < 32) *(LAS f32x4*)(dk_l + tid * 4) = rd; } while (0)
        HS_LOAD(c0); HS_STORE();
        __syncthreads();
        for (int cl = 0; cl < HG_CPS; ++cl) {
            if (cl + 1 < HG_CPS) HS_LOAD(c0 + cl + 1);
            bf16x8v vf[4];
#pragma unroll
            for (int s4 = 0; s4 < 4; ++s4) { const LAS unsigned char* p = lds + HG_V + vb * 4096 + s4 * 1024 + trl; const s16x4 a0 = vtr(p), a1 = vtr(p + 512); vf[s4] = (bf16x8v){a0[0], a0[1], a0[2], a0[3], a1[0], a1[1], a1[2], a1[3]}; }
#pragma unroll
            for (int i = 0; i < 2; ++i) { const int kb = 2 * tb + i; f32x16 S = i ? S1 : S0;
#pragma unroll
                for (int g = 0; g < 4; ++g) { const f32x4 d4 = *(const LAS f32x4*)(dk_l + 32 * kb + 8 * g + 4 * hi);
#pragma unroll
                    for (int j = 0; j < 4; ++j) S[4 * g + j] *= d4[j]; }
#pragma unroll
                for (int s4 = 0; s4 < 4; ++s4) { const LAS unsigned char* p = lds + HG_KE + kb * 4096 + s4 * 1024 + trl; const s16x4 a0 = vtr(p), a1 = vtr(p + 512);
                    const bf16x8v kef = (bf16x8v){a0[0], a0[1], a0[2], a0[3], a1[0], a1[1], a1[2], a1[3]};
                    S = __builtin_amdgcn_mfma_f32_32x32x16_bf16(kef, vf[s4], S, 0, 0, 0); }
                if (i) S1 = S; else S0 = S; }
            if (tid < 128) ptot *= dk_l[tid];
            __syncthreads();
            if (cl + 1 < HG_CPS) HS_STORE();
            __syncthreads();
        }
        float* L = HL + ((size_t)bh * 3 + seg) * 16384;
#pragma unroll
        for (int i = 0; i < 2; ++i) { const int kb = 2 * tb + i; const f32x16 S = i ? S1 : S0;
#pragma unroll
            for (int r = 0; r < 16; ++r) L[(32 * kb + crow(r, hi)) * 128 + 32 * vb + r32] = S[r]; }
        if (tid < 128) HP[((size_t)bh * 3 + seg) * 128 + tid] = ptot;
#undef HS_LOAD
#undef HS_STORE
    }
}
struct Args { const void* in[19]; float* out; unsigned char* ws; int ph_lo, ph_hi; };
__global__ void __launch_bounds__(NWAVES * 64, 2) fwd(Args args) {
    extern __shared__ __attribute__((aligned(16))) unsigned char lds_raw[];
    LAS unsigned char* lds = (LAS unsigned char*)lds_raw;
    volatile LAS unsigned* MISC = (volatile LAS unsigned*)(lds + MISC_OFF);
    const int tid = threadIdx.x, G = gridDim.x, blk = blockIdx.x;
    unsigned char* ws = args.ws;
    unsigned* ctl = (unsigned*)(ws + WS_CTL);
    for (int u = tid; u < (LDS_BYTES - LDSCTL_OFF) / 4; u += NWAVES * 64) ((LAS unsigned*)(lds + LDSCTL_OFF))[u] = 0u;
    __syncthreads();
    XcdBarrier bar; bar.bar = ctl + CW_BAR; bar.x = 0; bar.st = nullptr;
    if (N_LAUNCHES == 1) bar = xcd_barrier_post(ctl + CW_BAR, MISC + 8);
#define GRID_BAR() do { if (N_LAUNCHES == 1) xcd_barrier(bar); } while (0)
    const int lo = args.ph_lo, hi = args.ph_hi;
#define IN(k) (lo <= (k) && (k) < hi)
#define OT() ({ int t_ = tid; asm volatile("" : "+v"(t_)); t_; })
#define BOTH(k) (IN(k) && IN((k) + 1))
#ifndef PROBE_PHASE
#define PROBE_PHASE -1
#endif
#define REP(k) ((k) == PROBE_PHASE ? 2 : 1)
    const float* x = (const float*)args.in[0]; const int* positions = (const int*)args.in[1];
    const float* g_mix = (const float*)args.in[2]; const float* g_ffn = (const float*)args.in[3]; const float* g_final = (const float*)args.in[4];
    const float* sinks = (const float*)args.in[7]; const float* rec_norm_g = (const float*)args.in[10]; const float* w_router = (const float*)args.in[15];
    float* out = args.out;
    bf16* H = (bf16*)(ws + WS_H); bf16* BIG = (bf16*)(ws + WS_BIG);
    const size_t PLANE = (size_t)NTOK * D;
    bf16* H2 = (bf16*)(ws + WS_H2); float* RSP = (float*)(ws + WS_RSP);
    unsigned* SSQ1 = (unsigned*)(ws + WS_CTL + CTL_SSQ1); unsigned* SSQ2 = (unsigned*)(ws + WS_CTL + CTL_SSQ2); unsigned* SSQ3 = (unsigned*)(ws + WS_CTL + CTL_SSQ3);

    if (IN(0)) for (int rep_ = 0; rep_ < REP(0); ++rep_) {
        P0Args pa; pa.g_ffn0 = g_ffn; pa.g_mix1 = g_mix + D; pa.g_ffn1 = g_ffn + D; pa.x = x; pa.g0 = g_mix; pa.w_in_attn = (const float*)args.in[5]; pa.w_out_attn = (const float*)args.in[6]; pa.w_in_rec = (const float*)args.in[8]; pa.w_out_rec = (const float*)args.in[11];
        pa.w_gate = (const float*)args.in[12]; pa.w_up = (const float*)args.in[13]; pa.w_down = (const float*)args.in[14]; pa.w_gate_moe = (const float*)args.in[16]; pa.w_up_moe = (const float*)args.in[17]; pa.w_down_moe = (const float*)args.in[18];
        pa.rlb = (const float*)args.in[9]; pa.pos = positions; pa.ws = ws;
        phase_prologue(pa, lds, blk, G, OT());
        if (BOTH(0)) GRID_BAR();
    }
    if (IN(1)) {
        pg8::Gemm g{H, (const bf16*)(ws + WS_W_INATT), NTOK, QKV_N, D}; pg8::StaticOrder S; S.init(NTOK, QKV_N, G, blk);
        pg8::EpiBf16Plain E{BIG, QKV_N, 1 << 20};
        pg8::gemm_phase<pg8::EpiBf16Plain, pg8::StaticOrder, PG8_ALIGN, PG8_SP2>(lds, g, S, E);
        if (BOTH(1)) GRID_BAR();
    }
    if (IN(2)) { phase_rope(BIG, (const float*)(ws + WS_ROPE), blk, G, OT()); if (BOTH(2)) GRID_BAR(); }
    if (IN(3)) for (int rep_ = 0; rep_ < REP(3); ++rep_) { phase_attn(BIG, sinks, H, (bf16*)(ws + WS_OB), (float*)(ws + WS_LSE), lds, blk, G, OT()); if (BOTH(3)) GRID_BAR(); }
    if (IN(4)) {
        pg8::Gemm g{H, (const bf16*)(ws + WS_W_OUTATT), NTOK, D, D}; pg8::StaticOrder S; S.init(NTOK, D, G, blk);
        pg8::EpiRes E{x, out, D, H2, SSQ1};
        pg8::gemm_phase<pg8::EpiRes, pg8::StaticOrder, PG8_ALIGN, PG8_SP2>(lds, g, S, E);
        if (BOTH(4)) GRID_BAR();
    }
    if (IN(6)) {
        pg8::Gemm g{H2, (const bf16*)(ws + WS_W_GU), NTOK, 2 * FF, D}; pg8::StaticOrder S; S.init(NTOK, 2 * FF, G, blk);
        pg8::EpiSwiglu E{BIG, FF, 1 << 20, 0, SSQ1, nullptr};
        pg8::gemm_phase<pg8::EpiSwiglu, pg8::StaticOrder, PG8_ALIGN, PG8_SP2>(lds, g, S, E);
#if PROBE_PHASE == 6
        GRID_BAR(); pg8::gemm_phase<pg8::EpiSwiglu, pg8::StaticOrder, PG8_ALIGN, PG8_SP2>(lds, g, S, E);
#endif
        if (BOTH(6)) GRID_BAR();
    }
    if (IN(7)) {
        pg8::Gemm g{BIG, (const bf16*)(ws + WS_W_DN), NTOK, D, FF}; pg8::StaticOrder S; S.init(NTOK, D, G, blk);
        pg8::EpiRes E{out, out, D, H, SSQ2};
        pg8::gemm_phase<pg8::EpiRes, pg8::StaticOrder, PG8_ALIGN, PG8_SP2>(lds, g, S, E);
        if (BOTH(7)) GRID_BAR();
    }
    if (IN(9)) {
        pg8::Gemm g{H, (const bf16*)(ws + WS_W_INREC), NTOK, REC_N, D}; pg8::StaticOrder S; S.init(NTOK, REC_N, G, blk);
        pg8::EpiRec2 E{BIG, PLANE, (const float*)(ws + WS_LBK), (float*)(ws + WS_DK), SSQ2};
        pg8::gemm_phase<pg8::EpiRec2, pg8::StaticOrder, PG8_ALIGN, PG8_SP2>(lds, g, S, E);
        if (BOTH(9)) GRID_BAR();
    }
    if (IN(10)) for (int rep_ = 0; rep_ < REP(10); ++rep_) { phase_hgrn_state(BIG + 2 * PLANE, BIG + 3 * PLANE, (const float*)(ws + WS_DK), (float*)(ws + WS_HL), (float*)(ws + WS_HP), lds, blk, G, OT()); if (BOTH(10)) GRID_BAR(); }
    if (IN(11)) for (int rep_ = 0; rep_ < REP(11); ++rep_) { phase_hgrn(BIG, BIG + PLANE, BIG + 2 * PLANE, BIG + 3 * PLANE, BIG + 4 * PLANE, (const float*)(ws + WS_DK), rec_norm_g, H, (const float*)(ws + WS_HL), (const float*)(ws + WS_HP), lds, blk, G, OT()); if (BOTH(11)) GRID_BAR(); }
    if (IN(12)) {
        pg8::Gemm g{H, (const bf16*)(ws + WS_W_OUTREC), NTOK, D, D}; pg8::StaticOrder S; S.init(NTOK, D, G, blk);
        pg8::EpiRes E{out, out, D, H2, SSQ3};
        pg8::gemm_phase<pg8::EpiRes, pg8::StaticOrder, PG8_ALIGN, PG8_SP2>(lds, g, S, E);
        if (BOTH(12)) GRID_BAR();
    }
    int4* meta = (int4*)(ws + WS_META); int* hist = (int*)(ws + WS_HIST); int* dest = (int*)(ws + WS_DEST); int* info = (int*)(ws + WS_INFO);
    bf16* Y = (bf16*)(ws + WS_Y); bf16* HID = (bf16*)(ws + WS_HID);
    if (IN(13)) for (int rep_ = 0; rep_ < REP(13); ++rep_) { phase_router(out, g_ffn + D, w_router, SSQ3, meta, hist, lds, blk, G, OT()); if (BOTH(13)) GRID_BAR(); }
    if (IN(14)) for (int rep_ = 0; rep_ < REP(14); ++rep_) { phase_scatter(H2, SSQ3, meta, hist, dest, info, Y, RSP, lds, blk, G, OT()); if (BOTH(14)) GRID_BAR(); }
    for (int c = 0; c < 3; ++c) {
        if (IN(15 + 2 * c) || IN(16 + 2 * c)) {
            const int T = info[8]; const int tile0 = 256 * c; int ntl = T - tile0; ntl = ntl > 256 ? 256 : ntl; ntl = ntl < 0 ? 0 : ntl;
            pg8::MoeOrder S; S.tile0 = tile0; S.te0 = info[0]; S.te1 = info[1]; S.te2 = info[2]; S.te3 = info[3]; S.te4 = info[4]; S.te5 = info[5]; S.te6 = info[6];
            if (IN(15 + 2 * c)) {
                S.nN = 28; S.so.init(ntl * 256, 2 * FF, G, blk);
                pg8::Gemm g{Y, (const bf16*)(ws + WS_WMOE_GU), 0, 0, D};
                pg8::EpiSwiglu E{HID, FF, 28, tile0, nullptr, RSP};
                pg8::gemm_phase<pg8::EpiSwiglu, pg8::MoeOrder, PG8_ALIGN, PG8_SP2>(lds, g, S, E);
                if (BOTH(15 + 2 * c)) GRID_BAR();
            }
            if (IN(16 + 2 * c)) {
                S.nN = 4; S.so.init(ntl * 256, D, G, blk);
                pg8::Gemm g{HID - (size_t)tile0 * 256 * FF, (const bf16*)(ws + WS_WMOE_DN), 0, 0, FF};
                pg8::EpiBf16Plain E{Y, D, 4};
                pg8::gemm_phase<pg8::EpiBf16Plain, pg8::MoeOrder, PG8_ALIGN, PG8_SP2>(lds, g, S, E);
                if (BOTH(16 + 2 * c)) GRID_BAR();
            }
        }
    }
    if (IN(21)) phase_combine(out, Y, meta, dest, g_final, blk, G, OT());
#undef IN
#undef BOTH
}

extern "C" void kernel_launch(void* const* d_in, const int* in_sizes, int n_in, void* d_out, int out_size, void* d_ws, size_t ws_size, hipStream_t stream) {
    static int grid = 0;
    if (grid == 0) {
        if (n_in != 19 || in_sizes[0] != NTOK * D || out_size != NTOK * D || ws_size < WS_END) { fprintf(stderr, "kernel_launch: unexpected shapes / workspace (n_in %d, ws %zu); nothing launched\n", n_in, ws_size); grid = -1; return; }
        int dev = 0, cus = 0, per_cu = 0;
        if (hipGetDevice(&dev) != hipSuccess || hipDeviceGetAttribute(&cus, hipDeviceAttributeMultiprocessorCount, dev) != hipSuccess) { grid = -1; return; }
        if (hipFuncSetAttribute((const void*)fwd, hipFuncAttributeMaxDynamicSharedMemorySize, LDS_BYTES) != hipSuccess) { fprintf(stderr, "kernel_launch: hipFuncSetAttribute failed\n"); grid = -1; return; }
        if (hipOccupancyMaxActiveBlocksPerMultiprocessor(&per_cu, (const void*)fwd, NWAVES * 64, LDS_BYTES) != hipSuccess || per_cu < 1) fprintf(stderr, "kernel_launch: occupancy query says %d\n", per_cu);
        (void)hipGetLastError();
        grid = cus;
    }
    if (grid < 0) return;
    if (hipMemsetAsync((char*)d_ws + WS_CTL, 0, CTL_ZERO_BYTES, stream) != hipSuccess) return;
    Args a{};
    for (int i = 0; i < 19; ++i) a.in[i] = d_in[i];
    a.out = (float*)d_out; a.ws = (unsigned char*)d_ws;
    if (N_LAUNCHES == 1) { a.ph_lo = 0; a.ph_hi = NPH; hipLaunchKernelGGL(fwd, dim3(grid), dim3(NWAVES * 64), LDS_BYTES, stream, a); }
    else for (int li = 0; li < NPH; ++li) { a.ph_lo = li; a.ph_hi = li + 1; hipLaunchKernelGGL(fwd, dim3(grid), dim3(NWAVES * 64), LDS_BYTES, stream, a); }
}
```

```cpp
#include <hip/hip_runtime.h>
#include <cstdio>
#include <cstdint>
#define PROBE_PHASE -1
namespace pg8 {
#define PG8_LAS __attribute__((address_space(3)))
typedef unsigned short bf16_t;
typedef short bf16x8 __attribute__((ext_vector_type(8)));
typedef float f32x4 __attribute__((ext_vector_type(4)));
typedef unsigned u32x4 __attribute__((ext_vector_type(4)));
constexpr int BM = 256, BK = 64, HALF = 128, HTB = HALF * BK * 2  , STAGE_BYTES = 8 * HTB, NXCD = 8, WGM = 8;

__host__ __device__ __forceinline__ int lds_byte(int r, int c) { const int st = (r >> 4) * 2 + (c >> 5), rr = r & 15, cc = c & 31, ob = rr * 64 + cc * 2; return st * 1024 + (ob ^ (((ob >> 9) & 1) << 5)); }
__host__ __device__ __forceinline__ void stage_rc(int b, int& R, int& C) { const int st = b / 1024, sb = b % 1024, swz = sb ^ (((sb >> 9) & 1) << 5); R = (st >> 1) * 16 + swz / 64; C = (st & 1) * 32 + (swz % 64) / 2; }
__host__ __device__ __forceinline__ int perm32(int rho) { const int n = rho >> 4, i = rho & 15; return 8 * (i >> 2) + 4 * n + (i & 3); }

struct Unit { int pm, pn; };
struct Gemm { const bf16_t* A; const bf16_t* Bt; int M, N, K; };

struct StaticOrder {
    int nM, nN, nwg, G, c;
    __host__ __device__ void init(int M, int N, int G_, int c_) { nM = M / BM; nN = N / BM; nwg = nM * nN; G = G_; c = c_; }
    __host__ __device__ bool next(int i, Unit& u) const {
        const long L = (long)i * G + c; if (L >= nwg) return false;
        int wgid = (int)L; { const int q = nwg / NXCD, r = nwg % NXCD, xcd = wgid % NXCD, off = wgid / NXCD; wgid = (xcd < r ? xcd * (q + 1) : r * (q + 1) + (xcd - r) * q) + off; }
        const int nig = WGM * nN, gid = wgid / nig, fm = gid * WGM, gsz = (nM - fm) < WGM ? (nM - fm) : WGM;
        u.pm = fm + ((wgid % nig) % gsz); u.pn = (wgid % nig) / gsz; return true;
    }
    __device__ __forceinline__ void a_ready(const Unit&) const {}
    __device__ __forceinline__ void done(const Unit&) const {}
};
__device__ __forceinline__ unsigned cvt_pk_bf16(float lo, float hi) { unsigned r; asm volatile("v_cvt_pk_bf16_f32 %0, %1, %2" : "=v"(r) : "v"(lo), "v"(hi)); return r; }
typedef unsigned u32x2 __attribute__((ext_vector_type(2)));
__device__ __forceinline__ float sigmoid_f(float x) { return __builtin_amdgcn_rcpf(1.0f + __builtin_amdgcn_exp2f(-1.44269504089f * x)); }
__device__ __forceinline__ float silu_f(float x) { return x * sigmoid_f(x); }
__device__ __forceinline__ u32x4 pack8(const f32x4& v0, const f32x4& v1) { u32x4 w; w.x = cvt_pk_bf16(v0[0], v0[1]); w.y = cvt_pk_bf16(v0[2], v0[3]); w.z = cvt_pk_bf16(v1[0], v1[1]); w.w = cvt_pk_bf16(v1[2], v1[3]); return w; }
struct EpiBf16Plain {
    static constexpr bool PERM = true, AFTER_DRAIN = false;
    bf16_t* O; int ldc; int nmod;
    __device__ __forceinline__ void operator()(const f32x4 (&acc)[2][2][4][2], const Unit& u, int wr, int wc, int fr, int fq) const {
        const int row0 = u.pm * BM + wr * 64 + fr; const int col0 = (u.pn % nmod) * BM + wc * 32 + 8 * fq;
#pragma unroll
        for (int ai = 0; ai < 2; ++ai)
#pragma unroll
            for (int m = 0; m < 4; ++m) { bf16_t* rowp = O + (size_t)(row0 + ai * HALF + m * 16) * ldc + col0;
#pragma unroll
                for (int bj = 0; bj < 2; ++bj) *(u32x4*)(rowp + bj * HALF) = pack8(acc[ai][bj][m][0], acc[ai][bj][m][1]); }
    }
};
struct EpiQkvRope {
    static constexpr bool PERM = true, AFTER_DRAIN = false;
    bf16_t* O; const float* rope;
    __device__ __forceinline__ void operator()(const f32x4 (&acc)[2][2][4][2], const Unit& u, int wr, int wc, int fr, int fq) const {
        const int row0 = u.pm * BM + wr * 64 + fr; const int col0 = u.pn * BM + wc * 32 + 8 * fq;
        const bool lrot = ((wc & 1) == 0) && (fq < 2);
#pragma unroll
        for (int ai = 0; ai < 2; ++ai)
#pragma unroll
            for (int m = 0; m < 4; ++m) { const int row = row0 + ai * HALF + m * 16; bf16_t* rowp = O + (size_t)row * 2304 + col0;
#pragma unroll
                for (int bj = 0; bj < 2; ++bj) { f32x4 v0 = acc[ai][bj][m][0], v1 = acc[ai][bj][m][1];
                    const bool urot = (u.pn < 4) || (u.pn == 6) || (u.pn == 7) || (u.pn == 8 && bj == 0);
                    if (urot) {
                        const f32x4* t = (const f32x4*)(rope + (size_t)row * 16); const f32x4 c0 = t[0], c1 = t[1], s0 = t[2], s1 = t[3];
                        f32x4 p0, p1;
#pragma unroll
                        for (int j = 0; j < 4; ++j) { p0[j] = __shfl_xor(v0[j], 16); p1[j] = __shfl_xor(v1[j], 16); }
                        if (lrot) { const float sg = (fq == 0) ? -1.0f : 1.0f;
#pragma unroll
                            for (int j = 0; j < 4; ++j) { v0[j] = v0[j] * c0[j] + sg * p0[j] * s0[j]; v1[j] = v1[j] * c1[j] + sg * p1[j] * s1[j]; } }
                    }
                    *(u32x4*)(rowp + bj * HALF) = pack8(v0, v1); } }
    }
};
struct EpiRes {
    static constexpr bool PERM = false, AFTER_DRAIN = false;
    const float* base; float* out; int ldc; bf16_t* hb; unsigned* ssq;
    __device__ __forceinline__ void operator()(const f32x4 (&acc)[2][2][4][2], const Unit& u, int wr, int wc, int fr, int fq) const {
        const int row0 = u.pm * BM + wr * 64 + fr, col0 = u.pn * BM + wc * 32 + 4 * fq;
        f32x4 cur[4], nxt[4];
#pragma unroll
        for (int q = 0; q < 4; ++q) cur[q] = *(const f32x4*)(base + (size_t)row0 * ldc + col0 + (q >> 1) * HALF + (q & 1) * 16);
#pragma unroll
        for (int g = 0; g < 8; ++g) { const int ai = g >> 2, m = g & 3; const int row = row0 + ai * HALF + m * 16; const size_t off = (size_t)row * ldc + col0;
            if (g < 7) { const int ai2 = (g + 1) >> 2, m2 = (g + 1) & 3; const size_t off2 = (size_t)(row0 + ai2 * HALF + m2 * 16) * ldc + col0;
#pragma unroll
                for (int q = 0; q < 4; ++q) nxt[q] = *(const f32x4*)(base + off2 + (q >> 1) * HALF + (q & 1) * 16); }
            float ss = 0.f;
#pragma unroll
            for (int q = 0; q < 4; ++q) { const int bj = q >> 1, n = q & 1; const f32x4 v = cur[q] + acc[ai][bj][m][n]; *(f32x4*)(out + off + bj * HALF + n * 16) = v;
                u32x2 w; w.x = cvt_pk_bf16(v[0], v[1]); w.y = cvt_pk_bf16(v[2], v[3]); *(u32x2*)(hb + off + bj * HALF + n * 16) = w;
                ss += (v[0] * v[0] + v[1] * v[1]) + (v[2] * v[2] + v[3] * v[3]); }
            ss += __shfl_xor(ss, 16); ss += __shfl_xor(ss, 32);
            if (fq == 0) __hip_atomic_fetch_add(ssq + row, __float2uint_rn(ss * 65536.0f), __ATOMIC_RELAXED, __HIP_MEMORY_SCOPE_AGENT);
            asm volatile("" ::: "memory");
#pragma unroll
            for (int q = 0; q < 4; ++q) cur[q] = nxt[q]; }
    }
};
struct EpiSwiglu {
    static constexpr bool PERM = true, AFTER_DRAIN = false;
    bf16_t* O; int ldc; int nN; int tile0; const unsigned* ssq; const float* rsd;
    __device__ __forceinline__ void operator()(const f32x4 (&acc)[2][2][4][2], const Unit& u, int wr, int wc, int fr, int fq) const {
        const int row0 = (u.pm - tile0) * BM + wr * 64 + fr; const int col0 = (u.pn % nN) * HALF + wc * 32 + 8 * fq; const int arow0 = u.pm * BM + wr * 64 + fr;
#pragma unroll
        for (int ai = 0; ai < 2; ++ai)
#pragma unroll
            for (int m = 0; m < 4; ++m) { bf16_t* rowp = O + (size_t)(row0 + ai * HALF + m * 16) * ldc + col0;
                const int ar = arow0 + ai * HALF + m * 16; const float rs = rsd ? rsd[ar] : 1.0f / sqrtf((float)ssq[ar] * (1.f / (1024.f * 65536.f)) + 1e-6f);
                f32x4 h0, h1;
#pragma unroll
                for (int j = 0; j < 4; ++j) { h0[j] = silu_f(rs * acc[ai][0][m][0][j]) * (rs * acc[ai][1][m][0][j]); h1[j] = silu_f(rs * acc[ai][0][m][1][j]) * (rs * acc[ai][1][m][1][j]); }
                *(u32x4*)rowp = pack8(h0, h1); }
    }
};
struct EpiRec {
    static constexpr bool PERM = true, AFTER_DRAIN = false;
    bf16_t* P; size_t plane; const float* lbk;
    __device__ __forceinline__ void operator()(const f32x4 (&acc)[2][2][4][2], const Unit& u, int wr, int wc, int fr, int fq) const {
        const int hd = u.pn & 7; const bool second = (u.pn >> 3) != 0;
        const int row0 = u.pm * BM + wr * 64 + fr; const int ch0 = hd * HALF + wc * 32 + 8 * fq;
        const f32x4 l0 = *(const f32x4*)(lbk + ch0), l1 = *(const f32x4*)(lbk + ch0 + 4);
        bf16_t* pa = P + (second ? 2 * plane : 0); bf16_t* pb = pa + plane;
#pragma unroll
        for (int ai = 0; ai < 2; ++ai)
#pragma unroll
            for (int m = 0; m < 4; ++m) { const size_t off = (size_t)(row0 + ai * HALF + m * 16) * 1024 + ch0;
                f32x4 a0 = acc[ai][0][m][0], a1 = acc[ai][0][m][1], b0 = acc[ai][1][m][0], b1 = acc[ai][1][m][1];
                if (!second) {
#pragma unroll
                    for (int j = 0; j < 4; ++j) { a0[j] = silu_f(a0[j]); a1[j] = silu_f(a1[j]); b0[j] = l0[j] * sigmoid_f(-b0[j]); b1[j] = l1[j] * sigmoid_f(-b1[j]); }
                } else {
#pragma unroll
                    for (int j = 0; j < 4; ++j) { b0[j] = silu_f(b0[j]); b1[j] = silu_f(b1[j]); }
                }
                *(u32x4*)(pa + off) = pack8(a0, a1); *(u32x4*)(pb + off) = pack8(b0, b1); }
    }
};
struct MoeOrder {
    StaticOrder so; int tile0, nN; int te0, te1, te2, te3, te4, te5, te6;
    __device__ __forceinline__ bool next(int i, Unit& u) const {
        Unit l; if (!so.next(i, l)) return false;
        const int pm = tile0 + l.pm;
        const int e = (pm >= te0) + (pm >= te1) + (pm >= te2) + (pm >= te3) + (pm >= te4) + (pm >= te5) + (pm >= te6);
        u.pm = pm; u.pn = e * nN + l.pn; return true;
    }
    __device__ __forceinline__ void a_ready(const Unit&) const {}
    __device__ __forceinline__ void done(const Unit&) const {}
};

template <int CTRL> __device__ __forceinline__ float dpp0(float v) { return __builtin_bit_cast(float, __builtin_amdgcn_update_dpp(0, __builtin_bit_cast(int, v), CTRL, 0xf, 0xf, true)); }
struct EpiRec2 {
    static constexpr bool PERM = true, AFTER_DRAIN = false;
    bf16_t* P; size_t plane; const float* lbk; float* DK; const unsigned* ssq;
    __device__ __forceinline__ void operator()(const f32x4 (&acc)[2][2][4][2], const Unit& u, int wr, int wc, int fr, int fq) const {
        const int hd = u.pn & 7; const bool second = (u.pn >> 3) != 0;
        const int row0 = u.pm * BM + wr * 64 + fr; const int ch0 = hd * HALF + wc * 32 + 8 * fq;
        if (second) {
#pragma unroll
            for (int ai = 0; ai < 2; ++ai)
#pragma unroll
                for (int m = 0; m < 4; ++m) { const size_t off = (size_t)(row0 + ai * HALF + m * 16) * 1024 + ch0;
                    const float rsm = 1.0f / sqrtf((float)ssq[row0 + ai * HALF + m * 16] * (1.f / (1024.f * 65536.f)) + 1e-6f);
                    f32x4 b0 = acc[ai][1][m][0], b1 = acc[ai][1][m][1]; const f32x4 a0 = acc[ai][0][m][0] * rsm, a1 = acc[ai][0][m][1] * rsm;
#pragma unroll
                    for (int j = 0; j < 4; ++j) { b0[j] = silu_f(rsm * b0[j]); b1[j] = silu_f(rsm * b1[j]); }
                    *(u32x4*)(P + 3 * plane + off) = pack8(a0, a1); *(u32x4*)(P + 4 * plane + off) = pack8(b0, b1); }
        } else {
            const int lane15 = (fq * 16 + fr) | 15;
#pragma unroll
            for (int ai = 0; ai < 2; ++ai) {
                float rs4[4];
#pragma unroll
                for (int m = 0; m < 4; ++m) rs4[m] = 1.0f / sqrtf((float)ssq[row0 + ai * HALF + m * 16] * (1.f / (1024.f * 65536.f)) + 1e-6f);
#pragma unroll
                for (int n = 0; n < 2; ++n) {
                    const f32x4 lbv = *(const f32x4*)(lbk + ch0 + 4 * n);
                    float kk[4][4], bb[4][4];
#pragma unroll
                    for (int m = 0; m < 4; ++m)
#pragma unroll
                        for (int j = 0; j < 4; ++j) { const float k_ = lbv[j] * sigmoid_f(-rs4[m] * acc[ai][1][m][n][j]); kk[m][j] = k_; float x = __logf(1.0f - k_);
                            x += dpp0<0x111>(x); x += dpp0<0x112>(x); x += dpp0<0x114>(x); x += dpp0<0x118>(x); bb[m][j] = x; }
                    float run[4] = {0.f, 0.f, 0.f, 0.f};
#pragma unroll
                    for (int m = 0; m < 4; ++m)
#pragma unroll
                        for (int j = 0; j < 4; ++j) { const float tot = __shfl(bb[m][j], lane15); bb[m][j] += run[j]; run[j] += tot; }
#pragma unroll
                    for (int m = 0; m < 4; ++m) { const size_t off = (size_t)(row0 + ai * HALF + m * 16) * 1024 + ch0 + 4 * n;
                        float qe[4], ki[4], ke[4];
#pragma unroll
                        for (int j = 0; j < 4; ++j) { const float bt = bb[m][j]; qe[j] = silu_f(rs4[m] * acc[ai][0][m][n][j]) * __expf(bt); ki[j] = kk[m][j] * __expf(fminf(-bt, 80.f)); ke[j] = kk[m][j] * __expf(run[j] - bt); }
                        u32x2 w; w.x = cvt_pk_bf16(qe[0], qe[1]); w.y = cvt_pk_bf16(qe[2], qe[3]); *(u32x2*)(P + off) = w;
                        w.x = cvt_pk_bf16(ki[0], ki[1]); w.y = cvt_pk_bf16(ki[2], ki[3]); *(u32x2*)(P + plane + off) = w;
                        w.x = cvt_pk_bf16(ke[0], ke[1]); w.y = cvt_pk_bf16(ke[2], ke[3]); *(u32x2*)(P + 2 * plane + off) = w; }
                    if (fr == 0) { const int chunk = 4 * u.pm + 2 * ai + wr; *(f32x4*)(DK + (size_t)chunk * 1024 + ch0 + 4 * n) = (f32x4){__expf(run[0]), __expf(run[1]), __expf(run[2]), __expf(run[3])}; }
                }
            }
        }
    }
};
template <class Epi, class Sched, bool ALIGN_EPI = false, bool SP2 = false>
__device__ __forceinline__ void gemm_phase(PG8_LAS unsigned char* lds, const Gemm g, const Sched& S, const Epi& E) {
    const int tid = threadIdx.x, wid = __builtin_amdgcn_readfirstlane(tid >> 6), lane = tid & 63, wr = wid >> 2, wc = wid & 3, fr = lane & 15, fq = lane >> 4;
    const int K = g.K, nt = K / BK;
    unsigned voffA[2], voffB[2];
#pragma unroll
    for (int i = 0; i < 2; ++i) { int R, C; stage_rc(tid * 16 + i * 8192, R, C); const int Rb = Epi::PERM ? ((R & ~31) + perm32(R & 31)) : R;
        voffA[i] = (unsigned)(R * K + C) * 2u; voffB[i] = (unsigned)(Rb * K + C) * 2u; }
    const size_t kstep = (size_t)(BK * 2);
    const size_t hstep = (size_t)HALF * K * 2;
    const size_t tstep = 2 * hstep;
    const unsigned ldsw = (unsigned)wid * 1024u;
    const int aoff = lds_byte(wr * 64 + fr, fq * 8), boff = lds_byte(wc * 32 + fr, fq * 8);
#define PG8_SA(b, h) (((b) * 2 + (h)) * HTB)
#define PG8_SB(b, h) ((4 + (b) * 2 + (h)) * HTB)
#define PG8_STAGE(bufoff, gbase, voff) do { _Pragma("unroll") for (int _i = 0; _i < 2; ++_i) \
        __builtin_amdgcn_global_load_lds((const unsigned*)((const char*)(gbase) + (voff)[_i]), (PG8_LAS unsigned*)(lds + (bufoff) + ldsw + _i * 8192), 16, 0, 0); } while (0)
#define PG8_LDA(dst, b, h) do { _Pragma("unroll") for (int m = 0; m < 4; ++m) _Pragma("unroll") for (int k = 0; k < 2; ++k) dst[m][k] = *(const PG8_LAS bf16x8*)(lds + PG8_SA(b, h) + aoff + m * 2048 + k * 1024); } while (0)
#define PG8_LDB(dst, b, h) do { _Pragma("unroll") for (int n = 0; n < 2; ++n) _Pragma("unroll") for (int k = 0; k < 2; ++k) dst[n][k] = *(const PG8_LAS bf16x8*)(lds + PG8_SB(b, h) + boff + n * 2048 + k * 1024); } while (0)
#define PG8_MMA(ai, bj, At, Bt) do { __builtin_amdgcn_s_setprio(1); _Pragma("unroll") for (int m = 0; m < 4; ++m) _Pragma("unroll") for (int n = 0; n < 2; ++n) _Pragma("unroll") for (int k = 0; k < 2; ++k) \
        acc[ai][bj][m][n] = __builtin_amdgcn_mfma_f32_16x16x32_bf16(Bt[n][k], At[m][k], acc[ai][bj][m][n], 0, 0, 0); __builtin_amdgcn_s_setprio(0); } while (0)
#define PG8_WAIT_V(n) asm volatile("s_waitcnt vmcnt(" #n ")" ::: "memory")
#define PG8_WAIT_L(n) asm volatile("s_waitcnt lgkmcnt(" #n ")" ::: "memory")
#define PG8_BAR __builtin_amdgcn_s_barrier()
#define PG8_SCHED __builtin_amdgcn_sched_barrier(0)
    Unit cur, nxt; int ui = 0;
    if (!S.next(0, cur)) return;
    f32x4 acc[2][2][4][2];
#pragma unroll
    for (int a = 0; a < 2; ++a)
#pragma unroll
        for (int b = 0; b < 2; ++b)
#pragma unroll
            for (int m = 0; m < 4; ++m)
#pragma unroll
                for (int n = 0; n < 2; ++n) acc[a][b][m][n] = (f32x4){0.f, 0.f, 0.f, 0.f};
    bf16x8 At[4][2], B0[2][2], B1[2][2];
    const char* cA = (const char*)g.A + (size_t)cur.pm * tstep; const char* cB = (const char*)g.Bt + (size_t)cur.pn * tstep;
    S.a_ready(cur);
    if constexpr (SP2) {
        PG8_STAGE(PG8_SB(0, 0), cB, voffB); PG8_STAGE(PG8_SB(0, 1), cB + hstep, voffB); PG8_STAGE(PG8_SA(0, 0), cA, voffA); PG8_STAGE(PG8_SA(0, 1), cA + hstep, voffA);
        if (wr == 1) PG8_BAR;
        PG8_WAIT_V(2); PG8_BAR;
        PG8_STAGE(PG8_SB(1, 0), cB + kstep, voffB); PG8_STAGE(PG8_SA(1, 0), cA + kstep, voffA); PG8_STAGE(PG8_SB(1, 1), cB + hstep + kstep, voffB);
        PG8_WAIT_V(6); PG8_BAR;
    } else {
        PG8_STAGE(PG8_SB(0, 0), cB, voffB); PG8_STAGE(PG8_SA(0, 0), cA, voffA); PG8_STAGE(PG8_SB(0, 1), cB + hstep, voffB); PG8_STAGE(PG8_SA(0, 1), cA + hstep, voffA);
        if (wr == 1) PG8_BAR;
        PG8_WAIT_V(4); PG8_BAR;
        PG8_STAGE(PG8_SB(1, 0), cB + kstep, voffB); PG8_STAGE(PG8_SA(1, 0), cA + kstep, voffA); PG8_STAGE(PG8_SB(1, 1), cB + hstep + kstep, voffB);
        PG8_WAIT_V(6); PG8_BAR;
    }
    for (;;) {
        const bool has_next = S.next(ui + 1, nxt);
        const char* nA = has_next ? (const char*)g.A + (size_t)nxt.pm * tstep : cA; const char* nB = has_next ? (const char*)g.Bt + (size_t)nxt.pn * tstep : cB;
        for (int t = 0; t < nt; t += 2) {
            const bool last = (t == nt - 2);
            const char* a1 = cA + (size_t)(t + 1) * kstep;
            const char* a2 = last ? nA : cA + (size_t)(t + 2) * kstep; const char* b2 = last ? nB : cB + (size_t)(t + 2) * kstep;
            const char* a3 = a2 + kstep; const char* b3 = b2 + kstep;
            if (last && has_next) S.a_ready(nxt);
            if constexpr (SP2) {
            PG8_LDB(B0, 0, 0); PG8_LDB(B1, 0, 1); PG8_SCHED; PG8_LDA(At, 0, 0); PG8_STAGE(PG8_SA(1, 1), a1 + hstep, voffA);
            PG8_WAIT_V(8); PG8_WAIT_L(0); PG8_BAR; PG8_MMA(0, 0, At, B0); PG8_MMA(0, 1, At, B1); PG8_BAR; PG8_SCHED;
            PG8_LDA(At, 0, 1); PG8_STAGE(PG8_SB(0, 0), b2, voffB); PG8_STAGE(PG8_SB(0, 1), b2 + hstep, voffB); PG8_STAGE(PG8_SA(0, 0), a2, voffA);
            PG8_WAIT_V(8); PG8_WAIT_L(0); PG8_BAR; PG8_MMA(1, 0, At, B0); PG8_MMA(1, 1, At, B1); PG8_BAR; PG8_SCHED;
            PG8_LDB(B0, 1, 0); PG8_LDB(B1, 1, 1); PG8_SCHED; PG8_LDA(At, 1, 0); PG8_STAGE(PG8_SA(0, 1), a2 + hstep, voffA);
            PG8_WAIT_V(8); PG8_WAIT_L(0); PG8_BAR; PG8_MMA(0, 0, At, B0); PG8_MMA(0, 1, At, B1); PG8_BAR; PG8_SCHED;
            PG8_LDA(At, 1, 1); PG8_STAGE(PG8_SB(1, 0), b3, voffB); PG8_STAGE(PG8_SB(1, 1), b3 + hstep, voffB); PG8_STAGE(PG8_SA(1, 0), a3, voffA);
            PG8_WAIT_V(8); PG8_WAIT_L(0); PG8_BAR; PG8_MMA(1, 0, At, B0); PG8_MMA(1, 1, At, B1); PG8_BAR; PG8_SCHED;
            } else {
            PG8_LDB(B0, 0, 0); PG8_SCHED; PG8_LDA(At, 0, 0); PG8_STAGE(PG8_SA(1, 1), a1 + hstep, voffA);
            PG8_WAIT_L(8); PG8_BAR; PG8_WAIT_L(0); PG8_MMA(0, 0, At, B0); PG8_BAR; PG8_SCHED;
            PG8_LDB(B1, 0, 1); PG8_STAGE(PG8_SB(0, 0), b2, voffB);
            PG8_BAR; PG8_WAIT_L(0); PG8_MMA(0, 1, At, B1); PG8_BAR;
            PG8_LDA(At, 0, 1); PG8_STAGE(PG8_SA(0, 0), a2, voffA);
            PG8_BAR; PG8_WAIT_L(0); PG8_MMA(1, 0, At, B0); PG8_BAR; PG8_SCHED;
            PG8_STAGE(PG8_SB(0, 1), b2 + hstep, voffB);
            PG8_WAIT_V(6); PG8_BAR; PG8_MMA(1, 1, At, B1); PG8_BAR;
            PG8_LDB(B0, 1, 0); PG8_SCHED; PG8_LDA(At, 1, 0); PG8_STAGE(PG8_SA(0, 1), a2 + hstep, voffA);
            PG8_WAIT_L(8); PG8_BAR; PG8_WAIT_L(0); PG8_MMA(0, 0, At, B0); PG8_BAR; PG8_SCHED;
            PG8_LDB(B1, 1, 1); PG8_STAGE(PG8_SB(1, 0), b3, voffB);
            PG8_BAR; PG8_WAIT_L(0); PG8_MMA(0, 1, At, B1); PG8_BAR;
            PG8_LDA(At, 1, 1); PG8_STAGE(PG8_SA(1, 0), a3, voffA);
            PG8_BAR; PG8_WAIT_L(0); PG8_MMA(1, 0, At, B0); PG8_BAR; PG8_SCHED;
            PG8_STAGE(PG8_SB(1, 1), b3 + hstep, voffB);
            PG8_WAIT_V(6); PG8_BAR; PG8_MMA(1, 1, At, B1); PG8_BAR;
            }
        }
        if constexpr (ALIGN_EPI) { if (wr == 0) PG8_BAR; }
        if constexpr (!Epi::AFTER_DRAIN) { E(acc, cur, wr, wc, fr, fq); S.done(cur); }
        if (!has_next) break;
#pragma unroll
        for (int a = 0; a < 2; ++a)
#pragma unroll
            for (int b = 0; b < 2; ++b)
#pragma unroll
                for (int m = 0; m < 4; ++m)
#pragma unroll
                    for (int n = 0; n < 2; ++n) acc[a][b][m][n] = (f32x4){0.f, 0.f, 0.f, 0.f};
        cur = nxt; cA = nA; cB = nB; ++ui;
        if constexpr (ALIGN_EPI) { if (wr == 1) PG8_BAR; }
    }
    PG8_WAIT_V(0);
    if constexpr (!ALIGN_EPI) { if (wr == 0) PG8_BAR; }
    PG8_BAR;
    if constexpr (Epi::AFTER_DRAIN) { E.fused(acc, cur, wr, wc, fr, fq, lds, wid, lane); S.done(cur); }
#undef PG8_SA
#undef PG8_SB
#undef PG8_STAGE
#undef PG8_LDA
#undef PG8_LDB
#undef PG8_MMA
#undef PG8_WAIT_V
#undef PG8_WAIT_L
#undef PG8_BAR
#undef PG8_SCHED
}
}
#ifndef PG8_SP2
#define PG8_SP2 true
#endif
#ifndef PG8_ALIGN
#define PG8_ALIGN true
#endif
constexpr int NWAVES = 8;
constexpr int BATCH = 8, SEQ = 8192, D = 1024, NTOK = BATCH * SEQ;
constexpr int QKV_N = 2304, FF = 3584, NEXP = 8, REC_N = 4096;
constexpr float EPS = 1e-6f;
constexpr int NPH = 22;
#ifndef MK_N_LAUNCHES
#define MK_N_LAUNCHES 1
#endif
constexpr int N_LAUNCHES = MK_N_LAUNCHES;
constexpr size_t MiB = 1u << 20;
constexpr size_t WS_CTL = 0, CTL_ZERO_BYTES = 1 * MiB;
constexpr size_t WS_WMOE_GU = 1 * MiB;
constexpr size_t WS_WMOE_DN = 113 * MiB;
constexpr size_t WS_H = 169 * MiB;
constexpr size_t WS_W_INATT = 297 * MiB;
constexpr size_t WS_W_OUTATT = WS_W_INATT + (size_t)QKV_N * D * 2;
constexpr size_t WS_W_GU = WS_W_OUTATT + (size_t)D * D * 2;
constexpr size_t WS_W_DN = WS_W_GU + (size_t)2 * FF * D * 2;
constexpr size_t WS_W_INREC = WS_W_DN + (size_t)D * FF * 2;
constexpr size_t WS_W_OUTREC = WS_W_INREC + (size_t)REC_N * D * 2;
constexpr size_t WS_BIG = 335 * MiB;
constexpr size_t WS_Y = 297 * MiB;
constexpr size_t WS_HID = 557 * MiB;
constexpr size_t WS_MISC = 1008 * MiB;
constexpr size_t WS_ROPE = WS_MISC;
constexpr size_t WS_META = WS_MISC + 4 * MiB;
constexpr size_t WS_DEST = WS_MISC + 5 * MiB;
constexpr size_t WS_HIST = WS_MISC + 6 * MiB;
constexpr size_t WS_INFO = WS_HIST + 8192;
constexpr size_t WS_LBK = WS_INFO + 256;
constexpr size_t WS_OB = 623 * MiB;
constexpr size_t WS_LSE = 751 * MiB;
constexpr size_t WS_DK = WS_MISC + 8 * MiB;
constexpr size_t WS_HL = 976 * MiB;
constexpr size_t WS_HP = 988 * MiB;
constexpr size_t WS_H2 = 847 * MiB;
constexpr size_t WS_RSP = WS_MISC + 12 * MiB;
constexpr size_t CTL_SSQ1 = 128 * 1024, CTL_SSQ2 = 384 * 1024, CTL_SSQ3 = 640 * 1024;
constexpr size_t WS_END = 1024 * MiB;
static_assert(WS_W_OUTREC + (size_t)D * D * 2 <= WS_BIG && WS_BIG + 640 * MiB <= WS_MISC && WS_Y + 260 * MiB <= WS_HID && WS_HID + 448 * MiB <= WS_MISC && WS_LBK + 4096 <= WS_END, "d_ws map");
constexpr int CW_BAR = 4096;
constexpr int RING_BYTES = 131072;
constexpr int LDSCTL_OFF = RING_BYTES, MISC_OFF = LDSCTL_OFF + 320;
constexpr int LDS_BYTES = 147456;

#define GAS __attribute__((address_space(1)))
#define LAS __attribute__((address_space(3)))
typedef unsigned short bf16;
typedef unsigned v4u __attribute__((ext_vector_type(4)));
typedef unsigned v2u __attribute__((ext_vector_type(2)));
typedef float f32x4 __attribute__((ext_vector_type(4)));
#define LDS_WAIT() asm volatile("s_waitcnt lgkmcnt(0)" ::: "memory")
__device__ __forceinline__ unsigned f2bf(float f) { unsigned u = __builtin_bit_cast(unsigned, f); return (u + 0x7fffu + ((u >> 16) & 1u)) >> 16; }
__device__ __forceinline__ unsigned pk2(float lo, float hi) { return f2bf(lo) | (f2bf(hi) << 16); }
__device__ __forceinline__ float bflo(unsigned w) { return __builtin_bit_cast(float, w << 16); }
__device__ __forceinline__ float bfhi(unsigned w) { return __builtin_bit_cast(float, w & 0xffff0000u); }
__device__ __forceinline__ float wave_sum(float v) {
#pragma unroll
    for (int o = 1; o < 64; o <<= 1) v += __shfl_xor(v, o);
    return v;
}
#define XB_TMO      128
#define XB_XCNT(j)  (256  + 64 * (j))
#define XB_XSUB(j)  (1280 + 64 * (j))
#define XB_XGEN(j)  (2304 + 64 * (j))
#define XB_TOP      3328
#define XB_TOPGEN   3392
#define XCD_BAR_WORDS 3456
#define XB_SPIN_CAP (1u << 24)

__device__ __forceinline__ unsigned xb_ld(unsigned* p)              { return __hip_atomic_load(p, __ATOMIC_RELAXED, __HIP_MEMORY_SCOPE_AGENT); }
__device__ __forceinline__ unsigned xb_add(unsigned* p, unsigned v) { return __hip_atomic_fetch_add(p, v, __ATOMIC_RELAXED, __HIP_MEMORY_SCOPE_AGENT); }
__device__ __forceinline__ unsigned xb_xcc_id() { return (unsigned)__builtin_amdgcn_s_getreg((3 << 11) | 20) & 0xFu; }
#define XB_SPIN(cond, bar) do { unsigned _sp = 0; while (cond) { __builtin_amdgcn_s_sleep(1); \
    if ((++_sp & 255u) == 0u) { if (xb_ld(&(bar)[XB_TMO])) break; if (_sp > XB_SPIN_CAP) { atomicAdd(&(bar)[XB_TMO], 1u); break; } } } } while (0)

struct XcdBarrier {
    unsigned* bar; unsigned x;
    volatile LAS unsigned* st;
};

__device__ __forceinline__ XcdBarrier xcd_barrier_post(unsigned* bar, volatile LAS unsigned* st) {
    XcdBarrier b; b.bar = bar; b.x = xb_xcc_id(); b.st = st;
    if (threadIdx.x == 0) (void)xb_add(&bar[XB_XCNT(b.x)], 1u);
    return b;
}
__device__ __forceinline__ void xcd_barrier_complete(unsigned* bar, unsigned x, unsigned& nloc, unsigned& nx) {
    const unsigned G = gridDim.x * gridDim.y * gridDim.z;
    unsigned sum, cnt, mine, sp = 0u;
    for (;;) {
        sum = 0u; cnt = 0u; mine = 0u;
#pragma unroll
        for (unsigned j = 0; j < 16; ++j) { const unsigned c = xb_ld(&bar[XB_XCNT(j)]); sum += c; cnt += (c > 0u) ? 1u : 0u; mine = (j == x) ? c : mine; }
        if (sum == G) break;
        __builtin_amdgcn_s_sleep(1);
        if ((++sp & 255u) == 0u) { if (xb_ld(&bar[XB_TMO])) break; if (sp > XB_SPIN_CAP) { atomicAdd(&bar[XB_TMO], 1u); break; } }
    }
    nloc = mine > 0u ? mine : 1u; nx = cnt > 0u ? cnt : 1u;
}

__device__ __forceinline__ void xcd_barrier(const XcdBarrier& b) {
    asm volatile("s_waitcnt vmcnt(0)" ::: "memory");
    __syncthreads();
    if (threadIdx.x == 0) {
        unsigned* bar = b.bar;
        __builtin_amdgcn_s_waitcnt(0);
        unsigned nloc = b.st[0], nx = b.st[1];
        if (nloc == 0u) { xcd_barrier_complete(bar, b.x, nloc, nx); b.st[0] = nloc; b.st[1] = nx; }
        const unsigned old = xb_add(&bar[XB_XSUB(b.x)], 1u);
        const unsigned gen = old / nloc;
        if (old + 1u == (gen + 1u) * nloc) {
            __builtin_amdgcn_fence(__ATOMIC_RELEASE, "agent");
            asm volatile("s_waitcnt vmcnt(0)" ::: "memory");
            const unsigned og = xb_add(&bar[XB_TOP], 1u);
            const unsigned tg = og / nx;
            if (og + 1u == (tg + 1u) * nx) xb_add(&bar[XB_TOPGEN], 1u);
            else XB_SPIN(xb_ld(&bar[XB_TOPGEN]) == tg, bar);
            __builtin_amdgcn_fence(__ATOMIC_ACQUIRE, "agent");
            xb_add(&bar[XB_XGEN(b.x)], 1u);
            asm volatile("s_waitcnt vmcnt(0)" ::: "memory");
        } else {
            XB_SPIN(xb_ld(&bar[XB_XGEN(b.x)]) == gen, bar);
            __builtin_amdgcn_fence(__ATOMIC_ACQUIRE, "agent");
            asm volatile("s_waitcnt vmcnt(0)" ::: "memory");
        }
    }
    __syncthreads();
}
__device__ __forceinline__ void transpose_item(const float* W, int N, bf16* WT, int K, int k0, int n0, int drow0, LAS float* scr, int lane, const float* gk) {
#pragma unroll 8
    for (int i = 0; i < 32; ++i) { const int kk = 2 * i + (lane >> 5); scr[kk * 33 + (lane & 31)] = W[(size_t)(k0 + kk) * N + n0 + (lane & 31)]; }
    LDS_WAIT(); asm volatile("" ::: "memory");
    const int c = lane & 7;
    f32x4 g0 = (f32x4){1.f, 1.f, 1.f, 1.f}, g1 = g0;
    if (gk) { g0 = *(const f32x4*)(gk + k0 + 8 * c); g1 = *(const f32x4*)(gk + k0 + 8 * c + 4); }
#pragma unroll
    for (int j = 0; j < 4; ++j) { const int n = (lane >> 3) + 8 * j; const LAS float* s = scr + (8 * c) * 33 + n;
        v4u o; o.x = pk2(s[0 * 33] * g0.x, s[1 * 33] * g0.y); o.y = pk2(s[2 * 33] * g0.z, s[3 * 33] * g0.w); o.z = pk2(s[4 * 33] * g1.x, s[5 * 33] * g1.y); o.w = pk2(s[6 * 33] * g1.z, s[7 * 33] * g1.w);
        *(v4u*)(WT + (size_t)(drow0 + n) * K + k0 + 8 * c) = o; }
    LDS_WAIT(); asm volatile("" ::: "memory");
}
__device__ __forceinline__ int dest_row(int mode, int n0) {
    if (mode == 0) return n0;
    if (mode == 1) return 256 * (n0 >> 7) + (n0 & 127);
    if (mode == 2) return 256 * (n0 >> 7) + 128 + (n0 & 127);
    const int sec = n0 >> 10, c = n0 & 1023, hd = c >> 7, w = c & 127;
    return ((sec >> 1) ? 2048 : 0) + 256 * hd + ((sec & 1) ? 128 : 0) + w;
}
__device__ __forceinline__ void conv_matrix_item(const float* W, int K, int N, bf16* WT, int mode, int r, LAS float* scr, int lane, const float* gk = nullptr) {
    const int nblk = N / 32, kb = r / nblk, nb = r % nblk;
    transpose_item(W, N, WT, K, 64 * kb, 32 * nb, dest_row(mode, 32 * nb), scr, lane, gk);
}
__device__ __forceinline__ void rms_row_to_bf16(const float* xrow, const float* g, bf16* orow, int lane) {
    const f32x4* xr = (const f32x4*)xrow + lane; const f32x4* gr = (const f32x4*)g + lane;
    f32x4 v[4]; float s = 0.f;
#pragma unroll
    for (int j = 0; j < 4; ++j) { v[j] = xr[64 * j]; s += (v[j].x * v[j].x + v[j].y * v[j].y) + (v[j].z * v[j].z + v[j].w * v[j].w); }
    const float rstd = 1.0f / sqrtf(wave_sum(s) * (1.f / D) + EPS);
    unsigned long long* o8 = (unsigned long long*)orow + lane;
#pragma unroll
    for (int j = 0; j < 4; ++j) { const f32x4 gg = gr[64 * j];
        o8[64 * j] = (unsigned long long)pk2(v[j].x * rstd * gg.x, v[j].y * rstd * gg.y) | ((unsigned long long)pk2(v[j].z * rstd * gg.z, v[j].w * rstd * gg.w) << 32); }
}
__device__ __forceinline__ float inv_freq(int j) {
    return j == 0 ? 1.000000000e+00f : j == 1 ? 1.939227432e-01f : j == 2 ? 3.760603070e-02f : j == 3 ? 7.292664610e-03f : j == 4 ? 1.414213562e-03f : j == 5 ? 2.742481884e-04f : j == 6 ? 5.318295734e-05f : 1.031338525e-05f;
}
struct P0Args { const float *g_ffn0, *g_mix1, *g_ffn1; const float *x, *g0, *w_in_attn, *w_out_attn, *w_in_rec, *w_out_rec, *w_gate, *w_up, *w_down, *w_gate_moe, *w_up_moe, *w_down_moe, *rlb; const int* pos; unsigned char* ws; };
__device__ __forceinline__ void phase_prologue(const P0Args& a, LAS unsigned char* lds, int blk, int G, int tid) {
    const int wave = tid >> 6, lane = tid & 63;
    LAS float* scr = (LAS float*)(lds + wave * 16384);
    const int gw = blk * NWAVES + wave, NGW = G * NWAVES;
    unsigned char* ws = a.ws;
    constexpr int I_INATT = 16 * (QKV_N / 32), I_SQ = 16 * 32, I_GU = 16 * (FF / 32), I_DN = (FF / 64) * 32, I_INREC = 16 * (REC_N / 32);
    constexpr int NITEMS = I_INATT + I_SQ + 2 * I_GU + I_DN + I_INREC + I_SQ + NEXP * (2 * I_GU + I_DN);
    for (int it = gw; it < NITEMS; it += NGW) {
        int r = it;
        if (r < I_INATT) { conv_matrix_item(a.w_in_attn, D, QKV_N, (bf16*)(ws + WS_W_INATT), 0, r, scr, lane); continue; } r -= I_INATT;
        if (r < I_SQ) { conv_matrix_item(a.w_out_attn, D, D, (bf16*)(ws + WS_W_OUTATT), 0, r, scr, lane); continue; } r -= I_SQ;
        if (r < I_GU) { conv_matrix_item(a.w_gate, D, FF, (bf16*)(ws + WS_W_GU), 1, r, scr, lane, a.g_ffn0); continue; } r -= I_GU;
        if (r < I_GU) { conv_matrix_item(a.w_up, D, FF, (bf16*)(ws + WS_W_GU), 2, r, scr, lane, a.g_ffn0); continue; } r -= I_GU;
        if (r < I_DN) { conv_matrix_item(a.w_down, FF, D, (bf16*)(ws + WS_W_DN), 0, r, scr, lane); continue; } r -= I_DN;
        if (r < I_INREC) { conv_matrix_item(a.w_in_rec, D, REC_N, (bf16*)(ws + WS_W_INREC), 3, r, scr, lane, a.g_mix1); continue; } r -= I_INREC;
        if (r < I_SQ) { conv_matrix_item(a.w_out_rec, D, D, (bf16*)(ws + WS_W_OUTREC), 0, r, scr, lane); continue; } r -= I_SQ;
        if (r < NEXP * I_GU) { const int e = r / I_GU, q = r % I_GU; conv_matrix_item(a.w_gate_moe + (size_t)e * D * FF, D, FF, (bf16*)(ws + WS_WMOE_GU) + (size_t)e * 2 * FF * D, 1, q, scr, lane, a.g_ffn1); continue; } r -= NEXP * I_GU;
        if (r < NEXP * I_GU) { const int e = r / I_GU, q = r % I_GU; conv_matrix_item(a.w_up_moe + (size_t)e * D * FF, D, FF, (bf16*)(ws + WS_WMOE_GU) + (size_t)e * 2 * FF * D, 2, q, scr, lane, a.g_ffn1); continue; } r -= NEXP * I_GU;
        { const int e = r / I_DN, q = r % I_DN; conv_matrix_item(a.w_down_moe + (size_t)e * FF * D, FF, D, (bf16*)(ws + WS_WMOE_DN) + (size_t)e * D * FF, 0, q, scr, lane); }
    }
    for (int m = gw; m < NTOK; m += NGW) rms_row_to_bf16(a.x + (size_t)m * D, a.g0, (bf16*)(ws + WS_H) + (size_t)m * D, lane);
    float* rope = (float*)(ws + WS_ROPE);
    for (int i = blk * 512 + tid; i < NTOK * 8; i += G * 512) { const int tok = i >> 3, j = i & 7;
        const float ang = (float)a.pos[tok] * inv_freq(j);
        const double turns = (double)ang * 0.15915494309189533577; const float fr = (float)(turns - __builtin_rint(turns));
        rope[tok * 16 + j] = __builtin_amdgcn_cosf(fr); rope[tok * 16 + 8 + j] = __builtin_amdgcn_sinf(fr); }
    float* lbk = (float*)(ws + WS_LBK);
    for (int i = blk * 512 + tid; i < 1024; i += G * 512) lbk[i] = 1.0f / (1.0f + __expf(a.rlb[1024 + i] - a.rlb[i]));
}
__device__ __forceinline__ void phase_rope(bf16* qkv, const float* rope, int blk, int G, int tid) {
    for (int i = blk * 512 + tid; i < NTOK * 26; i += G * 512) {
        const int tok = i / 26, hx = i % 26;
        const int col = hx < 8 ? hx * 64 : hx < 16 ? 512 + (hx - 8) * 64 : hx < 24 ? 1536 + (hx - 16) * 64 : 2048 + (hx - 24) * 64;
        v4u* p = (v4u*)(qkv + (size_t)tok * QKV_N + col);
        const v4u a = p[0], b = p[1];
        const f32x4* t = (const f32x4*)(rope + (size_t)tok * 16);
        const f32x4 c0 = t[0], c1 = t[1], s0 = t[2], s1 = t[3];
        const float x1[8] = {bflo(a.x), bfhi(a.x), bflo(a.y), bfhi(a.y), bflo(a.z), bfhi(a.z), bflo(a.w), bfhi(a.w)};
        const float x2[8] = {bflo(b.x), bfhi(b.x), bflo(b.y), bfhi(b.y), bflo(b.z), bfhi(b.z), bflo(b.w), bfhi(b.w)};
        const float cs[8] = {c0.x, c0.y, c0.z, c0.w, c1.x, c1.y, c1.z, c1.w}, sn[8] = {s0.x, s0.y, s0.z, s0.w, s1.x, s1.y, s1.z, s1.w};
        float y1[8], y2[8];
#pragma unroll
        for (int j = 0; j < 8; ++j) { y1[j] = x1[j] * cs[j] - x2[j] * sn[j]; y2[j] = x2[j] * cs[j] + x1[j] * sn[j]; }
        v4u oa, ob; oa.x = pk2(y1[0], y1[1]); oa.y = pk2(y1[2], y1[3]); oa.z = pk2(y1[4], y1[5]); oa.w = pk2(y1[6], y1[7]);
        ob.x = pk2(y2[0], y2[1]); ob.y = pk2(y2[2], y2[3]); ob.z = pk2(y2[4], y2[5]); ob.w = pk2(y2[6], y2[7]);
        p[0] = oa; p[1] = ob;
    }
}
__device__ __forceinline__ void attn_key(const bf16* krow, const bf16* vrow, const float (&q)[64], float (&o)[64], float& m, float& l) {
    float s = 0.f;
#pragma unroll
    for (int c = 0; c < 8; ++c) { const v4u kv = *(const v4u*)(krow + 8 * c);
        s += q[8 * c + 0] * bflo(kv.x) + q[8 * c + 1] * bfhi(kv.x) + q[8 * c + 2] * bflo(kv.y) + q[8 * c + 3] * bfhi(kv.y)
           + q[8 * c + 4] * bflo(kv.z) + q[8 * c + 5] * bfhi(kv.z) + q[8 * c + 6] * bflo(kv.w) + q[8 * c + 7] * bfhi(kv.w); }
    s *= 0.125f;
    const float mn = fmaxf(m, s), sc = __expf(m - mn), p = __expf(s - mn);
    l = l * sc + p; m = mn;
#pragma unroll
    for (int c = 0; c < 8; ++c) { const v4u vv = *(const v4u*)(vrow + 8 * c);
        o[8 * c + 0] = o[8 * c + 0] * sc + p * bflo(vv.x); o[8 * c + 1] = o[8 * c + 1] * sc + p * bfhi(vv.x);
        o[8 * c + 2] = o[8 * c + 2] * sc + p * bflo(vv.y); o[8 * c + 3] = o[8 * c + 3] * sc + p * bfhi(vv.y);
        o[8 * c + 4] = o[8 * c + 4] * sc + p * bflo(vv.z); o[8 * c + 5] = o[8 * c + 5] * sc + p * bfhi(vv.z);
        o[8 * c + 6] = o[8 * c + 6] * sc + p * bflo(vv.w); o[8 * c + 7] = o[8 * c + 7] * sc + p * bfhi(vv.w); }
}
__device__ __forceinline__ void phase_attn_naive(const bf16* qkv, const float* sinks, bf16* mix, int blk, int G, int tid) {
    for (int idx = blk * 512 + tid; idx < NTOK * 16; idx += G * 512) {
        const int hx = idx >> 16, tok = idx & 65535, b = tok >> 13, s = tok & 8191;
        const bool isB = hx >= 8; const int qh = hx - 8;
        const int qcol = isB ? 1536 + qh * 64 : hx * 64, kcol = isB ? 2048 + (qh >> 2) * 64 : 512 + hx * 64, vcol = isB ? 2176 + (qh >> 2) * 64 : 1024 + hx * 64, ocol = isB ? 512 + qh * 64 : hx * 64;
        float q[64], o[64]; float m = -INFINITY, l = 0.f;
        { const bf16* qp = qkv + (size_t)tok * QKV_N + qcol;
#pragma unroll
          for (int c = 0; c < 8; ++c) { const v4u w = *(const v4u*)(qp + 8 * c); q[8 * c] = bflo(w.x); q[8 * c + 1] = bfhi(w.x); q[8 * c + 2] = bflo(w.y); q[8 * c + 3] = bfhi(w.y); q[8 * c + 4] = bflo(w.z); q[8 * c + 5] = bfhi(w.z); q[8 * c + 6] = bflo(w.w); q[8 * c + 7] = bfhi(w.w); } }
#pragma unroll
        for (int i = 0; i < 64; ++i) o[i] = 0.f;
        const bf16* rb = qkv + (size_t)(b * SEQ) * QKV_N;
        if (!isB) {
            for (int jj = 0; jj < 387; ++jj) { const int d = jj < 129 ? 1 : jj < 258 ? 4 : 16, j = jj < 129 ? jj : jj < 258 ? jj - 129 : jj - 258;
                const int kt = s - d * j; if (kt < 0) continue;
                const bf16* r = rb + (size_t)kt * QKV_N; attn_key(r + kcol, r + vcol, q, o, m, l); }
        } else {
            for (int j = 0; j < 128; ++j) { const int kt = s - j; if (kt < 0) break;
                const bf16* r = rb + (size_t)kt * QKV_N; attn_key(r + kcol, r + vcol, q, o, m, l); }
            const float sk = sinks[qh]; const float mn = fmaxf(m, sk), sc = __expf(m - mn);
            l = l * sc + __expf(sk - mn); m = mn;
#pragma unroll
            for (int i = 0; i < 64; ++i) o[i] *= sc;
        }
        const float rl = 1.0f / l;
        v4u* op = (v4u*)(mix + (size_t)tok * D + ocol);
#pragma unroll
        for (int c = 0; c < 8; ++c) { v4u w; w.x = pk2(o[8 * c] * rl, o[8 * c + 1] * rl); w.y = pk2(o[8 * c + 2] * rl, o[8 * c + 3] * rl); w.z = pk2(o[8 * c + 4] * rl, o[8 * c + 5] * rl); w.w = pk2(o[8 * c + 6] * rl, o[8 * c + 7] * rl); op[c] = w; }
    }
}
__device__ __forceinline__ void phase_norm(const float* x, const float* g, bf16* out, int blk, int G, int tid) {
    const int wave = tid >> 6, lane = tid & 63;
    for (int m = blk * NWAVES + wave; m < NTOK; m += G * NWAVES) rms_row_to_bf16(x + (size_t)m * D, g, out + (size_t)m * D, lane);
}
typedef float f32x16 __attribute__((ext_vector_type(16)));
typedef short bf16x8v __attribute__((ext_vector_type(8)));
typedef short s16x4 __attribute__((ext_vector_type(4)));
typedef short v4i16_t __attribute__((ext_vector_type(4)));
__device__ __forceinline__ int crow(int r, int hi) { return (r & 3) + 8 * (r >> 2) + 4 * hi; }
__device__ __forceinline__ s16x4 vtr(const LAS unsigned char* p) { return __builtin_bit_cast(s16x4, __builtin_amdgcn_ds_read_tr16_b64_v4i16((LAS v4i16_t*)p)); }
struct AttnSub { int b, dstride, r, P0, qcol, kcol, vcol, mode, hx; };
__device__ __forceinline__ void attn_subunit(const AttnSub su, const bf16* qkv, const float* sinks, bf16* mix, bf16* OB, float* LSE, LAS unsigned char* lh, int t256, int hw, int lane) {
    const int r32 = lane & 31, hi = lane >> 5;
    const size_t rowb = (size_t)su.b * SEQ;
    {
        const int c = t256 & 7, k0 = t256 >> 3;
        v4u kreg[8], vreg[8];
#pragma unroll
        for (int i = 0; i < 8; ++i) { const int key = k0 + 32 * i, pos = su.P0 - 128 + key;
            if (pos >= 0) { const bf16* rp = qkv + (rowb + su.r + (size_t)su.dstride * pos) * QKV_N; kreg[i] = *(const v4u*)(rp + su.kcol + 8 * c); vreg[i] = *(const v4u*)(rp + su.vcol + 8 * c); }
            else { kreg[i] = (v4u){0u, 0u, 0u, 0u}; vreg[i] = kreg[i]; } }
#pragma unroll
        for (int i = 0; i < 8; ++i) { const int key = k0 + 32 * i;
            *(LAS v4u*)(lh + key * 128 + ((c ^ (key & 7)) * 16)) = kreg[i];
            *(LAS v4u*)(lh + 32768 + (c >> 2) * 16384 + key * 64 + (c & 3) * 16) = vreg[i]; }
    }
    const int qpos = su.P0 + 32 * hw + r32;
    const size_t qrow = rowb + su.r + (size_t)su.dstride * qpos;
    bf16x8v qf[4];
#pragma unroll
    for (int ks = 0; ks < 4; ++ks) qf[ks] = *(const bf16x8v*)(qkv + qrow * QKV_N + su.qcol + 16 * ks + 8 * hi);
    __syncthreads();
    f32x16 oT[2]; oT[0] = (f32x16){}; oT[1] = (f32x16){};
    float m = -1e30f, l = 0.f;
    const float C = 0.125f * 1.4426950408889634f;
    const int mlo = (su.mode == 3) ? 1 : 0;
    int kt = hw; if (su.P0 == 0 && kt < 4) kt = 4;
    for (; kt <= hw + 4; ++kt) {
        f32x16 s = (f32x16){};
        const LAS unsigned char* kb = lh + (32 * kt + r32) * 128; const int sw = r32 & 7;
#pragma unroll
        for (int ks = 0; ks < 4; ++ks) { const bf16x8v kf = *(const LAS bf16x8v*)(kb + (((2 * ks + hi) ^ sw) * 16)); s = __builtin_amdgcn_mfma_f32_32x32x16_bf16(kf, qf[ks], s, 0, 0, 0); }
        if (kt == hw) {
#pragma unroll
            for (int r = 0; r < 16; ++r) if (crow(r, hi) < r32 + mlo) s[r] = -INFINITY; }
        if (kt == hw + 4) {
#pragma unroll
            for (int r = 0; r < 16; ++r) if (crow(r, hi) > r32) s[r] = -INFINITY; }
        float mx = s[0];
#pragma unroll
        for (int r = 1; r < 16; ++r) mx = fmaxf(mx, s[r]);
        mx = fmaxf(mx, __shfl_xor(mx, 32));
        const float mn = fmaxf(m, mx), alpha = __builtin_amdgcn_exp2f((m - mn) * C);
        float ls = 0.f; f32x16 p;
#pragma unroll
        for (int r = 0; r < 16; ++r) { p[r] = __builtin_amdgcn_exp2f((s[r] - mn) * C); ls += p[r]; }
        l = l * alpha + ls; m = mn;
#pragma unroll
        for (int r = 0; r < 16; ++r) { oT[0][r] *= alpha; oT[1][r] *= alpha; }
        v4u pw0, pw1;
        pw0.x = pk2(p[0], p[1]); pw0.y = pk2(p[2], p[3]); pw0.z = pk2(p[4], p[5]); pw0.w = pk2(p[6], p[7]);
        pw1.x = pk2(p[8], p[9]); pw1.y = pk2(p[10], p[11]); pw1.z = pk2(p[12], p[13]); pw1.w = pk2(p[14], p[15]);
        const bf16x8v pa0 = __builtin_bit_cast(bf16x8v, pw0), pa1 = __builtin_bit_cast(bf16x8v, pw1);
        const LAS unsigned char* vb = lh + 32768 + (32 * kt + 4 * hi + ((lane & 15) >> 2)) * 64 + ((lane >> 4) & 1) * 32 + (lane & 3) * 8;
#pragma unroll
        for (int dt = 0; dt < 2; ++dt) {
            const s16x4 a0 = vtr(vb + dt * 16384), a1 = vtr(vb + dt * 16384 + 512), b0 = vtr(vb + dt * 16384 + 1024), b1 = vtr(vb + dt * 16384 + 1536);
            const bf16x8v vf0 = (bf16x8v){a0[0], a0[1], a0[2], a0[3], a1[0], a1[1], a1[2], a1[3]}, vf1 = (bf16x8v){b0[0], b0[1], b0[2], b0[3], b1[0], b1[1], b1[2], b1[3]};
            oT[dt] = __builtin_amdgcn_mfma_f32_32x32x16_bf16(vf0, pa0, oT[dt], 0, 0, 0);
            oT[dt] = __builtin_amdgcn_mfma_f32_32x32x16_bf16(vf1, pa1, oT[dt], 0, 0, 0);
        }
    }
    float lt = l + __shfl_xor(l, 32);
    if (su.mode == 3) { const float sraw = 8.0f * sinks[su.hx]; const float mn = fmaxf(m, sraw), alpha = __builtin_amdgcn_exp2f((m - mn) * C);
        lt = lt * alpha + __builtin_amdgcn_exp2f((sraw - mn) * C); m = mn;
#pragma unroll
        for (int r = 0; r < 16; ++r) { oT[0][r] *= alpha; oT[1][r] *= alpha; } }
    const float inv = 1.0f / lt;
    if (su.mode < 2) {
        bf16* ob = OB + (size_t)su.mode * NTOK * 512 + qrow * 512 + su.hx * 64;
#pragma unroll
        for (int dt = 0; dt < 2; ++dt)
#pragma unroll
            for (int g = 0; g < 4; ++g) { v2u w; w.x = pk2(oT[dt][4 * g] * inv, oT[dt][4 * g + 1] * inv); w.y = pk2(oT[dt][4 * g + 2] * inv, oT[dt][4 * g + 3] * inv); *(v2u*)(ob + 32 * dt + 8 * g + 4 * hi) = w; }
        if (hi == 0) LSE[(size_t)su.mode * NTOK * 8 + qrow * 8 + su.hx] = 0.125f * m + __logf(lt);
    } else if (su.mode == 2) {
        const float l3 = 0.125f * m + __logf(lt), l1 = LSE[qrow * 8 + su.hx], l2 = LSE[(size_t)NTOK * 8 + qrow * 8 + su.hx];
        const float M = fmaxf(l3, fmaxf(l1, l2)); float w1 = __expf(l1 - M), w2 = __expf(l2 - M), w3 = __expf(l3 - M);
        const float ws = 1.0f / (w1 + w2 + w3); w1 *= ws; w2 *= ws; w3 *= ws * inv;
        const bf16* o1 = OB + qrow * 512 + su.hx * 64; const bf16* o2 = o1 + (size_t)NTOK * 512;
        bf16* mp = mix + qrow * D + su.hx * 64;
#pragma unroll
        for (int dt = 0; dt < 2; ++dt)
#pragma unroll
            for (int g = 0; g < 4; ++g) { const int dd = 32 * dt + 8 * g + 4 * hi; const v2u a = *(const v2u*)(o1 + dd), b = *(const v2u*)(o2 + dd);
                v2u w; w.x = pk2(w1 * bflo(a.x) + w2 * bflo(b.x) + w3 * oT[dt][4 * g], w1 * bfhi(a.x) + w2 * bfhi(b.x) + w3 * oT[dt][4 * g + 1]);
                w.y = pk2(w1 * bflo(a.y) + w2 * bflo(b.y) + w3 * oT[dt][4 * g + 2], w1 * bfhi(a.y) + w2 * bfhi(b.y) + w3 * oT[dt][4 * g + 3]); *(v2u*)(mp + dd) = w; }
    } else {
        bf16* mp = mix + qrow * D + 512 + su.hx * 64;
#pragma unroll
        for (int dt = 0; dt < 2; ++dt)
#pragma unroll
            for (int g = 0; g < 4; ++g) { v2u w; w.x = pk2(oT[dt][4 * g] * inv, oT[dt][4 * g + 1] * inv); w.y = pk2(oT[dt][4 * g + 2] * inv, oT[dt][4 * g + 3] * inv); *(v2u*)(mp + 32 * dt + 8 * g + 4 * hi) = w; }
    }
    asm volatile("s_waitcnt vmcnt(0)" ::: "memory");
    __syncthreads();
}
__device__ __forceinline__ void phase_attn(const bf16* qkv, const float* sinks, bf16* mix, bf16* OB, float* LSE, LAS unsigned char* lds, int blk, int G, int tid) {
    const int wave = tid >> 6, lane = tid & 63, hf = wave >> 2, hw = wave & 3, t256 = tid & 255;
    LAS unsigned char* lh = lds + hf * 65536;
    for (int ai = blk; ai < 256; ai += G) {
        const int b = ai >> 5, h = (ai >> 2) & 7, T0 = (ai & 3) * 2048;
        for (int pp = 0; pp < 24; ++pp) {
            const int su = 2 * pp + hf, br = su >> 4, k = su & 15;
            AttnSub s; s.b = b; s.hx = h; s.qcol = h * 64; s.kcol = 512 + h * 64; s.vcol = 1024 + h * 64; s.mode = br;
            if (br == 0) { s.dstride = 1; s.r = 0; s.P0 = T0 + 128 * k; }
            else if (br == 1) { s.dstride = 4; s.r = k >> 2; s.P0 = (T0 >> 2) + 128 * (k & 3); }
            else { s.dstride = 16; s.r = k; s.P0 = T0 >> 4; }
            attn_subunit(s, qkv, sinks, mix, OB, LSE, lh, t256, hw, lane);
        }
    }
    for (int bp = blk; bp < 2048; bp += G) {
        const int b = bp >> 8, nb = (bp >> 2) & 63, kv = (bp >> 1) & 1, qh = kv * 4 + 2 * (bp & 1) + hf;
        AttnSub s; s.b = b; s.hx = qh; s.qcol = 1536 + qh * 64; s.kcol = 2048 + kv * 64; s.vcol = 2176 + kv * 64; s.mode = 3; s.dstride = 1; s.r = 0; s.P0 = 128 * nb;
        attn_subunit(s, qkv, sinks, mix, OB, LSE, lh, t256, hw, lane);
    }
}
__device__ __forceinline__ void phase_hgrn_naive(const bf16* Qp, const bf16* Kp, const bf16* Vp, bf16* Oraw, LAS unsigned char* lds, int blk, int G, int tid) {
    LAS float* sq = (LAS float*)lds; LAS float* sk = sq + 2048; LAS float* sf = sk + 2048; LAS float* sv = sf + 2048; LAS float* part = sv + 2048;
    const int v = tid & 127, kq = tid >> 7;
    const int lr = tid >> 5, lc = (tid & 31) * 4;
    for (int bh = blk; bh < BATCH * 8; bh += G) {
        const int b = bh >> 3, h = bh & 7;
        float S[32];
#pragma unroll
        for (int i = 0; i < 32; ++i) S[i] = 0.f;
        for (int t0 = 0; t0 < SEQ; t0 += 16) {
            const size_t base = (size_t)(b * SEQ + t0 + lr) * D + h * 128 + lc;
            { const v2u w = *(const v2u*)(Qp + base); *(LAS f32x4*)(sq + lr * 128 + lc) = (f32x4){bflo(w.x), bfhi(w.x), bflo(w.y), bfhi(w.y)}; }
            { const v2u w = *(const v2u*)(Kp + base); const f32x4 kk = (f32x4){bflo(w.x), bfhi(w.x), bflo(w.y), bfhi(w.y)}; *(LAS f32x4*)(sk + lr * 128 + lc) = kk; *(LAS f32x4*)(sf + lr * 128 + lc) = (f32x4){1.f - kk.x, 1.f - kk.y, 1.f - kk.z, 1.f - kk.w}; }
            { const v2u w = *(const v2u*)(Vp + base); *(LAS f32x4*)(sv + lr * 128 + lc) = (f32x4){bflo(w.x), bfhi(w.x), bflo(w.y), bfhi(w.y)}; }
            __syncthreads();
            for (int t = 0; t < 16; ++t) {
                const float vt = sv[t * 128 + v]; float po = 0.f;
#pragma unroll
                for (int i4 = 0; i4 < 8; ++i4) { const int kx = t * 128 + kq * 32 + i4 * 4;
                    const f32x4 q4 = *(const LAS f32x4*)(sq + kx), k4 = *(const LAS f32x4*)(sk + kx), f4 = *(const LAS f32x4*)(sf + kx);
#pragma unroll
                    for (int j = 0; j < 4; ++j) { S[i4 * 4 + j] = f4[j] * S[i4 * 4 + j] + k4[j] * vt; po += q4[j] * S[i4 * 4 + j]; } }
                part[(t * 4 + kq) * 128 + v] = po;
            }
            __syncthreads();
            { const f32x4 p0 = *(const LAS f32x4*)(part + (lr * 4 + 0) * 128 + lc), p1 = *(const LAS f32x4*)(part + (lr * 4 + 1) * 128 + lc), p2 = *(const LAS f32x4*)(part + (lr * 4 + 2) * 128 + lc), p3 = *(const LAS f32x4*)(part + (lr * 4 + 3) * 128 + lc);
              const f32x4 r = (p0 + p1) + (p2 + p3); v2u w; w.x = pk2(r.x, r.y); w.y = pk2(r.z, r.w); *(v2u*)(Oraw + base) = w; }
        }
        __syncthreads();
    }
}
__device__ __forceinline__ void phase_gate(bf16* O, const bf16* Gp, const float* norm_g, int blk, int G, int tid) {
    const int wave = tid >> 6, lane = tid & 63;
    for (int m = blk * NWAVES + wave; m < NTOK; m += G * NWAVES) {
        v4u* op = (v4u*)(O + (size_t)m * D + lane * 16); const v4u* gp = (const v4u*)(Gp + (size_t)m * D + lane * 16);
        const v4u a = op[0], b = op[1], ga = gp[0], gb = gp[1];
        float x[16] = {bflo(a.x), bfhi(a.x), bflo(a.y), bfhi(a.y), bflo(a.z), bfhi(a.z), bflo(a.w), bfhi(a.w), bflo(b.x), bfhi(b.x), bflo(b.y), bfhi(b.y), bflo(b.z), bfhi(b.z), bflo(b.w), bfhi(b.w)};
        const float gg[16] = {bflo(ga.x), bfhi(ga.x), bflo(ga.y), bfhi(ga.y), bflo(ga.z), bfhi(ga.z), bflo(ga.w), bfhi(ga.w), bflo(gb.x), bfhi(gb.x), bflo(gb.y), bfhi(gb.y), bflo(gb.z), bfhi(gb.z), bflo(gb.w), bfhi(gb.w)};
        float ss = 0.f;
#pragma unroll
        for (int i = 0; i < 16; ++i) ss += x[i] * x[i];
        ss += __shfl_xor(ss, 1); ss += __shfl_xor(ss, 2); ss += __shfl_xor(ss, 4);
        const float rstd = 1.0f / sqrtf(ss * (1.f / 128.f) + EPS);
        const f32x4* ng = (const f32x4*)(norm_g + lane * 16);
        float y[16];
#pragma unroll
        for (int i4 = 0; i4 < 4; ++i4) { const f32x4 n4 = ng[i4];
#pragma unroll
            for (int j = 0; j < 4; ++j) y[i4 * 4 + j] = x[i4 * 4 + j] * rstd * n4[j] * gg[i4 * 4 + j]; }
        v4u oa, ob; oa.x = pk2(y[0], y[1]); oa.y = pk2(y[2], y[3]); oa.z = pk2(y[4], y[5]); oa.w = pk2(y[6], y[7]);
        ob.x = pk2(y[8], y[9]); ob.y = pk2(y[10], y[11]); ob.z = pk2(y[12], y[13]); ob.w = pk2(y[14], y[15]);
        op[0] = oa; op[1] = ob;
    }
}
__device__ __forceinline__ void phase_router(const float* x, const float* g, const float* w_router, const unsigned* ssq, int4* meta, int* hist, LAS unsigned char* lds, int blk, int G, int tid) {
    const int wave = tid >> 6, lane = tid & 63;
    LAS float* swr = (LAS float*)lds;
    LAS int* scnt = (LAS int*)(lds + 32768);
    for (int i = tid; i < 8192; i += 512) swr[i] = w_router[i] * g[i >> 3];
    __syncthreads();
    for (int tb = blk; tb < 256; tb += G) {
        if (tid < 8) scnt[tid] = 0;
        __syncthreads();
        int c0 = 0, c1 = 0, c2 = 0, c3 = 0, c4 = 0, c5 = 0, c6 = 0, c7 = 0;
        for (int i = 0; i < 32; i += 2) {
            float lg[2][8];
#pragma unroll
            for (int t2 = 0; t2 < 2; ++t2) { const int tok = tb * 256 + wave * 32 + i + t2;
                const f32x4* xr = (const f32x4*)(x + (size_t)tok * D) + lane;
                f32x4 v[4];
#pragma unroll
                for (int j = 0; j < 4; ++j) v[j] = xr[64 * j];
#pragma unroll
                for (int e = 0; e < 8; ++e) lg[t2][e] = 0.f;
#pragma unroll
                for (int j = 0; j < 4; ++j)
#pragma unroll
                    for (int c = 0; c < 4; ++c) { const float hv = v[j][c]; const int d = 256 * j + 4 * lane + c;
                        const f32x4 w0 = *(const LAS f32x4*)(swr + d * 8), w1 = *(const LAS f32x4*)(swr + d * 8 + 4);
                        lg[t2][0] += hv * w0.x; lg[t2][1] += hv * w0.y; lg[t2][2] += hv * w0.z; lg[t2][3] += hv * w0.w; lg[t2][4] += hv * w1.x; lg[t2][5] += hv * w1.y; lg[t2][6] += hv * w1.z; lg[t2][7] += hv * w1.w; } }
#pragma unroll
            for (int t2 = 0; t2 < 2; ++t2) { const int tok = tb * 256 + wave * 32 + i + t2;
                const float rstd = 1.0f / sqrtf((float)ssq[tok] * (1.f / (1024.f * 65536.f)) + EPS);
#pragma unroll
                for (int e = 0; e < 8; ++e) lg[t2][e] = wave_sum(lg[t2][e]) * rstd;
                int e0 = 0; float v0 = lg[t2][0];
#pragma unroll
                for (int e = 1; e < 8; ++e) if (lg[t2][e] > v0) { v0 = lg[t2][e]; e0 = e; }
                int e1 = -1; float v1 = -INFINITY;
#pragma unroll
                for (int e = 0; e < 8; ++e) if (e != e0 && lg[t2][e] > v1) { v1 = lg[t2][e]; e1 = e; }
                const float g1 = 1.0f / (1.0f + __expf(v0 - v1)), g0 = 1.0f - g1;
                if (lane == 0) meta[tok] = make_int4(e0, e1, __builtin_bit_cast(int, g0), __builtin_bit_cast(int, g1));
                c0 += (e0 == 0) + (e1 == 0); c1 += (e0 == 1) + (e1 == 1); c2 += (e0 == 2) + (e1 == 2); c3 += (e0 == 3) + (e1 == 3);
                c4 += (e0 == 4) + (e1 == 4); c5 += (e0 == 5) + (e1 == 5); c6 += (e0 == 6) + (e1 == 6); c7 += (e0 == 7) + (e1 == 7); }
        }
        if (lane == 0) { const int cc[8] = {c0, c1, c2, c3, c4, c5, c6, c7};
#pragma unroll
            for (int e = 0; e < 8; ++e) __hip_atomic_fetch_add(&scnt[e], cc[e], __ATOMIC_RELAXED, __HIP_MEMORY_SCOPE_WORKGROUP); }
        __syncthreads();
        if (tid < 8) hist[tb * 8 + tid] = scnt[tid];
        __syncthreads();
    }
}
__device__ __forceinline__ void phase_scatter(const bf16* hb, const unsigned* ssq, const int4* meta, const int* hist, int* dest, int* info, bf16* perm, float* rsp, LAS unsigned char* lds, int blk, int G, int tid) {
    const int wave = tid >> 6, lane = tid & 63;
    LAS int* shist = (LAS int*)lds;
    LAS int* ssize = shist + 2048; LAS int* sbpre = ssize + 8; LAS int* spst = sbpre + 8; LAS int* sntl = spst + 8;
    LAS int* se = sntl + 8; LAS int* sdest = se + 512;
    for (int tb = blk; tb < 256; tb += G) {
        for (int i = tid; i < 2048; i += 512) shist[i] = hist[i];
        __syncthreads();
        if (tid < 8) { int sz = 0, bp = 0; for (int b = 0; b < 256; ++b) { const int hv = shist[b * 8 + tid]; sz += hv; bp += (b < tb) ? hv : 0; } ssize[tid] = sz; sbpre[tid] = bp; }
        __syncthreads();
        if (tid == 0) { int ts = 0; for (int e = 0; e < 8; ++e) { const int nt = (ssize[e] + 255) >> 8; spst[e] = ts * 256; sntl[e] = nt; ts += nt; if (tb == 0) info[e] = ts; } if (tb == 0) info[8] = ts; }
        { const int4 mt = meta[tb * 256 + (tid >> 1)]; se[tid] = (tid & 1) ? mt.y : mt.x; }
        __syncthreads();
        { const int e = se[tid]; int rank = 0; for (int p = 0; p < tid; ++p) rank += (se[p] == e) ? 1 : 0;
          const int dd = spst[e] + sbpre[e] + rank; sdest[tid] = dd; dest[(tb * 256) * 2 + tid] = dd;
          rsp[dd] = 1.0f / sqrtf((float)ssq[tb * 256 + (tid >> 1)] * (1.f / (1024.f * 65536.f)) + EPS); }
        __syncthreads();
        for (int i = 0; i < 32; i += 4) {
            v4u ra[4], rb[4];
#pragma unroll
            for (int q = 0; q < 4; ++q) { const v4u* src = (const v4u*)(hb + (size_t)(tb * 256 + wave * 32 + i + q) * D) + lane; ra[q] = src[0]; rb[q] = src[64]; }
#pragma unroll
            for (int q = 0; q < 4; ++q) { const int lt = wave * 32 + i + q;
                v4u* o0 = (v4u*)(perm + (size_t)sdest[2 * lt] * D) + lane; v4u* o1 = (v4u*)(perm + (size_t)sdest[2 * lt + 1] * D) + lane;
                o0[0] = ra[q]; o0[64] = rb[q]; o1[0] = ra[q]; o1[64] = rb[q]; } }
        if (tb < 8) { const int r0 = spst[tb] + ssize[tb], r1 = spst[tb] + sntl[tb] * 256;
            for (int r = r0 + wave; r < r1; r += NWAVES) { v4u* o = (v4u*)(perm + (size_t)r * D) + lane; o[0] = (v4u){0u, 0u, 0u, 0u}; o[64] = (v4u){0u, 0u, 0u, 0u}; if (lane == 0) rsp[r] = 0.f; } }
        __syncthreads();
    }
}
__device__ __forceinline__ void phase_combine(float* x, const bf16* y, const int4* meta, const int* dest, const float* gf, int blk, int G, int tid) {
    const int wave = tid >> 6, lane = tid & 63; const int stride = G * NWAVES;
    for (int m0 = blk * NWAVES + wave; m0 < NTOK; m0 += 2 * stride) {
        f32x4 v[2][4]; v2u ya[2][4], yb[2][4]; float g0[2], g1[2]; bool ok[2];
#pragma unroll
        for (int t = 0; t < 2; ++t) { const int m = m0 + t * stride; ok[t] = m < NTOK; const int mm = ok[t] ? m : m0;
            const int4 mt = meta[mm]; g0[t] = __builtin_bit_cast(float, mt.z); g1[t] = __builtin_bit_cast(float, mt.w);
            const int d0 = dest[2 * mm], d1 = dest[2 * mm + 1];
            const f32x4* xr = (const f32x4*)(x + (size_t)mm * D) + lane;
            const v2u* y0 = (const v2u*)(y + (size_t)d0 * D) + lane; const v2u* y1 = (const v2u*)(y + (size_t)d1 * D) + lane;
#pragma unroll
            for (int j = 0; j < 4; ++j) { v[t][j] = xr[64 * j]; ya[t][j] = y0[64 * j]; yb[t][j] = y1[64 * j]; } }
#pragma unroll
        for (int t = 0; t < 2; ++t) { const int m = m0 + t * stride; float s = 0.f;
#pragma unroll
            for (int j = 0; j < 4; ++j) { const v2u a = ya[t][j], b = yb[t][j]; f32x4 q = v[t][j];
                q.x += g0[t] * bflo(a.x) + g1[t] * bflo(b.x); q.y += g0[t] * bfhi(a.x) + g1[t] * bfhi(b.x); q.z += g0[t] * bflo(a.y) + g1[t] * bflo(b.y); q.w += g0[t] * bfhi(a.y) + g1[t] * bfhi(b.y);
                v[t][j] = q; s += (q.x * q.x + q.y * q.y) + (q.z * q.z + q.w * q.w); }
            const float rstd = 1.0f / sqrtf(wave_sum(s) * (1.f / D) + EPS);
            if (ok[t]) { f32x4* xo = (f32x4*)(x + (size_t)m * D) + lane; const f32x4* gr = (const f32x4*)gf + lane;
#pragma unroll
                for (int j = 0; j < 4; ++j) { const f32x4 gg = gr[64 * j]; xo[64 * j] = (f32x4){v[t][j].x * rstd * gg.x, v[t][j].y * rstd * gg.y, v[t][j].z * rstd * gg.z, v[t][j].w * rstd * gg.w}; } } }
    }
}
constexpr int HG_NSEG = 4, HG_CPS = 32;
constexpr int HG_QE = 0, HG_KI = 16384, HG_KE = 32768, HG_V = 49152, HG_ST = 65536, HG_DK = 132096, HG_SSQ = 132608, HG_NG = 133632;
__device__ __forceinline__ void phase_hgrn(const bf16* QE, const bf16* KI, const bf16* KE, const bf16* Vp, const bf16* Gp, const float* DK, const float* norm_g, bf16* Og, const float* HL, const float* HP, LAS unsigned char* lds, int blk, int G, int tid) {
    const int wave = tid >> 6, lane = tid & 63, r32 = lane & 31, hi = lane >> 5, tb = wave >> 2, vb = wave & 3;
    const int sw = r32 & 15;
    const int trl = (4 * hi + ((lane & 15) >> 2)) * 64 + ((lane >> 4) & 1) * 32 + (lane & 3) * 8;
    LAS float* dk_l = (LAS float*)(lds + HG_DK); LAS float* ssq = (LAS float*)(lds + HG_SSQ);
    for (int un = blk; un < BATCH * 8 * HG_NSEG; un += G) {
        const int bh = un >> 2, seg = un & 3, b = bh >> 3, h = bh & 7, c0 = seg * HG_CPS;
        f32x16 S0 = (f32x16){}, S1 = (f32x16){};
        {
            const float* L = HL + (size_t)bh * 3 * 16384; const float* Pt = HP + (size_t)bh * 3 * 128;
            LAS float* sl = (LAS float*)lds;
#pragma unroll 2
            for (int i = 0; i < 8; ++i) { const int idx = (tid + 512 * i) * 4, k = idx >> 7; f32x4 a = (f32x4){0.f, 0.f, 0.f, 0.f};
                if (seg > 0) a = *(const f32x4*)(L + idx);
                if (seg > 1) a = a * Pt[128 + k] + *(const f32x4*)(L + 16384 + idx);
                if (seg > 2) a = a * Pt[256 + k] + *(const f32x4*)(L + 32768 + idx);
                *(LAS f32x4*)(sl + idx) = a; }
            __syncthreads();
#pragma unroll
            for (int i = 0; i < 2; ++i) { const int kb = 2 * tb + i; f32x16 S;
#pragma unroll
                for (int r = 0; r < 16; ++r) S[r] = sl[(32 * kb + crow(r, hi)) * 128 + 32 * vb + r32];
#pragma unroll
                for (int g = 0; g < 4; ++g) { v2u w; w.x = pk2(S[4 * g], S[4 * g + 1]); w.y = pk2(S[4 * g + 2], S[4 * g + 3]);
                    *(LAS v2u*)(lds + HG_ST + (32 * vb + r32) * 256 + (((4 * kb + g) ^ sw) * 16) + hi * 8) = w; }
                if (i) S1 = S; else S0 = S; }
            __syncthreads();
        }
        if (tid < 32) *(LAS f32x4*)(lds + HG_NG + tid * 16) = *(const f32x4*)(norm_g + h * 128 + tid * 4);
        v4u rq[2], rk[2], re[2], rv[2]; f32x4 rd = (f32x4){0.f, 0.f, 0.f, 0.f};
#define HG_LOAD(c) do { const size_t row0_ = (size_t)b * SEQ + 64 * (c); \
            _Pragma("unroll") for (int i = 0; i < 2; ++i) { const int idx = tid + 512 * i, row = idx >> 4, cc = idx & 15; const size_t go = (row0_ + row) * 1024 + h * 128 + cc * 8; \
                rq[i] = *(const v4u*)(QE + go); rk[i] = *(const v4u*)(KI + go); re[i] = *(const v4u*)(KE + go); rv[i] = *(const v4u*)(Vp + go); } \
            if (tid < 32) rd = *(const f32x4*)(DK + ((size_t)b * 128 + (c)) * 1024 + h * 128 + tid * 4); } while (0)
#define HG_STORE() do { \
            _Pragma("unroll") for (int i = 0; i < 2; ++i) { const int idx = tid + 512 * i, row = idx >> 4, cc = idx & 15; \
                *(LAS v4u*)(lds + HG_QE + row * 256 + ((cc ^ (row & 15)) * 16)) = rq[i]; *(LAS v4u*)(lds + HG_KI + row * 256 + ((cc ^ (row & 15)) * 16)) = rk[i]; \
                *(LAS v4u*)(lds + HG_KE + (cc >> 2) * 4096 + row * 64 + (cc & 3) * 16) = re[i]; *(LAS v4u*)(lds + HG_V + (cc >> 2) * 4096 + row * 64 + (cc & 3) * 16) = rv[i]; } \
            if (tid < 32) *(LAS f32x4*)(dk_l + tid * 4) = rd; } while (0)
        HG_LOAD(c0); HG_STORE();
        __syncthreads();
        for (int cl = 0; cl < HG_CPS; ++cl) { const int c = c0 + cl;
            if (cl + 1 < HG_CPS) HG_LOAD(c + 1);
            const size_t rowo = ((size_t)b * SEQ + 64 * c + 32 * tb + r32) * 1024 + h * 128 + 32 * vb + 4 * hi;
            v2u ggv[4];
#pragma unroll
            for (int g = 0; g < 4; ++g) ggv[g] = *(const v2u*)(Gp + rowo + 8 * g);
            LAS unsigned char* st_cur = lds + HG_ST + (cl & 1) * 32768; LAS unsigned char* st_nxt = lds + HG_ST + ((cl + 1) & 1) * 32768;
            bf16x8v qf[8];
#pragma unroll
            for (int ks = 0; ks < 8; ++ks) qf[ks] = *(const LAS bf16x8v*)(lds + HG_QE + (32 * tb + r32) * 256 + (((2 * ks + hi) ^ sw) * 16));
            f32x16 oT = (f32x16){};
#pragma unroll
            for (int ks = 0; ks < 8; ++ks) { const bf16x8v sf = *(const LAS bf16x8v*)(st_cur + (32 * vb + r32) * 256 + (((2 * ks + hi) ^ sw) * 16)); oT = __builtin_amdgcn_mfma_f32_32x32x16_bf16(sf, qf[ks], oT, 0, 0, 0); }
            v4u pw[4];
            { f32x16 X0 = (f32x16){};
#pragma unroll
              for (int ks = 0; ks < 8; ++ks) { const bf16x8v kf = *(const LAS bf16x8v*)(lds + HG_KI + r32 * 256 + (((2 * ks + hi) ^ sw) * 16)); X0 = __builtin_amdgcn_mfma_f32_32x32x16_bf16(kf, qf[ks], X0, 0, 0, 0); }
              if (tb == 0) {
#pragma unroll
                  for (int r = 0; r < 16; ++r) if (crow(r, hi) > r32) X0[r] = 0.f; }
              pw[0].x = pk2(X0[0], X0[1]); pw[0].y = pk2(X0[2], X0[3]); pw[0].z = pk2(X0[4], X0[5]); pw[0].w = pk2(X0[6], X0[7]); pw[1].x = pk2(X0[8], X0[9]); pw[1].y = pk2(X0[10], X0[11]); pw[1].z = pk2(X0[12], X0[13]); pw[1].w = pk2(X0[14], X0[15]); }
            if (tb == 1) { f32x16 X1 = (f32x16){};
#pragma unroll
              for (int ks = 0; ks < 8; ++ks) { const bf16x8v kf = *(const LAS bf16x8v*)(lds + HG_KI + (32 + r32) * 256 + (((2 * ks + hi) ^ sw) * 16)); X1 = __builtin_amdgcn_mfma_f32_32x32x16_bf16(kf, qf[ks], X1, 0, 0, 0); }
#pragma unroll
              for (int r = 0; r < 16; ++r) if (crow(r, hi) > r32) X1[r] = 0.f;
              pw[2].x = pk2(X1[0], X1[1]); pw[2].y = pk2(X1[2], X1[3]); pw[2].z = pk2(X1[4], X1[5]); pw[2].w = pk2(X1[6], X1[7]); pw[3].x = pk2(X1[8], X1[9]); pw[3].y = pk2(X1[10], X1[11]); pw[3].z = pk2(X1[12], X1[13]); pw[3].w = pk2(X1[14], X1[15]); }
            asm volatile("" ::: "memory");
            bf16x8v vf[4];
#pragma unroll
            for (int s4 = 0; s4 < 4; ++s4) { const LAS unsigned char* p = lds + HG_V + vb * 4096 + s4 * 1024 + trl; const s16x4 a0 = vtr(p), a1 = vtr(p + 512); vf[s4] = (bf16x8v){a0[0], a0[1], a0[2], a0[3], a1[0], a1[1], a1[2], a1[3]}; }
            oT = __builtin_amdgcn_mfma_f32_32x32x16_bf16(vf[0], __builtin_bit_cast(bf16x8v, pw[0]), oT, 0, 0, 0); oT = __builtin_amdgcn_mfma_f32_32x32x16_bf16(vf[1], __builtin_bit_cast(bf16x8v, pw[1]), oT, 0, 0, 0);
            if (tb == 1) { oT = __builtin_amdgcn_mfma_f32_32x32x16_bf16(vf[2], __builtin_bit_cast(bf16x8v, pw[2]), oT, 0, 0, 0); oT = __builtin_amdgcn_mfma_f32_32x32x16_bf16(vf[3], __builtin_bit_cast(bf16x8v, pw[3]), oT, 0, 0, 0); }
            { float ss = 0.f;
#pragma unroll
              for (int r = 0; r < 16; ++r) ss += oT[r] * oT[r];
              ss += __shfl_xor(ss, 32); if (hi == 0) ssq[(tb * 4 + vb) * 32 + r32] = ss; }
#pragma unroll
            for (int i = 0; i < 2; ++i) { const int kb = 2 * tb + i; f32x16 S = i ? S1 : S0;
#pragma unroll
                for (int g = 0; g < 4; ++g) { const f32x4 d4 = *(const LAS f32x4*)(dk_l + 32 * kb + 8 * g + 4 * hi);
#pragma unroll
                    for (int j = 0; j < 4; ++j) S[4 * g + j] *= d4[j]; }
#pragma unroll
                for (int s4 = 0; s4 < 4; ++s4) { const LAS unsigned char* p = lds + HG_KE + kb * 4096 + s4 * 1024 + trl; const s16x4 a0 = vtr(p), a1 = vtr(p + 512);
                    const bf16x8v kef = (bf16x8v){a0[0], a0[1], a0[2], a0[3], a1[0], a1[1], a1[2], a1[3]};
                    S = __builtin_amdgcn_mfma_f32_32x32x16_bf16(kef, vf[s4], S, 0, 0, 0); }
#pragma unroll
                for (int g = 0; g < 4; ++g) { v2u w; w.x = pk2(S[4 * g], S[4 * g + 1]); w.y = pk2(S[4 * g + 2], S[4 * g + 3]);
                    *(LAS v2u*)(st_nxt + (32 * vb + r32) * 256 + (((4 * kb + g) ^ sw) * 16) + hi * 8) = w; }
                if (i) S1 = S; else S0 = S; }
            __syncthreads();
            { const float tot = (ssq[(tb * 4 + 0) * 32 + r32] + ssq[(tb * 4 + 1) * 32 + r32]) + (ssq[(tb * 4 + 2) * 32 + r32] + ssq[(tb * 4 + 3) * 32 + r32]);
              const float rstd = 1.0f / sqrtf(tot * (1.f / 128.f) + EPS);
#pragma unroll
              for (int g = 0; g < 4; ++g) { const f32x4 ng = *(const LAS f32x4*)(lds + HG_NG + (32 * vb + 8 * g + 4 * hi) * 4); const v2u gg = ggv[g];
                  v2u w; w.x = pk2(oT[4 * g] * rstd * ng.x * bflo(gg.x), oT[4 * g + 1] * rstd * ng.y * bfhi(gg.x)); w.y = pk2(oT[4 * g + 2] * rstd * ng.z * bflo(gg.y), oT[4 * g + 3] * rstd * ng.w * bfhi(gg.y));
                  *(v2u*)(Og + rowo + 8 * g) = w; } }
            if (cl + 1 < HG_CPS) HG_STORE();
            __syncthreads();
        }
#undef HG_LOAD
#undef HG_STORE
    }
}

__device__ __forceinline__ void phase_hgrn_state(const bf16* KE, const bf16* Vp, const float* DK, float* HL, float* HP, LAS unsigned char* lds, int blk, int G, int tid) {
    const int wave = tid >> 6, lane = tid & 63, r32 = lane & 31, hi = lane >> 5, tb = wave >> 2, vb = wave & 3;
    const int trl = (4 * hi + ((lane & 15) >> 2)) * 64 + ((lane >> 4) & 1) * 32 + (lane & 3) * 8;
    LAS float* dk_l = (LAS float*)(lds + HG_DK);
    for (int un = blk; un < BATCH * 8 * 3; un += G) {
        const int bh = un / 3, seg = un % 3, b = bh >> 3, h = bh & 7, c0 = seg * HG_CPS;
        f32x16 S0 = (f32x16){}, S1 = (f32x16){};
        float ptot = 1.0f;
        v4u re[2], rv[2]; f32x4 rd = (f32x4){0.f, 0.f, 0.f, 0.f};
#define HS_LOAD(c) do { const size_t row0_ = (size_t)b * SEQ + 64 * (c); \
            _Pragma("unroll") for (int i = 0; i < 2; ++i) { const int idx = tid + 512 * i, row = idx >> 4, cc = idx & 15; const size_t go = (row0_ + row) * 1024 + h * 128 + cc * 8; \
                re[i] = *(const v4u*)(KE + go); rv[i] = *(const v4u*)(Vp + go); } \
            if (tid < 32) rd = *(const f32x4*)(DK + ((size_t)b * 128 + (c)) * 1024 + h * 128 + tid * 4); } while (0)
#define HS_STORE() do { \
            _Pragma("unroll") for (int i = 0; i < 2; ++i) { const int idx = tid + 512 * i, row = idx >> 4, cc = idx & 15; \
                *(LAS v4u*)(lds + HG_KE + (cc >> 2) * 4096 + row * 64 + (cc & 3) * 16) = re[i]; *(LAS v4u*)(lds + HG_V + (cc >> 2) * 4096 + row * 64 + (cc & 3) * 16) = rv[i]; } \
            if (tid < 32) *(LAS f32x4*)(dk_l + tid * 4) = rd; } while (0)
        HS_LOAD(c0); HS_STORE();
        __syncthreads();
        for (int cl = 0; cl < HG_CPS; ++cl) {
            if (cl + 1 < HG_CPS) HS_LOAD(c0 + cl + 1);
            bf16x8v vf[4];
#pragma unroll
            for (int s4 = 0; s4 < 4; ++s4) { const LAS unsigned char* p = lds + HG_V + vb * 4096 + s4 * 1024 + trl; const s16x4 a0 = vtr(p), a1 = vtr(p + 512); vf[s4] = (bf16x8v){a0[0], a0[1], a0[2], a0[3], a1[0], a1[1], a1[2], a1[3]}; }
#pragma unroll
            for (int i = 0; i < 2; ++i) { const int kb = 2 * tb + i; f32x16 S = i ? S1 : S0;
#pragma unroll
                for (int g = 0; g < 4; ++g) { const f32x4 d4 = *(const LAS f32x4*)(dk_l + 32 * kb + 8 * g + 4 * hi);
#pragma unroll
                    for (int j = 0; j < 4; ++j) S[4 * g + j] *= d4[j]; }
#pragma unroll
                for (int s4 = 0; s4 < 4; ++s4) { const LAS unsigned char* p = lds + HG_KE + kb * 4096 + s4 * 1024 + trl; const s16x4 a0 = vtr(p), a1 = vtr(p + 512);
                    const bf16x8v kef = (bf16x8v){a0[0], a0[1], a0[2], a0[3], a1[0], a1[1], a1[2], a1[3]};
                    S = __builtin_amdgcn_mfma_f32_32x32x16_bf16(kef, vf[s4], S, 0, 0, 0); }
                if (i) S1 = S; else S0 = S; }
            if (tid < 128) ptot *= dk_l[tid];
            __syncthreads();
            if (cl + 1 < HG_CPS) HS_STORE();
            __syncthreads();
        }
        float* L = HL + ((size_t)bh * 3 + seg) * 16384;
#pragma unroll
        for (int i = 0; i < 2; ++i) { const int kb = 2 * tb + i; const f32x16 S = i ? S1 : S0;
#pragma unroll
            for (int r = 0; r < 16; ++r) L[(32 * kb + crow(r, hi)) * 128 + 32 * vb + r32] = S[r]; }
        if (tid < 128) HP[((size_t)bh * 3 + seg) * 128 + tid] = ptot;
#undef HS_LOAD
#undef HS_STORE
    }
}
struct Args { const void* in[19]; float* out; unsigned char* ws; int ph_lo, ph_hi; };
__global__ void __launch_bounds__(NWAVES * 64, 2) fwd(Args args) {
    extern __shared__ __attribute__((aligned(16))) unsigned char lds_raw[];
    LAS unsigned char* lds = (LAS unsigned char*)lds_raw;
    volatile LAS unsigned* MISC = (volatile LAS unsigned*)(lds + MISC_OFF);
    const int tid = threadIdx.x, G = gridDim.x, blk = blockIdx.x;
    unsigned char* ws = args.ws;
    unsigned* ctl = (unsigned*)(ws + WS_CTL);
    for (int u = tid; u < (LDS_BYTES - LDSCTL_OFF) / 4; u += NWAVES * 64) ((LAS unsigned*)(lds + LDSCTL_OFF))[u] = 0u;
    __syncthreads();
    XcdBarrier bar; bar.bar = ctl + CW_BAR; bar.x = 0; bar.st = nullptr;
    if (N_LAUNCHES == 1) bar = xcd_barrier_post(ctl + CW_BAR, MISC + 8);
#define GRID_BAR() do { if (N_LAUNCHES == 1) xcd_barrier(bar); } while (0)
    const int lo = args.ph_lo, hi = args.ph_hi;
#define IN(k) (lo <= (k) && (k) < hi)
#define OT() ({ int t_ = tid; asm volatile("" : "+v"(t_)); t_; })
#define BOTH(k) (IN(k) && IN((k) + 1))
#ifndef PROBE_PHASE
#define PROBE_PHASE -1
#endif
#define REP(k) ((k) == PROBE_PHASE ? 2 : 1)
    const float* x = (const float*)args.in[0]; const int* positions = (const int*)args.in[1];
    const float* g_mix = (const float*)args.in[2]; const float* g_ffn = (const float*)args.in[3]; const float* g_final = (const float*)args.in[4];
    const float* sinks = (const float*)args.in[7]; const float* rec_norm_g = (const float*)args.in[10]; const float* w_router = (const float*)args.in[15];
    float* out = args.out;
    bf16* H = (bf16*)(ws + WS_H); bf16* BIG = (bf16*)(ws + WS_BIG);
    const size_t PLANE = (size_t)NTOK * D;
    bf16* H2 = (bf16*)(ws + WS_H2); float* RSP = (float*)(ws + WS_RSP);
    unsigned* SSQ1 = (unsigned*)(ws + WS_CTL + CTL_SSQ1); unsigned* SSQ2 = (unsigned*)(ws + WS_CTL + CTL_SSQ2); unsigned* SSQ3 = (unsigned*)(ws + WS_CTL + CTL_SSQ3);

    if (IN(0)) for (int rep_ = 0; rep_ < REP(0); ++rep_) {
        P0Args pa; pa.g_ffn0 = g_ffn; pa.g_mix1 = g_mix + D; pa.g_ffn1 = g_ffn + D; pa.x = x; pa.g0 = g_mix; pa.w_in_attn = (const float*)args.in[5]; pa.w_out_attn = (const float*)args.in[6]; pa.w_in_rec = (const float*)args.in[8]; pa.w_out_rec = (const float*)args.in[11];
        pa.w_gate = (const float*)args.in[12]; pa.w_up = (const float*)args.in[13]; pa.w_down = (const float*)args.in[14]; pa.w_gate_moe = (const float*)args.in[16]; pa.w_up_moe = (const float*)args.in[17]; pa.w_down_moe = (const float*)args.in[18];
        pa.rlb = (const float*)args.in[9]; pa.pos = positions; pa.ws = ws;
        phase_prologue(pa, lds, blk, G, OT());
        if (BOTH(0)) GRID_BAR();
    }
    if (IN(1)) {
        pg8::Gemm g{H, (const bf16*)(ws + WS_W_INATT), NTOK, QKV_N, D}; pg8::StaticOrder S; S.init(NTOK, QKV_N, G, blk);
        pg8::EpiQkvRope E{BIG, (const float*)(ws + WS_ROPE)};
        pg8::gemm_phase<pg8::EpiQkvRope, pg8::StaticOrder, PG8_ALIGN, PG8_SP2>(lds, g, S, E);
        if (BOTH(1)) GRID_BAR();
    }
    if (IN(3)) for (int rep_ = 0; rep_ < REP(3); ++rep_) { phase_attn(BIG, sinks, H, (bf16*)(ws + WS_OB), (float*)(ws + WS_LSE), lds, blk, G, OT()); if (BOTH(3)) GRID_BAR(); }
    if (IN(4)) {
        pg8::Gemm g{H, (const bf16*)(ws + WS_W_OUTATT), NTOK, D, D}; pg8::StaticOrder S; S.init(NTOK, D, G, blk);
        pg8::EpiRes E{x, out, D, H2, SSQ1};
        pg8::gemm_phase<pg8::EpiRes, pg8::StaticOrder, PG8_ALIGN, PG8_SP2>(lds, g, S, E);
        if (BOTH(4)) GRID_BAR();
    }
    if (IN(6)) {
        pg8::Gemm g{H2, (const bf16*)(ws + WS_W_GU), NTOK, 2 * FF, D}; pg8::StaticOrder S; S.init(NTOK, 2 * FF, G, blk);
        pg8::EpiSwiglu E{BIG, FF, 1 << 20, 0, SSQ1, nullptr};
        pg8::gemm_phase<pg8::EpiSwiglu, pg8::StaticOrder, PG8_ALIGN, PG8_SP2>(lds, g, S, E);
#if PROBE_PHASE == 6
        GRID_BAR(); pg8::gemm_phase<pg8::EpiSwiglu, pg8::StaticOrder, PG8_ALIGN, PG8_SP2>(lds, g, S, E);
#endif
        if (BOTH(6)) GRID_BAR();
    }
    if (IN(7)) {
        pg8::Gemm g{BIG, (const bf16*)(ws + WS_W_DN), NTOK, D, FF}; pg8::StaticOrder S; S.init(NTOK, D, G, blk);
        pg8::EpiRes E{out, out, D, H, SSQ2};
        pg8::gemm_phase<pg8::EpiRes, pg8::StaticOrder, PG8_ALIGN, PG8_SP2>(lds, g, S, E);
        if (BOTH(7)) GRID_BAR();
    }
    if (IN(9)) {
        pg8::Gemm g{H, (const bf16*)(ws + WS_W_INREC), NTOK, REC_N, D}; pg8::StaticOrder S; S.init(NTOK, REC_N, G, blk);
        pg8::EpiRec2 E{BIG, PLANE, (const float*)(ws + WS_LBK), (float*)(ws + WS_DK), SSQ2};
        pg8::gemm_phase<pg8::EpiRec2, pg8::StaticOrder, PG8_ALIGN, PG8_SP2>(lds, g, S, E);
        if (BOTH(9)) GRID_BAR();
    }
    if (IN(10)) for (int rep_ = 0; rep_ < REP(10); ++rep_) { phase_hgrn_state(BIG + 2 * PLANE, BIG + 3 * PLANE, (const float*)(ws + WS_DK), (float*)(ws + WS_HL), (float*)(ws + WS_HP), lds, blk, G, OT()); if (BOTH(10)) GRID_BAR(); }
    if (IN(11)) for (int rep_ = 0; rep_ < REP(11); ++rep_) { phase_hgrn(BIG, BIG + PLANE, BIG + 2 * PLANE, BIG + 3 * PLANE, BIG + 4 * PLANE, (const float*)(ws + WS_DK), rec_norm_g, H, (const float*)(ws + WS_HL), (const float*)(ws + WS_HP), lds, blk, G, OT()); if (BOTH(11)) GRID_BAR(); }
    if (IN(12)) {
        pg8::Gemm g{H, (const bf16*)(ws + WS_W_OUTREC), NTOK, D, D}; pg8::StaticOrder S; S.init(NTOK, D, G, blk);
        pg8::EpiRes E{out, out, D, H2, SSQ3};
        pg8::gemm_phase<pg8::EpiRes, pg8::StaticOrder, PG8_ALIGN, PG8_SP2>(lds, g, S, E);
        if (BOTH(12)) GRID_BAR();
    }
    int4* meta = (int4*)(ws + WS_META); int* hist = (int*)(ws + WS_HIST); int* dest = (int*)(ws + WS_DEST); int* info = (int*)(ws + WS_INFO);
    bf16* Y = (bf16*)(ws + WS_Y); bf16* HID = (bf16*)(ws + WS_HID);
    if (IN(13)) for (int rep_ = 0; rep_ < REP(13); ++rep_) { phase_router(out, g_ffn + D, w_router, SSQ3, meta, hist, lds, blk, G, OT()); if (BOTH(13)) GRID_BAR(); }
    if (IN(14)) for (int rep_ = 0; rep_ < REP(14); ++rep_) { phase_scatter(H2, SSQ3, meta, hist, dest, info, Y, RSP, lds, blk, G, OT()); if (BOTH(14)) GRID_BAR(); }
    for (int c = 0; c < 3; ++c) {
        if (IN(15 + 2 * c) || IN(16 + 2 * c)) {
            const int T = info[8]; const int tile0 = 256 * c; int ntl = T - tile0; ntl = ntl > 256 ? 256 : ntl; ntl = ntl < 0 ? 0 : ntl;
            pg8::MoeOrder S; S.tile0 = tile0; S.te0 = info[0]; S.te1 = info[1]; S.te2 = info[2]; S.te3 = info[3]; S.te4 = info[4]; S.te5 = info[5]; S.te6 = info[6];
            if (IN(15 + 2 * c)) {
                S.nN = 28; S.so.init(ntl * 256, 2 * FF, G, blk);
                pg8::Gemm g{Y, (const bf16*)(ws + WS_WMOE_GU), 0, 0, D};
                pg8::EpiSwiglu E{HID, FF, 28, tile0, nullptr, RSP};
                pg8::gemm_phase<pg8::EpiSwiglu, pg8::MoeOrder, PG8_ALIGN, PG8_SP2>(lds, g, S, E);
                if (BOTH(15 + 2 * c)) GRID_BAR();
            }
            if (IN(16 + 2 * c)) {
                S.nN = 4; S.so.init(ntl * 256, D, G, blk);
                pg8::Gemm g{HID - (size_t)tile0 * 256 * FF, (const bf16*)(ws + WS_WMOE_DN), 0, 0, FF};
                pg8::EpiBf16Plain E{Y, D, 4};
                pg8::gemm_phase<pg8::EpiBf16Plain, pg8::MoeOrder, PG8_ALIGN, PG8_SP2>(lds, g, S, E);
                if (BOTH(16 + 2 * c)) GRID_BAR();
            }
        }
    }
    if (IN(21)) phase_combine(out, Y, meta, dest, g_final, blk, G, OT());
#undef IN
#undef BOTH
}

extern "C" void kernel_launch(void* const* d_in, const int* in_sizes, int n_in, void* d_out, int out_size, void* d_ws, size_t ws_size, hipStream_t stream) {
    static int grid = 0;
    if (grid == 0) {
        if (n_in != 19 || in_sizes[0] != NTOK * D || out_size != NTOK * D || ws_size < WS_END) { fprintf(stderr, "kernel_launch: unexpected shapes / workspace (n_in %d, ws %zu); nothing launched\n", n_in, ws_size); grid = -1; return; }
        int dev = 0, cus = 0, per_cu = 0;
        if (hipGetDevice(&dev) != hipSuccess || hipDeviceGetAttribute(&cus, hipDeviceAttributeMultiprocessorCount, dev) != hipSuccess) { grid = -1; return; }
        if (hipFuncSetAttribute((const void*)fwd, hipFuncAttributeMaxDynamicSharedMemorySize, LDS_BYTES) != hipSuccess) { fprintf(stderr, "kernel_launch: hipFuncSetAttribute failed\n"); grid = -1; return; }
        if (hipOccupancyMaxActiveBlocksPerMultiprocessor(&per_cu, (const void*)fwd, NWAVES * 64, LDS_BYTES) != hipSuccess || per_cu < 1) fprintf(stderr, "kernel_launch: occupancy query says %d\n", per_cu);
        (void)hipGetLastError();
        grid = cus;
    }
    if (grid < 0) return;
    if (hipMemsetAsync((char*)d_ws + WS_CTL, 0, CTL_ZERO_BYTES, stream) != hipSuccess) return;
    Args a{};
    for (int i = 0; i < 19; ++i) a.in[i] = d_in[i];
    a.out = (float*)d_out; a.ws = (unsigned char*)d_ws;
    if (N_LAUNCHES == 1) { a.ph_lo = 0; a.ph_hi = NPH; hipLaunchKernelGGL(fwd, dim3(grid), dim3(NWAVES * 64), LDS_BYTES, stream, a); }
    else for (int li = 0; li < NPH; ++li) { a.ph_lo = li; a.ph_hi = li + 1; hipLaunchKernelGGL(fwd, dim3(grid), dim3(NWAVES * 64), LDS_BYTES, stream, a); }
}
```

```cpp
#include <hip/hip_runtime.h>
#include <cstdio>
#include <cstdint>
#define PROBE_PHASE -1
#define STAGGER_TICKS 0
#define PRB_SEL 0
#define PRB_MUL 1
#define PRB_SEL2 0
namespace pg8 {
#define PG8_LAS __attribute__((address_space(3)))
typedef unsigned short bf16_t;
typedef short bf16x8 __attribute__((ext_vector_type(8)));
typedef float f32x4 __attribute__((ext_vector_type(4)));
typedef unsigned u32x4 __attribute__((ext_vector_type(4)));
constexpr int BM = 256, BK = 64, HALF = 128, HTB = HALF * BK * 2  , STAGE_BYTES = 8 * HTB, NXCD = 8, WGM = 8;

__host__ __device__ __forceinline__ int lds_byte(int r, int c) { const int st = (r >> 4) * 2 + (c >> 5), rr = r & 15, cc = c & 31, ob = rr * 64 + cc * 2; return st * 1024 + (ob ^ (((ob >> 9) & 1) << 5)); }
__host__ __device__ __forceinline__ void stage_rc(int b, int& R, int& C) { const int st = b / 1024, sb = b % 1024, swz = sb ^ (((sb >> 9) & 1) << 5); R = (st >> 1) * 16 + swz / 64; C = (st & 1) * 32 + (swz % 64) / 2; }
__host__ __device__ __forceinline__ int perm32(int rho) { const int n = rho >> 4, i = rho & 15; return 8 * (i >> 2) + 4 * n + (i & 3); }

struct Unit { int pm, pn; };
struct Gemm { const bf16_t* A; const bf16_t* Bt; int M, N, K; };

struct StaticOrder {
    int nM, nN, nwg, G, c;
    __host__ __device__ void init(int M, int N, int G_, int c_) { nM = M / BM; nN = N / BM; nwg = nM * nN; G = G_; c = c_; }
    __host__ __device__ bool next(int i, Unit& u) const {
        const long L = (long)i * G + c; if (L >= nwg) return false;
        int wgid = (int)L; { const int q = nwg / NXCD, r = nwg % NXCD, xcd = wgid % NXCD, off = wgid / NXCD; wgid = (xcd < r ? xcd * (q + 1) : r * (q + 1) + (xcd - r) * q) + off; }
        const int nig = WGM * nN, gid = wgid / nig, fm = gid * WGM, gsz = (nM - fm) < WGM ? (nM - fm) : WGM;
        u.pm = fm + ((wgid % nig) % gsz); u.pn = (wgid % nig) / gsz; return true;
    }
    __device__ __forceinline__ void a_ready(const Unit&) const {}
    __device__ __forceinline__ void done(const Unit&) const {}
};
typedef float f32x2c_t __attribute__((ext_vector_type(2))); typedef __bf16 bf16x2c_t __attribute__((ext_vector_type(2)));
__device__ __forceinline__ unsigned cvt_pk_bf16(float lo, float hi) { const f32x2c_t v = {lo, hi}; const bf16x2c_t b = __builtin_convertvector(v, bf16x2c_t); return __builtin_bit_cast(unsigned, b); }
typedef unsigned u32x2 __attribute__((ext_vector_type(2)));
__device__ __forceinline__ float sigmoid_f(float x) { return __builtin_amdgcn_rcpf(1.0f + __builtin_amdgcn_exp2f(-1.44269504089f * x)); }
__device__ __forceinline__ float silu_f(float x) { return x * sigmoid_f(x); }
__device__ __forceinline__ unsigned pk4_fp8(float a, float b, float c, float d) { int w = __builtin_amdgcn_cvt_pk_fp8_f32(a, b, 0, false); w = __builtin_amdgcn_cvt_pk_fp8_f32(c, d, w, true); return (unsigned)w; }
__device__ __forceinline__ u32x4 pack8(const f32x4& v0, const f32x4& v1) { u32x4 w; w.x = cvt_pk_bf16(v0[0], v0[1]); w.y = cvt_pk_bf16(v0[2], v0[3]); w.z = cvt_pk_bf16(v1[0], v1[1]); w.w = cvt_pk_bf16(v1[2], v1[3]); return w; }
struct EpiBf16Plain {
    static constexpr bool PERM = true, AFTER_DRAIN = false; static constexpr int NST = 16;
    bf16_t* O; int ldc; int nmod; float scale;
    __device__ __forceinline__ void operator()(const f32x4 (&acc)[2][2][4][2], const Unit& u, int wr, int wc, int fr, int fq) const {
        const int row0 = u.pm * BM + wr * 64 + fr; const int col0 = (u.pn % nmod) * BM + wc * 32 + 8 * fq;
#pragma unroll
        for (int ai = 0; ai < 2; ++ai)
#pragma unroll
            for (int m = 0; m < 4; ++m) { bf16_t* rowp = O + (size_t)(row0 + ai * HALF + m * 16) * ldc + col0;
#pragma unroll
                for (int bj = 0; bj < 2; ++bj) *(u32x4*)(rowp + bj * HALF) = pack8(acc[ai][bj][m][0] * scale, acc[ai][bj][m][1] * scale); }
    }
};
struct EpiQkvRope {
    static constexpr bool PERM = true, AFTER_DRAIN = false; static constexpr int NST = 16;
    bf16_t* O; int ldo; const float* rope; const float* rs0;
    __device__ __forceinline__ void operator()(const f32x4 (&acc)[2][2][4][2], const Unit& u, int wr, int wc, int fr, int fq) const {
        const int row0 = u.pm * BM + wr * 64 + fr; const int col0 = u.pn * BM + wc * 32 + 8 * fq;
        const bool lrot = ((wc & 1) == 0) && (fq < 2);
        const bool anyrot = (u.pn < 4) || (u.pn >= 6);
        float rs8[8];
#pragma unroll
        for (int g = 0; g < 8; ++g) rs8[g] = rs0[row0 + (g >> 2) * HALF + (g & 3) * 16];
#pragma unroll
        for (int ai2 = 0; ai2 < 4; ++ai2) { const int ai = ai2 >> 1;
            f32x4 tb[4][4];
            if (anyrot) {
#pragma unroll
                for (int m = 2 * (ai2 & 1); m < 2 * (ai2 & 1) + 2; ++m) { const f32x4* t = (const f32x4*)(rope + (size_t)(row0 + ai * HALF + m * 16) * 16);
#pragma unroll
                    for (int q = 0; q < 4; ++q) tb[m][q] = t[q]; } }
#pragma unroll
            for (int m = 2 * (ai2 & 1); m < 2 * (ai2 & 1) + 2; ++m) { const int row = row0 + ai * HALF + m * 16; bf16_t* rowp = O + (size_t)row * ldo + col0; const float rsr = rs8[ai * 4 + m];
#pragma unroll
                for (int bj = 0; bj < 2; ++bj) { f32x4 v0 = acc[ai][bj][m][0] * rsr, v1 = acc[ai][bj][m][1] * rsr;
                    const bool urot = (u.pn < 4) || (u.pn == 6) || (u.pn == 7) || (u.pn == 8 && bj == 0);
                    if (urot) {
                        const f32x4 c0 = tb[m][0], c1 = tb[m][1], s0 = tb[m][2], s1 = tb[m][3];
                        f32x4 p0, p1;
#pragma unroll
                        for (int j = 0; j < 4; ++j) { p0[j] = __shfl_xor(v0[j], 16); p1[j] = __shfl_xor(v1[j], 16); }
                        if (lrot) { const float sg = (fq == 0) ? -1.0f : 1.0f;
#pragma unroll
                            for (int j = 0; j < 4; ++j) { v0[j] = v0[j] * c0[j] + sg * p0[j] * s0[j]; v1[j] = v1[j] * c1[j] + sg * p1[j] * s1[j]; } }
                    }
                    *(u32x4*)(rowp + bj * HALF) = pack8(v0, v1); } } }
    }
};
template <bool BASE_F32> struct EpiResB {
    static constexpr bool PERM = true, AFTER_DRAIN = false; static constexpr int NST = 24;
    const void* base; bf16_t* hb; unsigned* ssq; int ldc;
    __device__ __forceinline__ void load(f32x4 (&d)[4], size_t off) const {
        if constexpr (BASE_F32) { const float* b = (const float*)base + off; d[0] = *(const f32x4*)b; d[1] = *(const f32x4*)(b + 4); d[2] = *(const f32x4*)(b + HALF); d[3] = *(const f32x4*)(b + HALF + 4); }
        else { const bf16_t* b = (const bf16_t*)base + off; const u32x4 w0 = *(const u32x4*)b, w1 = *(const u32x4*)(b + HALF);
            d[0] = (f32x4){__builtin_bit_cast(float, w0.x << 16), __builtin_bit_cast(float, w0.x & 0xffff0000u), __builtin_bit_cast(float, w0.y << 16), __builtin_bit_cast(float, w0.y & 0xffff0000u)};
            d[1] = (f32x4){__builtin_bit_cast(float, w0.z << 16), __builtin_bit_cast(float, w0.z & 0xffff0000u), __builtin_bit_cast(float, w0.w << 16), __builtin_bit_cast(float, w0.w & 0xffff0000u)};
            d[2] = (f32x4){__builtin_bit_cast(float, w1.x << 16), __builtin_bit_cast(float, w1.x & 0xffff0000u), __builtin_bit_cast(float, w1.y << 16), __builtin_bit_cast(float, w1.y & 0xffff0000u)};
            d[3] = (f32x4){__builtin_bit_cast(float, w1.z << 16), __builtin_bit_cast(float, w1.z & 0xffff0000u), __builtin_bit_cast(float, w1.w << 16), __builtin_bit_cast(float, w1.w & 0xffff0000u)}; }
    }
    __device__ __forceinline__ void operator()(const f32x4 (&acc)[2][2][4][2], const Unit& u, int wr, int wc, int fr, int fq) const {
        const int row0 = u.pm * BM + wr * 64 + fr, col0 = u.pn * BM + wc * 32 + 8 * fq;
        f32x4 cur[4], nxt[4];
        load(cur, (size_t)row0 * ldc + col0);
#pragma unroll
        for (int g = 0; g < 8; ++g) { const int ai = g >> 2, m = g & 3; const int row = row0 + ai * HALF + m * 16; const size_t off = (size_t)row * ldc + col0;
            if (g < 7) { const int ai2 = (g + 1) >> 2, m2 = (g + 1) & 3; load(nxt, (size_t)(row0 + ai2 * HALF + m2 * 16) * ldc + col0); }
            float ss = 0.f;
#pragma unroll
            for (int bj = 0; bj < 2; ++bj) { const f32x4 v0 = cur[2 * bj] + acc[ai][bj][m][0], v1 = cur[2 * bj + 1] + acc[ai][bj][m][1];
                *(u32x4*)(hb + off + bj * HALF) = pack8(v0, v1);
                ss += ((v0[0] * v0[0] + v0[1] * v0[1]) + (v0[2] * v0[2] + v0[3] * v0[3])) + ((v1[0] * v1[0] + v1[1] * v1[1]) + (v1[2] * v1[2] + v1[3] * v1[3])); }
            ss += __shfl_xor(ss, 16); ss += __shfl_xor(ss, 32);
            if (fq == 0) __hip_atomic_fetch_add(ssq + row, __float2uint_rn(ss * 65536.0f), __ATOMIC_RELAXED, __HIP_MEMORY_SCOPE_AGENT);
            asm volatile("" ::: "memory");
#pragma unroll
            for (int q = 0; q < 4; ++q) cur[q] = nxt[q]; }
    }
};
template <bool F8> struct EpiSwigluT {
    static constexpr bool PERM = true, AFTER_DRAIN = false; static constexpr int NST = 8;
    void* O; int ldc; int nN; int tile0; const void* rs; float cs;
    __device__ __forceinline__ void operator()(const f32x4 (&acc)[2][2][4][2], const Unit& u, int wr, int wc, int fr, int fq) const {
        const int row0 = (u.pm - tile0) * BM + wr * 64 + fr; const int col0 = (u.pn % nN) * HALF + wc * 32 + 8 * fq; const int arow0 = u.pm * BM + wr * 64 + fr;
        unsigned sq8[8];
        if constexpr (!F8) {
#pragma unroll
            for (int g = 0; g < 8; ++g) sq8[g] = ((const unsigned*)rs)[arow0 + (g >> 2) * HALF + (g & 3) * 16]; }
#pragma unroll
        for (int ai = 0; ai < 2; ++ai)
#pragma unroll
            for (int m = 0; m < 4; ++m) {
                float rsv; if constexpr (F8) rsv = cs; else rsv = 1.0f / sqrtf((float)sq8[ai * 4 + m] * (1.f / (1024.f * 65536.f)) + 1e-6f);
                f32x4 h0, h1;
#pragma unroll
                for (int j = 0; j < 4; ++j) { h0[j] = silu_f(rsv * acc[ai][0][m][0][j]) * (rsv * acc[ai][1][m][0][j]); h1[j] = silu_f(rsv * acc[ai][0][m][1][j]) * (rsv * acc[ai][1][m][1][j]); }
                if constexpr (F8) {
#pragma unroll
                    for (int j = 0; j < 4; ++j) { h0[j] = __builtin_amdgcn_fmed3f(h0[j] * 4.0f, -448.0f, 448.0f); h1[j] = __builtin_amdgcn_fmed3f(h1[j] * 4.0f, -448.0f, 448.0f); }
                    u32x2 w; w.x = pk4_fp8(h0[0], h0[1], h0[2], h0[3]); w.y = pk4_fp8(h1[0], h1[1], h1[2], h1[3]);
                    *(u32x2*)((unsigned char*)O + (size_t)(row0 + ai * HALF + m * 16) * ldc + col0) = w; }
                else *(u32x4*)((bf16_t*)O + (size_t)(row0 + ai * HALF + m * 16) * ldc + col0) = pack8(h0, h1); }
    }
};
typedef EpiSwigluT<false> EpiSwiglu;
struct MoeOrder {
    StaticOrder so; int tile0, nN; int te0, te1, te2, te3, te4, te5, te6;
    __device__ __forceinline__ bool next(int i, Unit& u) const {
        Unit l; if (!so.next(i, l)) return false;
        const int pm = tile0 + l.pm;
        const int e = (pm >= te0) + (pm >= te1) + (pm >= te2) + (pm >= te3) + (pm >= te4) + (pm >= te5) + (pm >= te6);
        u.pm = pm; u.pn = e * nN + l.pn; return true;
    }
    __device__ __forceinline__ void a_ready(const Unit&) const {}
    __device__ __forceinline__ void done(const Unit&) const {}
};
template <int CTRL> __device__ __forceinline__ float dpp0(float v) { return __builtin_bit_cast(float, __builtin_amdgcn_update_dpp(0, __builtin_bit_cast(int, v), CTRL, 0xf, 0xf, true)); }
struct EpiRec2 {
    static constexpr bool PERM = true, AFTER_DRAIN = false; static constexpr int NST = 16;
    bf16_t* P; size_t plane; const float* lbk; float* DK; const unsigned* ssq;
    __device__ __forceinline__ void operator()(const f32x4 (&acc)[2][2][4][2], const Unit& u, int wr, int wc, int fr, int fq) const {
        const int hd = u.pn & 7; const bool second = (u.pn >> 3) != 0;
        const int row0 = u.pm * BM + wr * 64 + fr; const int ch0 = hd * HALF + wc * 32 + 8 * fq;
        const size_t pb0 = ((size_t)((u.pm * BM) >> 13) * 8 + hd) * 8192 * 128 + (size_t)(row0 & 8191) * 128 + wc * 32 + 8 * fq;
        float rs8[8];
#pragma unroll
        for (int g = 0; g < 8; ++g) rs8[g] = 1.0f / sqrtf((float)ssq[row0 + (g >> 2) * HALF + (g & 3) * 16] * (1.f / (1024.f * 65536.f)) + 1e-6f);
        if (second) {
#pragma unroll
            for (int ai = 0; ai < 2; ++ai)
#pragma unroll
                for (int m = 0; m < 4; ++m) { const size_t off = pb0 + (size_t)(ai * HALF + m * 16) * 128;
                    const float rsm = rs8[ai * 4 + m];
                    f32x4 b0 = acc[ai][1][m][0], b1 = acc[ai][1][m][1]; const f32x4 a0 = acc[ai][0][m][0] * rsm, a1 = acc[ai][0][m][1] * rsm;
#pragma unroll
                    for (int j = 0; j < 4; ++j) { b0[j] = silu_f(rsm * b0[j]); b1[j] = silu_f(rsm * b1[j]); }
                    *(u32x4*)(P + 2 * plane + off) = pack8(a0, a1); *(u32x4*)(P + 3 * plane + off) = pack8(b0, b1); }
        } else {
            const int lane15 = (fq * 16 + fr) | 15;
            const f32x4 lb2[2] = {*(const f32x4*)(lbk + ch0), *(const f32x4*)(lbk + ch0 + 4)};
#pragma unroll
            for (int ai = 0; ai < 2; ++ai) {
                float rs4[4];
#pragma unroll
                for (int m = 0; m < 4; ++m) rs4[m] = rs8[ai * 4 + m];
#pragma unroll
                for (int n = 0; n < 2; ++n) {
                    const f32x4 lbv = lb2[n];
                    float kk[4][4], bb[4][4];
#pragma unroll
                    for (int m = 0; m < 4; ++m)
#pragma unroll
                        for (int j = 0; j < 4; ++j) { const float k_ = lbv[j] * sigmoid_f(-rs4[m] * acc[ai][1][m][n][j]); kk[m][j] = k_; float x = __logf(1.0f - k_);
                            x += dpp0<0x111>(x); x += dpp0<0x112>(x); x += dpp0<0x114>(x); x += dpp0<0x118>(x); bb[m][j] = x; }
                    float run[4] = {0.f, 0.f, 0.f, 0.f};
#pragma unroll
                    for (int m = 0; m < 4; ++m)
#pragma unroll
                        for (int j = 0; j < 4; ++j) { const float tot = __shfl(bb[m][j], lane15); bb[m][j] += run[j]; run[j] += tot; }
#pragma unroll
                    for (int m = 0; m < 4; ++m) { const size_t off = pb0 + (size_t)(ai * HALF + m * 16) * 128 + 4 * n;
                        float qe[4], ki[4];
#pragma unroll
                        for (int j = 0; j < 4; ++j) { const float bt = bb[m][j]; qe[j] = silu_f(rs4[m] * acc[ai][0][m][n][j]) * __expf(bt); ki[j] = kk[m][j] * __expf(fminf(-bt, 80.f)); }
                        u32x2 w; w.x = cvt_pk_bf16(qe[0], qe[1]); w.y = cvt_pk_bf16(qe[2], qe[3]); *(u32x2*)(P + off) = w;
                        w.x = cvt_pk_bf16(ki[0], ki[1]); w.y = cvt_pk_bf16(ki[2], ki[3]); *(u32x2*)(P + plane + off) = w; }
                    if (fr == 0) { const int chunk = 4 * u.pm + 2 * ai + wr; *(f32x4*)(DK + (size_t)chunk * 1024 + ch0 + 4 * n) = (f32x4){__expf(run[0]), __expf(run[1]), __expf(run[2]), __expf(run[3])}; }
                }
            }
        }
    }
};
template <class Epi, class Sched, bool ALIGN_EPI = false, bool SP2 = false>
__device__ __forceinline__ void gemm_phase(PG8_LAS unsigned char* lds, const Gemm g, const Sched& S, const Epi& E, volatile PG8_LAS unsigned* prbp = nullptr) {
#if PROBE_PHASE == 77
    unsigned prk = 0, pre = 0, prr = 0, pra = 0, prt0 = 0, prt1 = 0, prtA = 0, prt2 = (unsigned)__builtin_amdgcn_s_memrealtime();
#endif
    int tid_ = threadIdx.x; asm volatile("" : "+v"(tid_));
    const int tid = tid_, wid = __builtin_amdgcn_readfirstlane(tid >> 6), lane = tid & 63, wr = wid >> 2, wc = wid & 3, fr = lane & 15, fq = lane >> 4;
    const int K = g.K, nt = K / BK;
    unsigned voffA[2], voffB[2];
#pragma unroll
    for (int i = 0; i < 2; ++i) { int R, C; stage_rc(tid * 16 + i * 8192, R, C); const int Rb = Epi::PERM ? ((R & ~31) + perm32(R & 31)) : R;
        voffA[i] = (unsigned)(R * K + C) * 2u; voffB[i] = (unsigned)(Rb * K + C) * 2u; }
    const size_t kstep = (size_t)(BK * 2);
    const size_t hstep = (size_t)HALF * K * 2;
    const size_t tstep = 2 * hstep;
    const unsigned ldsw = (unsigned)wid * 1024u;
    const int aoff = lds_byte(wr * 64 + fr, fq * 8), boff = lds_byte(wc * 32 + fr, fq * 8);
#define PG8_SA(b, h) (((b) * 2 + (h)) * HTB)
#define PG8_SB(b, h) ((4 + (b) * 2 + (h)) * HTB)
#define PG8_STAGE(bufoff, gbase, voff) do { _Pragma("unroll") for (int _i = 0; _i < 2; ++_i) \
        __builtin_amdgcn_global_load_lds((const unsigned*)((const char*)(gbase) + (voff)[_i]), (PG8_LAS unsigned*)(lds + (bufoff) + ldsw + _i * 8192), 16, 0, 0); } while (0)
#define PG8_LDA(dst, b, h) do { _Pragma("unroll") for (int m = 0; m < 4; ++m) _Pragma("unroll") for (int k = 0; k < 2; ++k) dst[m][k] = *(const PG8_LAS bf16x8*)(lds + PG8_SA(b, h) + aoff + m * 2048 + k * 1024); } while (0)
#define PG8_LDB(dst, b, h) do { _Pragma("unroll") for (int n = 0; n < 2; ++n) _Pragma("unroll") for (int k = 0; k < 2; ++k) dst[n][k] = *(const PG8_LAS bf16x8*)(lds + PG8_SB(b, h) + boff + n * 2048 + k * 1024); } while (0)
#define PG8_MMA(ai, bj, At, Bt) do { __builtin_amdgcn_s_setprio(1); _Pragma("unroll") for (int m = 0; m < 4; ++m) _Pragma("unroll") for (int n = 0; n < 2; ++n) _Pragma("unroll") for (int k = 0; k < 2; ++k) \
        acc[ai][bj][m][n] = __builtin_amdgcn_mfma_f32_16x16x32_bf16(Bt[n][k], At[m][k], acc[ai][bj][m][n], 0, 0, 0); __builtin_amdgcn_s_setprio(0); } while (0)
#define PG8_WAIT_V(n) asm volatile("s_waitcnt vmcnt(" #n ")" ::: "memory")
#define PG8_WAIT_V8R(relax) do { if (relax) asm volatile("s_waitcnt vmcnt(%0)" :: "n"(8 + Epi::NST) : "memory"); else asm volatile("s_waitcnt vmcnt(8)" ::: "memory"); } while (0)
#define PG8_WAIT_L(n) asm volatile("s_waitcnt lgkmcnt(" #n ")" ::: "memory")
#define PG8_BAR __builtin_amdgcn_s_barrier()
#define PG8_SCHED __builtin_amdgcn_sched_barrier(0)
    Unit cur, nxt; int ui = 0;
    if (!S.next(0, cur)) return;
    f32x4 acc[2][2][4][2];
#pragma unroll
    for (int a = 0; a < 2; ++a)
#pragma unroll
        for (int b = 0; b < 2; ++b)
#pragma unroll
            for (int m = 0; m < 4; ++m)
#pragma unroll
                for (int n = 0; n < 2; ++n) acc[a][b][m][n] = (f32x4){0.f, 0.f, 0.f, 0.f};
    bf16x8 At[4][2], B0[2][2], B1[2][2];
    const char* cA = (const char*)g.A + (size_t)cur.pm * tstep; const char* cB = (const char*)g.Bt + (size_t)cur.pn * tstep;
    S.a_ready(cur);
    if constexpr (SP2) {
        PG8_STAGE(PG8_SB(0, 0), cB, voffB); PG8_STAGE(PG8_SB(0, 1), cB + hstep, voffB); PG8_STAGE(PG8_SA(0, 0), cA, voffA); PG8_STAGE(PG8_SA(0, 1), cA + hstep, voffA);
        if (wr == 1) PG8_BAR;
        PG8_WAIT_V(2); PG8_BAR;
        PG8_STAGE(PG8_SB(1, 0), cB + kstep, voffB); PG8_STAGE(PG8_SA(1, 0), cA + kstep, voffA); PG8_STAGE(PG8_SB(1, 1), cB + hstep + kstep, voffB);
        PG8_WAIT_V(6); PG8_BAR;
    } else {
        PG8_STAGE(PG8_SB(0, 0), cB, voffB); PG8_STAGE(PG8_SA(0, 0), cA, voffA); PG8_STAGE(PG8_SB(0, 1), cB + hstep, voffB); PG8_STAGE(PG8_SA(0, 1), cA + hstep, voffA);
        if (wr == 1) PG8_BAR;
        PG8_WAIT_V(4); PG8_BAR;
        PG8_STAGE(PG8_SB(1, 0), cB + kstep, voffB); PG8_STAGE(PG8_SA(1, 0), cA + kstep, voffA); PG8_STAGE(PG8_SB(1, 1), cB + hstep + kstep, voffB);
        PG8_WAIT_V(6); PG8_BAR;
    }
    for (;;) {
        const bool has_next = S.next(ui + 1, nxt);
        const char* nA = has_next ? (const char*)g.A + (size_t)nxt.pm * tstep : cA; const char* nB = has_next ? (const char*)g.Bt + (size_t)nxt.pn * tstep : cB;
#if PROBE_PHASE == 77
        prt0 = (unsigned)__builtin_amdgcn_s_memrealtime();
#endif
        for (int t = 0; t < nt; t += 2) {
            const bool last = (t == nt - 2);
            const char* a1 = cA + (size_t)(t + 1) * kstep;
            const char* a2 = last ? nA : cA + (size_t)(t + 2) * kstep; const char* b2 = last ? nB : cB + (size_t)(t + 2) * kstep;
            const char* a3 = a2 + kstep; const char* b3 = b2 + kstep;
            if (last && has_next) S.a_ready(nxt);
            if constexpr (SP2) {
            PG8_LDB(B0, 0, 0); PG8_LDB(B1, 0, 1); PG8_SCHED; PG8_LDA(At, 0, 0); PG8_STAGE(PG8_SA(1, 1), a1 + hstep, voffA);
            PG8_WAIT_V(8); PG8_WAIT_L(0); PG8_BAR; PG8_MMA(0, 0, At, B0); PG8_MMA(0, 1, At, B1); PG8_BAR; PG8_SCHED;
            PG8_LDA(At, 0, 1); PG8_STAGE(PG8_SB(0, 0), b2, voffB); PG8_STAGE(PG8_SB(0, 1), b2 + hstep, voffB); PG8_STAGE(PG8_SA(0, 0), a2, voffA);
            PG8_WAIT_V(8); PG8_WAIT_L(0); PG8_BAR; PG8_MMA(1, 0, At, B0); PG8_MMA(1, 1, At, B1); PG8_BAR; PG8_SCHED;
            PG8_LDB(B0, 1, 0); PG8_LDB(B1, 1, 1); PG8_SCHED; PG8_LDA(At, 1, 0); PG8_STAGE(PG8_SA(0, 1), a2 + hstep, voffA);
            PG8_WAIT_V(8); PG8_WAIT_L(0); PG8_BAR; PG8_MMA(0, 0, At, B0); PG8_MMA(0, 1, At, B1); PG8_BAR; PG8_SCHED;
            PG8_LDA(At, 1, 1); PG8_STAGE(PG8_SB(1, 0), b3, voffB); PG8_STAGE(PG8_SB(1, 1), b3 + hstep, voffB); PG8_STAGE(PG8_SA(1, 0), a3, voffA);
            PG8_WAIT_V(8); PG8_WAIT_L(0); PG8_BAR; PG8_MMA(1, 0, At, B0); PG8_MMA(1, 1, At, B1); PG8_BAR; PG8_SCHED;
            } else {
            PG8_LDB(B0, 0, 0); PG8_SCHED; PG8_LDA(At, 0, 0); PG8_STAGE(PG8_SA(1, 1), a1 + hstep, voffA);
            PG8_WAIT_L(8); PG8_BAR; PG8_WAIT_L(0); PG8_MMA(0, 0, At, B0); PG8_BAR; PG8_SCHED;
            PG8_LDB(B1, 0, 1); PG8_STAGE(PG8_SB(0, 0), b2, voffB);
            PG8_BAR; PG8_WAIT_L(0); PG8_MMA(0, 1, At, B1); PG8_BAR;
            PG8_LDA(At, 0, 1); PG8_STAGE(PG8_SA(0, 0), a2, voffA);
            PG8_BAR; PG8_WAIT_L(0); PG8_MMA(1, 0, At, B0); PG8_BAR; PG8_SCHED;
            PG8_STAGE(PG8_SB(0, 1), b2 + hstep, voffB);
            PG8_WAIT_V(6); PG8_BAR; PG8_MMA(1, 1, At, B1); PG8_BAR;
            PG8_LDB(B0, 1, 0); PG8_SCHED; PG8_LDA(At, 1, 0); PG8_STAGE(PG8_SA(0, 1), a2 + hstep, voffA);
            PG8_WAIT_L(8); PG8_BAR; PG8_WAIT_L(0); PG8_MMA(0, 0, At, B0); PG8_BAR; PG8_SCHED;
            PG8_LDB(B1, 1, 1); PG8_STAGE(PG8_SB(1, 0), b3, voffB);
            PG8_BAR; PG8_WAIT_L(0); PG8_MMA(0, 1, At, B1); PG8_BAR;
            PG8_LDA(At, 1, 1); PG8_STAGE(PG8_SA(1, 0), a3, voffA);
            PG8_BAR; PG8_WAIT_L(0); PG8_MMA(1, 0, At, B0); PG8_BAR; PG8_SCHED;
            PG8_STAGE(PG8_SB(1, 1), b3 + hstep, voffB);
            PG8_WAIT_V(6); PG8_BAR; PG8_MMA(1, 1, At, B1); PG8_BAR;
            }
        }
#if PROBE_PHASE == 77
        prt1 = (unsigned)__builtin_amdgcn_s_memrealtime(); prk += prt1 - prt0;
#endif
        if constexpr (ALIGN_EPI) { if (wr == 0) PG8_BAR; }
#if PROBE_PHASE == 77
        prtA = (unsigned)__builtin_amdgcn_s_memrealtime(); pra += prtA - prt1;
#endif
        if constexpr (!Epi::AFTER_DRAIN) { E(acc, cur, wr, wc, fr, fq); S.done(cur); }
#if PROBE_PHASE == 77
        prt2 = (unsigned)__builtin_amdgcn_s_memrealtime(); pre += prt2 - prtA;
        asm volatile("s_waitcnt vmcnt(0)" ::: "memory"); prr += (unsigned)__builtin_amdgcn_s_memrealtime() - prt2;
#endif
        if (!has_next) break;
#pragma unroll
        for (int a = 0; a < 2; ++a)
#pragma unroll
            for (int b = 0; b < 2; ++b)
#pragma unroll
                for (int m = 0; m < 4; ++m)
#pragma unroll
                    for (int n = 0; n < 2; ++n) acc[a][b][m][n] = (f32x4){0.f, 0.f, 0.f, 0.f};
        cur = nxt; cA = nA; cB = nB; ++ui;
        if constexpr (ALIGN_EPI) { if (wr == 1) PG8_BAR; }
    }
#if PROBE_PHASE == 77
    if (prbp && blockIdx.x == 0 && tid == PRB_SEL2) { prbp[0] = prk; prbp[1] = pre; prbp[2] = prr; prbp[3] = pra; }
#endif
    PG8_WAIT_V(0);
    if constexpr (!ALIGN_EPI) { if (wr == 0) PG8_BAR; }
    PG8_BAR;
    if constexpr (Epi::AFTER_DRAIN) { E.fused(acc, cur, wr, wc, fr, fq, lds, wid, lane); S.done(cur); }
#undef PG8_SA
#undef PG8_SB
#undef PG8_STAGE
#undef PG8_LDA
#undef PG8_LDB
#undef PG8_MMA
#undef PG8_WAIT_V
#undef PG8_WAIT_V8R
#undef PG8_WAIT_L
#undef PG8_BAR
#undef PG8_SCHED
}

typedef int v8i_t __attribute__((ext_vector_type(8)));
typedef short bf16x16_t __attribute__((ext_vector_type(16)));
template <class Epi, class Sched, bool ALIGN_EPI = false, bool SP2 = false>
__device__ __forceinline__ void gemm_phase8(PG8_LAS unsigned char* lds, const Gemm g, const Sched& S, const Epi& E) {
    int tid_ = threadIdx.x; asm volatile("" : "+v"(tid_));
    const int tid = tid_, wid = __builtin_amdgcn_readfirstlane(tid >> 6), lane = tid & 63, wr = wid >> 2, wc = wid & 3, fr = lane & 15, fq = lane >> 4;
    const int K = g.K, nt = K / 128;
    unsigned voffA[2], voffB[2];
#pragma unroll
    for (int i = 0; i < 2; ++i) { int R, C; stage_rc(tid * 16 + i * 8192, R, C); const int Rb = Epi::PERM ? ((R & ~31) + perm32(R & 31)) : R;
        voffA[i] = (unsigned)(R * K + 2 * C); voffB[i] = (unsigned)(Rb * K + 2 * C); }
    const size_t kstep = (size_t)(BK * 2);
    const size_t hstep = (size_t)HALF * K;
    const size_t tstep = 2 * hstep;
    const unsigned ldsw = (unsigned)wid * 1024u;
    const int aoff = lds_byte(wr * 64 + fr, fq * 16), boff = lds_byte(wc * 32 + fr, fq * 16);
#define PG8_SA(b, h) (((b) * 2 + (h)) * HTB)
#define PG8_SB(b, h) ((4 + (b) * 2 + (h)) * HTB)
#define PG8_STAGE(bufoff, gbase, voff) do { _Pragma("unroll") for (int _i = 0; _i < 2; ++_i) \
        __builtin_amdgcn_global_load_lds((const unsigned*)((const char*)(gbase) + (voff)[_i]), (PG8_LAS unsigned*)(lds + (bufoff) + ldsw + _i * 8192), 16, 0, 0); } while (0)
#define PG8_LD32(dst, addr) do { const u32x4 lo_ = *(const PG8_LAS u32x4*)(addr), hi_ = *(const PG8_LAS u32x4*)((addr) + 16); dst = (v8i_t){(int)lo_.x, (int)lo_.y, (int)lo_.z, (int)lo_.w, (int)hi_.x, (int)hi_.y, (int)hi_.z, (int)hi_.w}; } while (0)
#define PG8_LDA(dst, b, h) do { _Pragma("unroll") for (int m = 0; m < 4; ++m) PG8_LD32(dst[m], lds + PG8_SA(b, h) + aoff + m * 2048); } while (0)
#define PG8_LDB(dst, b, h) do { _Pragma("unroll") for (int n = 0; n < 2; ++n) PG8_LD32(dst[n], lds + PG8_SB(b, h) + boff + n * 2048); } while (0)
#define PG8_MMA(ai, bj, At, Bt) do { __builtin_amdgcn_s_setprio(1); _Pragma("unroll") for (int m = 0; m < 4; ++m) _Pragma("unroll") for (int n = 0; n < 2; ++n) \
        asm volatile("v_mfma_scale_f32_16x16x128_f8f6f4 %0, %1, %2, %0, %3, %3 op_sel_hi:[0,0,0]" : "+v"(acc[ai][bj][m][n]) : "v"(Bt[n]), "v"(At[m]), "v"(f8one)); __builtin_amdgcn_s_setprio(0); asm volatile("s_nop 4"); } while (0)
#define PG8_WAIT_V(n) asm volatile("s_waitcnt vmcnt(" #n ")" ::: "memory")
#define PG8_WAIT_V8R(relax) do { if (relax) asm volatile("s_waitcnt vmcnt(%0)" :: "n"(8 + Epi::NST) : "memory"); else asm volatile("s_waitcnt vmcnt(8)" ::: "memory"); } while (0)
#define PG8_WAIT_L(n) asm volatile("s_waitcnt lgkmcnt(" #n ")" ::: "memory")
#define PG8_BAR __builtin_amdgcn_s_barrier()
#define PG8_SCHED __builtin_amdgcn_sched_barrier(0)
    Unit cur, nxt; int ui = 0;
    if (!S.next(0, cur)) return;
    f32x4 acc[2][2][4][2];
#pragma unroll
    for (int a = 0; a < 2; ++a)
#pragma unroll
        for (int b = 0; b < 2; ++b)
#pragma unroll
            for (int m = 0; m < 4; ++m)
#pragma unroll
                for (int n = 0; n < 2; ++n) acc[a][b][m][n] = (f32x4){0.f, 0.f, 0.f, 0.f};
    v8i_t At[4], B0[2], B1[2]; const int f8one = 0x7f7f7f7f;
    const char* cA = (const char*)g.A + (size_t)cur.pm * tstep; const char* cB = (const char*)g.Bt + (size_t)cur.pn * tstep;
    S.a_ready(cur);
    if constexpr (SP2) {
        PG8_STAGE(PG8_SB(0, 0), cB, voffB); PG8_STAGE(PG8_SB(0, 1), cB + hstep, voffB); PG8_STAGE(PG8_SA(0, 0), cA, voffA); PG8_STAGE(PG8_SA(0, 1), cA + hstep, voffA);
        if (wr == 1) PG8_BAR;
        PG8_WAIT_V(2); PG8_BAR;
        PG8_STAGE(PG8_SB(1, 0), cB + kstep, voffB); PG8_STAGE(PG8_SA(1, 0), cA + kstep, voffA); PG8_STAGE(PG8_SB(1, 1), cB + hstep + kstep, voffB);
        PG8_WAIT_V(6); PG8_BAR;
    } else {
        PG8_STAGE(PG8_SB(0, 0), cB, voffB); PG8_STAGE(PG8_SA(0, 0), cA, voffA); PG8_STAGE(PG8_SB(0, 1), cB + hstep, voffB); PG8_STAGE(PG8_SA(0, 1), cA + hstep, voffA);
        if (wr == 1) PG8_BAR;
        PG8_WAIT_V(4); PG8_BAR;
        PG8_STAGE(PG8_SB(1, 0), cB + kstep, voffB); PG8_STAGE(PG8_SA(1, 0), cA + kstep, voffA); PG8_STAGE(PG8_SB(1, 1), cB + hstep + kstep, voffB);
        PG8_WAIT_V(6); PG8_BAR;
    }
    for (;;) {
        const bool has_next = S.next(ui + 1, nxt);
        const char* nA = has_next ? (const char*)g.A + (size_t)nxt.pm * tstep : cA; const char* nB = has_next ? (const char*)g.Bt + (size_t)nxt.pn * tstep : cB;
        for (int t = 0; t < nt; t += 2) {
            const bool last = (t == nt - 2);
            const char* a1 = cA + (size_t)(t + 1) * kstep;
            const char* a2 = last ? nA : cA + (size_t)(t + 2) * kstep; const char* b2 = last ? nB : cB + (size_t)(t + 2) * kstep;
            const char* a3 = a2 + kstep; const char* b3 = b2 + kstep;
            if (last && has_next) S.a_ready(nxt);
            if constexpr (SP2) {
            PG8_LDB(B0, 0, 0); PG8_LDB(B1, 0, 1); PG8_SCHED; PG8_LDA(At, 0, 0); PG8_STAGE(PG8_SA(1, 1), a1 + hstep, voffA);
            PG8_WAIT_V(8); PG8_WAIT_L(0); PG8_BAR; PG8_MMA(0, 0, At, B0); PG8_MMA(0, 1, At, B1); PG8_BAR; PG8_SCHED;
            PG8_LDA(At, 0, 1); PG8_STAGE(PG8_SB(0, 0), b2, voffB); PG8_STAGE(PG8_SB(0, 1), b2 + hstep, voffB); PG8_STAGE(PG8_SA(0, 0), a2, voffA);
            PG8_WAIT_V(8); PG8_WAIT_L(0); PG8_BAR; PG8_MMA(1, 0, At, B0); PG8_MMA(1, 1, At, B1); PG8_BAR; PG8_SCHED;
            PG8_LDB(B0, 1, 0); PG8_LDB(B1, 1, 1); PG8_SCHED; PG8_LDA(At, 1, 0); PG8_STAGE(PG8_SA(0, 1), a2 + hstep, voffA);
            PG8_WAIT_V(8); PG8_WAIT_L(0); PG8_BAR; PG8_MMA(0, 0, At, B0); PG8_MMA(0, 1, At, B1); PG8_BAR; PG8_SCHED;
            PG8_LDA(At, 1, 1); PG8_STAGE(PG8_SB(1, 0), b3, voffB); PG8_STAGE(PG8_SB(1, 1), b3 + hstep, voffB); PG8_STAGE(PG8_SA(1, 0), a3, voffA);
            PG8_WAIT_V(8); PG8_WAIT_L(0); PG8_BAR; PG8_MMA(1, 0, At, B0); PG8_MMA(1, 1, At, B1); PG8_BAR; PG8_SCHED;
            } else {
            PG8_LDB(B0, 0, 0); PG8_SCHED; PG8_LDA(At, 0, 0); PG8_STAGE(PG8_SA(1, 1), a1 + hstep, voffA);
            PG8_WAIT_L(8); PG8_BAR; PG8_WAIT_L(0); PG8_MMA(0, 0, At, B0); PG8_BAR; PG8_SCHED;
            PG8_LDB(B1, 0, 1); PG8_STAGE(PG8_SB(0, 0), b2, voffB);
            PG8_BAR; PG8_WAIT_L(0); PG8_MMA(0, 1, At, B1); PG8_BAR;
            PG8_LDA(At, 0, 1); PG8_STAGE(PG8_SA(0, 0), a2, voffA);
            PG8_BAR; PG8_WAIT_L(0); PG8_MMA(1, 0, At, B0); PG8_BAR; PG8_SCHED;
            PG8_STAGE(PG8_SB(0, 1), b2 + hstep, voffB);
            PG8_WAIT_V(6); PG8_BAR; PG8_MMA(1, 1, At, B1); PG8_BAR;
            PG8_LDB(B0, 1, 0); PG8_SCHED; PG8_LDA(At, 1, 0); PG8_STAGE(PG8_SA(0, 1), a2 + hstep, voffA);
            PG8_WAIT_L(8); PG8_BAR; PG8_WAIT_L(0); PG8_MMA(0, 0, At, B0); PG8_BAR; PG8_SCHED;
            PG8_LDB(B1, 1, 1); PG8_STAGE(PG8_SB(1, 0), b3, voffB);
            PG8_BAR; PG8_WAIT_L(0); PG8_MMA(0, 1, At, B1); PG8_BAR;
            PG8_LDA(At, 1, 1); PG8_STAGE(PG8_SA(1, 0), a3, voffA);
            PG8_BAR; PG8_WAIT_L(0); PG8_MMA(1, 0, At, B0); PG8_BAR; PG8_SCHED;
            PG8_STAGE(PG8_SB(1, 1), b3 + hstep, voffB);
            PG8_WAIT_V(6); PG8_BAR; PG8_MMA(1, 1, At, B1); PG8_BAR;
            }
        }
        if constexpr (ALIGN_EPI) { if (wr == 0) PG8_BAR; }
        if constexpr (!Epi::AFTER_DRAIN) { E(acc, cur, wr, wc, fr, fq); S.done(cur); }
        if (!has_next) break;
#pragma unroll
        for (int a = 0; a < 2; ++a)
#pragma unroll
            for (int b = 0; b < 2; ++b)
#pragma unroll
                for (int m = 0; m < 4; ++m)
#pragma unroll
                    for (int n = 0; n < 2; ++n) acc[a][b][m][n] = (f32x4){0.f, 0.f, 0.f, 0.f};
        cur = nxt; cA = nA; cB = nB; ++ui;
        if constexpr (ALIGN_EPI) { if (wr == 1) PG8_BAR; }
    }
    PG8_WAIT_V(0);
    if constexpr (!ALIGN_EPI) { if (wr == 0) PG8_BAR; }
    PG8_BAR;
    if constexpr (Epi::AFTER_DRAIN) { E.fused(acc, cur, wr, wc, fr, fq, lds, wid, lane); S.done(cur); }
#undef PG8_SA
#undef PG8_SB
#undef PG8_STAGE
#undef PG8_LDA
#undef PG8_LDB
#undef PG8_MMA
#undef PG8_LD32
#undef PG8_WAIT_V
#undef PG8_WAIT_V8R
#undef PG8_WAIT_L
#undef PG8_BAR
#undef PG8_SCHED
}

}
#ifndef PG8_SP2
#define PG8_SP2 true
#endif
#ifndef PG8_ALIGN
#define PG8_ALIGN true
#endif
constexpr int NWAVES = 8;
constexpr int BATCH = 8, SEQ = 8192, D = 1024, NTOK = BATCH * SEQ;
constexpr int QKV_LD = 2304;
constexpr int QKV_N = 2304, FF = 3584, NEXP = 8, REC_N = 4096;
constexpr float EPS = 1e-6f;
constexpr float F8_HSCALE = 4.0f, F8_WDSCALE = 64.0f;
constexpr float F8_ASCALE = 8.0f, F8_WGSCALE = 32.0f;
constexpr int NPH = 22;
#ifndef MK_N_LAUNCHES
#define MK_N_LAUNCHES 1
#endif
constexpr int N_LAUNCHES = MK_N_LAUNCHES;
constexpr size_t MiB = 1u << 20;
constexpr size_t WS_CTL = 0, CTL_ZERO_BYTES = 1 * MiB;
constexpr size_t WS_WMOE_DN = 1 * MiB;
constexpr size_t WS_WMOE_GU = 29 * MiB;
constexpr size_t WS_H = 85 * MiB;
constexpr size_t WS_W_INATT = 297 * MiB;
constexpr size_t WS_W_OUTATT = WS_W_INATT + (size_t)QKV_N * D * 2;
constexpr size_t WS_W_GU = WS_W_OUTATT + (size_t)D * D * 2;
constexpr size_t WS_W_DN = WS_W_GU + (size_t)2 * FF * D * 2;
constexpr size_t WS_W_INREC = WS_W_DN + (size_t)D * FF * 2;
constexpr size_t WS_W_OUTREC = WS_W_INREC + (size_t)REC_N * D * 2;
constexpr size_t WS_BIG = 335 * MiB;
constexpr size_t WS_Y = 29 * MiB;
constexpr size_t WS_HID = 289 * MiB;
constexpr size_t WS_MISC = 1008 * MiB;
constexpr size_t WS_ROPE = WS_MISC;
constexpr size_t WS_META = WS_MISC + 4 * MiB;
constexpr size_t WS_DEST = WS_MISC + 5 * MiB;
constexpr size_t WS_HIST = WS_MISC + 6 * MiB;
constexpr size_t WS_INFO = WS_HIST + 8192;
constexpr size_t WS_LBK = WS_INFO + 4096;
constexpr size_t WS_OB = 623 * MiB;
constexpr size_t WS_LSE = 751 * MiB;
constexpr size_t WS_DK = WS_MISC + 8 * MiB;
constexpr size_t WS_HL = 848 * MiB;
constexpr size_t WS_HP = 860 * MiB;
constexpr size_t WS_H2 = 880 * MiB;
constexpr size_t WS_RSP = WS_MISC + 12 * MiB;
constexpr size_t CTL_SSQ1 = 128 * 1024, CTL_SSQ2 = 384 * 1024, CTL_SSQ3 = 640 * 1024;
constexpr size_t WS_RS0 = WS_MISC + 13 * MiB;
constexpr size_t WS_P8 = 85 * MiB;
constexpr size_t WS_END = 1024 * MiB;
static_assert(WS_W_OUTREC + (size_t)D * D * 2 <= WS_BIG && WS_BIG + 512 * MiB <= WS_MISC && WS_WMOE_DN + 28 * MiB <= WS_Y && WS_Y + 260 * MiB <= WS_HID && WS_P8 + 130 * MiB <= WS_Y + 260 * MiB && WS_HID + 455 * MiB <= WS_H2 && WS_H + 128 * MiB <= WS_W_INATT && WS_H2 + 128 * MiB <= WS_MISC && WS_BIG + 512 * MiB <= WS_H2 && WS_HL >= WS_BIG + 512 * MiB && WS_LBK + 4096 <= WS_END, "d_ws map");
constexpr int CW_BAR = 4096;
constexpr int RING_BYTES = 131072;
constexpr int LDSCTL_OFF = RING_BYTES, MISC_OFF = LDSCTL_OFF + 320;
constexpr int LDS_BYTES = 147456;

#define GAS __attribute__((address_space(1)))
#define LAS __attribute__((address_space(3)))
typedef unsigned short bf16;
typedef unsigned v4u __attribute__((ext_vector_type(4)));
typedef unsigned v2u __attribute__((ext_vector_type(2)));
typedef float f32x4 __attribute__((ext_vector_type(4)));
#define LDS_WAIT() asm volatile("s_waitcnt lgkmcnt(0)" ::: "memory")
typedef float f32x2_t __attribute__((ext_vector_type(2))); typedef __bf16 bf16x2_t __attribute__((ext_vector_type(2)));
__device__ __forceinline__ unsigned pk2(float lo, float hi) { const f32x2_t v = {lo, hi}; const bf16x2_t b = __builtin_convertvector(v, bf16x2_t); return __builtin_bit_cast(unsigned, b); }
__device__ __forceinline__ float bflo(unsigned w) { return __builtin_bit_cast(float, w << 16); }
__device__ __forceinline__ float bfhi(unsigned w) { return __builtin_bit_cast(float, w & 0xffff0000u); }
__device__ __forceinline__ float wave_sum(float v) {
#pragma unroll
    for (int o = 1; o < 64; o <<= 1) v += __shfl_xor(v, o);
    return v;
}
#define XB_TMO      128
#define XB_XCNT(j)  (256  + 64 * (j))
#define XB_XSUB(j)  (1280 + 64 * (j))
#define XB_XGEN(j)  (2304 + 64 * (j))
#define XB_TOP      3328
#define XB_TOPGEN   3392
#define XCD_BAR_WORDS 3456
#define XB_SPIN_CAP (1u << 24)

__device__ __forceinline__ unsigned xb_ld(unsigned* p)              { return __hip_atomic_load(p, __ATOMIC_RELAXED, __HIP_MEMORY_SCOPE_AGENT); }
__device__ __forceinline__ unsigned xb_add(unsigned* p, unsigned v) { return __hip_atomic_fetch_add(p, v, __ATOMIC_RELAXED, __HIP_MEMORY_SCOPE_AGENT); }
__device__ __forceinline__ unsigned xb_xcc_id() { return (unsigned)__builtin_amdgcn_s_getreg((3 << 11) | 20) & 0xFu; }
#define XB_SPIN(cond, bar) do { unsigned _sp = 0; while (cond) { __builtin_amdgcn_s_sleep(1); \
    if ((++_sp & 255u) == 0u) { if (xb_ld(&(bar)[XB_TMO])) break; if (_sp > XB_SPIN_CAP) { atomicAdd(&(bar)[XB_TMO], 1u); break; } } } } while (0)

struct XcdBarrier {
    unsigned* bar; unsigned x;
    volatile LAS unsigned* st;
};

__device__ __forceinline__ XcdBarrier xcd_barrier_post(unsigned* bar, volatile LAS unsigned* st) {
    XcdBarrier b; b.bar = bar; b.x = xb_xcc_id(); b.st = st;
    if (threadIdx.x == 0) (void)xb_add(&bar[XB_XCNT(b.x)], 1u);
    return b;
}
__device__ __forceinline__ void xcd_barrier_complete(unsigned* bar, unsigned x, unsigned& nloc, unsigned& nx) {
    const unsigned G = gridDim.x * gridDim.y * gridDim.z;
    unsigned sum, cnt, mine, sp = 0u;
    for (;;) {
        sum = 0u; cnt = 0u; mine = 0u;
#pragma unroll
        for (unsigned j = 0; j < 16; ++j) { const unsigned c = xb_ld(&bar[XB_XCNT(j)]); sum += c; cnt += (c > 0u) ? 1u : 0u; mine = (j == x) ? c : mine; }
        if (sum == G) break;
        __builtin_amdgcn_s_sleep(1);
        if ((++sp & 255u) == 0u) { if (xb_ld(&bar[XB_TMO])) break; if (sp > XB_SPIN_CAP) { atomicAdd(&bar[XB_TMO], 1u); break; } }
    }
    nloc = mine > 0u ? mine : 1u; nx = cnt > 0u ? cnt : 1u;
}

__device__ __forceinline__ void xcd_barrier(const XcdBarrier& b) {
    asm volatile("s_waitcnt vmcnt(0)" ::: "memory");
    __syncthreads();
    if (threadIdx.x == 0) {
        unsigned* bar = b.bar;
        __builtin_amdgcn_s_waitcnt(0);
        unsigned nloc = b.st[0], nx = b.st[1];
        if (nloc == 0u) { xcd_barrier_complete(bar, b.x, nloc, nx); b.st[0] = nloc; b.st[1] = nx; }
        const unsigned old = xb_add(&bar[XB_XSUB(b.x)], 1u);
        const unsigned gen = old / nloc;
        if (old + 1u == (gen + 1u) * nloc) {
            __builtin_amdgcn_fence(__ATOMIC_RELEASE, "agent");
            asm volatile("s_waitcnt vmcnt(0)" ::: "memory");
            const unsigned og = xb_add(&bar[XB_TOP], 1u);
            const unsigned tg = og / nx;
            if (og + 1u == (tg + 1u) * nx) xb_add(&bar[XB_TOPGEN], 1u);
            else XB_SPIN(xb_ld(&bar[XB_TOPGEN]) == tg, bar);
            __builtin_amdgcn_fence(__ATOMIC_ACQUIRE, "agent");
            xb_add(&bar[XB_XGEN(b.x)], 1u);
            asm volatile("s_waitcnt vmcnt(0)" ::: "memory");
        } else {
            XB_SPIN(xb_ld(&bar[XB_XGEN(b.x)]) == gen, bar);
            __builtin_amdgcn_fence(__ATOMIC_ACQUIRE, "agent");
            asm volatile("s_waitcnt vmcnt(0)" ::: "memory");
        }
    }
    __syncthreads();
}
struct ConvItem { const float* W; bf16* WT; const float* gk; int N, K, k0, n0, drow0; float f8scale; };
__device__ __forceinline__ void conv_load(const ConvItem& c, f32x4 (&t)[8], int lane) {
    const int rr = lane >> 3, cq = (lane & 7) * 4;
#pragma unroll
    for (int i = 0; i < 8; ++i) t[i] = *(const f32x4*)(c.W + (size_t)(c.k0 + rr + 8 * i) * c.N + c.n0 + cq);
}
__device__ __forceinline__ void conv_store(const ConvItem& c, const f32x4 (&t)[8], LAS float* scr, int lane) {
    { const int rr = lane >> 3, cq = (lane & 7) * 4;
#pragma unroll
      for (int i = 0; i < 8; ++i) { LAS float* d = scr + (rr + 8 * i) * 33 + cq; d[0] = t[i].x; d[1] = t[i].y; d[2] = t[i].z; d[3] = t[i].w; } }
    LDS_WAIT(); asm volatile("" ::: "memory");
    const int cc = lane & 7;
    f32x4 g0 = (f32x4){1.f, 1.f, 1.f, 1.f}, g1 = g0;
    if (c.gk) { g0 = *(const f32x4*)(c.gk + c.k0 + 8 * cc); g1 = *(const f32x4*)(c.gk + c.k0 + 8 * cc + 4); }
#pragma unroll
    for (int j = 0; j < 4; ++j) { const int n = (lane >> 3) + 8 * j; const LAS float* s = scr + (8 * cc) * 33 + n;
        if (c.f8scale != 0.f) { const float q = c.f8scale; v2u o8; o8.x = pg8::pk4_fp8(s[0 * 33] * g0.x * q, s[1 * 33] * g0.y * q, s[2 * 33] * g0.z * q, s[3 * 33] * g0.w * q); o8.y = pg8::pk4_fp8(s[4 * 33] * g1.x * q, s[5 * 33] * g1.y * q, s[6 * 33] * g1.z * q, s[7 * 33] * g1.w * q);
            *(v2u*)((unsigned char*)c.WT + (size_t)(c.drow0 + n) * c.K + c.k0 + 8 * cc) = o8; }
        else { v4u o; o.x = pk2(s[0 * 33] * g0.x, s[1 * 33] * g0.y); o.y = pk2(s[2 * 33] * g0.z, s[3 * 33] * g0.w); o.z = pk2(s[4 * 33] * g1.x, s[5 * 33] * g1.y); o.w = pk2(s[6 * 33] * g1.z, s[7 * 33] * g1.w);
            *(v4u*)(c.WT + (size_t)(c.drow0 + n) * c.K + c.k0 + 8 * cc) = o; } }
    LDS_WAIT(); asm volatile("" ::: "memory");
}
__device__ __forceinline__ int dest_row(int mode, int n0) {
    if (mode == 0) return n0;
    if (mode == 1) return 256 * (n0 >> 7) + (n0 & 127);
    if (mode == 2) return 256 * (n0 >> 7) + 128 + (n0 & 127);
    const int sec = n0 >> 10, c = n0 & 1023, hd = c >> 7, w = c & 127;
    return ((sec >> 1) ? 2048 : 0) + 256 * hd + ((sec & 1) ? 128 : 0) + w;
}
__device__ __forceinline__ void conv_desc(ConvItem& c, const float* W, int K, int N, bf16* WT, int mode, int r, const float* gk, float f8scale = 0.f) {
    const int nblk = N / 32, kb = r / nblk, nb = r % nblk;
    c.f8scale = f8scale; c.W = W; c.WT = WT; c.gk = gk; c.N = N; c.K = K; c.k0 = 64 * kb; c.n0 = 32 * nb; c.drow0 = dest_row(mode, 32 * nb);
}
__device__ __forceinline__ float inv_freq(int j) {
    return j == 0 ? 1.000000000e+00f : j == 1 ? 1.939227432e-01f : j == 2 ? 3.760603070e-02f : j == 3 ? 7.292664610e-03f : j == 4 ? 1.414213562e-03f : j == 5 ? 2.742481884e-04f : j == 6 ? 5.318295734e-05f : 1.031338525e-05f;
}
struct P0Args { const float *g_ffn0, *g_mix1, *g_ffn1; const float *x, *g0, *w_in_attn, *w_out_attn, *w_in_rec, *w_out_rec, *w_gate, *w_up, *w_down, *w_gate_moe, *w_up_moe, *w_down_moe, *rlb; const int* pos; unsigned char* ws; };
__device__ __forceinline__ void phase_prologue(const P0Args& a, LAS unsigned char* lds, int blk, int G, int tid) {
    const int wave = tid >> 6, lane = tid & 63;
    LAS float* scr = (LAS float*)(lds + wave * 16384);
    const int gw = blk * NWAVES + wave, NGW = G * NWAVES;
    unsigned char* ws = a.ws;
    constexpr int I_INATT = 16 * (QKV_N / 32), I_SQ = 16 * 32, I_GU = 16 * (FF / 32), I_DN = (FF / 64) * 32, I_INREC = 16 * (REC_N / 32);
    constexpr int NITEMS = I_INATT + I_SQ + 2 * I_GU + I_DN + I_INREC + I_SQ + NEXP * (2 * I_GU + I_DN);
    auto decode = [&](int it, ConvItem& c) {
        int r = it;
        if (r < I_INATT) { conv_desc(c, a.w_in_attn, D, QKV_N, (bf16*)(ws + WS_W_INATT), 0, r, a.g0); return; } r -= I_INATT;
        if (r < I_SQ) { conv_desc(c, a.w_out_attn, D, D, (bf16*)(ws + WS_W_OUTATT), 0, r, nullptr); return; } r -= I_SQ;
        if (r < I_GU) { conv_desc(c, a.w_gate, D, FF, (bf16*)(ws + WS_W_GU), 1, r, a.g_ffn0); return; } r -= I_GU;
        if (r < I_GU) { conv_desc(c, a.w_up, D, FF, (bf16*)(ws + WS_W_GU), 2, r, a.g_ffn0); return; } r -= I_GU;
        if (r < I_DN) { conv_desc(c, a.w_down, FF, D, (bf16*)(ws + WS_W_DN), 0, r, nullptr); return; } r -= I_DN;
        if (r < I_INREC) { conv_desc(c, a.w_in_rec, D, REC_N, (bf16*)(ws + WS_W_INREC), 3, r, a.g_mix1); return; } r -= I_INREC;
        if (r < I_SQ) { conv_desc(c, a.w_out_rec, D, D, (bf16*)(ws + WS_W_OUTREC), 0, r, nullptr); return; } r -= I_SQ;
        if (r < NEXP * I_GU) { const int e = r / I_GU, q = r % I_GU; conv_desc(c, a.w_gate_moe + (size_t)e * D * FF, D, FF, (bf16*)(ws + WS_WMOE_GU + (size_t)e * 2 * FF * D), 1, q, a.g_ffn1, F8_WGSCALE); return; } r -= NEXP * I_GU;
        if (r < NEXP * I_GU) { const int e = r / I_GU, q = r % I_GU; conv_desc(c, a.w_up_moe + (size_t)e * D * FF, D, FF, (bf16*)(ws + WS_WMOE_GU + (size_t)e * 2 * FF * D), 2, q, a.g_ffn1, F8_WGSCALE); return; } r -= NEXP * I_GU;
        { const int e = r / I_DN, q = r % I_DN; conv_desc(c, a.w_down_moe + (size_t)e * FF * D, FF, D, (bf16*)(ws + WS_WMOE_DN + (size_t)e * D * FF), 0, q, nullptr, F8_WDSCALE); }
    };
    {
        ConvItem cur, nxt; f32x4 tc[8], tn[8];
        int it = gw; bool have = it < NITEMS;
        if (have) { decode(it, cur); conv_load(cur, tc, lane); }
        while (have) { const int itn = it + NGW; const bool hn = itn < NITEMS;
            if (hn) { decode(itn, nxt); conv_load(nxt, tn, lane); }
            conv_store(cur, tc, scr, lane);
            cur = nxt;
#pragma unroll
            for (int i = 0; i < 8; ++i) tc[i] = tn[i];
            it = itn; have = hn; }
    }
    { bf16* xb = (bf16*)(ws + WS_H2); float* rs0 = (float*)(ws + WS_RS0);
      for (int m0 = gw; m0 < NTOK; m0 += 2 * NGW) { f32x4 v[2][4];
#pragma unroll
          for (int t = 0; t < 2; ++t) { const int m = (m0 + t * NGW < NTOK) ? m0 + t * NGW : m0; const f32x4* xr = (const f32x4*)(a.x + (size_t)m * D) + lane;
#pragma unroll
              for (int j = 0; j < 4; ++j) v[t][j] = xr[64 * j]; }
#pragma unroll
          for (int t = 0; t < 2; ++t) { const int m = m0 + t * NGW; if (m >= NTOK) break; float s = 0.f;
#pragma unroll
              for (int j = 0; j < 4; ++j) s += (v[t][j].x * v[t][j].x + v[t][j].y * v[t][j].y) + (v[t][j].z * v[t][j].z + v[t][j].w * v[t][j].w);
              s = wave_sum(s); if (lane == 0) rs0[m] = 1.0f / sqrtf(s * (1.f / D) + EPS);
              unsigned long long* o8 = (unsigned long long*)(xb + (size_t)m * D) + lane;
#pragma unroll
              for (int j = 0; j < 4; ++j) o8[64 * j] = (unsigned long long)pk2(v[t][j].x, v[t][j].y) | ((unsigned long long)pk2(v[t][j].z, v[t][j].w) << 32); } } }
    float* rope = (float*)(ws + WS_ROPE);
    for (int i = blk * 512 + tid; i < NTOK * 8; i += G * 512) { const int tok = i >> 3, j = i & 7;
        const float ang = (float)a.pos[tok] * inv_freq(j);
        const double turns = (double)ang * 0.15915494309189533577; const float fr = (float)(turns - __builtin_rint(turns));
        rope[tok * 16 + j] = __builtin_amdgcn_cosf(fr); rope[tok * 16 + 8 + j] = __builtin_amdgcn_sinf(fr); }
    float* lbk = (float*)(ws + WS_LBK);
    for (int i = blk * 512 + tid; i < 1024; i += G * 512) lbk[i] = 1.0f / (1.0f + __expf(a.rlb[1024 + i] - a.rlb[i]));
}
typedef float f32x16 __attribute__((ext_vector_type(16)));
typedef short bf16x8v __attribute__((ext_vector_type(8)));
typedef short s16x4 __attribute__((ext_vector_type(4)));
typedef short v4i16_t __attribute__((ext_vector_type(4)));
__device__ __forceinline__ int crow(int r, int hi) { return (r & 3) + 8 * (r >> 2) + 4 * hi; }
__device__ __forceinline__ s16x4 vtr(const LAS unsigned char* p) { return __builtin_bit_cast(s16x4, __builtin_amdgcn_ds_read_tr16_b64_v4i16((LAS v4i16_t*)p)); }
struct AttnSub { int b, dstride, r, P0, qcol, kcol, vcol, mode, hx, chain, par; };
struct AttnRegs { v4u k[8], v[8]; };
__device__ __forceinline__ void attn_load(const AttnSub& su, const bf16* qkv, AttnRegs& R, int t256, int hw, int lane) {
    const size_t rowb = (size_t)su.b * SEQ;
    const int c = t256 & 7, k0 = t256 >> 3;
#pragma unroll
    for (int i = 0; i < 8; ++i) { const int key = k0 + 32 * i, pos = su.P0 - 128 + key;
        if (pos >= 0 && (i >= 4 || !su.chain)) { const bf16* rp = qkv + (rowb + su.r + (size_t)su.dstride * pos) * QKV_LD; R.k[i] = *(const v4u*)(rp + su.kcol + 8 * c); R.v[i] = *(const v4u*)(rp + su.vcol + 8 * c); }
        else { R.k[i] = (v4u){0u, 0u, 0u, 0u}; R.v[i] = R.k[i]; } }
}
__device__ __forceinline__ void attn_load_q(const AttnSub& su, const bf16* qkv, bf16x8v (&q)[4], int hw, int lane) {
    const int r32 = lane & 31, hi = lane >> 5;
    const size_t qrow = (size_t)su.b * SEQ + su.r + (size_t)su.dstride * (su.P0 + 32 * hw + r32);
#pragma unroll
    for (int ks = 0; ks < 4; ++ks) q[ks] = *(const bf16x8v*)(qkv + qrow * QKV_LD + su.qcol + 16 * ks + 8 * hi);
}
__device__ __forceinline__ void attn_stage(const AttnSub& su, const AttnRegs& R, LAS unsigned char* lh, int t256) {
    const int c = t256 & 7, k0 = t256 >> 3;
#pragma unroll
    for (int i = 0; i < 8; ++i) { if (i < 4 && su.chain) continue;
        const int prow = ((((i >> 2) ^ su.par ^ 1) & 1) << 7) + k0 + 32 * (i & 3);
        *(LAS v4u*)(lh + prow * 128 + ((c ^ (prow & 7)) * 16)) = R.k[i];
        *(LAS v4u*)(lh + 32768 + (c >> 2) * 16384 + prow * 64 + (c & 3) * 16) = R.v[i]; }
}
struct AttnMerge { float l1, l2; v2u o1[8], o2[8]; };
__device__ __forceinline__ void attn_load_merge(const AttnSub& su, const bf16* OB, const float* LSE, AttnMerge& M, int hw, int lane) {
    const int r32 = lane & 31, hi = lane >> 5;
    const size_t qrow = (size_t)su.b * SEQ + su.r + (size_t)su.dstride * (su.P0 + 32 * hw + r32);
    M.l1 = 0.f; M.l2 = 0.f;
    if (su.mode == 2) { M.l1 = LSE[qrow * 8 + su.hx]; M.l2 = LSE[(size_t)NTOK * 8 + qrow * 8 + su.hx];
        const bf16* p1 = OB + qrow * 512 + su.hx * 64 + 4 * hi; const bf16* p2 = p1 + (size_t)NTOK * 512;
#pragma unroll
        for (int i = 0; i < 8; ++i) { M.o1[i] = *(const v2u*)(p1 + 32 * (i >> 2) + 8 * (i & 3)); M.o2[i] = *(const v2u*)(p2 + 32 * (i >> 2) + 8 * (i & 3)); } }
}
__device__ __forceinline__ void attn_compute(const AttnSub su, bf16x8v (&qf)[4], const AttnMerge& M, const bool hn, const AttnSub& nxt, const bf16* qkv, const float* sinks, bf16* mix, bf16* OB, float* LSE, LAS unsigned char* lh, int hw, int lane) {
    const int r32 = lane & 31, hi = lane >> 5;
    const size_t qrow = (size_t)su.b * SEQ + su.r + (size_t)su.dstride * (su.P0 + 32 * hw + r32);
    f32x16 oT[2]; oT[0] = (f32x16){}; oT[1] = (f32x16){};
    float m = -1e30f, l = 0.f;
    const float C = 0.125f * 1.4426950408889634f;
    const int mlo = (su.mode == 3) ? 1 : 0;
    int kt = hw; if (su.P0 == 0 && kt < 4) kt = 4;
    for (; kt <= hw + 4; ++kt) {
        f32x16 s = (f32x16){};
        const int pkt = ((((kt >> 2) ^ su.par ^ 1) & 1) << 2) + (kt & 3);
        const LAS unsigned char* kb = lh + (32 * pkt + r32) * 128; const int sw = r32 & 7;
#pragma unroll
        for (int ks = 0; ks < 4; ++ks) { const bf16x8v kf = *(const LAS bf16x8v*)(kb + (((2 * ks + hi) ^ sw) * 16)); s = __builtin_amdgcn_mfma_f32_32x32x16_bf16(kf, qf[ks], s, 0, 0, 0); }
        if (kt == hw) {
#pragma unroll
            for (int r = 0; r < 16; ++r) if (crow(r, hi) < r32 + mlo) s[r] = -INFINITY; }
        if (kt == hw + 4) {
#pragma unroll
            for (int r = 0; r < 16; ++r) if (crow(r, hi) > r32) s[r] = -INFINITY; }
        float mx = s[0];
#pragma unroll
        for (int r = 1; r < 16; ++r) mx = fmaxf(mx, s[r]);
        mx = fmaxf(mx, __shfl_xor(mx, 32));
        const float mn = fmaxf(m, mx), nmc = -mn * C;
        float ls = 0.f; f32x16 p;
#pragma unroll
        for (int r = 0; r < 16; ++r) { p[r] = __builtin_amdgcn_exp2f(__builtin_fmaf(s[r], C, nmc)); ls += p[r]; }
        if (__any(mn > m)) {
            const float alpha = __builtin_amdgcn_exp2f((m - mn) * C); l *= alpha;
#pragma unroll
            for (int r = 0; r < 16; ++r) { oT[0][r] *= alpha; oT[1][r] *= alpha; } }
        l += ls; m = mn;
        v4u pw0, pw1;
        pw0.x = pk2(p[0], p[1]); pw0.y = pk2(p[2], p[3]); pw0.z = pk2(p[4], p[5]); pw0.w = pk2(p[6], p[7]);
        pw1.x = pk2(p[8], p[9]); pw1.y = pk2(p[10], p[11]); pw1.z = pk2(p[12], p[13]); pw1.w = pk2(p[14], p[15]);
        const bf16x8v pa0 = __builtin_bit_cast(bf16x8v, pw0), pa1 = __builtin_bit_cast(bf16x8v, pw1);
        const LAS unsigned char* vb = lh + 32768 + (32 * pkt + 4 * hi + ((lane & 15) >> 2)) * 64 + ((lane >> 4) & 1) * 32 + (lane & 3) * 8;
#pragma unroll
        for (int dt = 0; dt < 2; ++dt) {
            const s16x4 a0 = vtr(vb + dt * 16384), a1 = vtr(vb + dt * 16384 + 512), b0 = vtr(vb + dt * 16384 + 1024), b1 = vtr(vb + dt * 16384 + 1536);
            const bf16x8v vf0 = (bf16x8v){a0[0], a0[1], a0[2], a0[3], a1[0], a1[1], a1[2], a1[3]}, vf1 = (bf16x8v){b0[0], b0[1], b0[2], b0[3], b1[0], b1[1], b1[2], b1[3]};
            oT[dt] = __builtin_amdgcn_mfma_f32_32x32x16_bf16(vf0, pa0, oT[dt], 0, 0, 0);
            oT[dt] = __builtin_amdgcn_mfma_f32_32x32x16_bf16(vf1, pa1, oT[dt], 0, 0, 0);
        }
    }
    if (hn) attn_load_q(nxt, qkv, qf, hw, lane);
    float lt = l + __shfl_xor(l, 32);
    if (su.mode == 3) { const float sraw = 8.0f * sinks[su.hx]; const float mn = fmaxf(m, sraw), alpha = __builtin_amdgcn_exp2f((m - mn) * C);
        lt = lt * alpha + __builtin_amdgcn_exp2f((sraw - mn) * C); m = mn;
#pragma unroll
        for (int r = 0; r < 16; ++r) { oT[0][r] *= alpha; oT[1][r] *= alpha; } }
    const float inv = 1.0f / lt;
    if (su.mode < 2) {
        bf16* ob = OB + (size_t)su.mode * NTOK * 512 + qrow * 512 + su.hx * 64;
#pragma unroll
        for (int dt = 0; dt < 2; ++dt)
#pragma unroll
            for (int g = 0; g < 4; ++g) { v2u w; w.x = pk2(oT[dt][4 * g] * inv, oT[dt][4 * g + 1] * inv); w.y = pk2(oT[dt][4 * g + 2] * inv, oT[dt][4 * g + 3] * inv); *(v2u*)(ob + 32 * dt + 8 * g + 4 * hi) = w; }
        if (hi == 0) LSE[(size_t)su.mode * NTOK * 8 + qrow * 8 + su.hx] = 0.125f * m + __logf(lt);
    } else if (su.mode == 2) {
        const float l3 = 0.125f * m + __logf(lt);
        const float MX = fmaxf(l3, fmaxf(M.l1, M.l2)); float w1 = __expf(M.l1 - MX), w2 = __expf(M.l2 - MX), w3 = __expf(l3 - MX);
        const float ws = 1.0f / (w1 + w2 + w3); w1 *= ws; w2 *= ws; w3 *= ws * inv;
        bf16* mp = mix + qrow * D + su.hx * 64;
#pragma unroll
        for (int dt = 0; dt < 2; ++dt)
#pragma unroll
            for (int g = 0; g < 4; ++g) { const int dd = 32 * dt + 8 * g + 4 * hi; const v2u a = M.o1[4 * dt + g], b = M.o2[4 * dt + g];
                v2u w; w.x = pk2(w1 * bflo(a.x) + w2 * bflo(b.x) + w3 * oT[dt][4 * g], w1 * bfhi(a.x) + w2 * bfhi(b.x) + w3 * oT[dt][4 * g + 1]);
                w.y = pk2(w1 * bflo(a.y) + w2 * bflo(b.y) + w3 * oT[dt][4 * g + 2], w1 * bfhi(a.y) + w2 * bfhi(b.y) + w3 * oT[dt][4 * g + 3]); *(v2u*)(mp + dd) = w; }
    } else {
        bf16* mp = mix + qrow * D + 512 + su.hx * 64;
#pragma unroll
        for (int dt = 0; dt < 2; ++dt)
#pragma unroll
            for (int g = 0; g < 4; ++g) { v2u w; w.x = pk2(oT[dt][4 * g] * inv, oT[dt][4 * g + 1] * inv); w.y = pk2(oT[dt][4 * g + 2] * inv, oT[dt][4 * g + 3] * inv); *(v2u*)(mp + 32 * dt + 8 * g + 4 * hi) = w; }
    }
}
__device__ __forceinline__ bool attn_decode(int j, int blk, int G, int hf, int prev_par, AttnSub& s) {
    const int nA = (256 - blk + G - 1) / G;
    if (j < 24 * nA) { const int ai = blk + G * (j / 24), jj = j % 24, br = jj >> 3, i = jj & 7;
        const int b = ai >> 5, h = (ai >> 2) & 7, T0 = (ai & 3) * 2048;
        s.b = b; s.hx = h; s.qcol = h * 64; s.kcol = 512 + h * 64; s.vcol = 1024 + h * 64; s.mode = br;
        if (br == 0) { s.dstride = 1; s.r = 0; s.P0 = T0 + 128 * (8 * hf + i); s.chain = (i > 0); }
        else if (br == 1) { s.dstride = 4; s.r = 2 * hf + (i >> 2); s.P0 = (T0 >> 2) + 128 * (i & 3); s.chain = ((i & 3) > 0); }
        else { s.dstride = 16; s.r = 8 * hf + i; s.P0 = T0 >> 4; s.chain = 0; }
        s.par = s.chain ? (prev_par ^ 1) : 0;
        return true; }
    const int jb = j - 24 * nA, bp = blk + G * (jb >> 3), i = jb & 7; if (bp >= 256) return false;
    const int c = 2 * bp + hf, b = c >> 6, qh = (c >> 3) & 7, kv = qh >> 2;
    s.b = b; s.hx = qh; s.qcol = 1536 + qh * 64; s.kcol = 2048 + kv * 64; s.vcol = 2176 + kv * 64; s.mode = 3; s.dstride = 1; s.r = 0; s.P0 = 128 * (8 * (c & 7) + i);
    s.chain = (i > 0); s.par = s.chain ? (prev_par ^ 1) : 0;
    return true;
}
__device__ __forceinline__ void phase_attn(const bf16* qkv, const float* sinks, bf16* mix, bf16* OB, float* LSE, LAS unsigned char* lds, int blk, int G, int tid) {
    const int wave = tid >> 6, lane = tid & 63, hf = wave >> 2, hw = wave & 3, t256 = tid & 255;
    LAS unsigned char* lh = lds + hf * 65536;
    AttnSub cur, nxt; AttnRegs R; bf16x8v qf[4];
    bool have = attn_decode(0, blk, G, hf, 0, cur);
    if (have) { attn_load(cur, qkv, R, t256, hw, lane); attn_load_q(cur, qkv, qf, hw, lane); }
    for (int j = 0; have; ++j) {
        attn_stage(cur, R, lh, t256);
        __syncthreads();
        asm volatile("" :: "v"(qf[0]), "v"(qf[1]), "v"(qf[2]), "v"(qf[3]));
        AttnMerge M; attn_load_merge(cur, OB, LSE, M, hw, lane);
        const bool hn = attn_decode(j + 1, blk, G, hf, cur.par, nxt);
        if (hn) attn_load(nxt, qkv, R, t256, hw, lane);
        attn_compute(cur, qf, M, hn, nxt, qkv, sinks, mix, OB, LSE, lh, hw, lane);
        if (cur.mode == 1 && hn && nxt.mode == 2) asm volatile("s_waitcnt vmcnt(0)" ::: "memory");
        __syncthreads();
        cur = nxt; have = hn;
    }
}
__device__ __forceinline__ void phase_router(const bf16* x, const float* g, const float* w_router, const unsigned* ssq, int4* meta, int* hist, LAS unsigned char* lds, int blk, int G, int tid) {
    const int wave = tid >> 6, lane = tid & 63;
    LAS int* scnt = (LAS int*)lds;
    f32x4 wr[16][2];
#pragma unroll
    for (int c = 0; c < 16; ++c) { const int d = (c < 8 ? 0 : 512 - 8) + 8 * lane + c; const float gd = g[d];
        wr[c][0] = *(const f32x4*)(w_router + d * 8) * gd; wr[c][1] = *(const f32x4*)(w_router + d * 8 + 4) * gd; }
    for (int tb = blk; tb < 256; tb += G) {
        if (tid < 8) scnt[tid] = 0;
        __syncthreads();
        int c0 = 0, c1 = 0, c2 = 0, c3 = 0, c4 = 0, c5 = 0, c6 = 0, c7 = 0;
        for (int i = 0; i < 32; i += 2) {
            float lg[2][8]; v4u xa[2], xb[2];
#pragma unroll
            for (int t2 = 0; t2 < 2; ++t2) { const v4u* xr = (const v4u*)(x + (size_t)(tb * 256 + wave * 32 + i + t2) * D) + lane; xa[t2] = xr[0]; xb[t2] = xr[64]; }
#pragma unroll
            for (int t2 = 0; t2 < 2; ++t2) {
                const float hv[16] = {bflo(xa[t2].x), bfhi(xa[t2].x), bflo(xa[t2].y), bfhi(xa[t2].y), bflo(xa[t2].z), bfhi(xa[t2].z), bflo(xa[t2].w), bfhi(xa[t2].w), bflo(xb[t2].x), bfhi(xb[t2].x), bflo(xb[t2].y), bfhi(xb[t2].y), bflo(xb[t2].z), bfhi(xb[t2].z), bflo(xb[t2].w), bfhi(xb[t2].w)};
                f32x4 a0 = (f32x4){0.f, 0.f, 0.f, 0.f}, a1 = a0;
#pragma unroll
                for (int c = 0; c < 16; ++c) { a0 += wr[c][0] * hv[c]; a1 += wr[c][1] * hv[c]; }
                lg[t2][0] = a0.x; lg[t2][1] = a0.y; lg[t2][2] = a0.z; lg[t2][3] = a0.w; lg[t2][4] = a1.x; lg[t2][5] = a1.y; lg[t2][6] = a1.z; lg[t2][7] = a1.w; }
#pragma unroll
            for (int t2 = 0; t2 < 2; ++t2) { const int tok = tb * 256 + wave * 32 + i + t2;
                const float rstd = 1.0f / sqrtf((float)ssq[tok] * (1.f / (1024.f * 65536.f)) + EPS);
#pragma unroll
                for (int e = 0; e < 8; ++e) lg[t2][e] = wave_sum(lg[t2][e]) * rstd;
                int e0 = 0; float v0 = lg[t2][0];
#pragma unroll
                for (int e = 1; e < 8; ++e) if (lg[t2][e] > v0) { v0 = lg[t2][e]; e0 = e; }
                int e1 = -1; float v1 = -INFINITY;
#pragma unroll
                for (int e = 0; e < 8; ++e) if (e != e0 && lg[t2][e] > v1) { v1 = lg[t2][e]; e1 = e; }
                const float g1 = 1.0f / (1.0f + __expf(v0 - v1)), g0 = 1.0f - g1;
                if (lane == 0) meta[tok] = make_int4(e0, e1, __builtin_bit_cast(int, g0), __builtin_bit_cast(int, g1));
                c0 += (e0 == 0) + (e1 == 0); c1 += (e0 == 1) + (e1 == 1); c2 += (e0 == 2) + (e1 == 2); c3 += (e0 == 3) + (e1 == 3);
                c4 += (e0 == 4) + (e1 == 4); c5 += (e0 == 5) + (e1 == 5); c6 += (e0 == 6) + (e1 == 6); c7 += (e0 == 7) + (e1 == 7); }
        }
        if (lane == 0) { const int cc[8] = {c0, c1, c2, c3, c4, c5, c6, c7};
#pragma unroll
            for (int e = 0; e < 8; ++e) __hip_atomic_fetch_add(&scnt[e], cc[e], __ATOMIC_RELAXED, __HIP_MEMORY_SCOPE_WORKGROUP); }
        __syncthreads();
        if (tid < 8) hist[tb * 8 + tid] = scnt[tid];
        __syncthreads();
    }
}
__device__ __forceinline__ void phase_scatter(const bf16* hb, const unsigned* ssq, const int4* meta, const int* hist, int* dest, int* info, unsigned char* perm8, LAS unsigned char* lds, int blk, int G, int tid) {
    const int wave = tid >> 6, lane = tid & 63;
    LAS int* shist = (LAS int*)lds;
    LAS int* ssize = shist + 2048; LAS int* sbpre = ssize + 8; LAS int* spst = sbpre + 8; LAS int* sntl = spst + 8;
    LAS int* se = sntl + 8; LAS int* sdest = se + 512;
    for (int tb = blk; tb < 256; tb += G) {
        for (int i = tid; i < 2048; i += 512) shist[i] = hist[i];
        __syncthreads();
        if (tid < 8) { int sz = 0, bp = 0; for (int b = 0; b < 256; ++b) { const int hv = shist[b * 8 + tid]; sz += hv; bp += (b < tb) ? hv : 0; } ssize[tid] = sz; sbpre[tid] = bp; }
        __syncthreads();
        if (tid == 0) { int ts = 0; for (int e = 0; e < 8; ++e) { const int nt = (ssize[e] + 255) >> 8; spst[e] = ts * 256; sntl[e] = nt; if (tb == 0) for (int q = 0; q < nt; ++q) info[16 + ts + q] = e; ts += nt; if (tb == 0) info[e] = ts; } if (tb == 0) info[8] = ts; }
        { const int4 mt = meta[tb * 256 + (tid >> 1)]; se[tid] = (tid & 1) ? mt.y : mt.x; }
        __syncthreads();
        { const int e = se[tid]; int rank = 0; for (int p = 0; p < tid; ++p) rank += (se[p] == e) ? 1 : 0;
          const int dd = spst[e] + sbpre[e] + rank; sdest[tid] = dd; dest[(tb * 256) * 2 + tid] = dd; }
        __syncthreads();
        for (int i = 0; i < 32; i += 4) {
            v4u ra[4], rb[4];
#pragma unroll
            for (int q = 0; q < 4; ++q) { const v4u* src = (const v4u*)(hb + (size_t)(tb * 256 + wave * 32 + i + q) * D) + lane; ra[q] = src[0]; rb[q] = src[64]; }
#pragma unroll
            for (int q = 0; q < 4; ++q) { const int lt = wave * 32 + i + q;
                const float s = F8_ASCALE / sqrtf((float)ssq[tb * 256 + lt] * (1.f / (1024.f * 65536.f)) + EPS);
                v2u wa, wb;
                wa.x = pg8::pk4_fp8(bflo(ra[q].x) * s, bfhi(ra[q].x) * s, bflo(ra[q].y) * s, bfhi(ra[q].y) * s); wa.y = pg8::pk4_fp8(bflo(ra[q].z) * s, bfhi(ra[q].z) * s, bflo(ra[q].w) * s, bfhi(ra[q].w) * s);
                wb.x = pg8::pk4_fp8(bflo(rb[q].x) * s, bfhi(rb[q].x) * s, bflo(rb[q].y) * s, bfhi(rb[q].y) * s); wb.y = pg8::pk4_fp8(bflo(rb[q].z) * s, bfhi(rb[q].z) * s, bflo(rb[q].w) * s, bfhi(rb[q].w) * s);
                v2u* o0 = (v2u*)(perm8 + (size_t)sdest[2 * lt] * D) + lane; v2u* o1 = (v2u*)(perm8 + (size_t)sdest[2 * lt + 1] * D) + lane;
                o0[0] = wa; o0[64] = wb; o1[0] = wa; o1[64] = wb; } }
        if (tb < 8) { const int r0 = spst[tb] + ssize[tb], r1 = spst[tb] + sntl[tb] * 256;
            for (int r = r0 + wave; r < r1; r += NWAVES) { v4u* o = (v4u*)(perm8 + (size_t)r * D) + lane; o[0] = (v4u){0u, 0u, 0u, 0u}; } }
        __syncthreads();
    }
}
__device__ __forceinline__ void phase_combine(const bf16* x, float* out, const bf16* y, const int4* meta, const int* dest, const float* gf, int blk, int G, int tid) {
    const int wave = tid >> 6, lane = tid & 63; const int stride = G * NWAVES;
    for (int m0 = blk * NWAVES + wave; m0 < NTOK; m0 += 2 * stride) {
        v4u xa[2][2], ya[2][2], yb[2][2]; float g0[2], g1[2]; bool ok[2];
#pragma unroll
        for (int t = 0; t < 2; ++t) { const int m = m0 + t * stride; ok[t] = m < NTOK; const int mm = ok[t] ? m : m0;
            const int4 mt = meta[mm]; g0[t] = __builtin_bit_cast(float, mt.z); g1[t] = __builtin_bit_cast(float, mt.w);
            const int d0 = dest[2 * mm], d1 = dest[2 * mm + 1];
            const v4u* xr = (const v4u*)(x + (size_t)mm * D) + lane; const v4u* y0 = (const v4u*)(y + (size_t)d0 * D) + lane; const v4u* y1 = (const v4u*)(y + (size_t)d1 * D) + lane;
#pragma unroll
            for (int j = 0; j < 2; ++j) { xa[t][j] = xr[64 * j]; ya[t][j] = y0[64 * j]; yb[t][j] = y1[64 * j]; } }
#pragma unroll
        for (int t = 0; t < 2; ++t) { const int m = m0 + t * stride; float s = 0.f; float v[2][8];
#pragma unroll
            for (int j = 0; j < 2; ++j) { const unsigned xw[4] = {xa[t][j].x, xa[t][j].y, xa[t][j].z, xa[t][j].w}, aw[4] = {ya[t][j].x, ya[t][j].y, ya[t][j].z, ya[t][j].w}, bw[4] = {yb[t][j].x, yb[t][j].y, yb[t][j].z, yb[t][j].w};
#pragma unroll
                for (int q = 0; q < 4; ++q) { const float lo = bflo(xw[q]) + g0[t] * bflo(aw[q]) + g1[t] * bflo(bw[q]), hi = bfhi(xw[q]) + g0[t] * bfhi(aw[q]) + g1[t] * bfhi(bw[q]);
                    v[j][2 * q] = lo; v[j][2 * q + 1] = hi; s += lo * lo + hi * hi; } }
            const float rstd = 1.0f / sqrtf(wave_sum(s) * (1.f / D) + EPS);
            if (ok[t]) {
#pragma unroll
                for (int j = 0; j < 2; ++j) { float* op = out + (size_t)m * D + 512 * j + 8 * lane; const float* gp = gf + 512 * j + 8 * lane;
                    const f32x4 ga = *(const f32x4*)gp, gb = *(const f32x4*)(gp + 4);
                    *(f32x4*)op = (f32x4){v[j][0] * rstd * ga.x, v[j][1] * rstd * ga.y, v[j][2] * rstd * ga.z, v[j][3] * rstd * ga.w};
                    *(f32x4*)(op + 4) = (f32x4){v[j][4] * rstd * gb.x, v[j][5] * rstd * gb.y, v[j][6] * rstd * gb.z, v[j][7] * rstd * gb.w}; } } }
    }
}
__device__ __forceinline__ v4u scale8(const v4u a, const f32x4 d0, const f32x4 d1) {
    v4u o; o.x = pk2(bflo(a.x) * d0.x, bfhi(a.x) * d0.y); o.y = pk2(bflo(a.y) * d0.z, bfhi(a.y) * d0.w); o.z = pk2(bflo(a.z) * d1.x, bfhi(a.z) * d1.y); o.w = pk2(bflo(a.w) * d1.z, bfhi(a.w) * d1.w); return o; }
constexpr int HG_NSEG = 4, HG_CPS = 32;
constexpr int HG_QE = 0, HG_KI = 16384, HG_KE = 32768, HG_V = 49152, HG_ST = 65536, HG_DK = 132096, HG_SSQ = 132608, HG_NG = 133632;
__device__ __forceinline__ void phase_hgrn(const bf16* QE, const bf16* KI, const bf16* Vp, const bf16* Gp, const float* DK, const float* norm_g, bf16* Og, const float* HL, const float* HP, LAS unsigned char* lds, int blk, int G, int tid) {
    const int wave = tid >> 6, lane = tid & 63, r32 = lane & 31, hi = lane >> 5, tb = wave >> 2, vb = wave & 3;
    const int sw = r32 & 15;
    const int trl = (4 * hi + ((lane & 15) >> 2)) * 64 + ((lane >> 4) & 1) * 32 + (lane & 3) * 8;
    LAS float* dk_l = (LAS float*)(lds + HG_DK); LAS float* ssq = (LAS float*)(lds + HG_SSQ);
    for (int un = blk; un < BATCH * 8 * HG_NSEG; un += G) {
        const int bh = un >> 2, seg = un & 3, b = bh >> 3, h = bh & 7, c0 = seg * HG_CPS;
        f32x16 S0 = (f32x16){}, S1 = (f32x16){};
        {
            const float* L = HL + (size_t)bh * 3 * 16384; const float* Pt = HP + (size_t)bh * 3 * 128;
            LAS float* sl = (LAS float*)lds;
#pragma unroll 2
            for (int i = 0; i < 8; ++i) { const int idx = (tid + 512 * i) * 4, k = idx >> 7; f32x4 a = (f32x4){0.f, 0.f, 0.f, 0.f};
                if (seg > 0) a = *(const f32x4*)(L + idx);
                if (seg > 1) a = a * Pt[128 + k] + *(const f32x4*)(L + 16384 + idx);
                if (seg > 2) a = a * Pt[256 + k] + *(const f32x4*)(L + 32768 + idx);
                *(LAS f32x4*)(sl + idx) = a; }
            __syncthreads();
#pragma unroll
            for (int i = 0; i < 2; ++i) { const int kb = 2 * tb + i; f32x16 S;
#pragma unroll
                for (int r = 0; r < 16; ++r) S[r] = sl[(32 * kb + crow(r, hi)) * 128 + 32 * vb + r32];
#pragma unroll
                for (int g = 0; g < 4; ++g) { v2u w; w.x = pk2(S[4 * g], S[4 * g + 1]); w.y = pk2(S[4 * g + 2], S[4 * g + 3]);
                    *(LAS v2u*)(lds + HG_ST + (32 * vb + r32) * 256 + (((4 * kb + g) ^ sw) * 16) + hi * 8) = w; }
                if (i) S1 = S; else S0 = S; }
            __syncthreads();
        }
        if (tid < 32) *(LAS f32x4*)(lds + HG_NG + tid * 16) = *(const f32x4*)(norm_g + h * 128 + tid * 4);
        v4u rq[2], rk[2], rv[2]; f32x4 rd = (f32x4){0.f, 0.f, 0.f, 0.f}, rd0, rd1;
#define HG_LOAD(c) do { const size_t row0_ = (size_t)(b * 8 + h) * SEQ + 64 * (c);     \
            _Pragma("unroll") for (int i = 0; i < 2; ++i) { const int idx = tid + 512 * i, row = idx >> 4, cc = idx & 15; const size_t go = (row0_ + row) * 128 + cc * 8; \
                rq[i] = *(const v4u*)(QE + go); rk[i] = *(const v4u*)(KI + go); rv[i] = *(const v4u*)(Vp + go); } \
            { const float* dkp_ = DK + ((size_t)b * 128 + (c)) * 1024 + h * 128; rd0 = *(const f32x4*)(dkp_ + (tid & 15) * 8); rd1 = *(const f32x4*)(dkp_ + (tid & 15) * 8 + 4); if (tid < 32) rd = *(const f32x4*)(dkp_ + tid * 4); } } while (0)
#define HG_STORE() do { \
            _Pragma("unroll") for (int i = 0; i < 2; ++i) { const int idx = tid + 512 * i, row = idx >> 4, cc = idx & 15; \
                *(LAS v4u*)(lds + HG_QE + row * 256 + ((cc ^ (row & 15)) * 16)) = rq[i]; *(LAS v4u*)(lds + HG_KI + row * 256 + ((cc ^ (row & 15)) * 16)) = rk[i]; \
                *(LAS v4u*)(lds + HG_KE + (cc >> 2) * 4096 + row * 64 + (cc & 3) * 16) = scale8(rk[i], rd0, rd1); *(LAS v4u*)(lds + HG_V + (cc >> 2) * 4096 + row * 64 + (cc & 3) * 16) = rv[i]; } \
            if (tid < 32) *(LAS f32x4*)(dk_l + tid * 4) = rd; } while (0)
        HG_LOAD(c0); HG_STORE();
        __syncthreads();
        for (int cl = 0; cl < HG_CPS; ++cl) { const int c = c0 + cl;
#if PROBE_PHASE == 83
            volatile LAS unsigned* prb = (volatile LAS unsigned*)(lds + MISC_OFF) + 16; const bool prbw = (blk == 0 && tid == PRB_SEL2); const unsigned w0 = (unsigned)__builtin_amdgcn_s_memrealtime();
#endif
            if (cl + 1 < HG_CPS) HG_LOAD(c + 1);
            const size_t rowo = ((size_t)b * SEQ + 64 * c + 32 * tb + r32) * 1024 + h * 128 + 32 * vb + 4 * hi;
            v2u ggv[4];
#pragma unroll
            for (int g = 0; g < 4; ++g) ggv[g] = *(const v2u*)(Gp + ((size_t)(b * 8 + h) * SEQ + 64 * c + 32 * tb + r32) * 128 + 32 * vb + 4 * hi + 8 * g);
            LAS unsigned char* st_cur = lds + HG_ST + (cl & 1) * 32768; LAS unsigned char* st_nxt = lds + HG_ST + ((cl + 1) & 1) * 32768;
            bf16x8v qf[8];
#pragma unroll
            for (int ks = 0; ks < 8; ++ks) qf[ks] = *(const LAS bf16x8v*)(lds + HG_QE + (32 * tb + r32) * 256 + (((2 * ks + hi) ^ sw) * 16));
            f32x16 oT = (f32x16){};
#pragma unroll
            for (int ks = 0; ks < 8; ++ks) { const bf16x8v sf = *(const LAS bf16x8v*)(st_cur + (32 * vb + r32) * 256 + (((2 * ks + hi) ^ sw) * 16)); oT = __builtin_amdgcn_mfma_f32_32x32x16_bf16(sf, qf[ks], oT, 0, 0, 0); }
            v4u pw[4];
            { f32x16 X0 = (f32x16){};
#pragma unroll
              for (int ks = 0; ks < 8; ++ks) { const bf16x8v kf = *(const LAS bf16x8v*)(lds + HG_KI + r32 * 256 + (((2 * ks + hi) ^ sw) * 16)); X0 = __builtin_amdgcn_mfma_f32_32x32x16_bf16(kf, qf[ks], X0, 0, 0, 0); }
              if (tb == 0) {
#pragma unroll
                  for (int r = 0; r < 16; ++r) if (crow(r, hi) > r32) X0[r] = 0.f; }
              pw[0].x = pk2(X0[0], X0[1]); pw[0].y = pk2(X0[2], X0[3]); pw[0].z = pk2(X0[4], X0[5]); pw[0].w = pk2(X0[6], X0[7]); pw[1].x = pk2(X0[8], X0[9]); pw[1].y = pk2(X0[10], X0[11]); pw[1].z = pk2(X0[12], X0[13]); pw[1].w = pk2(X0[14], X0[15]); }
            if (tb == 1) { f32x16 X1 = (f32x16){};
#pragma unroll
              for (int ks = 0; ks < 8; ++ks) { const bf16x8v kf = *(const LAS bf16x8v*)(lds + HG_KI + (32 + r32) * 256 + (((2 * ks + hi) ^ sw) * 16)); X1 = __builtin_amdgcn_mfma_f32_32x32x16_bf16(kf, qf[ks], X1, 0, 0, 0); }
#pragma unroll
              for (int r = 0; r < 16; ++r) if (crow(r, hi) > r32) X1[r] = 0.f;
              pw[2].x = pk2(X1[0], X1[1]); pw[2].y = pk2(X1[2], X1[3]); pw[2].z = pk2(X1[4], X1[5]); pw[2].w = pk2(X1[6], X1[7]); pw[3].x = pk2(X1[8], X1[9]); pw[3].y = pk2(X1[10], X1[11]); pw[3].z = pk2(X1[12], X1[13]); pw[3].w = pk2(X1[14], X1[15]); }
            asm volatile("" ::: "memory");
            bf16x8v vf[4];
#pragma unroll
            for (int s4 = 0; s4 < 4; ++s4) { const LAS unsigned char* p = lds + HG_V + vb * 4096 + s4 * 1024 + trl; const s16x4 a0 = vtr(p), a1 = vtr(p + 512); vf[s4] = (bf16x8v){a0[0], a0[1], a0[2], a0[3], a1[0], a1[1], a1[2], a1[3]}; }
            oT = __builtin_amdgcn_mfma_f32_32x32x16_bf16(vf[0], __builtin_bit_cast(bf16x8v, pw[0]), oT, 0, 0, 0); oT = __builtin_amdgcn_mfma_f32_32x32x16_bf16(vf[1], __builtin_bit_cast(bf16x8v, pw[1]), oT, 0, 0, 0);
            if (tb == 1) { oT = __builtin_amdgcn_mfma_f32_32x32x16_bf16(vf[2], __builtin_bit_cast(bf16x8v, pw[2]), oT, 0, 0, 0); oT = __builtin_amdgcn_mfma_f32_32x32x16_bf16(vf[3], __builtin_bit_cast(bf16x8v, pw[3]), oT, 0, 0, 0); }
            { float ss = 0.f;
#pragma unroll
              for (int r = 0; r < 16; ++r) ss += oT[r] * oT[r];
              ss += __shfl_xor(ss, 32); if (hi == 0) ssq[(tb * 4 + vb) * 32 + r32] = ss; }
#pragma unroll
            for (int i = 0; i < 2; ++i) { const int kb = 2 * tb + i; f32x16 S = i ? S1 : S0;
#pragma unroll
                for (int g = 0; g < 4; ++g) { const f32x4 d4 = *(const LAS f32x4*)(dk_l + 32 * kb + 8 * g + 4 * hi);
#pragma unroll
                    for (int j = 0; j < 4; ++j) S[4 * g + j] *= d4[j]; }
#pragma unroll
                for (int s4 = 0; s4 < 4; ++s4) { const LAS unsigned char* p = lds + HG_KE + kb * 4096 + s4 * 1024 + trl; const s16x4 a0 = vtr(p), a1 = vtr(p + 512);
                    const bf16x8v kef = (bf16x8v){a0[0], a0[1], a0[2], a0[3], a1[0], a1[1], a1[2], a1[3]};
                    S = __builtin_amdgcn_mfma_f32_32x32x16_bf16(kef, vf[s4], S, 0, 0, 0); }
#pragma unroll
                for (int g = 0; g < 4; ++g) { v2u w; w.x = pk2(S[4 * g], S[4 * g + 1]); w.y = pk2(S[4 * g + 2], S[4 * g + 3]);
                    *(LAS v2u*)(st_nxt + (32 * vb + r32) * 256 + (((4 * kb + g) ^ sw) * 16) + hi * 8) = w; }
                if (i) S1 = S; else S0 = S; }
#if PROBE_PHASE == 83
            const unsigned w1 = (unsigned)__builtin_amdgcn_s_memrealtime();
#endif
            __syncthreads();
#if PROBE_PHASE == 83
            const unsigned w2 = (unsigned)__builtin_amdgcn_s_memrealtime();
#endif
            { const float tot = (ssq[(tb * 4 + 0) * 32 + r32] + ssq[(tb * 4 + 1) * 32 + r32]) + (ssq[(tb * 4 + 2) * 32 + r32] + ssq[(tb * 4 + 3) * 32 + r32]);
              const float rstd = 1.0f / sqrtf(tot * (1.f / 128.f) + EPS);
#pragma unroll
              for (int g = 0; g < 4; ++g) { const f32x4 ng = *(const LAS f32x4*)(lds + HG_NG + (32 * vb + 8 * g + 4 * hi) * 4); const v2u gg = ggv[g];
                  v2u w; w.x = pk2(oT[4 * g] * rstd * ng.x * bflo(gg.x), oT[4 * g + 1] * rstd * ng.y * bfhi(gg.x)); w.y = pk2(oT[4 * g + 2] * rstd * ng.z * bflo(gg.y), oT[4 * g + 3] * rstd * ng.w * bfhi(gg.y));
                  *(v2u*)(Og + rowo + 8 * g) = w; } }
            if (cl + 1 < HG_CPS) HG_STORE();
#if PROBE_PHASE == 83
            const unsigned w3 = (unsigned)__builtin_amdgcn_s_memrealtime();
#endif
            __syncthreads();
#if PROBE_PHASE == 83
            if (prbw) { const unsigned w4 = (unsigned)__builtin_amdgcn_s_memrealtime(); prb[0] += w1 - w0; prb[1] += w2 - w1; prb[2] += w3 - w2; prb[3] += w4 - w3; }
#endif
        }
#undef HG_LOAD
#undef HG_STORE
    }
}

struct HsRegs { v4u re[2], rv[2]; f32x4 rd, rd0, rd1; };
__device__ __forceinline__ void phase_hgrn_state(const bf16* KI, const bf16* Vp, const float* DK, float* HL, float* HP, LAS unsigned char* lds, int blk, int G, int tid) {
    const int wave = tid >> 6, lane = tid & 63, r32 = lane & 31, hi = lane >> 5, tb = wave >> 2, vb = wave & 3;
    const int trl = (4 * hi + ((lane & 15) >> 2)) * 64 + ((lane >> 4) & 1) * 32 + (lane & 3) * 8;
    constexpr int HS_KE = 0, HS_V = 16384, HS_BUF = 32768, HS_DK = 65536;
    for (int un = blk; un < BATCH * 8 * 3; un += G) {
        const int bh = un / 3, seg = un % 3, b = bh >> 3, h = bh & 7, c0 = seg * HG_CPS;
        f32x16 S0 = (f32x16){}, S1 = (f32x16){};
        float ptot = 1.0f;
        HsRegs R0, R1, R2, R3;
#define HS_LOAD(R, c) do { const size_t row0_ = (size_t)(b * 8 + h) * SEQ + 64 * (c); \
            _Pragma("unroll") for (int i = 0; i < 2; ++i) { const int idx = tid + 512 * i, row = idx >> 4, cc = idx & 15; const size_t go = (row0_ + row) * 128 + cc * 8; \
                R.re[i] = *(const v4u*)(KI + go); R.rv[i] = *(const v4u*)(Vp + go); } \
            { const float* dkp_ = DK + ((size_t)b * 128 + (c)) * 1024 + h * 128; R.rd0 = *(const f32x4*)(dkp_ + (tid & 15) * 8); R.rd1 = *(const f32x4*)(dkp_ + (tid & 15) * 8 + 4); R.rd = *(const f32x4*)(dkp_ + (tid & 31) * 4); } } while (0)
#define HS_STORE(R, bi) do { \
            _Pragma("unroll") for (int i = 0; i < 2; ++i) { const int idx = tid + 512 * i, row = idx >> 4, cc = idx & 15; \
                *(LAS v4u*)(lds + (bi) * HS_BUF + HS_KE + (cc >> 2) * 4096 + row * 64 + (cc & 3) * 16) = scale8(R.re[i], R.rd0, R.rd1); *(LAS v4u*)(lds + (bi) * HS_BUF + HS_V + (cc >> 2) * 4096 + row * 64 + (cc & 3) * 16) = R.rv[i]; } \
            if (tid < 32) *(LAS f32x4*)(lds + HS_DK + (bi) * 512 + tid * 16) = R.rd; } while (0)
#define HS_STEP(c, RL, bi, RS) do { \
            if ((c) + 3 < HG_CPS) HS_LOAD(RL, c0 + (c) + 3); \
            { const LAS float* dk_l = (const LAS float*)(lds + HS_DK + (bi) * 512); \
              bf16x8v vf[4]; \
              _Pragma("unroll") for (int s4 = 0; s4 < 4; ++s4) { const LAS unsigned char* p = lds + (bi) * HS_BUF + HS_V + vb * 4096 + s4 * 1024 + trl; const s16x4 a0 = vtr(p), a1 = vtr(p + 512); vf[s4] = (bf16x8v){a0[0], a0[1], a0[2], a0[3], a1[0], a1[1], a1[2], a1[3]}; } \
              _Pragma("unroll") for (int i = 0; i < 2; ++i) { const int kb = 2 * tb + i; f32x16 S = i ? S1 : S0; \
                _Pragma("unroll") for (int g = 0; g < 4; ++g) { const f32x4 d4 = *(const LAS f32x4*)(dk_l + 32 * kb + 8 * g + 4 * hi); \
                    _Pragma("unroll") for (int j = 0; j < 4; ++j) S[4 * g + j] *= d4[j]; } \
                _Pragma("unroll") for (int s4 = 0; s4 < 4; ++s4) { const LAS unsigned char* p = lds + (bi) * HS_BUF + HS_KE + kb * 4096 + s4 * 1024 + trl; const s16x4 a0 = vtr(p), a1 = vtr(p + 512); \
                    const bf16x8v kef = (bf16x8v){a0[0], a0[1], a0[2], a0[3], a1[0], a1[1], a1[2], a1[3]}; \
                    S = __builtin_amdgcn_mfma_f32_32x32x16_bf16(kef, vf[s4], S, 0, 0, 0); } \
                if (i) S1 = S; else S0 = S; } \
              if (tid < 128) ptot *= dk_l[tid]; } \
            if ((c) + 1 < HG_CPS) HS_STORE(RS, 1 - (bi)); \
            __syncthreads(); } while (0)
        HS_LOAD(R0, c0); HS_LOAD(R1, c0 + 1); HS_LOAD(R2, c0 + 2);
        HS_STORE(R0, 0);
        __syncthreads();
        for (int cl = 0; cl < HG_CPS; cl += 4) {
            HS_STEP(cl, R3, 0, R1); HS_STEP(cl + 1, R0, 1, R2); HS_STEP(cl + 2, R1, 0, R3); HS_STEP(cl + 3, R2, 1, R0);
        }
        float* L = HL + ((size_t)bh * 3 + seg) * 16384;
#pragma unroll
        for (int i = 0; i < 2; ++i) { const int kb = 2 * tb + i; const f32x16 S = i ? S1 : S0;
#pragma unroll
            for (int r = 0; r < 16; ++r) L[(32 * kb + crow(r, hi)) * 128 + 32 * vb + r32] = S[r]; }
        if (tid < 128) HP[((size_t)bh * 3 + seg) * 128 + tid] = ptot;
#undef HS_LOAD
#undef HS_STORE
#undef HS_STEP
    }
}
struct Args { const void* in[19]; float* out; unsigned char* ws; int ph_lo, ph_hi; };
__global__ void __launch_bounds__(NWAVES * 64, 2) fwd(Args args) {
    extern __shared__ __attribute__((aligned(16))) unsigned char lds_raw[];
    LAS unsigned char* lds = (LAS unsigned char*)lds_raw;
    volatile LAS unsigned* MISC = (volatile LAS unsigned*)(lds + MISC_OFF);
    const int tid = threadIdx.x, G = gridDim.x, blk = blockIdx.x;
    unsigned char* ws = args.ws;
    unsigned* ctl = (unsigned*)(ws + WS_CTL);
    for (int u = tid; u < (LDS_BYTES - LDSCTL_OFF) / 4; u += NWAVES * 64) ((LAS unsigned*)(lds + LDSCTL_OFF))[u] = 0u;
    __syncthreads();
    XcdBarrier bar; bar.bar = ctl + CW_BAR; bar.x = 0; bar.st = nullptr;
    if (N_LAUNCHES == 1) bar = xcd_barrier_post(ctl + CW_BAR, MISC + 8);
#if PROBE_PHASE == 78
#define GRID_BAR() do { if (N_LAUNCHES == 1) xcd_barrier(bar); if (blk == 0 && tid == 0) { MISC[32 + pstamp] = (unsigned)__builtin_amdgcn_s_memrealtime(); } ++pstamp; } while (0)
#else
#define GRID_BAR() do { if (N_LAUNCHES == 1) xcd_barrier(bar); } while (0)
#endif
    const int lo = args.ph_lo, hi = args.ph_hi;
#if PROBE_PHASE == 78
    int pstamp = 1; if (blk == 0 && tid == 0) MISC[32] = (unsigned)__builtin_amdgcn_s_memrealtime();
#endif
#define IN(k) (lo <= (k) && (k) < hi)
#define OT() ({ int t_ = tid; asm volatile("" : "+v"(t_)); t_; })
#ifndef STAGGER_TICKS
#define STAGGER_TICKS 0
#endif
#define STAGGER() do { if (STAGGER_TICKS) { const unsigned long long t0_ = __builtin_amdgcn_s_memrealtime(); const unsigned long long d_ = (unsigned long long)((blk >> 3) & 3) * STAGGER_TICKS; while (__builtin_amdgcn_s_memrealtime() - t0_ < d_) __builtin_amdgcn_s_sleep(8); } } while (0)
#define BOTH(k) (IN(k) && IN((k) + 1))
#ifndef PROBE_PHASE
#define PROBE_PHASE -1
#endif
#define REP(k) ((k) == PROBE_PHASE ? 2 : 1)
#if PROBE_PHASE == 77
#define PRBARG(n) , (MISC + 64 + 4 * (n))
#else
#define PRBARG(n)
#endif
    const float* x = (const float*)args.in[0]; const int* positions = (const int*)args.in[1];
    const float* g_mix = (const float*)args.in[2]; const float* g_ffn = (const float*)args.in[3]; const float* g_final = (const float*)args.in[4];
    const float* sinks = (const float*)args.in[7]; const float* rec_norm_g = (const float*)args.in[10]; const float* w_router = (const float*)args.in[15];
    float* out = args.out;
    bf16* H = (bf16*)(ws + WS_H); bf16* BIG = (bf16*)(ws + WS_BIG);
    const size_t PLANE = (size_t)NTOK * D;
    bf16* H2 = (bf16*)(ws + WS_H2); float* RSP = (float*)(ws + WS_RSP);
    unsigned* SSQ1 = (unsigned*)(ws + WS_CTL + CTL_SSQ1); unsigned* SSQ2 = (unsigned*)(ws + WS_CTL + CTL_SSQ2); unsigned* SSQ3 = (unsigned*)(ws + WS_CTL + CTL_SSQ3);

    if (IN(0)) for (int rep_ = 0; rep_ < REP(0); ++rep_) {
        P0Args pa; pa.g_ffn0 = g_ffn; pa.g_mix1 = g_mix + D; pa.g_ffn1 = g_ffn + D; pa.x = x; pa.g0 = g_mix; pa.w_in_attn = (const float*)args.in[5]; pa.w_out_attn = (const float*)args.in[6]; pa.w_in_rec = (const float*)args.in[8]; pa.w_out_rec = (const float*)args.in[11];
        pa.w_gate = (const float*)args.in[12]; pa.w_up = (const float*)args.in[13]; pa.w_down = (const float*)args.in[14]; pa.w_gate_moe = (const float*)args.in[16]; pa.w_up_moe = (const float*)args.in[17]; pa.w_down_moe = (const float*)args.in[18];
        pa.rlb = (const float*)args.in[9]; pa.pos = positions; pa.ws = ws;
        phase_prologue(pa, lds, blk, G, OT());
        if (BOTH(0)) GRID_BAR();
    }
    if (IN(1)) {
        pg8::Gemm g{H2, (const bf16*)(ws + WS_W_INATT), NTOK, QKV_N, D}; pg8::StaticOrder S; S.init(NTOK, QKV_N, G, blk);
        pg8::EpiQkvRope E{BIG, QKV_LD, (const float*)(ws + WS_ROPE), (const float*)(ws + WS_RS0)};
        pg8::gemm_phase<pg8::EpiQkvRope, pg8::StaticOrder, PG8_ALIGN, PG8_SP2>(lds, g, S, E PRBARG(1));
        if (BOTH(1)) GRID_BAR();
    }
    if (IN(3)) for (int rep_ = 0; rep_ < REP(3); ++rep_) { phase_attn(BIG, sinks, H, (bf16*)(ws + WS_OB), (float*)(ws + WS_LSE), lds, blk, G, OT()); if (BOTH(3)) GRID_BAR(); }
    if (IN(4)) {
        pg8::Gemm g{H, (const bf16*)(ws + WS_W_OUTATT), NTOK, D, D}; pg8::StaticOrder S; S.init(NTOK, D, G, blk);
        pg8::EpiResB<false> E{H2, H2, SSQ1, D};
        pg8::gemm_phase<pg8::EpiResB<false>, pg8::StaticOrder, PG8_ALIGN, PG8_SP2>(lds, g, S, E PRBARG(2));
        if (BOTH(4)) GRID_BAR();
    }
    if (IN(6)) {
#if PROBE_PHASE == 99
        { const unsigned long long t0_ = __builtin_amdgcn_s_memrealtime(); while (__builtin_amdgcn_s_memrealtime() - t0_ < 50000ull) __builtin_amdgcn_s_sleep(32); }
#endif
        pg8::Gemm g{H2, (const bf16*)(ws + WS_W_GU), NTOK, 2 * FF, D}; pg8::StaticOrder S; S.init(NTOK, 2 * FF, G, blk);
        pg8::EpiSwiglu E{BIG, FF, 1 << 20, 0, SSQ1, 1.0f};
        pg8::gemm_phase<pg8::EpiSwiglu, pg8::StaticOrder, PG8_ALIGN, PG8_SP2>(lds, g, S, E PRBARG(3));
#if PROBE_PHASE == 6
        GRID_BAR(); pg8::gemm_phase<pg8::EpiSwiglu, pg8::StaticOrder, PG8_ALIGN, PG8_SP2>(lds, g, S, E PRBARG(4));
#endif
        if (BOTH(6)) GRID_BAR();
    }
    if (IN(7)) {
        pg8::Gemm g{BIG, (const bf16*)(ws + WS_W_DN), NTOK, D, FF}; pg8::StaticOrder S; S.init(NTOK, D, G, blk);
        pg8::EpiResB<false> E{H2, H2, SSQ2, D};
        pg8::gemm_phase<pg8::EpiResB<false>, pg8::StaticOrder, PG8_ALIGN, PG8_SP2>(lds, g, S, E PRBARG(5));
        if (BOTH(7)) GRID_BAR();
    }
    if (IN(9)) {
        pg8::Gemm g{H2, (const bf16*)(ws + WS_W_INREC), NTOK, REC_N, D}; pg8::StaticOrder S; S.init(NTOK, REC_N, G, blk);
        pg8::EpiRec2 E{BIG, PLANE, (const float*)(ws + WS_LBK), (float*)(ws + WS_DK), SSQ2};
        pg8::gemm_phase<pg8::EpiRec2, pg8::StaticOrder, PG8_ALIGN, PG8_SP2>(lds, g, S, E PRBARG(6));
        if (BOTH(9)) GRID_BAR();
    }
    if (IN(10)) for (int rep_ = 0; rep_ < REP(10); ++rep_) { phase_hgrn_state(BIG + PLANE, BIG + 2 * PLANE, (const float*)(ws + WS_DK), (float*)(ws + WS_HL), (float*)(ws + WS_HP), lds, blk, G, OT()); if (BOTH(10)) GRID_BAR(); }
    if (IN(11)) for (int rep_ = 0; rep_ < REP(11); ++rep_) { phase_hgrn(BIG, BIG + PLANE, BIG + 2 * PLANE, BIG + 3 * PLANE, (const float*)(ws + WS_DK), rec_norm_g, H, (const float*)(ws + WS_HL), (const float*)(ws + WS_HP), lds, blk, G, OT()); if (BOTH(11)) GRID_BAR(); }
    if (IN(12)) {
        pg8::Gemm g{H, (const bf16*)(ws + WS_W_OUTREC), NTOK, D, D}; pg8::StaticOrder S; S.init(NTOK, D, G, blk);
        pg8::EpiResB<false> E{H2, H2, SSQ3, D};
        pg8::gemm_phase<pg8::EpiResB<false>, pg8::StaticOrder, PG8_ALIGN, PG8_SP2>(lds, g, S, E PRBARG(7));
        if (BOTH(12)) GRID_BAR();
    }
    int4* meta = (int4*)(ws + WS_META); int* hist = (int*)(ws + WS_HIST); int* dest = (int*)(ws + WS_DEST); int* info = (int*)(ws + WS_INFO);
    bf16* Y = (bf16*)(ws + WS_Y); bf16* HID = (bf16*)(ws + WS_HID); unsigned char* P8 = ws + WS_P8;
    if (IN(13)) for (int rep_ = 0; rep_ < REP(13); ++rep_) { phase_router(H2, g_ffn + D, w_router, SSQ3, meta, hist, lds, blk, G, OT()); if (BOTH(13)) GRID_BAR(); }
    if (IN(14)) for (int rep_ = 0; rep_ < REP(14); ++rep_) { phase_scatter(H2, SSQ3, meta, hist, dest, info, P8, lds, blk, G, OT()); if (BOTH(14)) GRID_BAR(); }
    if (IN(15) || IN(16)) {
        const int T = info[8]; const int tile0 = 0; const int ntl = T;
        pg8::MoeOrder S; S.tile0 = tile0; S.te0 = info[0]; S.te1 = info[1]; S.te2 = info[2]; S.te3 = info[3]; S.te4 = info[4]; S.te5 = info[5]; S.te6 = info[6];
        if (IN(15)) {
            S.nN = 28; S.so.init(ntl * 256, 2 * FF, G, blk);
            pg8::Gemm g{(const bf16*)P8, (const bf16*)(ws + WS_WMOE_GU), 0, 0, D};
            pg8::EpiSwigluT<true> E{HID, FF, 28, tile0, nullptr, 1.0f / (F8_ASCALE * F8_WGSCALE)};
            pg8::gemm_phase8<pg8::EpiSwigluT<true>, pg8::MoeOrder, PG8_ALIGN, PG8_SP2>(lds, g, S, E);
            if (BOTH(15)) GRID_BAR();
        }
        if (IN(16)) {
            S.nN = 4; S.so.init(ntl * 256, D, G, blk);
            pg8::Gemm g{(const bf16*)HID, (const bf16*)(ws + WS_WMOE_DN), 0, 0, FF};
            pg8::EpiBf16Plain E{Y, D, 4, 1.0f / (F8_HSCALE * F8_WDSCALE)};
            pg8::gemm_phase8<pg8::EpiBf16Plain, pg8::MoeOrder, PG8_ALIGN, PG8_SP2>(lds, g, S, E);
            if (IN(21)) GRID_BAR();
        }
    }
    if (IN(21)) phase_combine(H2, out, Y, meta, dest, g_final, blk, G, OT());
#if PROBE_PHASE == 78
    __syncthreads();
    if (blk == 0 && tid == 0) { const unsigned long long d_ = (unsigned long long)(MISC[32 + PRB_SEL] - MISC[32 + PRB_SEL - 1]) * PRB_MUL; const unsigned long long t0_ = __builtin_amdgcn_s_memrealtime(); while (__builtin_amdgcn_s_memrealtime() - t0_ < d_) __builtin_amdgcn_s_sleep(8); }
#endif
#if PROBE_PHASE == 77
    __syncthreads();
    if (blk == 0 && tid == 0) { const unsigned long long d_ = (unsigned long long)MISC[64 + PRB_SEL] * PRB_MUL; const unsigned long long t0_ = __builtin_amdgcn_s_memrealtime(); while (__builtin_amdgcn_s_memrealtime() - t0_ < d_) __builtin_amdgcn_s_sleep(8); }
#endif
#if PROBE_PHASE == 83
    __syncthreads();
    if (blk == 0 && tid == 0) { const unsigned long long d_ = (unsigned long long)MISC[16 + PRB_SEL] * PRB_MUL; const unsigned long long t0_ = __builtin_amdgcn_s_memrealtime(); while (__builtin_amdgcn_s_memrealtime() - t0_ < d_) __builtin_amdgcn_s_sleep(8); }
#endif
#undef IN
#undef BOTH
}

extern "C" void kernel_launch(void* const* d_in, const int* in_sizes, int n_in, void* d_out, int out_size, void* d_ws, size_t ws_size, hipStream_t stream) {
    static int grid = 0;
    if (grid == 0) {
        if (n_in != 19 || in_sizes[0] != NTOK * D || out_size != NTOK * D || ws_size < WS_END) { fprintf(stderr, "kernel_launch: unexpected shapes / workspace (n_in %d, ws %zu); nothing launched\n", n_in, ws_size); grid = -1; return; }
        int dev = 0, cus = 0, per_cu = 0;
        if (hipGetDevice(&dev) != hipSuccess || hipDeviceGetAttribute(&cus, hipDeviceAttributeMultiprocessorCount, dev) != hipSuccess) { grid = -1; return; }
        if (hipFuncSetAttribute((const void*)fwd, hipFuncAttributeMaxDynamicSharedMemorySize, LDS_BYTES) != hipSuccess) { fprintf(stderr, "kernel_launch: hipFuncSetAttribute failed\n"); grid = -1; return; }
        if (hipOccupancyMaxActiveBlocksPerMultiprocessor(&per_cu, (const void*)fwd, NWAVES * 64, LDS_BYTES) != hipSuccess || per_cu < 1) fprintf(stderr, "kernel_launch: occupancy query says %d\n", per_cu);
        (void)hipGetLastError();
        grid = cus;
    }
    if (grid < 0) return;
    if (hipMemsetAsync((char*)d_ws + WS_CTL, 0, CTL_ZERO_BYTES, stream) != hipSuccess) return;
    Args a{};
    for (int i = 0; i < 19; ++i) a.in[i] = d_in[i];
    a.out = (float*)d_out; a.ws = (unsigned char*)d_ws;
    if (N_LAUNCHES == 1) { a.ph_lo = 0; a.ph_hi = NPH; hipLaunchKernelGGL(fwd, dim3(grid), dim3(NWAVES * 64), LDS_BYTES, stream, a); }
    else for (int li = 0; li < NPH; ++li) { a.ph_lo = li; a.ph_hi = li + 1; hipLaunchKernelGGL(fwd, dim3(grid), dim3(NWAVES * 64), LDS_BYTES, stream, a); }
}
```

```cpp
#include <hip/hip_runtime.h>
#include <cstdio>
#include <cstdint>
#define PROBE_PHASE -1
#define STAGGER_TICKS 0
#define PRB_SEL 0
#define PRB_MUL 1
#define PRB_SEL2 0
namespace pg8 {
#define PG8_LAS __attribute__((address_space(3)))
typedef unsigned short bf16_t;
typedef short bf16x8 __attribute__((ext_vector_type(8)));
typedef float f32x4 __attribute__((ext_vector_type(4)));
typedef unsigned u32x4 __attribute__((ext_vector_type(4)));
constexpr int BM = 256, BK = 64, HALF = 128, HTB = HALF * BK * 2  , STAGE_BYTES = 8 * HTB, NXCD = 8, WGM = 8;

__host__ __device__ __forceinline__ int lds_byte(int r, int c) { const int st = (r >> 4) * 2 + (c >> 5), rr = r & 15, cc = c & 31, ob = rr * 64 + cc * 2; return st * 1024 + (ob ^ (((ob >> 9) & 1) << 5)); }
__host__ __device__ __forceinline__ void stage_rc(int b, int& R, int& C) { const int st = b / 1024, sb = b % 1024, swz = sb ^ (((sb >> 9) & 1) << 5); R = (st >> 1) * 16 + swz / 64; C = (st & 1) * 32 + (swz % 64) / 2; }
__host__ __device__ __forceinline__ int perm32(int rho) { const int n = rho >> 4, i = rho & 15; return 8 * (i >> 2) + 4 * n + (i & 3); }

struct Unit { int pm, pn; };
struct Gemm { const bf16_t* A; const bf16_t* Bt; int M, N, K; };

struct StaticOrder {
    int nM, nN, nwg, G, c;
    __host__ __device__ void init(int M, int N, int G_, int c_) { nM = M / BM; nN = N / BM; nwg = nM * nN; G = G_; c = c_; }
    __host__ __device__ bool next(int i, Unit& u) const {
        const long L = (long)i * G + c; if (L >= nwg) return false;
        int wgid = (int)L; { const int q = nwg / NXCD, r = nwg % NXCD, xcd = wgid % NXCD, off = wgid / NXCD; wgid = (xcd < r ? xcd * (q + 1) : r * (q + 1) + (xcd - r) * q) + off; }
        const int nig = WGM * nN, gid = wgid / nig, fm = gid * WGM, gsz = (nM - fm) < WGM ? (nM - fm) : WGM;
        u.pm = fm + ((wgid % nig) % gsz); u.pn = (wgid % nig) / gsz; return true;
    }
    __device__ __forceinline__ void a_ready(const Unit&) const {}
    __device__ __forceinline__ void done(const Unit&) const {}
};
typedef float f32x2c_t __attribute__((ext_vector_type(2))); typedef __bf16 bf16x2c_t __attribute__((ext_vector_type(2)));
__device__ __forceinline__ unsigned cvt_pk_bf16(float lo, float hi) { const f32x2c_t v = {lo, hi}; const bf16x2c_t b = __builtin_convertvector(v, bf16x2c_t); return __builtin_bit_cast(unsigned, b); }
typedef unsigned u32x2 __attribute__((ext_vector_type(2)));
__device__ __forceinline__ float sigmoid_f(float x) { return __builtin_amdgcn_rcpf(1.0f + __builtin_amdgcn_exp2f(-1.44269504089f * x)); }
__device__ __forceinline__ float silu_f(float x) { return x * sigmoid_f(x); }
__device__ __forceinline__ unsigned pk4_fp8(float a, float b, float c, float d) { int w = __builtin_amdgcn_cvt_pk_fp8_f32(a, b, 0, false); w = __builtin_amdgcn_cvt_pk_fp8_f32(c, d, w, true); return (unsigned)w; }
__device__ __forceinline__ u32x4 pack8(const f32x4& v0, const f32x4& v1) { u32x4 w; w.x = cvt_pk_bf16(v0[0], v0[1]); w.y = cvt_pk_bf16(v0[2], v0[3]); w.z = cvt_pk_bf16(v1[0], v1[1]); w.w = cvt_pk_bf16(v1[2], v1[3]); return w; }
struct EpiBf16Plain {
    static constexpr bool PERM = true, AFTER_DRAIN = false; static constexpr int NST = 16;
    bf16_t* O; int ldc; int nmod; float scale;
    __device__ __forceinline__ void operator()(const f32x4 (&acc)[2][2][4][2], const Unit& u, int wr, int wc, int fr, int fq) const {
        const int row0 = u.pm * BM + wr * 64 + fr; const int col0 = (u.pn % nmod) * BM + wc * 32 + 8 * fq;
#pragma unroll
        for (int ai = 0; ai < 2; ++ai)
#pragma unroll
            for (int m = 0; m < 4; ++m) { bf16_t* rowp = O + (size_t)(row0 + ai * HALF + m * 16) * ldc + col0;
#pragma unroll
                for (int bj = 0; bj < 2; ++bj) *(u32x4*)(rowp + bj * HALF) = pack8(acc[ai][bj][m][0] * scale, acc[ai][bj][m][1] * scale); }
    }
};
struct EpiQkvRope {
    static constexpr bool PERM = true, AFTER_DRAIN = false; static constexpr int NST = 16;
    bf16_t* O; int ldo; const float* rope; const float* rs0;
    __device__ __forceinline__ void operator()(const f32x4 (&acc)[2][2][4][2], const Unit& u, int wr, int wc, int fr, int fq) const {
        const int row0 = u.pm * BM + wr * 64 + fr; const int col0 = u.pn * BM + wc * 32 + 8 * fq;
        const bool lrot = ((wc & 1) == 0) && (fq < 2);
        const bool anyrot = (u.pn < 4) || (u.pn >= 6);
        float rs8[8];
#pragma unroll
        for (int g = 0; g < 8; ++g) rs8[g] = rs0[row0 + (g >> 2) * HALF + (g & 3) * 16];
#pragma unroll
        for (int ai2 = 0; ai2 < 4; ++ai2) { const int ai = ai2 >> 1;
            f32x4 tb[4][4];
            if (anyrot) {
#pragma unroll
                for (int m = 2 * (ai2 & 1); m < 2 * (ai2 & 1) + 2; ++m) { const f32x4* t = (const f32x4*)(rope + (size_t)(row0 + ai * HALF + m * 16) * 16);
#pragma unroll
                    for (int q = 0; q < 4; ++q) tb[m][q] = t[q]; } }
#pragma unroll
            for (int m = 2 * (ai2 & 1); m < 2 * (ai2 & 1) + 2; ++m) { const int row = row0 + ai * HALF + m * 16; bf16_t* rowp = O + (size_t)row * ldo + col0; const float rsr = rs8[ai * 4 + m];
#pragma unroll
                for (int bj = 0; bj < 2; ++bj) { f32x4 v0 = acc[ai][bj][m][0] * rsr, v1 = acc[ai][bj][m][1] * rsr;
                    const bool urot = (u.pn < 4) || (u.pn == 6) || (u.pn == 7) || (u.pn == 8 && bj == 0);
                    if (urot) {
                        const f32x4 c0 = tb[m][0], c1 = tb[m][1], s0 = tb[m][2], s1 = tb[m][3];
                        f32x4 p0, p1;
#pragma unroll
                        for (int j = 0; j < 4; ++j) { p0[j] = __shfl_xor(v0[j], 16); p1[j] = __shfl_xor(v1[j], 16); }
                        if (lrot) { const float sg = (fq == 0) ? -1.0f : 1.0f;
#pragma unroll
                            for (int j = 0; j < 4; ++j) { v0[j] = v0[j] * c0[j] + sg * p0[j] * s0[j]; v1[j] = v1[j] * c1[j] + sg * p1[j] * s1[j]; } }
                    }
                    *(u32x4*)(rowp + bj * HALF) = pack8(v0, v1); } } }
    }
};
template <bool BASE_F32> struct EpiResB {
    static constexpr bool PERM = true, AFTER_DRAIN = false; static constexpr int NST = 24;
    const void* base; bf16_t* hb; unsigned* ssq; int ldc;
    __device__ __forceinline__ void load(f32x4 (&d)[4], size_t off) const {
        if constexpr (BASE_F32) { const float* b = (const float*)base + off; d[0] = *(const f32x4*)b; d[1] = *(const f32x4*)(b + 4); d[2] = *(const f32x4*)(b + HALF); d[3] = *(const f32x4*)(b + HALF + 4); }
        else { const bf16_t* b = (const bf16_t*)base + off; const u32x4 w0 = *(const u32x4*)b, w1 = *(const u32x4*)(b + HALF);
            d[0] = (f32x4){__builtin_bit_cast(float, w0.x << 16), __builtin_bit_cast(float, w0.x & 0xffff0000u), __builtin_bit_cast(float, w0.y << 16), __builtin_bit_cast(float, w0.y & 0xffff0000u)};
            d[1] = (f32x4){__builtin_bit_cast(float, w0.z << 16), __builtin_bit_cast(float, w0.z & 0xffff0000u), __builtin_bit_cast(float, w0.w << 16), __builtin_bit_cast(float, w0.w & 0xffff0000u)};
            d[2] = (f32x4){__builtin_bit_cast(float, w1.x << 16), __builtin_bit_cast(float, w1.x & 0xffff0000u), __builtin_bit_cast(float, w1.y << 16), __builtin_bit_cast(float, w1.y & 0xffff0000u)};
            d[3] = (f32x4){__builtin_bit_cast(float, w1.z << 16), __builtin_bit_cast(float, w1.z & 0xffff0000u), __builtin_bit_cast(float, w1.w << 16), __builtin_bit_cast(float, w1.w & 0xffff0000u)}; }
    }
    __device__ __forceinline__ void operator()(const f32x4 (&acc)[2][2][4][2], const Unit& u, int wr, int wc, int fr, int fq) const {
        const int row0 = u.pm * BM + wr * 64 + fr, col0 = u.pn * BM + wc * 32 + 8 * fq;
        f32x4 cur[4], nxt[4];
        load(cur, (size_t)row0 * ldc + col0);
#pragma unroll
        for (int g = 0; g < 8; ++g) { const int ai = g >> 2, m = g & 3; const int row = row0 + ai * HALF + m * 16; const size_t off = (size_t)row * ldc + col0;
            if (g < 7) { const int ai2 = (g + 1) >> 2, m2 = (g + 1) & 3; load(nxt, (size_t)(row0 + ai2 * HALF + m2 * 16) * ldc + col0); }
            float ss = 0.f;
#pragma unroll
            for (int bj = 0; bj < 2; ++bj) { const f32x4 v0 = cur[2 * bj] + acc[ai][bj][m][0], v1 = cur[2 * bj + 1] + acc[ai][bj][m][1];
                *(u32x4*)(hb + off + bj * HALF) = pack8(v0, v1);
                ss += ((v0[0] * v0[0] + v0[1] * v0[1]) + (v0[2] * v0[2] + v0[3] * v0[3])) + ((v1[0] * v1[0] + v1[1] * v1[1]) + (v1[2] * v1[2] + v1[3] * v1[3])); }
            ss += __shfl_xor(ss, 16); ss += __shfl_xor(ss, 32);
            if (fq == 0) __hip_atomic_fetch_add(ssq + row, __float2uint_rn(ss * 65536.0f), __ATOMIC_RELAXED, __HIP_MEMORY_SCOPE_AGENT);
            asm volatile("" ::: "memory");
#pragma unroll
            for (int q = 0; q < 4; ++q) cur[q] = nxt[q]; }
    }
};
template <bool F8> struct EpiSwigluT {
    static constexpr bool PERM = true, AFTER_DRAIN = false; static constexpr int NST = 8;
    void* O; int ldc; int nN; int tile0; const void* rs; float cs;
    __device__ __forceinline__ void operator()(const f32x4 (&acc)[2][2][4][2], const Unit& u, int wr, int wc, int fr, int fq) const {
        const int row0 = (u.pm - tile0) * BM + wr * 64 + fr; const int col0 = (u.pn % nN) * HALF + wc * 32 + 8 * fq; const int arow0 = u.pm * BM + wr * 64 + fr;
        u32x2 wprev = (u32x2){0u, 0u};
        unsigned sq8[8];
        if constexpr (!F8) {
#pragma unroll
            for (int g = 0; g < 8; ++g) sq8[g] = ((const unsigned*)rs)[arow0 + (g >> 2) * HALF + (g & 3) * 16]; }
#pragma unroll
        for (int ai = 0; ai < 2; ++ai)
#pragma unroll
            for (int m = 0; m < 4; ++m) {
                float rsv; if constexpr (F8) rsv = cs; else rsv = 1.0f / sqrtf((float)sq8[ai * 4 + m] * (1.f / (1024.f * 65536.f)) + 1e-6f);
                f32x4 h0, h1;
#pragma unroll
                for (int j = 0; j < 4; ++j) { h0[j] = silu_f(rsv * acc[ai][0][m][0][j]) * (rsv * acc[ai][1][m][0][j]); h1[j] = silu_f(rsv * acc[ai][0][m][1][j]) * (rsv * acc[ai][1][m][1][j]); }
                if constexpr (F8) {
#pragma unroll
                    for (int j = 0; j < 4; ++j) { h0[j] = __builtin_amdgcn_fmed3f(h0[j] * 4.0f, -448.0f, 448.0f); h1[j] = __builtin_amdgcn_fmed3f(h1[j] * 4.0f, -448.0f, 448.0f); }
                    u32x2 w; w.x = pk4_fp8(h0[0], h0[1], h0[2], h0[3]); w.y = pk4_fp8(h1[0], h1[1], h1[2], h1[3]);
                    if (m & 1) { auto sx = __builtin_amdgcn_permlane16_swap(wprev.x, w.x, false, false); auto sy = __builtin_amdgcn_permlane16_swap(wprev.y, w.y, false, false);
                        const int mm = (fq & 1) ? m : m - 1;
                        *(u32x4*)((unsigned char*)O + (size_t)(row0 + ai * HALF + mm * 16) * ldc + (col0 & ~15)) = (u32x4){(unsigned)sx[0], (unsigned)sy[0], (unsigned)sx[1], (unsigned)sy[1]}; }
                    else wprev = w; }
                else *(u32x4*)((bf16_t*)O + (size_t)(row0 + ai * HALF + m * 16) * ldc + col0) = pack8(h0, h1); }
    }
};
typedef EpiSwigluT<false> EpiSwiglu;
struct MoeOrder {
    StaticOrder so; int tile0, nN; int te0, te1, te2, te3, te4, te5, te6;
    __device__ __forceinline__ bool next(int i, Unit& u) const {
        Unit l; if (!so.next(i, l)) return false;
        const int pm = tile0 + l.pm;
        const int e = (pm >= te0) + (pm >= te1) + (pm >= te2) + (pm >= te3) + (pm >= te4) + (pm >= te5) + (pm >= te6);
        u.pm = pm; u.pn = e * nN + l.pn; return true;
    }
    __device__ __forceinline__ void a_ready(const Unit&) const {}
    __device__ __forceinline__ void done(const Unit&) const {}
};
template <int CTRL> __device__ __forceinline__ float dpp0(float v) { return __builtin_bit_cast(float, __builtin_amdgcn_update_dpp(0, __builtin_bit_cast(int, v), CTRL, 0xf, 0xf, true)); }
struct EpiRec2 {
    static constexpr bool PERM = true, AFTER_DRAIN = false; static constexpr int NST = 16;
    bf16_t* P; size_t plane; const float* lbk; float* DK; const unsigned* ssq;
    __device__ __forceinline__ void operator()(const f32x4 (&acc)[2][2][4][2], const Unit& u, int wr, int wc, int fr, int fq) const {
        const int hd = u.pn & 7; const bool second = (u.pn >> 3) != 0;
        const int row0 = u.pm * BM + wr * 64 + fr; const int ch0 = hd * HALF + wc * 32 + 8 * fq;
        float rs8[8];
#pragma unroll
        for (int g = 0; g < 8; ++g) rs8[g] = 1.0f / sqrtf((float)ssq[row0 + (g >> 2) * HALF + (g & 3) * 16] * (1.f / (1024.f * 65536.f)) + 1e-6f);
        if (second) {
#pragma unroll
            for (int ai = 0; ai < 2; ++ai)
#pragma unroll
                for (int m = 0; m < 4; ++m) { const size_t off = (size_t)(row0 + ai * HALF + m * 16) * 1024 + ch0;
                    const float rsm = rs8[ai * 4 + m];
                    f32x4 b0 = acc[ai][1][m][0], b1 = acc[ai][1][m][1]; const f32x4 a0 = acc[ai][0][m][0] * rsm, a1 = acc[ai][0][m][1] * rsm;
#pragma unroll
                    for (int j = 0; j < 4; ++j) { b0[j] = silu_f(rsm * b0[j]); b1[j] = silu_f(rsm * b1[j]); }
                    *(u32x4*)(P + 2 * plane + off) = pack8(a0, a1); *(u32x4*)(P + 3 * plane + off) = pack8(b0, b1); }
        } else {
            const int lane15 = (fq * 16 + fr) | 15;
            const f32x4 lb2[2] = {*(const f32x4*)(lbk + ch0), *(const f32x4*)(lbk + ch0 + 4)};
#pragma unroll
            for (int ai = 0; ai < 2; ++ai) {
                float rs4[4];
#pragma unroll
                for (int m = 0; m < 4; ++m) rs4[m] = rs8[ai * 4 + m];
                u32x2 qw[4], kw[4];
#pragma unroll
                for (int n = 0; n < 2; ++n) {
                    const f32x4 lbv = lb2[n];
                    float kk[4][4], bb[4][4];
#pragma unroll
                    for (int m = 0; m < 4; ++m)
#pragma unroll
                        for (int j = 0; j < 4; ++j) { const float k_ = lbv[j] * sigmoid_f(-rs4[m] * acc[ai][1][m][n][j]); kk[m][j] = k_; float x = __logf(1.0f - k_);
                            x += dpp0<0x111>(x); x += dpp0<0x112>(x); x += dpp0<0x114>(x); x += dpp0<0x118>(x); bb[m][j] = x; }
                    float run[4] = {0.f, 0.f, 0.f, 0.f};
#pragma unroll
                    for (int m = 0; m < 4; ++m)
#pragma unroll
                        for (int j = 0; j < 4; ++j) { const float tot = __shfl(bb[m][j], lane15); bb[m][j] += run[j]; run[j] += tot; }
#pragma unroll
                    for (int m = 0; m < 4; ++m) { const size_t off = (size_t)(row0 + ai * HALF + m * 16) * 1024 + ch0;
                        float qe[4], ki[4];
#pragma unroll
                        for (int j = 0; j < 4; ++j) { const float bt = bb[m][j]; qe[j] = silu_f(rs4[m] * acc[ai][0][m][n][j]) * __expf(bt); ki[j] = kk[m][j] * __expf(fminf(-bt, 80.f)); }
                        u32x2 wq, wk; wq.x = cvt_pk_bf16(qe[0], qe[1]); wq.y = cvt_pk_bf16(qe[2], qe[3]); wk.x = cvt_pk_bf16(ki[0], ki[1]); wk.y = cvt_pk_bf16(ki[2], ki[3]);
                        if (n == 0) { qw[m] = wq; kw[m] = wk; }
                        else { *(u32x4*)(P + off) = (u32x4){qw[m].x, qw[m].y, wq.x, wq.y}; *(u32x4*)(P + plane + off) = (u32x4){kw[m].x, kw[m].y, wk.x, wk.y}; } }
                    if (fr == 0) { const int chunk = 4 * u.pm + 2 * ai + wr; *(f32x4*)(DK + (size_t)chunk * 1024 + ch0 + 4 * n) = (f32x4){__expf(run[0]), __expf(run[1]), __expf(run[2]), __expf(run[3])}; }
                }
            }
        }
    }
};
template <class Epi, class Sched, bool ALIGN_EPI = false, bool SP2 = false>
__device__ __forceinline__ void gemm_phase(PG8_LAS unsigned char* lds, const Gemm g, const Sched& S, const Epi& E, volatile PG8_LAS unsigned* prbp = nullptr) {
#if PROBE_PHASE == 77
    unsigned prk = 0, pre = 0, prr = 0, pra = 0, prt0 = 0, prt1 = 0, prtA = 0, prt2 = (unsigned)__builtin_amdgcn_s_memrealtime();
#endif
    int tid_ = threadIdx.x; asm volatile("" : "+v"(tid_));
    const int tid = tid_, wid = __builtin_amdgcn_readfirstlane(tid >> 6), lane = tid & 63, wr = wid >> 2, wc = wid & 3, fr = lane & 15, fq = lane >> 4;
    const int K = g.K, nt = K / BK;
    unsigned voffA[2], voffB[2];
#pragma unroll
    for (int i = 0; i < 2; ++i) { int R, C; stage_rc(tid * 16 + i * 8192, R, C); const int Rb = Epi::PERM ? ((R & ~31) + perm32(R & 31)) : R;
        voffA[i] = (unsigned)(R * K + C) * 2u; voffB[i] = (unsigned)(Rb * K + C) * 2u; }
    const size_t kstep = (size_t)(BK * 2);
    const size_t hstep = (size_t)HALF * K * 2;
    const size_t tstep = 2 * hstep;
    const unsigned ldsw = (unsigned)wid * 1024u;
    const int aoff = lds_byte(wr * 64 + fr, fq * 8), boff = lds_byte(wc * 32 + fr, fq * 8);
#define PG8_SA(b, h) (((b) * 2 + (h)) * HTB)
#define PG8_SB(b, h) ((4 + (b) * 2 + (h)) * HTB)
#define PG8_STAGE(bufoff, gbase, voff) do { _Pragma("unroll") for (int _i = 0; _i < 2; ++_i) \
        __builtin_amdgcn_global_load_lds((const unsigned*)((const char*)(gbase) + (voff)[_i]), (PG8_LAS unsigned*)(lds + (bufoff) + ldsw + _i * 8192), 16, 0, 0); } while (0)
#define PG8_LDA(dst, b, h) do { _Pragma("unroll") for (int m = 0; m < 4; ++m) _Pragma("unroll") for (int k = 0; k < 2; ++k) dst[m][k] = *(const PG8_LAS bf16x8*)(lds + PG8_SA(b, h) + aoff + m * 2048 + k * 1024); } while (0)
#define PG8_LDB(dst, b, h) do { _Pragma("unroll") for (int n = 0; n < 2; ++n) _Pragma("unroll") for (int k = 0; k < 2; ++k) dst[n][k] = *(const PG8_LAS bf16x8*)(lds + PG8_SB(b, h) + boff + n * 2048 + k * 1024); } while (0)
#define PG8_MMA(ai, bj, At, Bt) do { __builtin_amdgcn_s_setprio(1); _Pragma("unroll") for (int m = 0; m < 4; ++m) _Pragma("unroll") for (int n = 0; n < 2; ++n) _Pragma("unroll") for (int k = 0; k < 2; ++k) \
        acc[ai][bj][m][n] = __builtin_amdgcn_mfma_f32_16x16x32_bf16(Bt[n][k], At[m][k], acc[ai][bj][m][n], 0, 0, 0); __builtin_amdgcn_s_setprio(0); } while (0)
#define PG8_WAIT_V(n) asm volatile("s_waitcnt vmcnt(" #n ")" ::: "memory")
#define PG8_WAIT_V8R(relax) do { if (relax) asm volatile("s_waitcnt vmcnt(%0)" :: "n"(8 + Epi::NST) : "memory"); else asm volatile("s_waitcnt vmcnt(8)" ::: "memory"); } while (0)
#define PG8_WAIT_L(n) asm volatile("s_waitcnt lgkmcnt(" #n ")" ::: "memory")
#define PG8_BAR __builtin_amdgcn_s_barrier()
#define PG8_SCHED __builtin_amdgcn_sched_barrier(0)
    Unit cur, nxt; int ui = 0;
    if (!S.next(0, cur)) return;
    f32x4 acc[2][2][4][2];
#pragma unroll
    for (int a = 0; a < 2; ++a)
#pragma unroll
        for (int b = 0; b < 2; ++b)
#pragma unroll
            for (int m = 0; m < 4; ++m)
#pragma unroll
                for (int n = 0; n < 2; ++n) acc[a][b][m][n] = (f32x4){0.f, 0.f, 0.f, 0.f};
    bf16x8 At[4][2], B0[2][2], B1[2][2];
    const char* cA = (const char*)g.A + (size_t)cur.pm * tstep; const char* cB = (const char*)g.Bt + (size_t)cur.pn * tstep;
    S.a_ready(cur);
    if constexpr (SP2) {
        PG8_STAGE(PG8_SB(0, 0), cB, voffB); PG8_STAGE(PG8_SB(0, 1), cB + hstep, voffB); PG8_STAGE(PG8_SA(0, 0), cA, voffA); PG8_STAGE(PG8_SA(0, 1), cA + hstep, voffA);
        if (wr == 1) PG8_BAR;
        PG8_WAIT_V(2); PG8_BAR;
        PG8_STAGE(PG8_SB(1, 0), cB + kstep, voffB); PG8_STAGE(PG8_SA(1, 0), cA + kstep, voffA); PG8_STAGE(PG8_SB(1, 1), cB + hstep + kstep, voffB);
        PG8_WAIT_V(6); PG8_BAR;
    } else {
        PG8_STAGE(PG8_SB(0, 0), cB, voffB); PG8_STAGE(PG8_SA(0, 0), cA, voffA); PG8_STAGE(PG8_SB(0, 1), cB + hstep, voffB); PG8_STAGE(PG8_SA(0, 1), cA + hstep, voffA);
        if (wr == 1) PG8_BAR;
        PG8_WAIT_V(4); PG8_BAR;
        PG8_STAGE(PG8_SB(1, 0), cB + kstep, voffB); PG8_STAGE(PG8_SA(1, 0), cA + kstep, voffA); PG8_STAGE(PG8_SB(1, 1), cB + hstep + kstep, voffB);
        PG8_WAIT_V(6); PG8_BAR;
    }
    for (;;) {
        const bool has_next = S.next(ui + 1, nxt);
        const char* nA = has_next ? (const char*)g.A + (size_t)nxt.pm * tstep : cA; const char* nB = has_next ? (const char*)g.Bt + (size_t)nxt.pn * tstep : cB;
#if PROBE_PHASE == 77
        prt0 = (unsigned)__builtin_amdgcn_s_memrealtime();
#endif
        for (int t = 0; t < nt; t += 2) {
            const bool last = (t == nt - 2);
            const char* a1 = cA + (size_t)(t + 1) * kstep;
            const char* a2 = last ? nA : cA + (size_t)(t + 2) * kstep; const char* b2 = last ? nB : cB + (size_t)(t + 2) * kstep;
            const char* a3 = a2 + kstep; const char* b3 = b2 + kstep;
            if (last && has_next) S.a_ready(nxt);
            if constexpr (SP2) {
            PG8_LDB(B0, 0, 0); PG8_LDB(B1, 0, 1); PG8_SCHED; PG8_LDA(At, 0, 0); PG8_STAGE(PG8_SA(1, 1), a1 + hstep, voffA);
            PG8_WAIT_V(8); PG8_WAIT_L(0); PG8_BAR; PG8_MMA(0, 0, At, B0); PG8_MMA(0, 1, At, B1); PG8_BAR; PG8_SCHED;
            PG8_LDA(At, 0, 1); PG8_STAGE(PG8_SB(0, 0), b2, voffB); PG8_STAGE(PG8_SB(0, 1), b2 + hstep, voffB); PG8_STAGE(PG8_SA(0, 0), a2, voffA);
            PG8_WAIT_V(8); PG8_WAIT_L(0); PG8_BAR; PG8_MMA(1, 0, At, B0); PG8_MMA(1, 1, At, B1); PG8_BAR; PG8_SCHED;
            PG8_LDB(B0, 1, 0); PG8_LDB(B1, 1, 1); PG8_SCHED; PG8_LDA(At, 1, 0); PG8_STAGE(PG8_SA(0, 1), a2 + hstep, voffA);
            PG8_WAIT_V(8); PG8_WAIT_L(0); PG8_BAR; PG8_MMA(0, 0, At, B0); PG8_MMA(0, 1, At, B1); PG8_BAR; PG8_SCHED;
            PG8_LDA(At, 1, 1); PG8_STAGE(PG8_SB(1, 0), b3, voffB); PG8_STAGE(PG8_SB(1, 1), b3 + hstep, voffB); PG8_STAGE(PG8_SA(1, 0), a3, voffA);
            PG8_WAIT_V(8); PG8_WAIT_L(0); PG8_BAR; PG8_MMA(1, 0, At, B0); PG8_MMA(1, 1, At, B1); PG8_BAR; PG8_SCHED;
            } else {
            PG8_LDB(B0, 0, 0); PG8_SCHED; PG8_LDA(At, 0, 0); PG8_STAGE(PG8_SA(1, 1), a1 + hstep, voffA);
            PG8_WAIT_L(8); PG8_BAR; PG8_WAIT_L(0); PG8_MMA(0, 0, At, B0); PG8_BAR; PG8_SCHED;
            PG8_LDB(B1, 0, 1); PG8_STAGE(PG8_SB(0, 0), b2, voffB);
            PG8_BAR; PG8_WAIT_L(0); PG8_MMA(0, 1, At, B1); PG8_BAR;
            PG8_LDA(At, 0, 1); PG8_STAGE(PG8_SA(0, 0), a2, voffA);
            PG8_BAR; PG8_WAIT_L(0); PG8_MMA(1, 0, At, B0); PG8_BAR; PG8_SCHED;
            PG8_STAGE(PG8_SB(0, 1), b2 + hstep, voffB);
            PG8_WAIT_V(6); PG8_BAR; PG8_MMA(1, 1, At, B1); PG8_BAR;
            PG8_LDB(B0, 1, 0); PG8_SCHED; PG8_LDA(At, 1, 0); PG8_STAGE(PG8_SA(0, 1), a2 + hstep, voffA);
            PG8_WAIT_L(8); PG8_BAR; PG8_WAIT_L(0); PG8_MMA(0, 0, At, B0); PG8_BAR; PG8_SCHED;
            PG8_LDB(B1, 1, 1); PG8_STAGE(PG8_SB(1, 0), b3, voffB);
            PG8_BAR; PG8_WAIT_L(0); PG8_MMA(0, 1, At, B1); PG8_BAR;
            PG8_LDA(At, 1, 1); PG8_STAGE(PG8_SA(1, 0), a3, voffA);
            PG8_BAR; PG8_WAIT_L(0); PG8_MMA(1, 0, At, B0); PG8_BAR; PG8_SCHED;
            PG8_STAGE(PG8_SB(1, 1), b3 + hstep, voffB);
            PG8_WAIT_V(6); PG8_BAR; PG8_MMA(1, 1, At, B1); PG8_BAR;
            }
        }
#if PROBE_PHASE == 77
        prt1 = (unsigned)__builtin_amdgcn_s_memrealtime(); prk += prt1 - prt0;
#endif
        if constexpr (ALIGN_EPI) { if (wr == 0) PG8_BAR; }
#if PROBE_PHASE == 77
        prtA = (unsigned)__builtin_amdgcn_s_memrealtime(); pra += prtA - prt1;
#endif
        if constexpr (!Epi::AFTER_DRAIN) { E(acc, cur, wr, wc, fr, fq); S.done(cur); }
#if PROBE_PHASE == 77
        prt2 = (unsigned)__builtin_amdgcn_s_memrealtime(); pre += prt2 - prtA;
        asm volatile("s_waitcnt vmcnt(0)" ::: "memory"); prr += (unsigned)__builtin_amdgcn_s_memrealtime() - prt2;
#endif
        if (!has_next) break;
#pragma unroll
        for (int a = 0; a < 2; ++a)
#pragma unroll
            for (int b = 0; b < 2; ++b)
#pragma unroll
                for (int m = 0; m < 4; ++m)
#pragma unroll
                    for (int n = 0; n < 2; ++n) acc[a][b][m][n] = (f32x4){0.f, 0.f, 0.f, 0.f};
        cur = nxt; cA = nA; cB = nB; ++ui;
        if constexpr (ALIGN_EPI) { if (wr == 1) PG8_BAR; }
    }
#if PROBE_PHASE == 77
    if (prbp && blockIdx.x == 0 && tid == PRB_SEL2) { prbp[0] = prk; prbp[1] = pre; prbp[2] = prr; prbp[3] = pra; }
#endif
    PG8_WAIT_V(0);
    if constexpr (!ALIGN_EPI) { if (wr == 0) PG8_BAR; }
    PG8_BAR;
    if constexpr (Epi::AFTER_DRAIN) { E.fused(acc, cur, wr, wc, fr, fq, lds, wid, lane); S.done(cur); }
#undef PG8_SA
#undef PG8_SB
#undef PG8_STAGE
#undef PG8_LDA
#undef PG8_LDB
#undef PG8_MMA
#undef PG8_WAIT_V
#undef PG8_WAIT_V8R
#undef PG8_WAIT_L
#undef PG8_BAR
#undef PG8_SCHED
}

typedef int v8i_t __attribute__((ext_vector_type(8)));
typedef short bf16x16_t __attribute__((ext_vector_type(16)));
template <class Epi, class Sched, bool ALIGN_EPI = false, bool SP2 = false>
__device__ __forceinline__ void gemm_phase8(PG8_LAS unsigned char* lds, const Gemm g, const Sched& S, const Epi& E) {
    int tid_ = threadIdx.x; asm volatile("" : "+v"(tid_));
    const int tid = tid_, wid = __builtin_amdgcn_readfirstlane(tid >> 6), lane = tid & 63, wr = wid >> 2, wc = wid & 3, fr = lane & 15, fq = lane >> 4;
    const int K = g.K, nt = K / 128;
    unsigned voffA[2], voffB[2];
#pragma unroll
    for (int i = 0; i < 2; ++i) { int R, C; stage_rc(tid * 16 + i * 8192, R, C); const int Rb = Epi::PERM ? ((R & ~31) + perm32(R & 31)) : R;
        voffA[i] = (unsigned)(R * K + 2 * C); voffB[i] = (unsigned)(Rb * K + 2 * C); }
    const size_t kstep = (size_t)(BK * 2);
    const size_t hstep = (size_t)HALF * K;
    const size_t tstep = 2 * hstep;
    const unsigned ldsw = (unsigned)wid * 1024u;
    const int aoff = lds_byte(wr * 64 + fr, fq * 16), boff = lds_byte(wc * 32 + fr, fq * 16);
#define PG8_SA(b, h) (((b) * 2 + (h)) * HTB)
#define PG8_SB(b, h) ((4 + (b) * 2 + (h)) * HTB)
#define PG8_STAGE(bufoff, gbase, voff) do { _Pragma("unroll") for (int _i = 0; _i < 2; ++_i) \
        __builtin_amdgcn_global_load_lds((const unsigned*)((const char*)(gbase) + (voff)[_i]), (PG8_LAS unsigned*)(lds + (bufoff) + ldsw + _i * 8192), 16, 0, 0); } while (0)
#define PG8_LD32(dst, addr) do { const u32x4 lo_ = *(const PG8_LAS u32x4*)(addr), hi_ = *(const PG8_LAS u32x4*)((addr) + 16); dst = (v8i_t){(int)lo_.x, (int)lo_.y, (int)lo_.z, (int)lo_.w, (int)hi_.x, (int)hi_.y, (int)hi_.z, (int)hi_.w}; } while (0)
#define PG8_LDA(dst, b, h) do { _Pragma("unroll") for (int m = 0; m < 4; ++m) PG8_LD32(dst[m], lds + PG8_SA(b, h) + aoff + m * 2048); } while (0)
#define PG8_LDB(dst, b, h) do { _Pragma("unroll") for (int n = 0; n < 2; ++n) PG8_LD32(dst[n], lds + PG8_SB(b, h) + boff + n * 2048); } while (0)
#define PG8_MMA(ai, bj, At, Bt) do { __builtin_amdgcn_s_setprio(1); _Pragma("unroll") for (int m = 0; m < 4; ++m) _Pragma("unroll") for (int n = 0; n < 2; ++n) \
        asm volatile("v_mfma_scale_f32_16x16x128_f8f6f4 %0, %1, %2, %0, %3, %3 op_sel_hi:[0,0,0]" : "+v"(acc[ai][bj][m][n]) : "v"(Bt[n]), "v"(At[m]), "v"(f8one)); __builtin_amdgcn_s_setprio(0); asm volatile("s_nop 4"); } while (0)
#define PG8_WAIT_V(n) asm volatile("s_waitcnt vmcnt(" #n ")" ::: "memory")
#define PG8_WAIT_V8R(relax) do { if (relax) asm volatile("s_waitcnt vmcnt(%0)" :: "n"(8 + Epi::NST) : "memory"); else asm volatile("s_waitcnt vmcnt(8)" ::: "memory"); } while (0)
#define PG8_WAIT_L(n) asm volatile("s_waitcnt lgkmcnt(" #n ")" ::: "memory")
#define PG8_BAR __builtin_amdgcn_s_barrier()
#define PG8_SCHED __builtin_amdgcn_sched_barrier(0)
    Unit cur, nxt; int ui = 0;
    if (!S.next(0, cur)) return;
    f32x4 acc[2][2][4][2];
#pragma unroll
    for (int a = 0; a < 2; ++a)
#pragma unroll
        for (int b = 0; b < 2; ++b)
#pragma unroll
            for (int m = 0; m < 4; ++m)
#pragma unroll
                for (int n = 0; n < 2; ++n) acc[a][b][m][n] = (f32x4){0.f, 0.f, 0.f, 0.f};
    v8i_t At[4], B0[2], B1[2]; const int f8one = 0x7f7f7f7f;
    const char* cA = (const char*)g.A + (size_t)cur.pm * tstep; const char* cB = (const char*)g.Bt + (size_t)cur.pn * tstep;
    S.a_ready(cur);
    if constexpr (SP2) {
        PG8_STAGE(PG8_SB(0, 0), cB, voffB); PG8_STAGE(PG8_SB(0, 1), cB + hstep, voffB); PG8_STAGE(PG8_SA(0, 0), cA, voffA); PG8_STAGE(PG8_SA(0, 1), cA + hstep, voffA);
        if (wr == 1) PG8_BAR;
        PG8_WAIT_V(2); PG8_BAR;
        PG8_STAGE(PG8_SB(1, 0), cB + kstep, voffB); PG8_STAGE(PG8_SA(1, 0), cA + kstep, voffA); PG8_STAGE(PG8_SB(1, 1), cB + hstep + kstep, voffB);
        PG8_WAIT_V(6); PG8_BAR;
    } else {
        PG8_STAGE(PG8_SB(0, 0), cB, voffB); PG8_STAGE(PG8_SA(0, 0), cA, voffA); PG8_STAGE(PG8_SB(0, 1), cB + hstep, voffB); PG8_STAGE(PG8_SA(0, 1), cA + hstep, voffA);
        if (wr == 1) PG8_BAR;
        PG8_WAIT_V(4); PG8_BAR;
        PG8_STAGE(PG8_SB(1, 0), cB + kstep, voffB); PG8_STAGE(PG8_SA(1, 0), cA + kstep, voffA); PG8_STAGE(PG8_SB(1, 1), cB + hstep + kstep, voffB);
        PG8_WAIT_V(6); PG8_BAR;
    }
    for (;;) {
        const bool has_next = S.next(ui + 1, nxt);
        const char* nA = has_next ? (const char*)g.A + (size_t)nxt.pm * tstep : cA; const char* nB = has_next ? (const char*)g.Bt + (size_t)nxt.pn * tstep : cB;
        for (int t = 0; t < nt; t += 2) {
            const bool last = (t == nt - 2);
            const char* a1 = cA + (size_t)(t + 1) * kstep;
            const char* a2 = last ? nA : cA + (size_t)(t + 2) * kstep; const char* b2 = last ? nB : cB + (size_t)(t + 2) * kstep;
            const char* a3 = a2 + kstep; const char* b3 = b2 + kstep;
            if (last && has_next) S.a_ready(nxt);
            if constexpr (SP2) {
            PG8_LDB(B0, 0, 0); PG8_LDB(B1, 0, 1); PG8_SCHED; PG8_LDA(At, 0, 0); PG8_STAGE(PG8_SA(1, 1), a1 + hstep, voffA);
            PG8_WAIT_V(8); PG8_WAIT_L(0); PG8_BAR; PG8_MMA(0, 0, At, B0); PG8_MMA(0, 1, At, B1); PG8_BAR; PG8_SCHED;
            PG8_LDA(At, 0, 1); PG8_STAGE(PG8_SB(0, 0), b2, voffB); PG8_STAGE(PG8_SB(0, 1), b2 + hstep, voffB); PG8_STAGE(PG8_SA(0, 0), a2, voffA);
            PG8_WAIT_V(8); PG8_WAIT_L(0); PG8_BAR; PG8_MMA(1, 0, At, B0); PG8_MMA(1, 1, At, B1); PG8_BAR; PG8_SCHED;
            PG8_LDB(B0, 1, 0); PG8_LDB(B1, 1, 1); PG8_SCHED; PG8_LDA(At, 1, 0); PG8_STAGE(PG8_SA(0, 1), a2 + hstep, voffA);
            PG8_WAIT_V(8); PG8_WAIT_L(0); PG8_BAR; PG8_MMA(0, 0, At, B0); PG8_MMA(0, 1, At, B1); PG8_BAR; PG8_SCHED;
            PG8_LDA(At, 1, 1); PG8_STAGE(PG8_SB(1, 0), b3, voffB); PG8_STAGE(PG8_SB(1, 1), b3 + hstep, voffB); PG8_STAGE(PG8_SA(1, 0), a3, voffA);
            PG8_WAIT_V(8); PG8_WAIT_L(0); PG8_BAR; PG8_MMA(1, 0, At, B0); PG8_MMA(1, 1, At, B1); PG8_BAR; PG8_SCHED;
            } else {
            PG8_LDB(B0, 0, 0); PG8_SCHED; PG8_LDA(At, 0, 0); PG8_STAGE(PG8_SA(1, 1), a1 + hstep, voffA);
            PG8_WAIT_L(8); PG8_BAR; PG8_WAIT_L(0); PG8_MMA(0, 0, At, B0); PG8_BAR; PG8_SCHED;
            PG8_LDB(B1, 0, 1); PG8_STAGE(PG8_SB(0, 0), b2, voffB);
            PG8_BAR; PG8_WAIT_L(0); PG8_MMA(0, 1, At, B1); PG8_BAR;
            PG8_LDA(At, 0, 1); PG8_STAGE(PG8_SA(0, 0), a2, voffA);
            PG8_BAR; PG8_WAIT_L(0); PG8_MMA(1, 0, At, B0); PG8_BAR; PG8_SCHED;
            PG8_STAGE(PG8_SB(0, 1), b2 + hstep, voffB);
            PG8_WAIT_V(6); PG8_BAR; PG8_MMA(1, 1, At, B1); PG8_BAR;
            PG8_LDB(B0, 1, 0); PG8_SCHED; PG8_LDA(At, 1, 0); PG8_STAGE(PG8_SA(0, 1), a2 + hstep, voffA);
            PG8_WAIT_L(8); PG8_BAR; PG8_WAIT_L(0); PG8_MMA(0, 0, At, B0); PG8_BAR; PG8_SCHED;
            PG8_LDB(B1, 1, 1); PG8_STAGE(PG8_SB(1, 0), b3, voffB);
            PG8_BAR; PG8_WAIT_L(0); PG8_MMA(0, 1, At, B1); PG8_BAR;
            PG8_LDA(At, 1, 1); PG8_STAGE(PG8_SA(1, 0), a3, voffA);
            PG8_BAR; PG8_WAIT_L(0); PG8_MMA(1, 0, At, B0); PG8_BAR; PG8_SCHED;
            PG8_STAGE(PG8_SB(1, 1), b3 + hstep, voffB);
            PG8_WAIT_V(6); PG8_BAR; PG8_MMA(1, 1, At, B1); PG8_BAR;
            }
        }
        if constexpr (ALIGN_EPI) { if (wr == 0) PG8_BAR; }
        if constexpr (!Epi::AFTER_DRAIN) { E(acc, cur, wr, wc, fr, fq); S.done(cur); }
        if (!has_next) break;
#pragma unroll
        for (int a = 0; a < 2; ++a)
#pragma unroll
            for (int b = 0; b < 2; ++b)
#pragma unroll
                for (int m = 0; m < 4; ++m)
#pragma unroll
                    for (int n = 0; n < 2; ++n) acc[a][b][m][n] = (f32x4){0.f, 0.f, 0.f, 0.f};
        cur = nxt; cA = nA; cB = nB; ++ui;
        if constexpr (ALIGN_EPI) { if (wr == 1) PG8_BAR; }
    }
    PG8_WAIT_V(0);
    if constexpr (!ALIGN_EPI) { if (wr == 0) PG8_BAR; }
    PG8_BAR;
    if constexpr (Epi::AFTER_DRAIN) { E.fused(acc, cur, wr, wc, fr, fq, lds, wid, lane); S.done(cur); }
#undef PG8_SA
#undef PG8_SB
#undef PG8_STAGE
#undef PG8_LDA
#undef PG8_LDB
#undef PG8_MMA
#undef PG8_LD32
#undef PG8_WAIT_V
#undef PG8_WAIT_V8R
#undef PG8_WAIT_L
#undef PG8_BAR
#undef PG8_SCHED
}

}
#ifndef PG8_SP2
#define PG8_SP2 true
#endif
#ifndef PG8_ALIGN
#define PG8_ALIGN true
#endif
constexpr int NWAVES = 8;
constexpr int BATCH = 8, SEQ = 8192, D = 1024, NTOK = BATCH * SEQ;
constexpr int QKV_LD = 2304;
constexpr int QKV_N = 2304, FF = 3584, NEXP = 8, REC_N = 4096;
constexpr float EPS = 1e-6f;
constexpr float F8_HSCALE = 4.0f, F8_WDSCALE = 64.0f;
constexpr float F8_ASCALE = 8.0f, F8_WGSCALE = 32.0f;
constexpr int NPH = 22;
#ifndef MK_N_LAUNCHES
#define MK_N_LAUNCHES 1
#endif
constexpr int N_LAUNCHES = MK_N_LAUNCHES;
constexpr size_t MiB = 1u << 20;
constexpr size_t WS_CTL = 0, CTL_ZERO_BYTES = 1 * MiB;
constexpr size_t WS_WMOE_DN = 1 * MiB;
constexpr size_t WS_WMOE_GU = 29 * MiB;
constexpr size_t WS_H = 85 * MiB;
constexpr size_t WS_W_INATT = 297 * MiB;
constexpr size_t WS_W_OUTATT = WS_W_INATT + (size_t)QKV_N * D * 2;
constexpr size_t WS_W_GU = WS_W_OUTATT + (size_t)D * D * 2;
constexpr size_t WS_W_DN = WS_W_GU + (size_t)2 * FF * D * 2;
constexpr size_t WS_W_INREC = WS_W_DN + (size_t)D * FF * 2;
constexpr size_t WS_W_OUTREC = WS_W_INREC + (size_t)REC_N * D * 2;
constexpr size_t WS_BIG = 335 * MiB;
constexpr size_t WS_Y = 29 * MiB;
constexpr size_t WS_HID = 289 * MiB;
constexpr size_t WS_MISC = 1008 * MiB;
constexpr size_t WS_ROPE = WS_MISC;
constexpr size_t WS_META = WS_MISC + 4 * MiB;
constexpr size_t WS_DEST = WS_MISC + 5 * MiB;
constexpr size_t WS_HIST = WS_MISC + 6 * MiB;
constexpr size_t WS_INFO = WS_HIST + 8192;
constexpr size_t WS_LBK = WS_INFO + 4096;
constexpr size_t WS_OB = 623 * MiB;
constexpr size_t WS_LSE = 751 * MiB;
constexpr size_t WS_DK = WS_MISC + 8 * MiB;
constexpr size_t WS_HL = 848 * MiB;
constexpr size_t WS_HP = 860 * MiB;
constexpr size_t WS_H2 = 880 * MiB;
constexpr size_t WS_RSP = WS_MISC + 12 * MiB;
constexpr size_t CTL_SSQ1 = 128 * 1024, CTL_SSQ2 = 384 * 1024, CTL_SSQ3 = 640 * 1024;
constexpr size_t WS_RS0 = WS_MISC + 13 * MiB;
constexpr size_t WS_P8 = 85 * MiB;
constexpr size_t WS_END = 1024 * MiB;
static_assert(WS_W_OUTREC + (size_t)D * D * 2 <= WS_BIG && WS_BIG + 512 * MiB <= WS_MISC && WS_WMOE_DN + 28 * MiB <= WS_Y && WS_Y + 260 * MiB <= WS_HID && WS_P8 + 130 * MiB <= WS_Y + 260 * MiB && WS_HID + 455 * MiB <= WS_H2 && WS_H + 128 * MiB <= WS_W_INATT && WS_H2 + 128 * MiB <= WS_MISC && WS_BIG + 512 * MiB <= WS_H2 && WS_HL >= WS_BIG + 512 * MiB && WS_LBK + 4096 <= WS_END, "d_ws map");
constexpr int CW_BAR = 4096;
constexpr int RING_BYTES = 131072;
constexpr int LDSCTL_OFF = RING_BYTES, MISC_OFF = LDSCTL_OFF + 320;
constexpr int LDS_BYTES = 147456;

#define GAS __attribute__((address_space(1)))
#define LAS __attribute__((address_space(3)))
typedef unsigned short bf16;
typedef unsigned v4u __attribute__((ext_vector_type(4)));
typedef unsigned v2u __attribute__((ext_vector_type(2)));
typedef float f32x4 __attribute__((ext_vector_type(4)));
#define LDS_WAIT() asm volatile("s_waitcnt lgkmcnt(0)" ::: "memory")
typedef float f32x2_t __attribute__((ext_vector_type(2))); typedef __bf16 bf16x2_t __attribute__((ext_vector_type(2)));
__device__ __forceinline__ unsigned pk2(float lo, float hi) { const f32x2_t v = {lo, hi}; const bf16x2_t b = __builtin_convertvector(v, bf16x2_t); return __builtin_bit_cast(unsigned, b); }
__device__ __forceinline__ float bflo(unsigned w) { return __builtin_bit_cast(float, w << 16); }
__device__ __forceinline__ float bfhi(unsigned w) { return __builtin_bit_cast(float, w & 0xffff0000u); }
__device__ __forceinline__ float wave_sum(float v) {
    v += pg8::dpp0<0xB1>(v); v += pg8::dpp0<0x4E>(v); v += pg8::dpp0<0x124>(v); v += pg8::dpp0<0x128>(v);
    v += __shfl_xor(v, 16); v += __shfl_xor(v, 32);
    return v;
}
#define XB_TMO      128
#define XB_XCNT(j)  (256  + 64 * (j))
#define XB_XSUB(j)  (1280 + 64 * (j))
#define XB_XGEN(j)  (2304 + 64 * (j))
#define XB_TOP      3328
#define XB_TOPGEN   3392
#define XCD_BAR_WORDS 3456
#define XB_SPIN_CAP (1u << 24)

__device__ __forceinline__ unsigned xb_ld(unsigned* p)              { return __hip_atomic_load(p, __ATOMIC_RELAXED, __HIP_MEMORY_SCOPE_AGENT); }
__device__ __forceinline__ unsigned xb_add(unsigned* p, unsigned v) { return __hip_atomic_fetch_add(p, v, __ATOMIC_RELAXED, __HIP_MEMORY_SCOPE_AGENT); }
__device__ __forceinline__ unsigned xb_xcc_id() { return (unsigned)__builtin_amdgcn_s_getreg((3 << 11) | 20) & 0xFu; }
#define XB_SPIN(cond, bar) do { unsigned _sp = 0; while (cond) { __builtin_amdgcn_s_sleep(1); \
    if ((++_sp & 255u) == 0u) { if (xb_ld(&(bar)[XB_TMO])) break; if (_sp > XB_SPIN_CAP) { atomicAdd(&(bar)[XB_TMO], 1u); break; } } } } while (0)

struct XcdBarrier {
    unsigned* bar; unsigned x;
    volatile LAS unsigned* st;
};

__device__ __forceinline__ XcdBarrier xcd_barrier_post(unsigned* bar, volatile LAS unsigned* st) {
    XcdBarrier b; b.bar = bar; b.x = xb_xcc_id(); b.st = st;
    if (threadIdx.x == 0) (void)xb_add(&bar[XB_XCNT(b.x)], 1u);
    return b;
}
__device__ __forceinline__ void xcd_barrier_complete(unsigned* bar, unsigned x, unsigned& nloc, unsigned& nx) {
    const unsigned G = gridDim.x * gridDim.y * gridDim.z;
    unsigned sum, cnt, mine, sp = 0u;
    for (;;) {
        sum = 0u; cnt = 0u; mine = 0u;
#pragma unroll
        for (unsigned j = 0; j < 16; ++j) { const unsigned c = xb_ld(&bar[XB_XCNT(j)]); sum += c; cnt += (c > 0u) ? 1u : 0u; mine = (j == x) ? c : mine; }
        if (sum == G) break;
        __builtin_amdgcn_s_sleep(1);
        if ((++sp & 255u) == 0u) { if (xb_ld(&bar[XB_TMO])) break; if (sp > XB_SPIN_CAP) { atomicAdd(&bar[XB_TMO], 1u); break; } }
    }
    nloc = mine > 0u ? mine : 1u; nx = cnt > 0u ? cnt : 1u;
}

__device__ __forceinline__ void xcd_barrier(const XcdBarrier& b) {
    asm volatile("s_waitcnt vmcnt(0)" ::: "memory");
    __syncthreads();
    if (threadIdx.x == 0) {
        unsigned* bar = b.bar;
        __builtin_amdgcn_s_waitcnt(0);
        unsigned nloc = b.st[0], nx = b.st[1];
        if (nloc == 0u) { xcd_barrier_complete(bar, b.x, nloc, nx); b.st[0] = nloc; b.st[1] = nx; }
        const unsigned old = xb_add(&bar[XB_XSUB(b.x)], 1u);
        const unsigned gen = old / nloc;
        if (old + 1u == (gen + 1u) * nloc) {
            __builtin_amdgcn_fence(__ATOMIC_RELEASE, "agent");
            asm volatile("s_waitcnt vmcnt(0)" ::: "memory");
            const unsigned og = xb_add(&bar[XB_TOP], 1u);
            const unsigned tg = og / nx;
            if (og + 1u == (tg + 1u) * nx) xb_add(&bar[XB_TOPGEN], 1u);
            else XB_SPIN(xb_ld(&bar[XB_TOPGEN]) == tg, bar);
            __builtin_amdgcn_fence(__ATOMIC_ACQUIRE, "agent");
            xb_add(&bar[XB_XGEN(b.x)], 1u);
            asm volatile("s_waitcnt vmcnt(0)" ::: "memory");
        } else {
            XB_SPIN(xb_ld(&bar[XB_XGEN(b.x)]) == gen, bar);
            __builtin_amdgcn_fence(__ATOMIC_ACQUIRE, "agent");
            asm volatile("s_waitcnt vmcnt(0)" ::: "memory");
        }
    }
    __syncthreads();
}
struct ConvItem { const float* W; bf16* WT; const float* gk; int N, K, k0, n0, drow0; float f8scale; };
__device__ __forceinline__ void conv_load(const ConvItem& c, f32x4 (&t)[8], int lane) {
    const int rr = lane >> 3, cq = (lane & 7) * 4;
#pragma unroll
    for (int i = 0; i < 8; ++i) t[i] = *(const f32x4*)(c.W + (size_t)(c.k0 + rr + 8 * i) * c.N + c.n0 + cq);
}
__device__ __forceinline__ void conv_store(const ConvItem& c, const f32x4 (&t)[8], LAS float* scr, int lane) {
    { const int rr = lane >> 3, cq = (lane & 7) * 4;
#pragma unroll
      for (int i = 0; i < 8; ++i) { LAS float* d = scr + (rr + 8 * i) * 33 + cq; d[0] = t[i].x; d[1] = t[i].y; d[2] = t[i].z; d[3] = t[i].w; } }
    LDS_WAIT(); asm volatile("" ::: "memory");
    const int cc = lane & 7;
    f32x4 g0 = (f32x4){1.f, 1.f, 1.f, 1.f}, g1 = g0;
    if (c.gk) { g0 = *(const f32x4*)(c.gk + c.k0 + 8 * cc); g1 = *(const f32x4*)(c.gk + c.k0 + 8 * cc + 4); }
#pragma unroll
    for (int j = 0; j < 4; ++j) { const int n = (lane >> 3) + 8 * j; const LAS float* s = scr + (8 * cc) * 33 + n;
        if (c.f8scale != 0.f) { const float q = c.f8scale; v2u o8; o8.x = pg8::pk4_fp8(s[0 * 33] * g0.x * q, s[1 * 33] * g0.y * q, s[2 * 33] * g0.z * q, s[3 * 33] * g0.w * q); o8.y = pg8::pk4_fp8(s[4 * 33] * g1.x * q, s[5 * 33] * g1.y * q, s[6 * 33] * g1.z * q, s[7 * 33] * g1.w * q);
            *(v2u*)((unsigned char*)c.WT + (size_t)(c.drow0 + n) * c.K + c.k0 + 8 * cc) = o8; }
        else { v4u o; o.x = pk2(s[0 * 33] * g0.x, s[1 * 33] * g0.y); o.y = pk2(s[2 * 33] * g0.z, s[3 * 33] * g0.w); o.z = pk2(s[4 * 33] * g1.x, s[5 * 33] * g1.y); o.w = pk2(s[6 * 33] * g1.z, s[7 * 33] * g1.w);
            *(v4u*)(c.WT + (size_t)(c.drow0 + n) * c.K + c.k0 + 8 * cc) = o; } }
    LDS_WAIT(); asm volatile("" ::: "memory");
}
__device__ __forceinline__ int dest_row(int mode, int n0) {
    if (mode == 0) return n0;
    if (mode == 1) return 256 * (n0 >> 7) + (n0 & 127);
    if (mode == 2) return 256 * (n0 >> 7) + 128 + (n0 & 127);
    const int sec = n0 >> 10, c = n0 & 1023, hd = c >> 7, w = c & 127;
    return ((sec >> 1) ? 2048 : 0) + 256 * hd + ((sec & 1) ? 128 : 0) + w;
}
__device__ __forceinline__ void conv_desc(ConvItem& c, const float* W, int K, int N, bf16* WT, int mode, int r, const float* gk, float f8scale = 0.f) {
    const int nblk = N / 32, kb = r / nblk, nb = r % nblk;
    c.f8scale = f8scale; c.W = W; c.WT = WT; c.gk = gk; c.N = N; c.K = K; c.k0 = 64 * kb; c.n0 = 32 * nb; c.drow0 = dest_row(mode, 32 * nb);
}
__device__ __forceinline__ float inv_freq(int j) {
    return j == 0 ? 1.000000000e+00f : j == 1 ? 1.939227432e-01f : j == 2 ? 3.760603070e-02f : j == 3 ? 7.292664610e-03f : j == 4 ? 1.414213562e-03f : j == 5 ? 2.742481884e-04f : j == 6 ? 5.318295734e-05f : 1.031338525e-05f;
}
struct P0Args { const float *g_ffn0, *g_mix1, *g_ffn1; const float *x, *g0, *w_in_attn, *w_out_attn, *w_in_rec, *w_out_rec, *w_gate, *w_up, *w_down, *w_gate_moe, *w_up_moe, *w_down_moe, *rlb; const int* pos; unsigned char* ws; };
__device__ __forceinline__ void phase_prologue(const P0Args& a, LAS unsigned char* lds, int blk, int G, int tid) {
    const int wave = tid >> 6, lane = tid & 63;
    LAS float* scr = (LAS float*)(lds + wave * 16384);
    const int gw = blk * NWAVES + wave, NGW = G * NWAVES;
    unsigned char* ws = a.ws;
    constexpr int I_INATT = 16 * (QKV_N / 32), I_SQ = 16 * 32, I_GU = 16 * (FF / 32), I_DN = (FF / 64) * 32, I_INREC = 16 * (REC_N / 32);
    constexpr int NITEMS = I_INATT + I_SQ + 2 * I_GU + I_DN + I_INREC + I_SQ + NEXP * (2 * I_GU + I_DN);
    auto decode = [&](int it, ConvItem& c) {
        int r = it;
        if (r < I_INATT) { conv_desc(c, a.w_in_attn, D, QKV_N, (bf16*)(ws + WS_W_INATT), 0, r, a.g0); return; } r -= I_INATT;
        if (r < I_SQ) { conv_desc(c, a.w_out_attn, D, D, (bf16*)(ws + WS_W_OUTATT), 0, r, nullptr); return; } r -= I_SQ;
        if (r < I_GU) { conv_desc(c, a.w_gate, D, FF, (bf16*)(ws + WS_W_GU), 1, r, a.g_ffn0); return; } r -= I_GU;
        if (r < I_GU) { conv_desc(c, a.w_up, D, FF, (bf16*)(ws + WS_W_GU), 2, r, a.g_ffn0); return; } r -= I_GU;
        if (r < I_DN) { conv_desc(c, a.w_down, FF, D, (bf16*)(ws + WS_W_DN), 0, r, nullptr); return; } r -= I_DN;
        if (r < I_INREC) { conv_desc(c, a.w_in_rec, D, REC_N, (bf16*)(ws + WS_W_INREC), 3, r, a.g_mix1); return; } r -= I_INREC;
        if (r < I_SQ) { conv_desc(c, a.w_out_rec, D, D, (bf16*)(ws + WS_W_OUTREC), 0, r, nullptr); return; } r -= I_SQ;
        if (r < NEXP * I_GU) { const int e = r / I_GU, q = r % I_GU; conv_desc(c, a.w_gate_moe + (size_t)e * D * FF, D, FF, (bf16*)(ws + WS_WMOE_GU + (size_t)e * 2 * FF * D), 1, q, a.g_ffn1, F8_WGSCALE); return; } r -= NEXP * I_GU;
        if (r < NEXP * I_GU) { const int e = r / I_GU, q = r % I_GU; conv_desc(c, a.w_up_moe + (size_t)e * D * FF, D, FF, (bf16*)(ws + WS_WMOE_GU + (size_t)e * 2 * FF * D), 2, q, a.g_ffn1, F8_WGSCALE); return; } r -= NEXP * I_GU;
        { const int e = r / I_DN, q = r % I_DN; conv_desc(c, a.w_down_moe + (size_t)e * FF * D, FF, D, (bf16*)(ws + WS_WMOE_DN + (size_t)e * D * FF), 0, q, nullptr, F8_WDSCALE); }
    };
    {
        ConvItem cur, nxt; f32x4 tc[8], tn[8];
        int it = gw; bool have = it < NITEMS;
        if (have) { decode(it, cur); conv_load(cur, tc, lane); }
        while (have) { const int itn = it + NGW; const bool hn = itn < NITEMS;
            if (hn) { decode(itn, nxt); conv_load(nxt, tn, lane); }
            conv_store(cur, tc, scr, lane);
            cur = nxt;
#pragma unroll
            for (int i = 0; i < 8; ++i) tc[i] = tn[i];
            it = itn; have = hn; }
    }
    { bf16* xb = (bf16*)(ws + WS_H2); float* rs0 = (float*)(ws + WS_RS0);
      for (int m0 = gw; m0 < NTOK; m0 += 2 * NGW) { f32x4 v[2][4];
#pragma unroll
          for (int t = 0; t < 2; ++t) { const int m = (m0 + t * NGW < NTOK) ? m0 + t * NGW : m0; const f32x4* xr = (const f32x4*)(a.x + (size_t)m * D) + lane;
#pragma unroll
              for (int j = 0; j < 4; ++j) v[t][j] = xr[64 * j]; }
#pragma unroll
          for (int t = 0; t < 2; ++t) { const int m = m0 + t * NGW; if (m >= NTOK) break; float s = 0.f;
#pragma unroll
              for (int j = 0; j < 4; ++j) s += (v[t][j].x * v[t][j].x + v[t][j].y * v[t][j].y) + (v[t][j].z * v[t][j].z + v[t][j].w * v[t][j].w);
              s = wave_sum(s); if (lane == 0) rs0[m] = 1.0f / sqrtf(s * (1.f / D) + EPS);
              unsigned long long* o8 = (unsigned long long*)(xb + (size_t)m * D) + lane;
#pragma unroll
              for (int j = 0; j < 4; ++j) o8[64 * j] = (unsigned long long)pk2(v[t][j].x, v[t][j].y) | ((unsigned long long)pk2(v[t][j].z, v[t][j].w) << 32); } } }
    float* rope = (float*)(ws + WS_ROPE);
    for (int i = blk * 512 + tid; i < NTOK * 8; i += G * 512) { const int tok = i >> 3, j = i & 7;
        const float ang = (float)a.pos[tok] * inv_freq(j);
        const double turns = (double)ang * 0.15915494309189533577; const float fr = (float)(turns - __builtin_rint(turns));
        rope[tok * 16 + j] = __builtin_amdgcn_cosf(fr); rope[tok * 16 + 8 + j] = __builtin_amdgcn_sinf(fr); }
    float* lbk = (float*)(ws + WS_LBK);
    for (int i = blk * 512 + tid; i < 1024; i += G * 512) lbk[i] = 1.0f / (1.0f + __expf(a.rlb[1024 + i] - a.rlb[i]));
}
typedef float f32x16 __attribute__((ext_vector_type(16)));
typedef short bf16x8v __attribute__((ext_vector_type(8)));
typedef short s16x4 __attribute__((ext_vector_type(4)));
typedef short v4i16_t __attribute__((ext_vector_type(4)));
__device__ __forceinline__ int crow(int r, int hi) { return (r & 3) + 8 * (r >> 2) + 4 * hi; }
__device__ __forceinline__ s16x4 vtr(const LAS unsigned char* p) { return __builtin_bit_cast(s16x4, __builtin_amdgcn_ds_read_tr16_b64_v4i16((LAS v4i16_t*)p)); }
struct AttnSub { int b, dstride, r, P0, qcol, kcol, vcol, mode, hx, chain, par; };
struct AttnRegs { v4u k[8], v[8]; };
__device__ __forceinline__ void attn_load(const AttnSub& su, const bf16* qkv, AttnRegs& R, int t256, int hw, int lane) {
    const size_t rowb = (size_t)su.b * SEQ;
    const int c = t256 & 7, k0 = t256 >> 3;
#pragma unroll
    for (int i = 0; i < 8; ++i) { const int key = k0 + 32 * i, pos = su.P0 - 128 + key;
        if (pos >= 0 && (i >= 4 || !su.chain)) { const bf16* rp = qkv + (rowb + su.r + (size_t)su.dstride * pos) * QKV_LD; R.k[i] = *(const v4u*)(rp + su.kcol + 8 * c); R.v[i] = *(const v4u*)(rp + su.vcol + 8 * c); }
        else { R.k[i] = (v4u){0u, 0u, 0u, 0u}; R.v[i] = R.k[i]; } }
}
__device__ __forceinline__ void attn_load_q(const AttnSub& su, const bf16* qkv, bf16x8v (&q)[4], int hw, int lane) {
    const int r32 = lane & 31, hi = lane >> 5;
    const size_t qrow = (size_t)su.b * SEQ + su.r + (size_t)su.dstride * (su.P0 + 32 * hw + r32);
#pragma unroll
    for (int ks = 0; ks < 4; ++ks) q[ks] = *(const bf16x8v*)(qkv + qrow * QKV_LD + su.qcol + 16 * ks + 8 * hi);
}
__device__ __forceinline__ void attn_stage(const AttnSub& su, const AttnRegs& R, LAS unsigned char* lh, int t256) {
    const int c = t256 & 7, k0 = t256 >> 3;
#pragma unroll
    for (int i = 0; i < 8; ++i) { if (i < 4 && su.chain) continue;
        const int prow = ((((i >> 2) ^ su.par ^ 1) & 1) << 7) + k0 + 32 * (i & 3);
        *(LAS v4u*)(lh + prow * 128 + ((c ^ (prow & 7)) * 16)) = R.k[i];
        *(LAS v4u*)(lh + 32768 + (c >> 2) * 16384 + prow * 64 + (c & 3) * 16) = R.v[i]; }
}
struct AttnMerge { float l1, l2; v2u o1[8], o2[8]; };
__device__ __forceinline__ void attn_load_merge(const AttnSub& su, const bf16* OB, const float* LSE, AttnMerge& M, int hw, int lane) {
    const int r32 = lane & 31, hi = lane >> 5;
    const size_t qrow = (size_t)su.b * SEQ + su.r + (size_t)su.dstride * (su.P0 + 32 * hw + r32);
    M.l1 = 0.f; M.l2 = 0.f;
    if (su.mode == 2) { M.l1 = LSE[qrow * 8 + su.hx]; M.l2 = LSE[(size_t)NTOK * 8 + qrow * 8 + su.hx];
        const bf16* p1 = OB + qrow * 512 + su.hx * 64 + 4 * hi; const bf16* p2 = p1 + (size_t)NTOK * 512;
#pragma unroll
        for (int i = 0; i < 8; ++i) { M.o1[i] = *(const v2u*)(p1 + 32 * (i >> 2) + 8 * (i & 3)); M.o2[i] = *(const v2u*)(p2 + 32 * (i >> 2) + 8 * (i & 3)); } }
}
__device__ __forceinline__ void attn_compute(const AttnSub su, bf16x8v (&qf)[4], const AttnMerge& M, const bool hn, const AttnSub& nxt, const bf16* qkv, const float* sinks, bf16* mix, bf16* OB, float* LSE, LAS unsigned char* lh, int hw, int lane) {
    const int r32 = lane & 31, hi = lane >> 5;
    const size_t qrow = (size_t)su.b * SEQ + su.r + (size_t)su.dstride * (su.P0 + 32 * hw + r32);
    f32x16 oT[2]; oT[0] = (f32x16){}; oT[1] = (f32x16){};
    float m = -1e30f, l = 0.f;
    const float C = 0.125f * 1.4426950408889634f;
    const int mlo = (su.mode == 3) ? 1 : 0;
    int kt = hw; if (su.P0 == 0 && kt < 4) kt = 4;
    bf16x8v kf4[4]; const int sw = r32 & 7;
    { const int pk0 = ((((kt >> 2) ^ su.par ^ 1) & 1) << 2) + (kt & 3); const LAS unsigned char* kb0 = lh + (32 * pk0 + r32) * 128;
#pragma unroll
      for (int ks = 0; ks < 4; ++ks) kf4[ks] = *(const LAS bf16x8v*)(kb0 + (((2 * ks + hi) ^ sw) * 16)); }
    for (; kt <= hw + 4; ++kt) {
        f32x16 s = (f32x16){};
        const int pkt = ((((kt >> 2) ^ su.par ^ 1) & 1) << 2) + (kt & 3);
#pragma unroll
        for (int ks = 0; ks < 4; ++ks) s = __builtin_amdgcn_mfma_f32_32x32x16_bf16(kf4[ks], qf[ks], s, 0, 0, 0);
        if (kt < hw + 4) { const int pk1 = (((((kt + 1) >> 2) ^ su.par ^ 1) & 1) << 2) + ((kt + 1) & 3); const LAS unsigned char* kb1 = lh + (32 * pk1 + r32) * 128;
#pragma unroll
            for (int ks = 0; ks < 4; ++ks) kf4[ks] = *(const LAS bf16x8v*)(kb1 + (((2 * ks + hi) ^ sw) * 16)); }
        __builtin_amdgcn_sched_barrier(0);
        if (kt == hw) {
#pragma unroll
            for (int r = 0; r < 16; ++r) if (crow(r, hi) < r32 + mlo) s[r] = -INFINITY; }
        if (kt == hw + 4) {
#pragma unroll
            for (int r = 0; r < 16; ++r) if (crow(r, hi) > r32) s[r] = -INFINITY; }
        float mx = s[0];
#pragma unroll
        for (int r = 1; r < 16; ++r) mx = fmaxf(mx, s[r]);
        mx = fmaxf(mx, __shfl_xor(mx, 32));
        const float mn = fmaxf(m, mx), nmc = -mn * C;
        float ls = 0.f; f32x16 p;
#pragma unroll
        for (int r = 0; r < 16; ++r) { p[r] = __builtin_amdgcn_exp2f(__builtin_fmaf(s[r], C, nmc)); ls += p[r]; }
        if (__any(mn > m)) {
            const float alpha = __builtin_amdgcn_exp2f((m - mn) * C); l *= alpha;
#pragma unroll
            for (int r = 0; r < 16; ++r) { oT[0][r] *= alpha; oT[1][r] *= alpha; } }
        l += ls; m = mn;
        v4u pw0, pw1;
        pw0.x = pk2(p[0], p[1]); pw0.y = pk2(p[2], p[3]); pw0.z = pk2(p[4], p[5]); pw0.w = pk2(p[6], p[7]);
        pw1.x = pk2(p[8], p[9]); pw1.y = pk2(p[10], p[11]); pw1.z = pk2(p[12], p[13]); pw1.w = pk2(p[14], p[15]);
        const bf16x8v pa0 = __builtin_bit_cast(bf16x8v, pw0), pa1 = __builtin_bit_cast(bf16x8v, pw1);
        const LAS unsigned char* vb = lh + 32768 + (32 * pkt + 4 * hi + ((lane & 15) >> 2)) * 64 + ((lane >> 4) & 1) * 32 + (lane & 3) * 8;
#pragma unroll
        for (int dt = 0; dt < 2; ++dt) {
            const s16x4 a0 = vtr(vb + dt * 16384), a1 = vtr(vb + dt * 16384 + 512), b0 = vtr(vb + dt * 16384 + 1024), b1 = vtr(vb + dt * 16384 + 1536);
            const bf16x8v vf0 = (bf16x8v){a0[0], a0[1], a0[2], a0[3], a1[0], a1[1], a1[2], a1[3]}, vf1 = (bf16x8v){b0[0], b0[1], b0[2], b0[3], b1[0], b1[1], b1[2], b1[3]};
            oT[dt] = __builtin_amdgcn_mfma_f32_32x32x16_bf16(vf0, pa0, oT[dt], 0, 0, 0);
            oT[dt] = __builtin_amdgcn_mfma_f32_32x32x16_bf16(vf1, pa1, oT[dt], 0, 0, 0);
        }
    }
    if (hn) attn_load_q(nxt, qkv, qf, hw, lane);
    float lt = l + __shfl_xor(l, 32);
    if (su.mode == 3) { const float sraw = 8.0f * sinks[su.hx]; const float mn = fmaxf(m, sraw), alpha = __builtin_amdgcn_exp2f((m - mn) * C);
        lt = lt * alpha + __builtin_amdgcn_exp2f((sraw - mn) * C); m = mn;
#pragma unroll
        for (int r = 0; r < 16; ++r) { oT[0][r] *= alpha; oT[1][r] *= alpha; } }
    const float inv = 1.0f / lt;
    if (su.mode < 2) {
        bf16* ob = OB + (size_t)su.mode * NTOK * 512 + qrow * 512 + su.hx * 64;
#pragma unroll
        for (int dt = 0; dt < 2; ++dt)
#pragma unroll
            for (int g = 0; g < 4; ++g) { v2u w; w.x = pk2(oT[dt][4 * g] * inv, oT[dt][4 * g + 1] * inv); w.y = pk2(oT[dt][4 * g + 2] * inv, oT[dt][4 * g + 3] * inv); *(v2u*)(ob + 32 * dt + 8 * g + 4 * hi) = w; }
        if (hi == 0) LSE[(size_t)su.mode * NTOK * 8 + qrow * 8 + su.hx] = 0.125f * m + __logf(lt);
    } else if (su.mode == 2) {
        const float l3 = 0.125f * m + __logf(lt);
        const float MX = fmaxf(l3, fmaxf(M.l1, M.l2)); float w1 = __expf(M.l1 - MX), w2 = __expf(M.l2 - MX), w3 = __expf(l3 - MX);
        const float ws = 1.0f / (w1 + w2 + w3); w1 *= ws; w2 *= ws; w3 *= ws * inv;
        bf16* mp = mix + qrow * D + su.hx * 64;
#pragma unroll
        for (int dt = 0; dt < 2; ++dt)
#pragma unroll
            for (int g = 0; g < 4; ++g) { const int dd = 32 * dt + 8 * g + 4 * hi; const v2u a = M.o1[4 * dt + g], b = M.o2[4 * dt + g];
                v2u w; w.x = pk2(w1 * bflo(a.x) + w2 * bflo(b.x) + w3 * oT[dt][4 * g], w1 * bfhi(a.x) + w2 * bfhi(b.x) + w3 * oT[dt][4 * g + 1]);
                w.y = pk2(w1 * bflo(a.y) + w2 * bflo(b.y) + w3 * oT[dt][4 * g + 2], w1 * bfhi(a.y) + w2 * bfhi(b.y) + w3 * oT[dt][4 * g + 3]); *(v2u*)(mp + dd) = w; }
    } else {
        bf16* mp = mix + qrow * D + 512 + su.hx * 64;
#pragma unroll
        for (int dt = 0; dt < 2; ++dt)
#pragma unroll
            for (int g = 0; g < 4; ++g) { v2u w; w.x = pk2(oT[dt][4 * g] * inv, oT[dt][4 * g + 1] * inv); w.y = pk2(oT[dt][4 * g + 2] * inv, oT[dt][4 * g + 3] * inv); *(v2u*)(mp + 32 * dt + 8 * g + 4 * hi) = w; }
    }
}
__device__ __forceinline__ bool attn_decode(int j, int blk, int G, int hf, int prev_par, AttnSub& s) {
    const int nA = (256 - blk + G - 1) / G;
    if (j < 24 * nA) { const int ai = blk + G * (j / 24), jj = j % 24, br = jj >> 3, i = jj & 7;
        const int b = ai >> 5, h = (ai >> 2) & 7, T0 = (ai & 3) * 2048;
        s.b = b; s.hx = h; s.qcol = h * 64; s.kcol = 512 + h * 64; s.vcol = 1024 + h * 64; s.mode = br;
        if (br == 0) { s.dstride = 1; s.r = 0; s.P0 = T0 + 128 * (8 * hf + i); s.chain = (i > 0); }
        else if (br == 1) { s.dstride = 4; s.r = 2 * hf + (i >> 2); s.P0 = (T0 >> 2) + 128 * (i & 3); s.chain = ((i & 3) > 0); }
        else { s.dstride = 16; s.r = 8 * hf + i; s.P0 = T0 >> 4; s.chain = 0; }
        s.par = s.chain ? (prev_par ^ 1) : 0;
        return true; }
    const int jb = j - 24 * nA, bp = blk + G * (jb >> 3), i = jb & 7; if (bp >= 256) return false;
    const int c = 2 * bp + hf, b = c >> 6, qh = (c >> 3) & 7, kv = qh >> 2;
    s.b = b; s.hx = qh; s.qcol = 1536 + qh * 64; s.kcol = 2048 + kv * 64; s.vcol = 2176 + kv * 64; s.mode = 3; s.dstride = 1; s.r = 0; s.P0 = 128 * (8 * (c & 7) + i);
    s.chain = (i > 0); s.par = s.chain ? (prev_par ^ 1) : 0;
    return true;
}
__device__ __forceinline__ void phase_attn(const bf16* qkv, const float* sinks, bf16* mix, bf16* OB, float* LSE, LAS unsigned char* lds, int blk, int G, int tid) {
    const int wave = tid >> 6, lane = tid & 63, hf = wave >> 2, hw = wave & 3, t256 = tid & 255;
    LAS unsigned char* lh = lds + hf * 65536;
    AttnSub cur, nxt; AttnRegs R; bf16x8v qf[4];
    bool have = attn_decode(0, blk, G, hf, 0, cur);
    if (have) { attn_load(cur, qkv, R, t256, hw, lane); attn_load_q(cur, qkv, qf, hw, lane); }
    for (int j = 0; have; ++j) {
        attn_stage(cur, R, lh, t256);
        __syncthreads();
        asm volatile("" :: "v"(qf[0]), "v"(qf[1]), "v"(qf[2]), "v"(qf[3]));
        AttnMerge M; attn_load_merge(cur, OB, LSE, M, hw, lane);
        const bool hn = attn_decode(j + 1, blk, G, hf, cur.par, nxt);
        if (hn) attn_load(nxt, qkv, R, t256, hw, lane);
        attn_compute(cur, qf, M, hn, nxt, qkv, sinks, mix, OB, LSE, lh, hw, lane);
        if (cur.mode == 1 && hn && nxt.mode == 2) asm volatile("s_waitcnt vmcnt(0)" ::: "memory");
        __syncthreads();
        cur = nxt; have = hn;
    }
}
__device__ __forceinline__ void phase_router(const bf16* x, const float* g, const float* w_router, const unsigned* ssq, int4* meta, int* hist, LAS unsigned char* lds, int blk, int G, int tid) {
    const int wave = tid >> 6, lane = tid & 63;
    LAS int* scnt = (LAS int*)lds;
    f32x4 wr[16][2];
#pragma unroll
    for (int c = 0; c < 16; ++c) { const int d = (c < 8 ? 0 : 512 - 8) + 8 * lane + c; const float gd = g[d];
        wr[c][0] = *(const f32x4*)(w_router + d * 8) * gd; wr[c][1] = *(const f32x4*)(w_router + d * 8 + 4) * gd; }
    for (int tb = blk; tb < 256; tb += G) {
        if (tid < 8) scnt[tid] = 0;
        __syncthreads();
        int c0 = 0, c1 = 0, c2 = 0, c3 = 0, c4 = 0, c5 = 0, c6 = 0, c7 = 0;
        v4u xa[2], xb[2]; unsigned sq2[2];
#pragma unroll
        for (int t2 = 0; t2 < 2; ++t2) { const int tok = tb * 256 + wave * 32 + t2; const v4u* xr = (const v4u*)(x + (size_t)tok * D) + lane; xa[t2] = xr[0]; xb[t2] = xr[64]; sq2[t2] = ssq[tok]; }
        for (int i = 0; i < 32; i += 2) {
            float lg[2][8]; v4u na[2], nb[2]; unsigned nsq[2];
#pragma unroll
            for (int t2 = 0; t2 < 2; ++t2) { const int tok = tb * 256 + wave * 32 + ((i + 2) & 31) + t2; const v4u* xr = (const v4u*)(x + (size_t)tok * D) + lane; na[t2] = xr[0]; nb[t2] = xr[64]; nsq[t2] = ssq[tok]; }
#pragma unroll
            for (int t2 = 0; t2 < 2; ++t2) {
                const float hv[16] = {bflo(xa[t2].x), bfhi(xa[t2].x), bflo(xa[t2].y), bfhi(xa[t2].y), bflo(xa[t2].z), bfhi(xa[t2].z), bflo(xa[t2].w), bfhi(xa[t2].w), bflo(xb[t2].x), bfhi(xb[t2].x), bflo(xb[t2].y), bfhi(xb[t2].y), bflo(xb[t2].z), bfhi(xb[t2].z), bflo(xb[t2].w), bfhi(xb[t2].w)};
                f32x4 a0 = (f32x4){0.f, 0.f, 0.f, 0.f}, a1 = a0;
#pragma unroll
                for (int c = 0; c < 16; ++c) { a0 += wr[c][0] * hv[c]; a1 += wr[c][1] * hv[c]; }
                lg[t2][0] = a0.x; lg[t2][1] = a0.y; lg[t2][2] = a0.z; lg[t2][3] = a0.w; lg[t2][4] = a1.x; lg[t2][5] = a1.y; lg[t2][6] = a1.z; lg[t2][7] = a1.w; }
            float wfold;
            { const bool b0 = lane & 1, b1 = lane & 2, b2 = lane & 4, b3 = lane & 8;
              float w[8], w2[4], w3[2];
#pragma unroll
              for (int q = 0; q < 8; ++q) { const float mine = b0 ? lg[1][q] : lg[0][q], send = b0 ? lg[0][q] : lg[1][q]; w[q] = mine + pg8::dpp0<0xB1>(send); }
#pragma unroll
              for (int q = 0; q < 4; ++q) { const float mine = b1 ? w[4 + q] : w[q], send = b1 ? w[q] : w[4 + q]; w2[q] = mine + pg8::dpp0<0x4E>(send); }
#pragma unroll
              for (int q = 0; q < 2; ++q) { const float mine = b3 ? w2[2 + q] : w2[q], send = b3 ? w2[q] : w2[2 + q]; w3[q] = mine + pg8::dpp0<0x128>(send); }
              { const float mine = b2 ? w3[1] : w3[0], send = b2 ? w3[0] : w3[1]; const float r4 = pg8::dpp0<0x124>(send), r12 = pg8::dpp0<0x12C>(send); wfold = mine + (b2 ? r4 : r12); }
              wfold += __shfl_xor(wfold, 16); wfold += __shfl_xor(wfold, 32); }
#pragma unroll
            for (int t2 = 0; t2 < 2; ++t2) { const int tok = tb * 256 + wave * 32 + i + t2;
                const float rstd = 1.0f / sqrtf((float)sq2[t2] * (1.f / (1024.f * 65536.f)) + EPS);
#pragma unroll
                for (int e = 0; e < 8; ++e) lg[t2][e] = __builtin_bit_cast(float, __builtin_amdgcn_readlane(__builtin_bit_cast(int, wfold), t2 | (((e >> 2) & 1) << 1) | ((e & 1) << 2) | (((e >> 1) & 1) << 3))) * rstd;
                int e0 = 0; float v0 = lg[t2][0];
#pragma unroll
                for (int e = 1; e < 8; ++e) if (lg[t2][e] > v0) { v0 = lg[t2][e]; e0 = e; }
                int e1 = -1; float v1 = -INFINITY;
#pragma unroll
                for (int e = 0; e < 8; ++e) if (e != e0 && lg[t2][e] > v1) { v1 = lg[t2][e]; e1 = e; }
                const float g1 = 1.0f / (1.0f + __expf(v0 - v1)), g0 = 1.0f - g1;
                if (lane == 0) meta[tok] = make_int4(e0, e1, __builtin_bit_cast(int, g0), __builtin_bit_cast(int, g1));
                c0 += (e0 == 0) + (e1 == 0); c1 += (e0 == 1) + (e1 == 1); c2 += (e0 == 2) + (e1 == 2); c3 += (e0 == 3) + (e1 == 3);
                c4 += (e0 == 4) + (e1 == 4); c5 += (e0 == 5) + (e1 == 5); c6 += (e0 == 6) + (e1 == 6); c7 += (e0 == 7) + (e1 == 7); }
#pragma unroll
            for (int t2 = 0; t2 < 2; ++t2) { xa[t2] = na[t2]; xb[t2] = nb[t2]; sq2[t2] = nsq[t2]; }
        }
        if (lane == 0) { const int cc[8] = {c0, c1, c2, c3, c4, c5, c6, c7};
#pragma unroll
            for (int e = 0; e < 8; ++e) __hip_atomic_fetch_add(&scnt[e], cc[e], __ATOMIC_RELAXED, __HIP_MEMORY_SCOPE_WORKGROUP); }
        __syncthreads();
        if (tid < 8) hist[tb * 8 + tid] = scnt[tid];
        __syncthreads();
    }
}
__device__ __forceinline__ void phase_scatter(const bf16* hb, const unsigned* ssq, const int4* meta, const int* hist, int* dest, int* info, unsigned char* perm8, LAS unsigned char* lds, int blk, int G, int tid) {
    const int wave = tid >> 6, lane = tid & 63;
    LAS int* shist = (LAS int*)lds;
    LAS int* ssize = shist + 2048; LAS int* sbpre = ssize + 8; LAS int* spst = sbpre + 8; LAS int* sntl = spst + 8;
    LAS int* se = sntl + 8; LAS int* sdest = se + 512;
    for (int tb = blk; tb < 256; tb += G) {
        for (int i = tid; i < 2048; i += 512) shist[i] = hist[i];
        __syncthreads();
        { const int e = wave; int sz = 0, bp = 0;
#pragma unroll
          for (int j = 0; j < 4; ++j) { const int b = lane + 64 * j; const int hv = shist[b * 8 + e]; sz += hv; bp += (b < tb) ? hv : 0; }
#pragma unroll
          for (int o = 32; o > 0; o >>= 1) { sz += __shfl_xor(sz, o); bp += __shfl_xor(bp, o); }
          if (lane == 0) { ssize[e] = sz; sbpre[e] = bp; } }
        __syncthreads();
        if (tid == 0) { int ts = 0; for (int e = 0; e < 8; ++e) { const int nt = (ssize[e] + 255) >> 8; spst[e] = ts * 256; sntl[e] = nt; if (tb == 0) for (int q = 0; q < nt; ++q) info[16 + ts + q] = e; ts += nt; if (tb == 0) info[e] = ts; } if (tb == 0) info[8] = ts; }
        int my_e, rank_w;
        { const int4 mt = meta[tb * 256 + (tid >> 1)]; my_e = (tid & 1) ? mt.y : mt.x;
          unsigned long long mine = 0ull;
#pragma unroll
          for (int k = 0; k < 8; ++k) { const unsigned long long bk = __ballot(my_e == k); if (my_e == k) mine = bk; if (lane == k) se[wave * 8 + k] = __popcll(bk); }
          rank_w = __popcll(mine & ((1ull << lane) - 1ull)); }
        __syncthreads();
        { const int e = my_e; int pre = 0; for (int w = 0; w < wave; ++w) pre += se[w * 8 + e];
          const int dd = spst[e] + sbpre[e] + pre + rank_w; sdest[tid] = dd; dest[(tb * 256) * 2 + tid] = dd; }
        __syncthreads();
        for (int i = 0; i < 32; i += 4) {
            v4u ra[4], rb[4];
#pragma unroll
            for (int q = 0; q < 4; ++q) { const v4u* src = (const v4u*)(hb + (size_t)(tb * 256 + wave * 32 + i + q) * D) + lane; ra[q] = src[0]; rb[q] = src[64]; }
#pragma unroll
            for (int q = 0; q < 4; ++q) { const int lt = wave * 32 + i + q;
                const float s = F8_ASCALE / sqrtf((float)ssq[tb * 256 + lt] * (1.f / (1024.f * 65536.f)) + EPS);
                v2u wa, wb;
                wa.x = pg8::pk4_fp8(bflo(ra[q].x) * s, bfhi(ra[q].x) * s, bflo(ra[q].y) * s, bfhi(ra[q].y) * s); wa.y = pg8::pk4_fp8(bflo(ra[q].z) * s, bfhi(ra[q].z) * s, bflo(ra[q].w) * s, bfhi(ra[q].w) * s);
                wb.x = pg8::pk4_fp8(bflo(rb[q].x) * s, bfhi(rb[q].x) * s, bflo(rb[q].y) * s, bfhi(rb[q].y) * s); wb.y = pg8::pk4_fp8(bflo(rb[q].z) * s, bfhi(rb[q].z) * s, bflo(rb[q].w) * s, bfhi(rb[q].w) * s);
                v2u* o0 = (v2u*)(perm8 + (size_t)sdest[2 * lt] * D) + lane; v2u* o1 = (v2u*)(perm8 + (size_t)sdest[2 * lt + 1] * D) + lane;
                o0[0] = wa; o0[64] = wb; o1[0] = wa; o1[64] = wb; } }
        if (tb < 8) { const int r0 = spst[tb] + ssize[tb], r1 = spst[tb] + sntl[tb] * 256;
            for (int r = r0 + wave; r < r1; r += NWAVES) { v4u* o = (v4u*)(perm8 + (size_t)r * D) + lane; o[0] = (v4u){0u, 0u, 0u, 0u}; } }
        __syncthreads();
    }
}
struct CombMeta { float g0[2], g1[2]; int d0[2], d1[2], mm[2]; };
struct CombRows { v4u xa[2][2], ya[2][2], yb[2][2]; };
__device__ __forceinline__ void comb_meta(CombMeta& c, int m0, int stride, const int4* meta, const int* dest) {
#pragma unroll
    for (int t = 0; t < 2; ++t) { const int m = m0 + t * stride; const int mm = (m < NTOK) ? m : 0; c.mm[t] = mm;
        const int4 mt = meta[mm]; c.g0[t] = __builtin_bit_cast(float, mt.z); c.g1[t] = __builtin_bit_cast(float, mt.w); c.d0[t] = dest[2 * mm]; c.d1[t] = dest[2 * mm + 1]; }
}
__device__ __forceinline__ void comb_rows(CombRows& r, const CombMeta& c, const bf16* x, const bf16* y, int lane) {
#pragma unroll
    for (int t = 0; t < 2; ++t) { const v4u* xr = (const v4u*)(x + (size_t)c.mm[t] * D) + lane; const v4u* y0 = (const v4u*)(y + (size_t)c.d0[t] * D) + lane; const v4u* y1 = (const v4u*)(y + (size_t)c.d1[t] * D) + lane;
#pragma unroll
        for (int j = 0; j < 2; ++j) { r.xa[t][j] = xr[64 * j]; r.ya[t][j] = y0[64 * j]; r.yb[t][j] = y1[64 * j]; } }
}
__device__ __forceinline__ void phase_combine(const bf16* x, float* out, const bf16* y, const int4* meta, const int* dest, const float* gf, int blk, int G, int tid) {
    const int wave = tid >> 6, lane = tid & 63; const int stride = G * NWAVES;
    f32x4 ga[2], gb[2];
#pragma unroll
    for (int j = 0; j < 2; ++j) { const float* gp = gf + 512 * j + 8 * lane; ga[j] = *(const f32x4*)gp; gb[j] = *(const f32x4*)(gp + 4); }
    const int mfirst = blk * NWAVES + wave;
    CombMeta mc, mn; CombRows rc, rn;
    comb_meta(mc, mfirst, stride, meta, dest); comb_rows(rc, mc, x, y, lane);
    comb_meta(mn, mfirst + 2 * stride, stride, meta, dest);
    for (int m0 = mfirst; m0 < NTOK; m0 += 2 * stride) {
        comb_rows(rn, mn, x, y, lane);
        CombMeta mf; comb_meta(mf, m0 + 4 * stride, stride, meta, dest);
#pragma unroll
        for (int t = 0; t < 2; ++t) { const int m = m0 + t * stride; float s = 0.f; float v[2][8];
#pragma unroll
            for (int j = 0; j < 2; ++j) { const unsigned xw[4] = {rc.xa[t][j].x, rc.xa[t][j].y, rc.xa[t][j].z, rc.xa[t][j].w}, aw[4] = {rc.ya[t][j].x, rc.ya[t][j].y, rc.ya[t][j].z, rc.ya[t][j].w}, bw[4] = {rc.yb[t][j].x, rc.yb[t][j].y, rc.yb[t][j].z, rc.yb[t][j].w};
#pragma unroll
                for (int q = 0; q < 4; ++q) { const float lo = bflo(xw[q]) + mc.g0[t] * bflo(aw[q]) + mc.g1[t] * bflo(bw[q]), hi = bfhi(xw[q]) + mc.g0[t] * bfhi(aw[q]) + mc.g1[t] * bfhi(bw[q]);
                    v[j][2 * q] = lo; v[j][2 * q + 1] = hi; s += lo * lo + hi * hi; } }
            const float rstd = 1.0f / sqrtf(wave_sum(s) * (1.f / D) + EPS);
            if (m < NTOK) {
#pragma unroll
                for (int j = 0; j < 2; ++j) { float* op = out + (size_t)m * D + 512 * j + 8 * lane;
                    *(f32x4*)op = (f32x4){v[j][0] * rstd * ga[j].x, v[j][1] * rstd * ga[j].y, v[j][2] * rstd * ga[j].z, v[j][3] * rstd * ga[j].w};
                    *(f32x4*)(op + 4) = (f32x4){v[j][4] * rstd * gb[j].x, v[j][5] * rstd * gb[j].y, v[j][6] * rstd * gb[j].z, v[j][7] * rstd * gb[j].w}; } } }
        rc = rn; mc = mn; mn = mf;
    }
}
__device__ __forceinline__ v4u scale8(const v4u a, const f32x4 d0, const f32x4 d1) {
    v4u o; o.x = pk2(bflo(a.x) * d0.x, bfhi(a.x) * d0.y); o.y = pk2(bflo(a.y) * d0.z, bfhi(a.y) * d0.w); o.z = pk2(bflo(a.z) * d1.x, bfhi(a.z) * d1.y); o.w = pk2(bflo(a.w) * d1.z, bfhi(a.w) * d1.w); return o; }
constexpr int HG_NSEG = 4, HG_CPS = 32;
constexpr int HG_QE = 0, HG_KI = 16384, HG_KE = 32768, HG_V = 49152, HG_ST = 65536, HG_DK = 132096, HG_SSQ = 132608, HG_NG = 133632;
__device__ __forceinline__ void phase_hgrn(const bf16* QE, const bf16* KI, const bf16* Vp, const bf16* Gp, const float* DK, const float* norm_g, bf16* Og, const float* HL, const float* HP, LAS unsigned char* lds, int blk, int G, int tid) {
    const int wave = tid >> 6, lane = tid & 63, r32 = lane & 31, hi = lane >> 5, tb = wave >> 2, vb = wave & 3;
    const int sw = r32 & 15;
    const int trl = (4 * hi + ((lane & 15) >> 2)) * 64 + ((lane >> 4) & 1) * 32 + (lane & 3) * 8;
    LAS float* dk_l = (LAS float*)(lds + HG_DK); LAS float* ssq = (LAS float*)(lds + HG_SSQ);
    for (int un = blk; un < BATCH * 8 * HG_NSEG; un += G) {
        const int bh = un >> 2, seg = un & 3, b = bh >> 3, h = bh & 7, c0 = seg * HG_CPS;
        f32x16 S0 = (f32x16){}, S1 = (f32x16){};
        {
            const float* L = HL + (size_t)bh * 3 * 16384; const float* Pt = HP + (size_t)bh * 3 * 128;
            LAS float* sl = (LAS float*)lds;
#pragma unroll 2
            for (int i = 0; i < 8; ++i) { const int idx = (tid + 512 * i) * 4, k = idx >> 7; f32x4 a = (f32x4){0.f, 0.f, 0.f, 0.f};
                if (seg > 0) a = *(const f32x4*)(L + idx);
                if (seg > 1) a = a * Pt[128 + k] + *(const f32x4*)(L + 16384 + idx);
                if (seg > 2) a = a * Pt[256 + k] + *(const f32x4*)(L + 32768 + idx);
                *(LAS f32x4*)(sl + idx) = a; }
            __syncthreads();
#pragma unroll
            for (int i = 0; i < 2; ++i) { const int kb = 2 * tb + i; f32x16 S;
#pragma unroll
                for (int r = 0; r < 16; ++r) S[r] = sl[(32 * kb + crow(r, hi)) * 128 + 32 * vb + r32];
#pragma unroll
                for (int g = 0; g < 4; ++g) { v2u w; w.x = pk2(S[4 * g], S[4 * g + 1]); w.y = pk2(S[4 * g + 2], S[4 * g + 3]);
                    *(LAS v2u*)(lds + HG_ST + (32 * vb + r32) * 256 + (((4 * kb + g) ^ sw) * 16) + hi * 8) = w; }
                if (i) S1 = S; else S0 = S; }
            __syncthreads();
        }
        if (tid < 32) *(LAS f32x4*)(lds + HG_NG + tid * 16) = *(const f32x4*)(norm_g + h * 128 + tid * 4);
        v4u rq[2], rk[2], rv[2]; f32x4 rd = (f32x4){0.f, 0.f, 0.f, 0.f}, rd0, rd1;
#define HG_LOAD(c) do { const size_t row0_ = (size_t)b * SEQ + 64 * (c); \
            _Pragma("unroll") for (int i = 0; i < 2; ++i) { const int idx = tid + 512 * i, row = idx >> 4, cc = idx & 15; const size_t go = (row0_ + row) * 1024 + h * 128 + cc * 8; \
                rq[i] = *(const v4u*)(QE + go); rk[i] = *(const v4u*)(KI + go); rv[i] = *(const v4u*)(Vp + go); } \
            { const float* dkp_ = DK + ((size_t)b * 128 + (c)) * 1024 + h * 128; rd0 = *(const f32x4*)(dkp_ + (tid & 15) * 8); rd1 = *(const f32x4*)(dkp_ + (tid & 15) * 8 + 4); if (tid < 32) rd = *(const f32x4*)(dkp_ + tid * 4); } } while (0)
#define HG_STORE() do { \
            _Pragma("unroll") for (int i = 0; i < 2; ++i) { const int idx = tid + 512 * i, row = idx >> 4, cc = idx & 15; \
                *(LAS v4u*)(lds + HG_QE + row * 256 + ((cc ^ (row & 15)) * 16)) = rq[i]; *(LAS v4u*)(lds + HG_KI + row * 256 + ((cc ^ (row & 15)) * 16)) = rk[i]; \
                *(LAS v4u*)(lds + HG_KE + (cc >> 2) * 4096 + row * 64 + (cc & 3) * 16) = scale8(rk[i], rd0, rd1); *(LAS v4u*)(lds + HG_V + (cc >> 2) * 4096 + row * 64 + (cc & 3) * 16) = rv[i]; } \
            if (tid < 32) *(LAS f32x4*)(dk_l + tid * 4) = rd; } while (0)
        HG_LOAD(c0); HG_STORE();
        __syncthreads();
        for (int cl = 0; cl < HG_CPS; ++cl) { const int c = c0 + cl;
#if PROBE_PHASE == 83
            volatile LAS unsigned* prb = (volatile LAS unsigned*)(lds + MISC_OFF) + 16; const bool prbw = (blk == 0 && tid == PRB_SEL2); const unsigned w0 = (unsigned)__builtin_amdgcn_s_memrealtime();
#endif
            if (cl + 1 < HG_CPS) HG_LOAD(c + 1);
            const size_t rowo = ((size_t)b * SEQ + 64 * c + 32 * tb + r32) * 1024 + h * 128 + 32 * vb + 4 * hi;
            v2u ggv[4];
#pragma unroll
            for (int g = 0; g < 4; ++g) ggv[g] = *(const v2u*)(Gp + rowo + 8 * g);
            LAS unsigned char* st_cur = lds + HG_ST + (cl & 1) * 32768; LAS unsigned char* st_nxt = lds + HG_ST + ((cl + 1) & 1) * 32768;
            bf16x8v qf[8];
#pragma unroll
            for (int ks = 0; ks < 8; ++ks) qf[ks] = *(const LAS bf16x8v*)(lds + HG_QE + (32 * tb + r32) * 256 + (((2 * ks + hi) ^ sw) * 16));
            f32x16 oT = (f32x16){};
#pragma unroll
            for (int ks = 0; ks < 8; ++ks) { const bf16x8v sf = *(const LAS bf16x8v*)(st_cur + (32 * vb + r32) * 256 + (((2 * ks + hi) ^ sw) * 16)); oT = __builtin_amdgcn_mfma_f32_32x32x16_bf16(sf, qf[ks], oT, 0, 0, 0); }
            v4u pw[4];
            { f32x16 X0 = (f32x16){};
#pragma unroll
              for (int ks = 0; ks < 8; ++ks) { const bf16x8v kf = *(const LAS bf16x8v*)(lds + HG_KI + r32 * 256 + (((2 * ks + hi) ^ sw) * 16)); X0 = __builtin_amdgcn_mfma_f32_32x32x16_bf16(kf, qf[ks], X0, 0, 0, 0); }
              if (tb == 0) {
#pragma unroll
                  for (int r = 0; r < 16; ++r) if (crow(r, hi) > r32) X0[r] = 0.f; }
              pw[0].x = pk2(X0[0], X0[1]); pw[0].y = pk2(X0[2], X0[3]); pw[0].z = pk2(X0[4], X0[5]); pw[0].w = pk2(X0[6], X0[7]); pw[1].x = pk2(X0[8], X0[9]); pw[1].y = pk2(X0[10], X0[11]); pw[1].z = pk2(X0[12], X0[13]); pw[1].w = pk2(X0[14], X0[15]); }
            if (tb == 1) { f32x16 X1 = (f32x16){};
#pragma unroll
              for (int ks = 0; ks < 8; ++ks) { const bf16x8v kf = *(const LAS bf16x8v*)(lds + HG_KI + (32 + r32) * 256 + (((2 * ks + hi) ^ sw) * 16)); X1 = __builtin_amdgcn_mfma_f32_32x32x16_bf16(kf, qf[ks], X1, 0, 0, 0); }
#pragma unroll
              for (int r = 0; r < 16; ++r) if (crow(r, hi) > r32) X1[r] = 0.f;
              pw[2].x = pk2(X1[0], X1[1]); pw[2].y = pk2(X1[2], X1[3]); pw[2].z = pk2(X1[4], X1[5]); pw[2].w = pk2(X1[6], X1[7]); pw[3].x = pk2(X1[8], X1[9]); pw[3].y = pk2(X1[10], X1[11]); pw[3].z = pk2(X1[12], X1[13]); pw[3].w = pk2(X1[14], X1[15]); }
            asm volatile("" ::: "memory");
            bf16x8v vf[4];
#pragma unroll
            for (int s4 = 0; s4 < 4; ++s4) { const LAS unsigned char* p = lds + HG_V + vb * 4096 + s4 * 1024 + trl; const s16x4 a0 = vtr(p), a1 = vtr(p + 512); vf[s4] = (bf16x8v){a0[0], a0[1], a0[2], a0[3], a1[0], a1[1], a1[2], a1[3]}; }
            oT = __builtin_amdgcn_mfma_f32_32x32x16_bf16(vf[0], __builtin_bit_cast(bf16x8v, pw[0]), oT, 0, 0, 0); oT = __builtin_amdgcn_mfma_f32_32x32x16_bf16(vf[1], __builtin_bit_cast(bf16x8v, pw[1]), oT, 0, 0, 0);
            if (tb == 1) { oT = __builtin_amdgcn_mfma_f32_32x32x16_bf16(vf[2], __builtin_bit_cast(bf16x8v, pw[2]), oT, 0, 0, 0); oT = __builtin_amdgcn_mfma_f32_32x32x16_bf16(vf[3], __builtin_bit_cast(bf16x8v, pw[3]), oT, 0, 0, 0); }
            { float ss = 0.f;
#pragma unroll
              for (int r = 0; r < 16; ++r) ss += oT[r] * oT[r];
              ss += __shfl_xor(ss, 32); if (hi == 0) ssq[(tb * 4 + vb) * 32 + r32] = ss; }
#pragma unroll
            for (int i = 0; i < 2; ++i) { const int kb = 2 * tb + i; f32x16 S = i ? S1 : S0;
#pragma unroll
                for (int g = 0; g < 4; ++g) { const f32x4 d4 = *(const LAS f32x4*)(dk_l + 32 * kb + 8 * g + 4 * hi);
#pragma unroll
                    for (int j = 0; j < 4; ++j) S[4 * g + j] *= d4[j]; }
#pragma unroll
                for (int s4 = 0; s4 < 4; ++s4) { const LAS unsigned char* p = lds + HG_KE + kb * 4096 + s4 * 1024 + trl; const s16x4 a0 = vtr(p), a1 = vtr(p + 512);
                    const bf16x8v kef = (bf16x8v){a0[0], a0[1], a0[2], a0[3], a1[0], a1[1], a1[2], a1[3]};
                    S = __builtin_amdgcn_mfma_f32_32x32x16_bf16(kef, vf[s4], S, 0, 0, 0); }
#pragma unroll
                for (int g = 0; g < 4; ++g) { v2u w; w.x = pk2(S[4 * g], S[4 * g + 1]); w.y = pk2(S[4 * g + 2], S[4 * g + 3]);
                    *(LAS v2u*)(st_nxt + (32 * vb + r32) * 256 + (((4 * kb + g) ^ sw) * 16) + hi * 8) = w; }
                if (i) S1 = S; else S0 = S; }
#if PROBE_PHASE == 83
            const unsigned w1 = (unsigned)__builtin_amdgcn_s_memrealtime();
#endif
            __syncthreads();
#if PROBE_PHASE == 83
            const unsigned w2 = (unsigned)__builtin_amdgcn_s_memrealtime();
#endif
            { const float tot = (ssq[(tb * 4 + 0) * 32 + r32] + ssq[(tb * 4 + 1) * 32 + r32]) + (ssq[(tb * 4 + 2) * 32 + r32] + ssq[(tb * 4 + 3) * 32 + r32]);
              const float rstd = 1.0f / sqrtf(tot * (1.f / 128.f) + EPS);
#pragma unroll
              for (int g = 0; g < 4; ++g) { const f32x4 ng = *(const LAS f32x4*)(lds + HG_NG + (32 * vb + 8 * g + 4 * hi) * 4); const v2u gg = ggv[g];
                  v2u w; w.x = pk2(oT[4 * g] * rstd * ng.x * bflo(gg.x), oT[4 * g + 1] * rstd * ng.y * bfhi(gg.x)); w.y = pk2(oT[4 * g + 2] * rstd * ng.z * bflo(gg.y), oT[4 * g + 3] * rstd * ng.w * bfhi(gg.y));
                  *(v2u*)(Og + rowo + 8 * g) = w; } }
            if (cl + 1 < HG_CPS) HG_STORE();
#if PROBE_PHASE == 83
            const unsigned w3 = (unsigned)__builtin_amdgcn_s_memrealtime();
#endif
            __syncthreads();
#if PROBE_PHASE == 83
            if (prbw) { const unsigned w4 = (unsigned)__builtin_amdgcn_s_memrealtime(); prb[0] += w1 - w0; prb[1] += w2 - w1; prb[2] += w3 - w2; prb[3] += w4 - w3; }
#endif
        }
#undef HG_LOAD
#undef HG_STORE
    }
}

struct HsRegs { v4u re[2], rv[2]; f32x4 rd, rd0, rd1; };
__device__ __forceinline__ void phase_hgrn_state(const bf16* KI, const bf16* Vp, const float* DK, float* HL, float* HP, LAS unsigned char* lds, int blk, int G, int tid) {
    const int wave = tid >> 6, lane = tid & 63, r32 = lane & 31, hi = lane >> 5, tb = wave >> 2, vb = wave & 3;
    const int trl = (4 * hi + ((lane & 15) >> 2)) * 64 + ((lane >> 4) & 1) * 32 + (lane & 3) * 8;
    constexpr int HS_KE = 0, HS_V = 16384, HS_BUF = 32768, HS_DK = 65536;
    for (int un = blk; un < BATCH * 8 * 3; un += G) {
        const int bh = un / 3, seg = un % 3, b = bh >> 3, h = bh & 7, c0 = seg * HG_CPS;
        f32x16 S0 = (f32x16){}, S1 = (f32x16){};
        float ptot = 1.0f;
        HsRegs R0, R1, R2, R3;
#define HS_LOAD(R, c) do { const size_t row0_ = (size_t)b * SEQ + 64 * (c); \
            _Pragma("unroll") for (int i = 0; i < 2; ++i) { const int idx = tid + 512 * i, row = idx >> 4, cc = idx & 15; const size_t go = (row0_ + row) * 1024 + h * 128 + cc * 8; \
                R.re[i] = *(const v4u*)(KI + go); R.rv[i] = *(const v4u*)(Vp + go); } \
            { const float* dkp_ = DK + ((size_t)b * 128 + (c)) * 1024 + h * 128; R.rd0 = *(const f32x4*)(dkp_ + (tid & 15) * 8); R.rd1 = *(const f32x4*)(dkp_ + (tid & 15) * 8 + 4); R.rd = *(const f32x4*)(dkp_ + (tid & 31) * 4); } } while (0)
#define HS_STORE(R, bi) do { \
            _Pragma("unroll") for (int i = 0; i < 2; ++i) { const int idx = tid + 512 * i, row = idx >> 4, cc = idx & 15; \
                *(LAS v4u*)(lds + (bi) * HS_BUF + HS_KE + (cc >> 2) * 4096 + row * 64 + (cc & 3) * 16) = scale8(R.re[i], R.rd0, R.rd1); *(LAS v4u*)(lds + (bi) * HS_BUF + HS_V + (cc >> 2) * 4096 + row * 64 + (cc & 3) * 16) = R.rv[i]; } \
            if (tid < 32) *(LAS f32x4*)(lds + HS_DK + (bi) * 512 + tid * 16) = R.rd; } while (0)
#define HS_STEP(c, RL, bi, RS) do { \
            if ((c) + 3 < HG_CPS) HS_LOAD(RL, c0 + (c) + 3); \
            { const LAS float* dk_l = (const LAS float*)(lds + HS_DK + (bi) * 512); \
              bf16x8v vf[4]; \
              _Pragma("unroll") for (int s4 = 0; s4 < 4; ++s4) { const LAS unsigned char* p = lds + (bi) * HS_BUF + HS_V + vb * 4096 + s4 * 1024 + trl; const s16x4 a0 = vtr(p), a1 = vtr(p + 512); vf[s4] = (bf16x8v){a0[0], a0[1], a0[2], a0[3], a1[0], a1[1], a1[2], a1[3]}; } \
              _Pragma("unroll") for (int i = 0; i < 2; ++i) { const int kb = 2 * tb + i; f32x16 S = i ? S1 : S0; \
                _Pragma("unroll") for (int g = 0; g < 4; ++g) { const f32x4 d4 = *(const LAS f32x4*)(dk_l + 32 * kb + 8 * g + 4 * hi); \
                    _Pragma("unroll") for (int j = 0; j < 4; ++j) S[4 * g + j] *= d4[j]; } \
                _Pragma("unroll") for (int s4 = 0; s4 < 4; ++s4) { const LAS unsigned char* p = lds + (bi) * HS_BUF + HS_KE + kb * 4096 + s4 * 1024 + trl; const s16x4 a0 = vtr(p), a1 = vtr(p + 512); \
                    const bf16x8v kef = (bf16x8v){a0[0], a0[1], a0[2], a0[3], a1[0], a1[1], a1[2], a1[3]}; \
                    S = __builtin_amdgcn_mfma_f32_32x32x16_bf16(kef, vf[s4], S, 0, 0, 0); } \
                if (i) S1 = S; else S0 = S; } \
              if (tid < 128) ptot *= dk_l[tid]; } \
            if ((c) + 1 < HG_CPS) HS_STORE(RS, 1 - (bi)); \
            __syncthreads(); } while (0)
        HS_LOAD(R0, c0); HS_LOAD(R1, c0 + 1); HS_LOAD(R2, c0 + 2);
        HS_STORE(R0, 0);
        __syncthreads();
        for (int cl = 0; cl < HG_CPS; cl += 4) {
            HS_STEP(cl, R3, 0, R1); HS_STEP(cl + 1, R0, 1, R2); HS_STEP(cl + 2, R1, 0, R3); HS_STEP(cl + 3, R2, 1, R0);
        }
        float* L = HL + ((size_t)bh * 3 + seg) * 16384;
#pragma unroll
        for (int i = 0; i < 2; ++i) { const int kb = 2 * tb + i; const f32x16 S = i ? S1 : S0;
#pragma unroll
            for (int r = 0; r < 16; ++r) L[(32 * kb + crow(r, hi)) * 128 + 32 * vb + r32] = S[r]; }
        if (tid < 128) HP[((size_t)bh * 3 + seg) * 128 + tid] = ptot;
#undef HS_LOAD
#undef HS_STORE
#undef HS_STEP
    }
}
struct Args { const void* in[19]; float* out; unsigned char* ws; int ph_lo, ph_hi; };
__global__ void __launch_bounds__(NWAVES * 64, 2) fwd(Args args) {
    extern __shared__ __attribute__((aligned(16))) unsigned char lds_raw[];
    LAS unsigned char* lds = (LAS unsigned char*)lds_raw;
    volatile LAS unsigned* MISC = (volatile LAS unsigned*)(lds + MISC_OFF);
    const int tid = threadIdx.x, G = gridDim.x, blk = blockIdx.x;
    unsigned char* ws = args.ws;
    unsigned* ctl = (unsigned*)(ws + WS_CTL);
    for (int u = tid; u < (LDS_BYTES - LDSCTL_OFF) / 4; u += NWAVES * 64) ((LAS unsigned*)(lds + LDSCTL_OFF))[u] = 0u;
    __syncthreads();
    XcdBarrier bar; bar.bar = ctl + CW_BAR; bar.x = 0; bar.st = nullptr;
    if (N_LAUNCHES == 1) bar = xcd_barrier_post(ctl + CW_BAR, MISC + 8);
#if PROBE_PHASE == 78
#define GRID_BAR() do { if (N_LAUNCHES == 1) xcd_barrier(bar); if (blk == 0 && tid == 0) { MISC[32 + pstamp] = (unsigned)__builtin_amdgcn_s_memrealtime(); } ++pstamp; } while (0)
#else
#define GRID_BAR() do { if (N_LAUNCHES == 1) xcd_barrier(bar); } while (0)
#endif
    const int lo = args.ph_lo, hi = args.ph_hi;
#if PROBE_PHASE == 78
    int pstamp = 1; if (blk == 0 && tid == 0) MISC[32] = (unsigned)__builtin_amdgcn_s_memrealtime();
#endif
#define IN(k) (lo <= (k) && (k) < hi)
#define OT() ({ int t_ = tid; asm volatile("" : "+v"(t_)); t_; })
#ifndef STAGGER_TICKS
#define STAGGER_TICKS 0
#endif
#define STAGGER() do { if (STAGGER_TICKS) { const unsigned long long t0_ = __builtin_amdgcn_s_memrealtime(); const unsigned long long d_ = (unsigned long long)((blk >> 3) & 3) * STAGGER_TICKS; while (__builtin_amdgcn_s_memrealtime() - t0_ < d_) __builtin_amdgcn_s_sleep(8); } } while (0)
#define BOTH(k) (IN(k) && IN((k) + 1))
#ifndef PROBE_PHASE
#define PROBE_PHASE -1
#endif
#define REP(k) ((k) == PROBE_PHASE ? 2 : 1)
#if PROBE_PHASE == 77
#define PRBARG(n) , (MISC + 64 + 4 * (n))
#else
#define PRBARG(n)
#endif
    const float* x = (const float*)args.in[0]; const int* positions = (const int*)args.in[1];
    const float* g_mix = (const float*)args.in[2]; const float* g_ffn = (const float*)args.in[3]; const float* g_final = (const float*)args.in[4];
    const float* sinks = (const float*)args.in[7]; const float* rec_norm_g = (const float*)args.in[10]; const float* w_router = (const float*)args.in[15];
    float* out = args.out;
    bf16* H = (bf16*)(ws + WS_H); bf16* BIG = (bf16*)(ws + WS_BIG);
    const size_t PLANE = (size_t)NTOK * D;
    bf16* H2 = (bf16*)(ws + WS_H2); float* RSP = (float*)(ws + WS_RSP);
    unsigned* SSQ1 = (unsigned*)(ws + WS_CTL + CTL_SSQ1); unsigned* SSQ2 = (unsigned*)(ws + WS_CTL + CTL_SSQ2); unsigned* SSQ3 = (unsigned*)(ws + WS_CTL + CTL_SSQ3);

    if (IN(0)) for (int rep_ = 0; rep_ < REP(0); ++rep_) {
        P0Args pa; pa.g_ffn0 = g_ffn; pa.g_mix1 = g_mix + D; pa.g_ffn1 = g_ffn + D; pa.x = x; pa.g0 = g_mix; pa.w_in_attn = (const float*)args.in[5]; pa.w_out_attn = (const float*)args.in[6]; pa.w_in_rec = (const float*)args.in[8]; pa.w_out_rec = (const float*)args.in[11];
        pa.w_gate = (const float*)args.in[12]; pa.w_up = (const float*)args.in[13]; pa.w_down = (const float*)args.in[14]; pa.w_gate_moe = (const float*)args.in[16]; pa.w_up_moe = (const float*)args.in[17]; pa.w_down_moe = (const float*)args.in[18];
        pa.rlb = (const float*)args.in[9]; pa.pos = positions; pa.ws = ws;
        phase_prologue(pa, lds, blk, G, OT());
        if (BOTH(0)) GRID_BAR();
    }
    if (IN(1)) {
        pg8::Gemm g{H2, (const bf16*)(ws + WS_W_INATT), NTOK, QKV_N, D}; pg8::StaticOrder S; S.init(NTOK, QKV_N, G, blk);
        pg8::EpiQkvRope E{BIG, QKV_LD, (const float*)(ws + WS_ROPE), (const float*)(ws + WS_RS0)};
        pg8::gemm_phase<pg8::EpiQkvRope, pg8::StaticOrder, PG8_ALIGN, PG8_SP2>(lds, g, S, E PRBARG(1));
        if (BOTH(1)) GRID_BAR();
    }
    if (IN(3)) for (int rep_ = 0; rep_ < REP(3); ++rep_) { phase_attn(BIG, sinks, H, (bf16*)(ws + WS_OB), (float*)(ws + WS_LSE), lds, blk, G, OT()); if (BOTH(3)) GRID_BAR(); }
    if (IN(4)) {
        pg8::Gemm g{H, (const bf16*)(ws + WS_W_OUTATT), NTOK, D, D}; pg8::StaticOrder S; S.init(NTOK, D, G, blk);
        pg8::EpiResB<false> E{H2, H2, SSQ1, D};
        pg8::gemm_phase<pg8::EpiResB<false>, pg8::StaticOrder, PG8_ALIGN, PG8_SP2>(lds, g, S, E PRBARG(2));
        if (BOTH(4)) GRID_BAR();
    }
    if (IN(6)) {
#if PROBE_PHASE == 99
        { const unsigned long long t0_ = __builtin_amdgcn_s_memrealtime(); while (__builtin_amdgcn_s_memrealtime() - t0_ < 50000ull) __builtin_amdgcn_s_sleep(32); }
#endif
        pg8::Gemm g{H2, (const bf16*)(ws + WS_W_GU), NTOK, 2 * FF, D}; pg8::StaticOrder S; S.init(NTOK, 2 * FF, G, blk);
        pg8::EpiSwiglu E{BIG, FF, 1 << 20, 0, SSQ1, 1.0f};
        pg8::gemm_phase<pg8::EpiSwiglu, pg8::StaticOrder, PG8_ALIGN, PG8_SP2>(lds, g, S, E PRBARG(3));
#if PROBE_PHASE == 6
        GRID_BAR(); pg8::gemm_phase<pg8::EpiSwiglu, pg8::StaticOrder, PG8_ALIGN, PG8_SP2>(lds, g, S, E PRBARG(4));
#endif
        if (BOTH(6)) GRID_BAR();
    }
    if (IN(7)) {
        pg8::Gemm g{BIG, (const bf16*)(ws + WS_W_DN), NTOK, D, FF}; pg8::StaticOrder S; S.init(NTOK, D, G, blk);
        pg8::EpiResB<false> E{H2, H2, SSQ2, D};
        pg8::gemm_phase<pg8::EpiResB<false>, pg8::StaticOrder, PG8_ALIGN, PG8_SP2>(lds, g, S, E PRBARG(5));
        if (BOTH(7)) GRID_BAR();
    }
    if (IN(9)) {
        pg8::Gemm g{H2, (const bf16*)(ws + WS_W_INREC), NTOK, REC_N, D}; pg8::StaticOrder S; S.init(NTOK, REC_N, G, blk);
        pg8::EpiRec2 E{BIG, PLANE, (const float*)(ws + WS_LBK), (float*)(ws + WS_DK), SSQ2};
        pg8::gemm_phase<pg8::EpiRec2, pg8::StaticOrder, PG8_ALIGN, PG8_SP2>(lds, g, S, E PRBARG(6));
        if (BOTH(9)) GRID_BAR();
    }
    if (IN(10)) for (int rep_ = 0; rep_ < REP(10); ++rep_) { phase_hgrn_state(BIG + PLANE, BIG + 2 * PLANE, (const float*)(ws + WS_DK), (float*)(ws + WS_HL), (float*)(ws + WS_HP), lds, blk, G, OT()); if (BOTH(10)) GRID_BAR(); }
    if (IN(11)) for (int rep_ = 0; rep_ < REP(11); ++rep_) { phase_hgrn(BIG, BIG + PLANE, BIG + 2 * PLANE, BIG + 3 * PLANE, (const float*)(ws + WS_DK), rec_norm_g, H, (const float*)(ws + WS_HL), (const float*)(ws + WS_HP), lds, blk, G, OT()); if (BOTH(11)) GRID_BAR(); }
    if (IN(12)) {
        pg8::Gemm g{H, (const bf16*)(ws + WS_W_OUTREC), NTOK, D, D}; pg8::StaticOrder S; S.init(NTOK, D, G, blk);
        pg8::EpiResB<false> E{H2, H2, SSQ3, D};
        pg8::gemm_phase<pg8::EpiResB<false>, pg8::StaticOrder, PG8_ALIGN, PG8_SP2>(lds, g, S, E PRBARG(7));
        if (BOTH(12)) GRID_BAR();
    }
    int4* meta = (int4*)(ws + WS_META); int* hist = (int*)(ws + WS_HIST); int* dest = (int*)(ws + WS_DEST); int* info = (int*)(ws + WS_INFO);
    bf16* Y = (bf16*)(ws + WS_Y); bf16* HID = (bf16*)(ws + WS_HID); unsigned char* P8 = ws + WS_P8;
    if (IN(13)) for (int rep_ = 0; rep_ < REP(13); ++rep_) { phase_router(H2, g_ffn + D, w_router, SSQ3, meta, hist, lds, blk, G, OT()); if (BOTH(13)) GRID_BAR(); }
    if (IN(14)) for (int rep_ = 0; rep_ < REP(14); ++rep_) { phase_scatter(H2, SSQ3, meta, hist, dest, info, P8, lds, blk, G, OT()); if (BOTH(14)) GRID_BAR(); }
    if (IN(15) || IN(16)) {
        const int T = info[8]; const int tile0 = 0; const int ntl = T;
        pg8::MoeOrder S; S.tile0 = tile0; S.te0 = info[0]; S.te1 = info[1]; S.te2 = info[2]; S.te3 = info[3]; S.te4 = info[4]; S.te5 = info[5]; S.te6 = info[6];
        if (IN(15)) {
            S.nN = 28; S.so.init(ntl * 256, 2 * FF, G, blk);
            pg8::Gemm g{(const bf16*)P8, (const bf16*)(ws + WS_WMOE_GU), 0, 0, D};
            pg8::EpiSwigluT<true> E{HID, FF, 28, tile0, nullptr, 1.0f / (F8_ASCALE * F8_WGSCALE)};
            pg8::gemm_phase8<pg8::EpiSwigluT<true>, pg8::MoeOrder, PG8_ALIGN, PG8_SP2>(lds, g, S, E);
            if (BOTH(15)) GRID_BAR();
        }
        if (IN(16)) {
            S.nN = 4; S.so.init(ntl * 256, D, G, blk);
            pg8::Gemm g{(const bf16*)HID, (const bf16*)(ws + WS_WMOE_DN), 0, 0, FF};
            pg8::EpiBf16Plain E{Y, D, 4, 1.0f / (F8_HSCALE * F8_WDSCALE)};
            pg8::gemm_phase8<pg8::EpiBf16Plain, pg8::MoeOrder, PG8_ALIGN, PG8_SP2>(lds, g, S, E);
            if (IN(21)) GRID_BAR();
        }
    }
    if (IN(21)) phase_combine(H2, out, Y, meta, dest, g_final, blk, G, OT());
#if PROBE_PHASE == 78
    __syncthreads();
    if (blk == 0 && tid == 0) MISC[32 + pstamp] = (unsigned)__builtin_amdgcn_s_memrealtime();
    __syncthreads();
    if (blk == 0 && tid == 0) { const unsigned long long d_ = (unsigned long long)(MISC[32 + PRB_SEL] - MISC[32 + PRB_SEL - 1]) * PRB_MUL; const unsigned long long t0_ = __builtin_amdgcn_s_memrealtime(); while (__builtin_amdgcn_s_memrealtime() - t0_ < d_) __builtin_amdgcn_s_sleep(8); }
#endif
#if PROBE_PHASE == 77
    __syncthreads();
    if (blk == 0 && tid == 0) { const unsigned long long d_ = (unsigned long long)MISC[64 + PRB_SEL] * PRB_MUL; const unsigned long long t0_ = __builtin_amdgcn_s_memrealtime(); while (__builtin_amdgcn_s_memrealtime() - t0_ < d_) __builtin_amdgcn_s_sleep(8); }
#endif
#if PROBE_PHASE == 83
    __syncthreads();
    if (blk == 0 && tid == 0) { const unsigned long long d_ = (unsigned long long)MISC[16 + PRB_SEL] * PRB_MUL; const unsigned long long t0_ = __builtin_amdgcn_s_memrealtime(); while (__builtin_amdgcn_s_memrealtime() - t0_ < d_) __builtin_amdgcn_s_sleep(8); }
#endif
#undef IN
#undef BOTH
}

extern "C" void kernel_launch(void* const* d_in, const int* in_sizes, int n_in, void* d_out, int out_size, void* d_ws, size_t ws_size, hipStream_t stream) {
    static int grid = 0;
    if (grid == 0) {
        if (n_in != 19 || in_sizes[0] != NTOK * D || out_size != NTOK * D || ws_size < WS_END) { fprintf(stderr, "kernel_launch: unexpected shapes / workspace (n_in %d, ws %zu); nothing launched\n", n_in, ws_size); grid = -1; return; }
        int dev = 0, cus = 0, per_cu = 0;
        if (hipGetDevice(&dev) != hipSuccess || hipDeviceGetAttribute(&cus, hipDeviceAttributeMultiprocessorCount, dev) != hipSuccess) { grid = -1; return; }
        if (hipFuncSetAttribute((const void*)fwd, hipFuncAttributeMaxDynamicSharedMemorySize, LDS_BYTES) != hipSuccess) { fprintf(stderr, "kernel_launch: hipFuncSetAttribute failed\n"); grid = -1; return; }
        if (hipOccupancyMaxActiveBlocksPerMultiprocessor(&per_cu, (const void*)fwd, NWAVES * 64, LDS_BYTES) != hipSuccess || per_cu < 1) fprintf(stderr, "kernel_launch: occupancy query says %d\n", per_cu);
        (void)hipGetLastError();
        grid = cus;
    }
    if (grid < 0) return;
    if (hipMemsetAsync((char*)d_ws + WS_CTL, 0, CTL_ZERO_BYTES, stream) != hipSuccess) return;
    Args a{};
    for (int i = 0; i < 19; ++i) a.in[i] = d_in[i];
    a.out = (float*)d_out; a.ws = (unsigned char*)d_ws;
    if (N_LAUNCHES == 1) { a.ph_lo = 0; a.ph_hi = NPH; hipLaunchKernelGGL(fwd, dim3(grid), dim3(NWAVES * 64), LDS_BYTES, stream, a); }
    else for (int li = 0; li < NPH; ++li) { a.ph_lo = li; a.ph_hi = li + 1; hipLaunchKernelGGL(fwd, dim3(grid), dim3(NWAVES * 64), LDS_BYTES, stream, a); }
}
```
